# Optimizing an MI355X kernel written in HIP

```python
import math
import jax, jax.numpy as jnp
from jax import lax
import numpy as np

D_MODEL = 1024
BATCH = 8
SEQ = 2048
DEPTH = 2

CTX_LEN = 256
GRID_W = 64
MIX_WIDTH = D_MODEL
ATTN_WIDTH = MIX_WIDTH // 2
FOURIER_WIDTH = MIX_WIDTH - ATTN_WIDTH
HEAD_DIM = 64
N_HEADS = ATTN_WIDTH // (2 * HEAD_DIM)
V_HEAD_DIM = 2 * HEAD_DIM
N_FGROUPS = 4
FGROUP_DIM = FOURIER_WIDTH // N_FGROUPS
IN_COLS = 2 * ATTN_WIDTH + N_HEADS * V_HEAD_DIM + FOURIER_WIDTH
D_FF = -(-8 * D_MODEL // (3 * 256)) * 256
ROPE_AXIS_DIM = HEAD_DIM // 2
ROPE_THETA = 10000.0
Q_BLOCK = 128
EPS = 1e-6

kernel_name = "hybrid_diffattn_fnet_dit_block"


def rms_norm(x, gain):
    xf = x.astype(jnp.float32)
    y = xf * lax.rsqrt(jnp.mean(xf * xf, axis=-1, keepdims=True) + EPS)
    return (y * gain.astype(jnp.float32)).astype(x.dtype)


def modulate(h, shift, scale):
    return h * (1 + scale) + shift


def axial_rope_tables(n_tokens):
    rows = n_tokens // GRID_W
    row = jnp.broadcast_to(jnp.arange(rows, dtype=jnp.float32)[:, None], (rows, GRID_W)).reshape(-1)
    col = jnp.broadcast_to(jnp.arange(GRID_W, dtype=jnp.float32)[None, :], (rows, GRID_W)).reshape(-1)
    inv = ROPE_THETA ** (-jnp.arange(0, ROPE_AXIS_DIM, 2, dtype=jnp.float32) / ROPE_AXIS_DIM)
    ang = jnp.concatenate([row[:, None] * inv, col[:, None] * inv], axis=-1)
    return jnp.cos(ang), jnp.sin(ang)


def apply_axial_rope(t, cos, sin):
    tf = t.astype(jnp.float32)
    c = cos[:, None, None, :]
    s = sin[:, None, None, :]
    half = ROPE_AXIS_DIM // 2

    def rot(ta, ca, sa):
        t1, t2 = ta[..., :half], ta[..., half:]
        return jnp.concatenate([t1 * ca - t2 * sa, t2 * ca + t1 * sa], axis=-1)

    out = jnp.concatenate([
        rot(tf[..., :ROPE_AXIS_DIM], c[..., :half], s[..., :half]),
        rot(tf[..., ROPE_AXIS_DIM:], c[..., half:], s[..., half:]),
    ], axis=-1)
    return out.astype(t.dtype)


def split_proj(h, w_in, q_gain, k_gain):
    B, L, _ = h.shape
    z = h @ w_in
    q, k, v, f = jnp.split(z, [ATTN_WIDTH, 2 * ATTN_WIDTH, 2 * ATTN_WIDTH + N_HEADS * V_HEAD_DIM], axis=-1)
    q = rms_norm(q.reshape(B, L, N_HEADS, 2, HEAD_DIM), q_gain)
    k = rms_norm(k.reshape(B, L, N_HEADS, 2, HEAD_DIM), k_gain)
    v = v.reshape(B, L, N_HEADS, V_HEAD_DIM)
    return q, k, v, f


def to_heads_qk(t):
    return t.transpose(0, 2, 3, 1, 4)


def to_heads_v(t):
    return t.transpose(0, 2, 1, 3)


def diff_attend(q, k, v, lam):
    s = jnp.einsum('bhiqd,bhikd->bhiqk', q.astype(jnp.float32), k.astype(jnp.float32)) * (HEAD_DIM ** -0.5)
    p = jax.nn.softmax(s, axis=-1)
    a = p[:, :, 0] - lam * p[:, :, 1]
    return jnp.einsum('bhqk,bhkv->bhqv', a, v.astype(jnp.float32)).astype(v.dtype)


def blocked_diff_attend(q, k, v, lam):
    B, H, _, L, d = q.shape
    nb = L // Q_BLOCK
    qb = q.reshape(B, H, 2, nb, Q_BLOCK, d).transpose(3, 0, 1, 2, 4, 5)
    out = lax.map(lambda qblk: diff_attend(qblk, k, v, lam), qb)
    return out.transpose(1, 2, 0, 3, 4).reshape(B, H, L, V_HEAD_DIM)


def heads_out(o, subln_gain, lambda_init):
    o = rms_norm(o, subln_gain) * (1.0 - lambda_init)
    B, H, L, Dv = o.shape
    return o.transpose(0, 2, 1, 3).reshape(B, L, H * Dv)


def fourier_mix(f, w_f):
    B, L, _ = f.shape
    fg = f.reshape(B, L, N_FGROUPS, FGROUP_DIM).astype(jnp.float32)
    spec = jnp.fft.fft2(fg, axes=(1, 3), norm='ortho').real.astype(f.dtype)
    return jnp.einsum('blgc,gcd->blgd', spec, w_f).reshape(B, L, FOURIER_WIDTH)


def swiglu(h, w_gate, w_up, w_down):
    return (jax.nn.silu(h @ w_gate) * (h @ w_up)) @ w_down


def setup_inputs(seed: int = 0) -> dict:
    key = jax.random.key(seed)
    ks = jax.random.split(key, 24)
    f32 = jnp.float32
    nrm = lambda k, shape, s: jax.random.normal(k, shape, f32) * s
    D = D_MODEL
    return {
        'x': nrm(ks[0], (BATCH, SEQ, D), 1.0),
        'c': nrm(ks[1], (BATCH, D), 1.0),
        'ctx': nrm(ks[2], (BATCH, CTX_LEN, D), 1.0),
        'c_ctx': nrm(ks[3], (D,), 1.0),
        'w_ada': nrm(ks[4], (DEPTH, D, 6 * D), 0.5 * D ** -0.5),
        'b_ada': nrm(ks[5], (DEPTH, 6 * D), 0.01),
        'norm1_g': 1.0 + nrm(ks[6], (DEPTH, D), 0.02),
        'norm2_g': 1.0 + nrm(ks[7], (DEPTH, D), 0.02),
        'w_in': nrm(ks[8], (DEPTH, D, IN_COLS), D ** -0.5),
        'q_norm_g': 1.0 + nrm(ks[9], (DEPTH, HEAD_DIM), 0.02),
        'k_norm_g': 1.0 + nrm(ks[10], (DEPTH, HEAD_DIM), 0.02),
        'lambda_q1': nrm(ks[11], (DEPTH, HEAD_DIM), 0.1),
        'lambda_k1': nrm(ks[12], (DEPTH, HEAD_DIM), 0.1),
        'lambda_q2': nrm(ks[13], (DEPTH, HEAD_DIM), 0.1),
        'lambda_k2': nrm(ks[14], (DEPTH, HEAD_DIM), 0.1),
        'subln_g': 1.0 + nrm(ks[15], (DEPTH, V_HEAD_DIM), 0.02),
        'w_fourier': nrm(ks[16], (DEPTH, N_FGROUPS, FGROUP_DIM, FGROUP_DIM), FGROUP_DIM ** -0.5),
        'w_out': nrm(ks[17], (DEPTH, MIX_WIDTH, D), MIX_WIDTH ** -0.5),
        'w_gate': nrm(ks[18], (DEPTH, D, D_FF), D ** -0.5),
        'w_up': nrm(ks[19], (DEPTH, D, D_FF), D ** -0.5),
        'w_down': nrm(ks[20], (DEPTH, D_FF, D), D_FF ** -0.5),
    }


def reference(x, c, ctx, c_ctx, w_ada, b_ada, norm1_g, norm2_g, w_in, q_norm_g, k_norm_g,
              lambda_q1, lambda_k1, lambda_q2, lambda_k2, subln_g, w_fourier, w_out,
              w_gate, w_up, w_down):
    L = x.shape[1]
    cos, sin = axial_rope_tables(L)
    for i in range(DEPTH):
        last = i == DEPTH - 1
        lambda_init = 0.8 - 0.6 * math.exp(-0.3 * i)
        lam = (jnp.exp(jnp.sum(lambda_q1[i].astype(jnp.float32) * lambda_k1[i].astype(jnp.float32)))
               - jnp.exp(jnp.sum(lambda_q2[i].astype(jnp.float32) * lambda_k2[i].astype(jnp.float32)))
               + lambda_init)

        mod_x = jax.nn.silu(c) @ w_ada[i] + b_ada[i]
        mod_c = jax.nn.silu(c_ctx) @ w_ada[i] + b_ada[i]
        sh_a, sc_a, g_a, sh_f, sc_f, g_f = [m[:, None, :] for m in jnp.split(mod_x, 6, axis=-1)]
        csh_a, csc_a, cg_a, csh_f, csc_f, cg_f = jnp.split(mod_c, 6, axis=-1)

        hc = modulate(rms_norm(ctx, norm1_g[i]), csh_a, csc_a)
        qc, kc, vc, fc = split_proj(hc, w_in[i], q_norm_g[i], k_norm_g[i])
        kc_h, vc_h = to_heads_qk(kc), to_heads_v(vc)

        hx = modulate(rms_norm(x, norm1_g[i]), sh_a, sc_a)
        qx, kx, vx, fx = split_proj(hx, w_in[i], q_norm_g[i], k_norm_g[i])
        qx = apply_axial_rope(qx, cos, sin)
        kx = apply_axial_rope(kx, cos, sin)
        k_all = jnp.concatenate([kc_h, to_heads_qk(kx)], axis=3)
        v_all = jnp.concatenate([vc_h, to_heads_v(vx)], axis=2)
        attn_x = heads_out(blocked_diff_attend(to_heads_qk(qx), k_all, v_all, lam), subln_g[i], lambda_init)
        four_x = fourier_mix(fx, w_fourier[i])
        mix_x = jnp.concatenate([attn_x, four_x], axis=-1) @ w_out[i]
        x_new = x + g_a * mix_x
        hx2 = modulate(rms_norm(x_new, norm2_g[i]), sh_f, sc_f)
        x_new = x_new + g_f * swiglu(hx2, w_gate[i], w_up[i], w_down[i])

        if not last:
            attn_c = heads_out(diff_attend(to_heads_qk(qc), kc_h, vc_h, lam), subln_g[i], lambda_init)
            four_c = fourier_mix(fc, w_fourier[i])
            mix_c = jnp.concatenate([attn_c, four_c], axis=-1) @ w_out[i]
            ctx = ctx + cg_a * mix_c
            hc2 = modulate(rms_norm(ctx, norm2_g[i]), csh_f, csc_f)
            ctx = ctx + cg_f * swiglu(hc2, w_gate[i], w_up[i], w_down[i])
        x = x_new
    return x
```

```cpp
#include <hip/hip_runtime.h>
#include <math.h>
namespace nv {
constexpr int D = 1024, NB = 8, L = 2048, CT = 256, NR = L + CT, INC = 2048, FF = 2816, DEPTH = 2;
constexpr float EPS = 1e-6f;

__global__ void k_mod(const float* __restrict__ c, const float* __restrict__ cctx, const float* __restrict__ w, const float* __restrict__ bb, float* __restrict__ mod) {
    int n = blockIdx.x * 256 + threadIdx.x; int j = blockIdx.y;
    const float* cv = (j < 8) ? c + j * D : cctx;
    float acc = 0.f;
    for (int k = 0; k < D; ++k) { float v = cv[k]; float s = v / (1.f + expf(-v)); acc += s * w[(size_t)k * 6144 + n]; }
    mod[j * 6144 + n] = acc + bb[n];
}
__global__ void k_rmsmod(const float* __restrict__ x, const float* __restrict__ g, const float* __restrict__ sh, const float* __restrict__ sc, float* __restrict__ out) {
    __shared__ float red[4];
    const float4 v = ((const float4*)(x + (size_t)blockIdx.x * D))[threadIdx.x];
    float s = v.x * v.x + v.y * v.y + v.z * v.z + v.w * v.w;
    for (int o = 32; o > 0; o >>= 1) s += __shfl_xor(s, o);
    if ((threadIdx.x & 63) == 0) red[threadIdx.x >> 6] = s;
    __syncthreads();
    s = red[0] + red[1] + red[2] + red[3];
    const float r = 1.0f / sqrtf(s / D + EPS);
    const float4 gg = ((const float4*)g)[threadIdx.x], a = ((const float4*)sc)[threadIdx.x], b = ((const float4*)sh)[threadIdx.x];
    float4 o; o.x = v.x * r * gg.x * (1.f + a.x) + b.x; o.y = v.y * r * gg.y * (1.f + a.y) + b.y; o.z = v.z * r * gg.z * (1.f + a.z) + b.z; o.w = v.w * r * gg.w * (1.f + a.w) + b.w;
    ((float4*)(out + (size_t)blockIdx.x * D))[threadIdx.x] = o;
}
__global__ __launch_bounds__(256) void k_gemm(const float* __restrict__ A, int lda, const float* __restrict__ Bm, int ldb, float* __restrict__ C, int ldc, int K, float alpha, float beta) {
    __shared__ float As[16][68], Bs[16][68];
    const int tx = threadIdx.x % 16, ty = threadIdx.x / 16, m0 = blockIdx.y * 64, n0 = blockIdx.x * 64;
    float acc[4][4] = {};
    for (int k0 = 0; k0 < K; k0 += 16) {
        { const int r = threadIdx.x / 4, kk = (threadIdx.x % 4) * 4; const float4 v = *(const float4*)(A + (size_t)(m0 + r) * lda + k0 + kk); As[kk][r] = v.x; As[kk + 1][r] = v.y; As[kk + 2][r] = v.z; As[kk + 3][r] = v.w; }
        { const int kk = threadIdx.x / 16, cc = (threadIdx.x % 16) * 4; *(float4*)&Bs[kk][cc] = *(const float4*)(Bm + (size_t)(k0 + kk) * ldb + n0 + cc); }
        __syncthreads();
#pragma unroll
        for (int kk = 0; kk < 16; ++kk) { float a[4], b[4];
#pragma unroll
            for (int i = 0; i < 4; ++i) { a[i] = As[kk][ty * 4 + i]; b[i] = Bs[kk][tx * 4 + i]; }
#pragma unroll
            for (int i = 0; i < 4; ++i)
#pragma unroll
                for (int j = 0; j < 4; ++j) acc[i][j] += a[i] * b[j]; }
        __syncthreads();
    }
    for (int i = 0; i < 4; ++i) for (int j = 0; j < 4; ++j) { float* p = C + (size_t)(m0 + ty * 4 + i) * ldc + n0 + tx * 4 + j; float v = alpha * acc[i][j]; if (beta != 0.f) v += beta * *p; *p = v; }
}
__global__ void k_qknorm_rope(float* __restrict__ z, const float* __restrict__ qg, const float* __restrict__ kg) {
    const int row = blockIdx.y, grp = blockIdx.x, t = threadIdx.x;
    float* p = z + (size_t)row * INC + grp * 64;
    float v = p[t]; float s = v * v;
    for (int o = 32; o > 0; o >>= 1) s += __shfl_xor(s, o);
    v = v * (1.0f / sqrtf(s / 64.f + EPS)) * ((grp < 8) ? qg[t] : kg[t]);
    if (row >= CT) {
        const int l = row - CT; const int pr = l / 64, pc = l % 64; const int j = t & 15;
        const double inv = pow(10000.0, -(double)j / 16.0); const double ang = (double)((t < 32) ? pr : pc) * inv;
        const float cs = (float)cos(ang), sn = (float)sin(ang);
        const float other = __shfl_xor(v, 16);
        v = (t & 16) ? (v * cs + other * sn) : (v * cs - other * sn);
    }
    p[t] = v;
}
__global__ __launch_bounds__(256) void k_attn(const float* __restrict__ z, float* __restrict__ out, int q_row0, int nk, const float* __restrict__ lq1, const float* __restrict__ lk1, const float* __restrict__ lq2, const float* __restrict__ lk2, float lambda_init, const float* __restrict__ subg) {
    __shared__ float a1[NR], a2[NR], qs[128], red[8], part[256];
    const int row = q_row0 + blockIdx.x, h = blockIdx.y, t = threadIdx.x;
    if (t < 128) qs[t] = z[(size_t)row * INC + h * 128 + t];
    __shared__ float lamsh;
    if (t < 64) { float u = lq1[t] * lk1[t], w = lq2[t] * lk2[t]; for (int o = 32; o > 0; o >>= 1) { u += __shfl_xor(u, o); w += __shfl_xor(w, o); } if (t == 0) lamsh = expf(u) - expf(w) + lambda_init; }
    __syncthreads();
    float m1 = -1e30f, m2 = -1e30f;
    for (int k = t; k < nk; k += 256) { const float* kp = z + (size_t)k * INC + 512 + h * 128; float s1 = 0.f, s2 = 0.f; for (int d = 0; d < 64; ++d) { s1 += qs[d] * kp[d]; s2 += qs[64 + d] * kp[64 + d]; } s1 *= 0.125f; s2 *= 0.125f; a1[k] = s1; a2[k] = s2; m1 = fmaxf(m1, s1); m2 = fmaxf(m2, s2); }
    for (int o = 32; o > 0; o >>= 1) { m1 = fmaxf(m1, __shfl_xor(m1, o)); m2 = fmaxf(m2, __shfl_xor(m2, o)); }
    if ((t & 63) == 0) { red[t >> 6] = m1; red[4 + (t >> 6)] = m2; }
    __syncthreads();
    m1 = fmaxf(fmaxf(red[0], red[1]), fmaxf(red[2], red[3])); m2 = fmaxf(fmaxf(red[4], red[5]), fmaxf(red[6], red[7]));
    __syncthreads();
    float l1 = 0.f, l2 = 0.f;
    for (int k = t; k < nk; k += 256) { float e1 = expf(a1[k] - m1), e2 = expf(a2[k] - m2); a1[k] = e1; a2[k] = e2; l1 += e1; l2 += e2; }
    for (int o = 32; o > 0; o >>= 1) { l1 += __shfl_xor(l1, o); l2 += __shfl_xor(l2, o); }
    if ((t & 63) == 0) { red[t >> 6] = l1; red[4 + (t >> 6)] = l2; }
    __syncthreads();
    l1 = red[0] + red[1] + red[2] + red[3]; l2 = red[4] + red[5] + red[6] + red[7];
    const float lam = lamsh;
    for (int k = t; k < nk; k += 256) a1[k] = a1[k] / l1 - lam * a2[k] / l2;
    __syncthreads();
    const int d = t & 127, half = t >> 7; float o = 0.f;
    for (int k = half; k < nk; k += 2) o += a1[k] * z[(size_t)k * INC + 1024 + h * 128 + d];
    part[t] = o; __syncthreads();
    if (t < 128) { o = part[t] + part[t + 128]; float s = o * o; for (int off = 32; off > 0; off >>= 1) s += __shfl_xor(s, off); if ((t & 63) == 0) red[t >> 6] = s; }
    __syncthreads();
    if (t < 128) { const float s = red[0] + red[1]; out[(size_t)row * 1024 + h * 128 + t] = o * (1.0f / sqrtf(s / 128.f + EPS)) * subg[t] * (1.f - lambda_init); }
}
__global__ void k_table(float* __restrict__ Ct, float* __restrict__ St, int n) {
    const int i = blockIdx.y, j = blockIdx.x * 256 + threadIdx.x; if (j >= n) return;
    const int p = (int)(((long long)i * j) % n); const double a = 2.0 * M_PI * (double)p / (double)n;
    Ct[(size_t)i * n + j] = (float)cos(a); St[(size_t)i * n + j] = (float)sin(a);
}
__global__ void k_resid(const float* __restrict__ xin, const float* __restrict__ g, const float* __restrict__ y, float* __restrict__ xout) {
    const size_t o = (size_t)blockIdx.x * D; const float4 a = ((const float4*)(xin + o))[threadIdx.x], gg = ((const float4*)g)[threadIdx.x], b = ((const float4*)(y + o))[threadIdx.x];
    float4 r; r.x = a.x + gg.x * b.x; r.y = a.y + gg.y * b.y; r.z = a.z + gg.z * b.z; r.w = a.w + gg.w * b.w; ((float4*)(xout + o))[threadIdx.x] = r;
}
__global__ void k_swiglu(float* __restrict__ a, const float* __restrict__ b, size_t n) { size_t i = (size_t)blockIdx.x * 256 + threadIdx.x; if (i < n) { float g = a[i]; a[i] = g / (1.f + expf(-g)) * b[i]; } }

struct In { const float *x, *c, *ctx, *cctx, *w_ada, *b_ada, *n1g, *n2g, *w_in, *qg, *kg, *lq1, *lk1, *lq2, *lk2, *subg, *wf, *w_out, *w_gate, *w_up, *w_down; };
inline void gemm(hipStream_t s, const float* A, int lda, const float* Bm, int ldb, float* C, int ldc, int M, int N, int K, float alpha = 1.f, float beta = 0.f) {
    k_gemm<<<dim3(N / 64, M / 64), 256, 0, s>>>(A, lda, Bm, ldb, C, ldc, K, alpha, beta);
}
inline void run(const In& I, float* xl, unsigned char* ws, hipStream_t s) {
    size_t off = 0; auto take = [&](size_t bytes) { unsigned char* p = ws + off; off += (bytes + 255) / 256 * 256; return (float*)p; };
    float* mod = take((size_t)DEPTH * 9 * 6144 * 4);
    float* CL = take((size_t)L * L * 4); float* SL = take((size_t)L * L * 4);
    float* CC = take((size_t)CT * CT * 4); float* SC = take((size_t)CT * CT * 4);
    float* C128 = take(128 * 128 * 4); float* S128 = take(128 * 128 * 4);
    float* xc = take((size_t)NB * CT * D * 4);
    float* hx = take((size_t)NR * D * 4); float* z = take((size_t)NR * INC * 4); float* mixin = take((size_t)NR * D * 4); float* mixout = take((size_t)NR * D * 4);
    float* P = take((size_t)L * 512 * 4); float* Q = take((size_t)L * 512 * 4); float* X = take((size_t)L * 512 * 4);
    float* ha = take((size_t)NR * FF * 4); float* hb = take((size_t)NR * FF * 4);
    hipMemcpyAsync(xl, I.x, (size_t)NB * L * D * 4, hipMemcpyDeviceToDevice, s);
    hipMemcpyAsync(xc, I.ctx, (size_t)NB * CT * D * 4, hipMemcpyDeviceToDevice, s);
    k_table<<<dim3(L / 256, L), 256, 0, s>>>(CL, SL, L); k_table<<<dim3(1, CT), 256, 0, s>>>(CC, SC, CT); k_table<<<dim3(1, 128), 256, 0, s>>>(C128, S128, 128);
    for (int i = 0; i < DEPTH; ++i) k_mod<<<dim3(6144 / 256, 9), 256, 0, s>>>(I.c, I.cctx, I.w_ada + (size_t)i * D * 6144, I.b_ada + i * 6144, mod + i * 9 * 6144);
    for (int i = 0; i < DEPTH; ++i) {
        const bool last = i == DEPTH - 1; const float lambda_init = 0.8f - 0.6f * expf(-0.3f * i);
        const float* md = mod + i * 9 * 6144;
        const float* w_in = I.w_in + (size_t)i * D * INC; const float* w_out = I.w_out + (size_t)i * D * D;
        const float* wg = I.w_gate + (size_t)i * D * FF; const float* wu = I.w_up + (size_t)i * D * FF; const float* wd = I.w_down + (size_t)i * FF * D;
        for (int b = 0; b < NB; ++b) {
            float* xb = xl + (size_t)b * L * D; float* cb = xc + (size_t)b * CT * D;
            const float* mc = md + 8 * 6144; const float* mx = md + b * 6144;
            k_rmsmod<<<CT, 256, 0, s>>>(cb, I.n1g + i * D, mc + 0, mc + 1024, hx);
            k_rmsmod<<<L, 256, 0, s>>>(xb, I.n1g + i * D, mx + 0, mx + 1024, hx + (size_t)CT * D);
            gemm(s, hx, D, w_in, INC, z, INC, NR, INC, D);
            k_qknorm_rope<<<dim3(16, NR), 64, 0, s>>>(z, I.qg + i * 64, I.kg + i * 64);
            k_attn<<<dim3(L, 4), 256, 0, s>>>(z, mixin, CT, NR, I.lq1 + i * 64, I.lk1 + i * 64, I.lq2 + i * 64, I.lk2 + i * 64, lambda_init, I.subg + i * 128);
            if (!last) k_attn<<<dim3(CT, 4), 256, 0, s>>>(z, mixin, 0, CT, I.lq1 + i * 64, I.lk1 + i * 64, I.lq2 + i * 64, I.lk2 + i * 64, lambda_init, I.subg + i * 128);
            { const float* f = z + (size_t)CT * INC + 1536;
              gemm(s, CL, L, f, INC, P, 512, L, 512, L); gemm(s, SL, L, f, INC, Q, 512, L, 512, L);
              const float sc = 1.0f / sqrtf((float)L * 128.f);
              for (int g = 0; g < 4; ++g) { gemm(s, P + g * 128, 512, C128, 128, X + g * 128, 512, L, 128, 128, sc, 0.f); gemm(s, Q + g * 128, 512, S128, 128, X + g * 128, 512, L, 128, 128, -sc, 1.f);
                  gemm(s, X + g * 128, 512, I.wf + ((size_t)i * 4 + g) * 128 * 128, 128, mixin + (size_t)CT * D + 512 + g * 128, D, L, 128, 128); } }
            if (!last) { const float* f = z + 1536;
              gemm(s, CC, CT, f, INC, P, 512, CT, 512, CT); gemm(s, SC, CT, f, INC, Q, 512, CT, 512, CT);
              const float sc = 1.0f / sqrtf((float)CT * 128.f);
              for (int g = 0; g < 4; ++g) { gemm(s, P + g * 128, 512, C128, 128, X + g * 128, 512, CT, 128, 128, sc, 0.f); gemm(s, Q + g * 128, 512, S128, 128, X + g * 128, 512, CT, 128, 128, -sc, 1.f);
                  gemm(s, X + g * 128, 512, I.wf + ((size_t)i * 4 + g) * 128 * 128, 128, mixin + 512 + g * 128, D, CT, 128, 128); } }
            const int r0 = last ? CT : 0, nr = NR - r0;
            gemm(s, mixin + (size_t)r0 * D, D, w_out, D, mixout + (size_t)r0 * D, D, nr, D, D);
            if (!last) k_resid<<<CT, 256, 0, s>>>(cb, mc + 2048, mixout, cb);
            k_resid<<<L, 256, 0, s>>>(xb, mx + 2048, mixout + (size_t)CT * D, xb);
            if (!last) k_rmsmod<<<CT, 256, 0, s>>>(cb, I.n2g + i * D, mc + 3072, mc + 4096, hx);
            k_rmsmod<<<L, 256, 0, s>>>(xb, I.n2g + i * D, mx + 3072, mx + 4096, hx + (size_t)CT * D);
            gemm(s, hx + (size_t)r0 * D, D, wg, FF, ha + (size_t)r0 * FF, FF, nr, FF, D);
            gemm(s, hx + (size_t)r0 * D, D, wu, FF, hb + (size_t)r0 * FF, FF, nr, FF, D);
            k_swiglu<<<(unsigned)(((size_t)nr * FF + 255) / 256), 256, 0, s>>>(ha + (size_t)r0 * FF, hb + (size_t)r0 * FF, (size_t)nr * FF);
            gemm(s, ha + (size_t)r0 * FF, FF, wd, D, mixout + (size_t)r0 * D, D, nr, D, FF);
            if (!last) k_resid<<<CT, 256, 0, s>>>(cb, mc + 5120, mixout, cb);
            k_resid<<<L, 256, 0, s>>>(xb, mx + 5120, mixout + (size_t)CT * D, xb);
        }
    }
}
}
extern "C" void kernel_launch(void* const* d_in, const int* in_sizes, int n_in, void* d_out, int out_size, void* d_ws, size_t ws_size, hipStream_t stream) {
    nv::In I;
    const float** p = (const float**)&I;
    for (int i = 0; i < 21; ++i) p[i] = (const float*)d_in[i];
    nv::run(I, (float*)d_out, (unsigned char*)d_ws, stream);
}
```

```cpp
#define MK_PER_PHASE 1
#include <hip/hip_runtime.h>
#include <cstdio>
#include <cstdint>
#include <math.h>
constexpr size_t EWS_MOD = 1u << 20, EWS_BIN = EWS_MOD + 512 * 1024, EWS_BGU = EWS_BIN + 256 * 1024, EWS_ROPE = EWS_BGU + 512 * 1024, EWS_SSQ = 5u << 20, EWS_A = 56u << 20, EWS_XC = 92u << 20,
                 EWS_QB = 100u << 20, EWS_KB = 118u << 20, EWS_VB = 136u << 20, EWS_TC = 186u << 20, EWS_T = 190u << 20, EWS_H = 100u << 20;
namespace pg8 {
#define PG8_LAS __attribute__((address_space(3)))
typedef unsigned short bf16_t;
typedef short bf16x8 __attribute__((ext_vector_type(8)));
typedef float f32x4 __attribute__((ext_vector_type(4)));
typedef unsigned u32x4 __attribute__((ext_vector_type(4)));
constexpr int BM = 256, BK = 64, HALF = 128, HTB = HALF * BK * 2  , STAGE_BYTES = 8 * HTB, NXCD = 8, WGM = 8;

__host__ __device__ __forceinline__ int lds_byte(int r, int c) { const int st = (r >> 4) * 2 + (c >> 5), rr = r & 15, cc = c & 31, ob = rr * 64 + cc * 2; return st * 1024 + (ob ^ (((ob >> 9) & 1) << 5)); }
__host__ __device__ __forceinline__ void stage_rc(int b, int& R, int& C) { const int st = b / 1024, sb = b % 1024, swz = sb ^ (((sb >> 9) & 1) << 5); R = (st >> 1) * 16 + swz / 64; C = (st & 1) * 32 + (swz % 64) / 2; }
__host__ __device__ __forceinline__ int perm32(int rho) { const int n = rho >> 4, i = rho & 15; return 8 * (i >> 2) + 4 * n + (i & 3); }

struct Unit { int pm, pn; };
struct Gemm { const bf16_t* A; const bf16_t* Bt; int M, N, K; };

struct StaticOrder {
    int nM, nN, nwg, G, c;
    __host__ __device__ void init(int M, int N, int G_, int c_) { nM = M / BM; nN = N / BM; nwg = nM * nN; G = G_; c = c_; }
    __host__ __device__ bool next(int i, Unit& u) const {
        const long L = (long)i * G + c; if (L >= nwg) return false;
        int wgid = (int)L; { const int q = nwg / NXCD, r = nwg % NXCD, xcd = wgid % NXCD, off = wgid / NXCD; wgid = (xcd < r ? xcd * (q + 1) : r * (q + 1) + (xcd - r) * q) + off; }
        const int nig = WGM * nN, gid = wgid / nig, fm = gid * WGM, gsz = (nM - fm) < WGM ? (nM - fm) : WGM;
        u.pm = fm + ((wgid % nig) % gsz); u.pn = (wgid % nig) / gsz; return true;
    }
    __device__ __forceinline__ void a_ready(const Unit&) const {}
    __device__ __forceinline__ void done(const Unit&) const {}
};

struct Sched2 {
    int nMa, nNa, nA, pmB, nMb, pnB, nNb, nB, G, c;
    __device__ void init(int nMa_, int nNa_, int pmB_, int nMb_, int pnB_, int nNb_, int G_, int c_, int rot) { nMa = nMa_; nNa = nNa_; nA = nMa * nNa; pmB = pmB_; nMb = nMb_; pnB = pnB_; nNb = nNb_; nB = nMb * nNb; G = G_; c = (c_ + rot) % G_; }
    __device__ bool next(int i, Unit& u) const {
        const long L = (long)i * G + c; if (L >= nA + nB) return false;
        if (L < nA) {
            int wgid = (int)L; { const int q = nA / NXCD, r = nA % NXCD, xcd = wgid % NXCD, off = wgid / NXCD; wgid = (xcd < r ? xcd * (q + 1) : r * (q + 1) + (xcd - r) * q) + off; }
            const int nig = WGM * nNa, gid = wgid / nig, fm = gid * WGM, gsz = (nMa - fm) < WGM ? (nMa - fm) : WGM;
            u.pm = fm + ((wgid % nig) % gsz); u.pn = (wgid % nig) / gsz;
        } else { const int r = (int)L - nA; u.pm = pmB + r % nMb; u.pn = pnB + r / nMb; }
        return true;
    }
    __device__ __forceinline__ void a_ready(const Unit&) const {}
    __device__ __forceinline__ void done(const Unit&) const {}
};
__device__ __forceinline__ unsigned cvt_pk_bf16(float lo, float hi) { unsigned r; asm volatile("v_cvt_pk_bf16_f32 %0, %1, %2" : "=v"(r) : "v"(lo), "v"(hi)); return r; }
typedef unsigned u32x2 __attribute__((ext_vector_type(2)));
__device__ __forceinline__ u32x2 pk4(f32x4 v) { u32x2 w; w.x = cvt_pk_bf16(v[0], v[1]); w.y = cvt_pk_bf16(v[2], v[3]); return w; }
__device__ __forceinline__ float dot4(f32x4 v) { return (v[0] * v[0] + v[1] * v[1]) + (v[2] * v[2] + v[3] * v[3]); }
constexpr int M_LAT_TILES = 64;
constexpr float QSCALE = 0.125f * 1.4426950408889634f;
constexpr float ZS_LAT = 1.0f / 512.0f;
constexpr float ZS_CTX = 0.005524271728019903f;

struct EpiIn {
    static constexpr bool PERM = false, AFTER_DRAIN = false;
    unsigned char* ws; int layer; const float* qg; const float* kg; const PG8_LAS float* rtab;
    __device__ __forceinline__ void operator()(const f32x4 (&acc)[2][2][4][2], const Unit& u, int ui, int wr, int wc, int fr, int fq) const {
        const int pm = u.pm, pn = u.pn; const bool lat = pm < M_LAT_TILES; const int bm = lat ? (pm >> 3) : 8;
        const float* bias = (const float*)(ws + EWS_BIN) + layer * 9 * 2560; const float* rope = (const float*)(ws + EWS_ROPE);
        bf16_t* QB = (bf16_t*)(ws + EWS_QB); bf16_t* KB = (bf16_t*)(ws + EWS_KB); bf16_t* VB = (bf16_t*)(ws + EWS_VB); bf16_t* T = (bf16_t*)(ws + EWS_T); bf16_t* Tc = (bf16_t*)(ws + EWS_TC);
        const float* bp = bias + bm * 2560 + pn * 256 + wc * 32 + fq * 4;
        f32x4 bv[2][2];
#pragma unroll
        for (int bj = 0; bj < 2; ++bj)
#pragma unroll
            for (int n = 0; n < 2; ++n) bv[bj][n] = *(const f32x4*)(bp + bj * 128 + n * 16);
        const PG8_LAS float* rt = rtab + ui * 256 + wr * 64 + fr;
        if (pn < 4) {
            const float* gp = (pn < 2 ? qg : kg) + fq * 4; const float qs = pn < 2 ? QSCALE : 1.f;
            f32x4 gv[2][2];
#pragma unroll
            for (int bj = 0; bj < 2; ++bj)
#pragma unroll
                for (int n = 0; n < 2; ++n) gv[bj][n] = *(const f32x4*)(gp + bj * 32 + n * 16) * qs;
            bf16_t* dst = (pn < 2 ? QB : KB) + (pn & 1) * 256 + wc * 64 + fq * 4;
#pragma unroll
            for (int ai = 0; ai < 2; ++ai)
#pragma unroll
                for (int m = 0; m < 4; ++m) {
                    const int rl = ai * 128 + wr * 64 + m * 16 + fr, row = pm * 256 + rl; const float r = rt[ai * 128 + m * 16];
                    f32x4 v[2][2]; float ssq = 0.f;
#pragma unroll
                    for (int bj = 0; bj < 2; ++bj)
#pragma unroll
                        for (int n = 0; n < 2; ++n) { v[bj][n] = acc[ai][bj][m][n] * r + bv[bj][n]; ssq += dot4(v[bj][n]); }
                    ssq += __shfl_xor(ssq, 16); ssq += __shfl_xor(ssq, 32);
                    const float rn = 1.0f / sqrtf(ssq * (1.0f / 64.0f) + 1e-6f);
#pragma unroll
                    for (int bj = 0; bj < 2; ++bj)
#pragma unroll
                        for (int n = 0; n < 2; ++n) v[bj][n] = v[bj][n] * rn * gv[bj][n];
                    if (lat) { const float* cp = rope + (row & 2047) * 32 + fq * 4;
#pragma unroll
                        for (int bj = 0; bj < 2; ++bj) { const f32x4 c4 = *(const f32x4*)(cp + bj * 16), s4 = *(const f32x4*)(cp + 65536 + bj * 16); const f32x4 t1 = v[bj][0], t2 = v[bj][1];
                            v[bj][0] = t1 * c4 - t2 * s4; v[bj][1] = t2 * c4 + t1 * s4; } }
#pragma unroll
                    for (int bj = 0; bj < 2; ++bj)
#pragma unroll
                        for (int n = 0; n < 2; ++n) *(u32x2*)(dst + (size_t)row * 512 + bj * 32 + n * 16) = pk4(v[bj][n]);
                }
        } else if (pn < 6) {
            bf16_t* dst = VB + (pn - 4) * 256 + wc * 32 + fq * 4;
#pragma unroll
            for (int ai = 0; ai < 2; ++ai)
#pragma unroll
                for (int m = 0; m < 4; ++m) {
                    const int rl = ai * 128 + wr * 64 + m * 16 + fr, row = pm * 256 + rl; const float r = rt[ai * 128 + m * 16];
#pragma unroll
                    for (int bj = 0; bj < 2; ++bj)
#pragma unroll
                        for (int n = 0; n < 2; ++n) *(u32x2*)(dst + (size_t)row * 512 + bj * 128 + n * 16) = pk4(acc[ai][bj][m][n] * r + bv[bj][n]);
                }
        } else {
            const int g = pn - 6; const float zs = lat ? ZS_LAT : ZS_CTX;
            const int b = lat ? (pm >> 3) : (pm - M_LAT_TILES); const int L = lat ? 2048 : 256; const int pos0 = lat ? (pm & 7) * 256 : 0;
            bf16_t* tb = (lat ? T : Tc) + (size_t)(b * 512 + g * 128 + wc * 32 + fq * 4) * 2 * L;
#pragma unroll
            for (int ai = 0; ai < 2; ++ai)
#pragma unroll
                for (int m = 0; m < 4; ++m) {
                    const int rl = ai * 128 + wr * 64 + m * 16 + fr, pos = pos0 + rl; const float r = rt[ai * 128 + m * 16];
#pragma unroll
                    for (int bj = 0; bj < 2; ++bj)
#pragma unroll
                        for (int n = 0; n < 2; ++n) { const f32x4 v = (acc[ai][bj][m][n] * r + bv[bj][n]) * zs; const u32x2 w = pk4(v);
                            bf16_t* p = tb + ((size_t)(n * 16) * 2 + bj) * L + pos;
                            p[0] = (bf16_t)(w.x & 0xffffu); p[(size_t)2 * L] = (bf16_t)(w.x >> 16); p[(size_t)4 * L] = (bf16_t)(w.y & 0xffffu); p[(size_t)6 * L] = (bf16_t)(w.y >> 16); }
                }
        }
    }
};
template <bool NEXT> struct EpiRes {
    static constexpr bool PERM = false, AFTER_DRAIN = false;
    const float* xl_in; const float* xc_in; float* xl_out;
    unsigned char* ws; int gate_off;
    const float* ng; int nsc_off;
    __device__ __forceinline__ void operator()(const f32x4 (&acc)[2][2][4][2], const Unit& u, int ui, int wr, int wc, int fr, int fq) const {
        const int pm = u.pm, pn = u.pn; const bool lat = pm < M_LAT_TILES; const int bm = lat ? (pm >> 3) : 8; const int col0 = pn * 256 + wc * 32 + fq * 4;
        const float* gate = (const float*)(ws + EWS_MOD) + gate_off; const float* nsc = (const float*)(ws + EWS_MOD) + nsc_off; bf16_t* A = (bf16_t*)(ws + EWS_A); float* ssq = (float*)(ws + EWS_SSQ); float* xc_out = (float*)(ws + EWS_XC);
        f32x4 ga[2][2], gv[2][2];
#pragma unroll
        for (int bj = 0; bj < 2; ++bj)
#pragma unroll
            for (int n = 0; n < 2; ++n) { const int c = col0 + bj * 128 + n * 16; ga[bj][n] = *(const f32x4*)(gate + bm * 6144 + c);
                if (NEXT) gv[bj][n] = *(const f32x4*)(ng + c) * (*(const f32x4*)(nsc + bm * 6144 + c) + 1.0f); }
        const float* xin = lat ? xl_in + (size_t)pm * 256 * 1024 : xc_in + (size_t)(pm - M_LAT_TILES) * 256 * 1024;
        float* xout = lat ? xl_out + (size_t)pm * 256 * 1024 : xc_out + (size_t)(pm - M_LAT_TILES) * 256 * 1024;
#pragma unroll
        for (int ai = 0; ai < 2; ++ai)
#pragma unroll
            for (int m = 0; m < 4; ++m) {
                const int rl = ai * 128 + wr * 64 + m * 16 + fr; const size_t row = (size_t)pm * 256 + rl; float ssq_ = 0.f;
#pragma unroll
                for (int bj = 0; bj < 2; ++bj)
#pragma unroll
                    for (int n = 0; n < 2; ++n) { const size_t off = (size_t)rl * 1024 + col0 + bj * 128 + n * 16; const f32x4 xo = *(const f32x4*)(xin + off); const f32x4 xn = xo + ga[bj][n] * acc[ai][bj][m][n];
                        *(f32x4*)(xout + off) = xn;
                        if (NEXT) { ssq_ += dot4(xn); *(u32x2*)(A + row * 1024 + col0 + bj * 128 + n * 16) = pk4(xn * gv[bj][n]); } }
                if (NEXT) { ssq_ += __shfl_xor(ssq_, 16); ssq_ += __shfl_xor(ssq_, 32); if (fq == 0) ssq[row * 16 + pn * 4 + wc] = ssq_; }
                asm volatile("" ::: "memory");
            }
    }
};
struct EpiGU {
    static constexpr bool PERM = false, AFTER_DRAIN = false;
    unsigned char* ws; int layer; const PG8_LAS float* rtab;
    __device__ __forceinline__ void operator()(const f32x4 (&acc)[2][2][4][2], const Unit& u, int ui, int wr, int wc, int fr, int fq) const {
        const int pm = u.pm, pn = u.pn; const int bm = pm < M_LAT_TILES ? (pm >> 3) : 8;
        const float* bias = (const float*)(ws + EWS_BGU) + layer * 9 * 5632; bf16_t* H = (bf16_t*)(ws + EWS_H);
        const float* bp = bias + bm * 5632 + pn * 256 + wc * 32 + fq * 4;
        f32x4 bg[2], bu[2];
#pragma unroll
        for (int n = 0; n < 2; ++n) { bg[n] = *(const f32x4*)(bp + n * 16); bu[n] = *(const f32x4*)(bp + 128 + n * 16); }
        const PG8_LAS float* rt = rtab + ui * 256 + wr * 64 + fr;
        bf16_t* dst = H + pn * 128 + wc * 32 + fq * 4;
#pragma unroll
        for (int ai = 0; ai < 2; ++ai)
#pragma unroll
            for (int m = 0; m < 4; ++m) {
                const int rl = ai * 128 + wr * 64 + m * 16 + fr; const size_t row = (size_t)pm * 256 + rl; const float r = rt[ai * 128 + m * 16];
#pragma unroll
                for (int n = 0; n < 2; ++n) { const f32x4 gg = acc[ai][0][m][n] * r + bg[n], uu = acc[ai][1][m][n] * r + bu[n]; f32x4 h;
#pragma unroll
                    for (int i = 0; i < 4; ++i) h[i] = gg[i] * __builtin_amdgcn_rcpf(1.0f + __builtin_amdgcn_exp2f(-1.4426950408889634f * gg[i])) * uu[i];
                    *(u32x2*)(dst + row * 2816 + n * 16) = pk4(h); }
            }
    }
};
struct EpiDft {
    static constexpr bool PERM = true, AFTER_DRAIN = false;
    bf16_t* MIX;
    __device__ __forceinline__ void operator()(const f32x4 (&acc)[2][2][4][2], const Unit& u, int ui, int wr, int wc, int fr, int fq) const {
        const int pn = u.pn;
#pragma unroll
        for (int bj = 0; bj < 2; ++bj) {
            const int c = pn * 256 + bj * 128 + wc * 32 + fq * 8; int rowbase, rstride, ch;
            if (pn < 128) { const int b = c >> 12, r = (c >> 9) & 7; ch = c & 511; rowbase = b * 2048 + r; rstride = 8; }
            else { const int c2 = c - 32768; const int b = c2 >> 9; ch = c2 & 511; rowbase = 16384 + b * 256; rstride = 1; }
#pragma unroll
            for (int ai = 0; ai < 2; ++ai)
#pragma unroll
                for (int m = 0; m < 4; ++m) { const int mm = ai * 128 + wr * 64 + m * 16 + fr; const size_t row = (size_t)rowbase + (size_t)mm * rstride;
                    const f32x4 v0 = acc[ai][bj][m][0], v1 = acc[ai][bj][m][1]; u32x4 w; w.x = cvt_pk_bf16(v0[0], v0[1]); w.y = cvt_pk_bf16(v0[2], v0[3]); w.z = cvt_pk_bf16(v1[0], v1[1]); w.w = cvt_pk_bf16(v1[2], v1[3]);
                    *(u32x4*)(MIX + row * 1024 + 512 + ch) = w; }
        }
    }
};
template <class Epi, class Sched, bool ALIGN_EPI = false, bool SP2 = false>
__device__ __forceinline__ void gemm_phase(PG8_LAS unsigned char* lds, const Gemm g, const Sched& S, const Epi& E) {
    int tid_ = threadIdx.x; asm volatile("" : "+v"(tid_));
    const int tid = tid_, wid = __builtin_amdgcn_readfirstlane(tid >> 6), lane = tid & 63, wr = wid >> 2, wc = wid & 3, fr = lane & 15, fq = lane >> 4;
    const int K = g.K, nt = K / BK;
    unsigned voffA[2], voffB[2];
#pragma unroll
    for (int i = 0; i < 2; ++i) { int R, C; stage_rc(tid * 16 + i * 8192, R, C); const int Rb = Epi::PERM ? ((R & ~31) + perm32(R & 31)) : R;
        voffA[i] = (unsigned)(R * K + C) * 2u; voffB[i] = (unsigned)(Rb * K + C) * 2u; }
    const size_t kstep = (size_t)(BK * 2);
    const size_t hstep = (size_t)HALF * K * 2;
    const size_t tstep = 2 * hstep;
    const unsigned ldsw = (unsigned)wid * 1024u;
    const int aoff = lds_byte(wr * 64 + fr, fq * 8), boff = lds_byte(wc * 32 + fr, fq * 8);
#define PG8_SA(b, h) (((b) * 2 + (h)) * HTB)
#define PG8_SB(b, h) ((4 + (b) * 2 + (h)) * HTB)
#define PG8_STAGE(bufoff, gbase, voff) do { _Pragma("unroll") for (int _i = 0; _i < 2; ++_i) \
        __builtin_amdgcn_global_load_lds((const unsigned*)((const char*)(gbase) + (voff)[_i]), (PG8_LAS unsigned*)(lds + (bufoff) + ldsw + _i * 8192), 16, 0, 0); } while (0)
#define PG8_LDA(dst, b, h) do { _Pragma("unroll") for (int m = 0; m < 4; ++m) _Pragma("unroll") for (int k = 0; k < 2; ++k) dst[m][k] = *(const PG8_LAS bf16x8*)(lds + PG8_SA(b, h) + aoff + m * 2048 + k * 1024); } while (0)
#define PG8_LDB(dst, b, h) do { _Pragma("unroll") for (int n = 0; n < 2; ++n) _Pragma("unroll") for (int k = 0; k < 2; ++k) dst[n][k] = *(const PG8_LAS bf16x8*)(lds + PG8_SB(b, h) + boff + n * 2048 + k * 1024); } while (0)
#define PG8_MMA(ai, bj, At, Bt) do { __builtin_amdgcn_s_setprio(1); _Pragma("unroll") for (int m = 0; m < 4; ++m) _Pragma("unroll") for (int n = 0; n < 2; ++n) _Pragma("unroll") for (int k = 0; k < 2; ++k) \
        acc[ai][bj][m][n] = __builtin_amdgcn_mfma_f32_16x16x32_bf16(Bt[n][k], At[m][k], acc[ai][bj][m][n], 0, 0, 0); __builtin_amdgcn_s_setprio(0); } while (0)
#define PG8_WAIT_V(n) asm volatile("s_waitcnt vmcnt(" #n ")" ::: "memory")
#define PG8_WAIT_L(n) asm volatile("s_waitcnt lgkmcnt(" #n ")" ::: "memory")
#define PG8_BAR __builtin_amdgcn_s_barrier()
#define PG8_SCHED __builtin_amdgcn_sched_barrier(0)
    Unit cur, nxt; int ui = 0;
    if (!S.next(0, cur)) return;
    f32x4 acc[2][2][4][2];
#pragma unroll
    for (int a = 0; a < 2; ++a)
#pragma unroll
        for (int b = 0; b < 2; ++b)
#pragma unroll
            for (int m = 0; m < 4; ++m)
#pragma unroll
                for (int n = 0; n < 2; ++n) acc[a][b][m][n] = (f32x4){0.f, 0.f, 0.f, 0.f};
    bf16x8 At[4][2], B0[2][2], B1[2][2];
    const char* cA = (const char*)g.A + (size_t)cur.pm * tstep; const char* cB = (const char*)g.Bt + (size_t)cur.pn * tstep;
    S.a_ready(cur);
    if constexpr (SP2) {
        PG8_STAGE(PG8_SB(0, 0), cB, voffB); PG8_STAGE(PG8_SB(0, 1), cB + hstep, voffB); PG8_STAGE(PG8_SA(0, 0), cA, voffA); PG8_STAGE(PG8_SA(0, 1), cA + hstep, voffA);
        if (wr == 1) PG8_BAR;
        PG8_WAIT_V(2); PG8_BAR;
        PG8_STAGE(PG8_SB(1, 0), cB + kstep, voffB); PG8_STAGE(PG8_SA(1, 0), cA + kstep, voffA); PG8_STAGE(PG8_SB(1, 1), cB + hstep + kstep, voffB);
        PG8_WAIT_V(6); PG8_BAR;
    } else {
        PG8_STAGE(PG8_SB(0, 0), cB, voffB); PG8_STAGE(PG8_SA(0, 0), cA, voffA); PG8_STAGE(PG8_SB(0, 1), cB + hstep, voffB); PG8_STAGE(PG8_SA(0, 1), cA + hstep, voffA);
        if (wr == 1) PG8_BAR;
        PG8_WAIT_V(4); PG8_BAR;
        PG8_STAGE(PG8_SB(1, 0), cB + kstep, voffB); PG8_STAGE(PG8_SA(1, 0), cA + kstep, voffA); PG8_STAGE(PG8_SB(1, 1), cB + hstep + kstep, voffB);
        PG8_WAIT_V(6); PG8_BAR;
    }
    for (;;) {
        const bool has_next = S.next(ui + 1, nxt);
        const char* nA = has_next ? (const char*)g.A + (size_t)nxt.pm * tstep : cA; const char* nB = has_next ? (const char*)g.Bt + (size_t)nxt.pn * tstep : cB;
        for (int t = 0; t < nt; t += 2) {
            const bool last = (t == nt - 2);
            const char* a1 = cA + (size_t)(t + 1) * kstep;
            const char* a2 = last ? nA : cA + (size_t)(t + 2) * kstep; const char* b2 = last ? nB : cB + (size_t)(t + 2) * kstep;
            const char* a3 = a2 + kstep; const char* b3 = b2 + kstep;
            if (last && has_next) S.a_ready(nxt);
            if constexpr (SP2) {
            PG8_LDB(B0, 0, 0); PG8_LDB(B1, 0, 1); PG8_SCHED; PG8_LDA(At, 0, 0); PG8_STAGE(PG8_SA(1, 1), a1 + hstep, voffA);
            PG8_WAIT_V(8); PG8_WAIT_L(0); PG8_BAR; PG8_MMA(0, 0, At, B0); PG8_MMA(0, 1, At, B1); PG8_BAR; PG8_SCHED;
            PG8_LDA(At, 0, 1); PG8_STAGE(PG8_SB(0, 0), b2, voffB); PG8_STAGE(PG8_SB(0, 1), b2 + hstep, voffB); PG8_STAGE(PG8_SA(0, 0), a2, voffA);
            PG8_WAIT_V(8); PG8_WAIT_L(0); PG8_BAR; PG8_MMA(1, 0, At, B0); PG8_MMA(1, 1, At, B1); PG8_BAR; PG8_SCHED;
            PG8_LDB(B0, 1, 0); PG8_LDB(B1, 1, 1); PG8_SCHED; PG8_LDA(At, 1, 0); PG8_STAGE(PG8_SA(0, 1), a2 + hstep, voffA);
            PG8_WAIT_V(8); PG8_WAIT_L(0); PG8_BAR; PG8_MMA(0, 0, At, B0); PG8_MMA(0, 1, At, B1); PG8_BAR; PG8_SCHED;
            PG8_LDA(At, 1, 1); PG8_STAGE(PG8_SB(1, 0), b3, voffB); PG8_STAGE(PG8_SB(1, 1), b3 + hstep, voffB); PG8_STAGE(PG8_SA(1, 0), a3, voffA);
            PG8_WAIT_V(8); PG8_WAIT_L(0); PG8_BAR; PG8_MMA(1, 0, At, B0); PG8_MMA(1, 1, At, B1); PG8_BAR; PG8_SCHED;
            } else {
            PG8_LDB(B0, 0, 0); PG8_SCHED; PG8_LDA(At, 0, 0); PG8_STAGE(PG8_SA(1, 1), a1 + hstep, voffA);
            PG8_WAIT_L(8); PG8_BAR; PG8_WAIT_L(0); PG8_MMA(0, 0, At, B0); PG8_BAR; PG8_SCHED;
            PG8_LDB(B1, 0, 1); PG8_STAGE(PG8_SB(0, 0), b2, voffB);
            PG8_BAR; PG8_WAIT_L(0); PG8_MMA(0, 1, At, B1); PG8_BAR;
            PG8_LDA(At, 0, 1); PG8_STAGE(PG8_SA(0, 0), a2, voffA);
            PG8_BAR; PG8_WAIT_L(0); PG8_MMA(1, 0, At, B0); PG8_BAR; PG8_SCHED;
            PG8_STAGE(PG8_SB(0, 1), b2 + hstep, voffB);
            PG8_WAIT_V(6); PG8_BAR; PG8_MMA(1, 1, At, B1); PG8_BAR;
            PG8_LDB(B0, 1, 0); PG8_SCHED; PG8_LDA(At, 1, 0); PG8_STAGE(PG8_SA(0, 1), a2 + hstep, voffA);
            PG8_WAIT_L(8); PG8_BAR; PG8_WAIT_L(0); PG8_MMA(0, 0, At, B0); PG8_BAR; PG8_SCHED;
            PG8_LDB(B1, 1, 1); PG8_STAGE(PG8_SB(1, 0), b3, voffB);
            PG8_BAR; PG8_WAIT_L(0); PG8_MMA(0, 1, At, B1); PG8_BAR;
            PG8_LDA(At, 1, 1); PG8_STAGE(PG8_SA(1, 0), a3, voffA);
            PG8_BAR; PG8_WAIT_L(0); PG8_MMA(1, 0, At, B0); PG8_BAR; PG8_SCHED;
            PG8_STAGE(PG8_SB(1, 1), b3 + hstep, voffB);
            PG8_WAIT_V(6); PG8_BAR; PG8_MMA(1, 1, At, B1); PG8_BAR;
            }
        }
        if constexpr (ALIGN_EPI) { if (wr == 0) PG8_BAR; }
        if constexpr (!Epi::AFTER_DRAIN) { E(acc, cur, ui, wr, wc, fr, fq); S.done(cur); }
        if (!has_next) break;
#pragma unroll
        for (int a = 0; a < 2; ++a)
#pragma unroll
            for (int b = 0; b < 2; ++b)
#pragma unroll
                for (int m = 0; m < 4; ++m)
#pragma unroll
                    for (int n = 0; n < 2; ++n) acc[a][b][m][n] = (f32x4){0.f, 0.f, 0.f, 0.f};
        cur = nxt; cA = nA; cB = nB; ++ui;
        if constexpr (ALIGN_EPI) { if (wr == 1) PG8_BAR; }
    }
    PG8_WAIT_V(0);
    if constexpr (!ALIGN_EPI) { if (wr == 0) PG8_BAR; }
    PG8_BAR;
    if constexpr (Epi::AFTER_DRAIN) { E.fused(acc, cur, wr, wc, fr, fq, lds, wid, lane); S.done(cur); }
#undef PG8_SA
#undef PG8_SB
#undef PG8_STAGE
#undef PG8_LDA
#undef PG8_LDB
#undef PG8_MMA
#undef PG8_WAIT_V
#undef PG8_WAIT_L
#undef PG8_BAR
#undef PG8_SCHED
}
}
#ifndef EN_ATTEPI
#define EN_ATTEPI 1
#endif
namespace att {
typedef unsigned short bf16;
using bf16x8 = __attribute__((ext_vector_type(8))) short;
using s16x4  = __attribute__((ext_vector_type(4))) short;
using f32x16 = __attribute__((ext_vector_type(16))) float;
using u32x4  = __attribute__((ext_vector_type(4))) unsigned;
constexpr int KVBLK = 64;
constexpr size_t SHM_V = KVBLK * 128 * 2, SHM_K = KVBLK * 128 * 2, SHM_ATTN = 2 * SHM_V + 2 * SHM_K + 8 * 64 * 4;
#define KSWZ(row, colB) ((row) * 256 + ((colB) ^ (((row) & 7) << 4)))
#define SBAR() __builtin_amdgcn_sched_barrier(0)
__device__ __forceinline__ int crow(int r, int hi) { return (r & 3) + 8 * (r >> 2) + 4 * hi; }
__device__ __forceinline__ unsigned cvtpk(float lo, float hi) { unsigned r; asm volatile("v_cvt_pk_bf16_f32 %0, %1, %2" : "=v"(r) : "v"(lo), "v"(hi)); return r; }
__device__ __forceinline__ bf16x8 ld8(const bf16* p) { return *reinterpret_cast<const bf16x8*>(p); }
__device__ __forceinline__ void sm_first(f32x16& p0, f32x16& p1, float negoff) {
  (void)p1; (void)negoff;
#pragma unroll
  for (int r = 0; r < 16; ++r) p0[r] = __builtin_amdgcn_exp2f(p0[r]);
}
__device__ __forceinline__ void sm_finish(f32x16& p0, f32x16& p1, float& l_reg, bf16x8& pa0, bf16x8& pa1, bf16x8& pa2, bf16x8& pa3) {
#pragma unroll
  for (int r = 0; r < 16; ++r) p1[r] = __builtin_amdgcn_exp2f(p1[r]);
  float ps = 0;
#pragma unroll
  for (int r = 0; r < 16; ++r) ps += p0[r];
#pragma unroll
  for (int r = 0; r < 16; ++r) ps += p1[r];
  l_reg += ps;
#define PK4(P, BASE, OUT) do { unsigned a0 = cvtpk(P[BASE + 0], P[BASE + 1]), a1 = cvtpk(P[BASE + 2], P[BASE + 3]);   \
    unsigned b0 = cvtpk(P[BASE + 4], P[BASE + 5]), b1 = cvtpk(P[BASE + 6], P[BASE + 7]);                              \
    auto r0 = __builtin_amdgcn_permlane32_swap(a0, b0, false, false); auto r1 = __builtin_amdgcn_permlane32_swap(a1, b1, false, false); \
    u32x4 w = {r0[0], r1[0], r0[1], r1[1]}; OUT = *reinterpret_cast<bf16x8*>(&w); } while (0)
  PK4(p0, 0, pa0); PK4(p0, 8, pa1); PK4(p1, 0, pa2); PK4(p1, 8, pa3);
#undef PK4
}
__device__ __forceinline__ void qkt(f32x16& p0, f32x16& p1, const bf16* Ks, const bf16x8* qr, int r32, int hi, int mapoff, float negoff) {
  p0 = f32x16{}; p1 = f32x16{}; (void)negoff;
#pragma unroll
  for (int d0 = 0; d0 < 4; ++d0) { const int cb = (mapoff + d0 * 16 + hi * 8) * 2;
    bf16x8 b0 = *reinterpret_cast<const bf16x8*>((const char*)Ks + KSWZ(r32, cb));
    bf16x8 b1 = *reinterpret_cast<const bf16x8*>((const char*)Ks + KSWZ(32 + r32, cb));
    p0 = __builtin_amdgcn_mfma_f32_32x32x16_bf16(b0, qr[d0], p0, 0, 0, 0);
    p1 = __builtin_amdgcn_mfma_f32_32x32x16_bf16(b1, qr[d0], p1, 0, 0, 0); }
}
__device__ __forceinline__ int v_st(int k, int c) { const int kk = (k & ~0xC) | ((k & 4) << 1) | ((k & 8) >> 1); return ((kk >> 3) * 4 + (c >> 5)) * 512 + ((kk & 7) * 32 + (c & 31)) * 2; }
__device__ __forceinline__ int v_rd_base(int lane) { return ((lane & 3) << 3) | (((lane >> 2) & 3) << 6) | (((lane >> 4) & 1) << 5) | (((lane >> 5) & 1) << 8); }
constexpr int v_rd_off(int d0, int ks, int half) { return d0 * 512 + ks * 4096 + half * 2048; }
template <int OFF> __device__ __forceinline__ s16x4 tr_read(int vb) { s16x4 r; asm volatile("ds_read_b64_tr_b16 %0, %1 offset:%2" : "=&v"(r) : "v"(vb), "i"(OFF) : "memory"); return r; }
template <int D0> __device__ __forceinline__ void pv_one(f32x16& od, int vb, bf16x8 pa0, bf16x8 pa1, bf16x8 pa2, bf16x8 pa3) {
  const s16x4 l0 = tr_read<v_rd_off(D0, 0, 0)>(vb), h0 = tr_read<v_rd_off(D0, 0, 1)>(vb), l1 = tr_read<v_rd_off(D0, 1, 0)>(vb), h1 = tr_read<v_rd_off(D0, 1, 1)>(vb);
  const s16x4 l2 = tr_read<v_rd_off(D0, 2, 0)>(vb), h2 = tr_read<v_rd_off(D0, 2, 1)>(vb), l3 = tr_read<v_rd_off(D0, 3, 0)>(vb), h3 = tr_read<v_rd_off(D0, 3, 1)>(vb);
  asm volatile("s_waitcnt lgkmcnt(0)" ::: "memory"); SBAR();
#define PK(L, H) (bf16x8){L[0], L[1], L[2], L[3], H[0], H[1], H[2], H[3]}
  od = __builtin_amdgcn_mfma_f32_32x32x16_bf16(pa0, PK(l0, h0), od, 0, 0, 0);
  od = __builtin_amdgcn_mfma_f32_32x32x16_bf16(pa1, PK(l1, h1), od, 0, 0, 0);
  od = __builtin_amdgcn_mfma_f32_32x32x16_bf16(pa2, PK(l2, h2), od, 0, 0, 0);
  od = __builtin_amdgcn_mfma_f32_32x32x16_bf16(pa3, PK(l3, h3), od, 0, 0, 0);
#undef PK
}
__device__ __forceinline__ void pv_d0(f32x16* o, int vb, bf16x8 pa0, bf16x8 pa1, bf16x8 pa2, bf16x8 pa3) {
  pv_one<0>(o[0], vb, pa0, pa1, pa2, pa3); pv_one<1>(o[1], vb, pa0, pa1, pa2, pa3); pv_one<2>(o[2], vb, pa0, pa1, pa2, pa3); pv_one<3>(o[3], vb, pa0, pa1, pa2, pa3);
}
__device__ __forceinline__ void attn_unit(const bf16* __restrict__ Qh, const bf16* __restrict__ Kh, const bf16* __restrict__ Vh, bf16* __restrict__ Oh, long qrow0, long k0a, int nt0, long k0b, int NT,
                                          float lam, float oscale, const float* __restrict__ subg, float negoff, char* lds) {
  int tid_ = threadIdx.x; asm volatile("" : "+v"(tid_));
  const int tid = tid_, wid = tid >> 6, lane = tid & 63, r32 = lane & 31, hi = lane >> 5, qsub = wid >> 1, map = wid & 1, mapoff = map * 64;
  bf16* V_lds = (bf16*)lds; bf16* K_lds = (bf16*)(lds + 2 * SHM_V);
  float* ws = (float*)(lds + 2 * SHM_V + 2 * SHM_K) + wid * 64; float* li_l = ws;
  float l_reg = 0; f32x16 o[4] = {}; bf16x8 qr[4];
  const bf16* Qw = Qh + (qrow0 + qsub * 32 + r32) * 512 + mapoff + hi * 8;
#pragma unroll
  for (int d0 = 0; d0 < 4; ++d0) qr[d0] = ld8(Qw + d0 * 16);
  const int sr = tid >> 4, sc = (tid & 15) * 8, vst0 = v_st(sr, sc), vst1 = v_st(32 + sr, sc);
  const int vb0 = (int)(uintptr_t)V_lds + v_rd_base(lane);
  bf16x8 vs0, vs1, ks0, ks1;
#define KROW(j) (((j) < nt0) ? (k0a + (long)(j) * KVBLK) : (k0b + (long)((j) - nt0) * KVBLK))
#define SLOAD(j) do { const long kr_ = KROW(j); vs0 = ld8(&Vh[(kr_ + sr) * 512 + sc]); vs1 = ld8(&Vh[(kr_ + 32 + sr) * 512 + sc]); \
    ks0 = ld8(&Kh[(kr_ + sr) * 512 + sc]); ks1 = ld8(&Kh[(kr_ + 32 + sr) * 512 + sc]); } while (0)
#define SWRITE(b) do { *(bf16x8*)((char*)V_lds + (b) * SHM_V + vst0) = vs0; *(bf16x8*)((char*)V_lds + (b) * SHM_V + vst1) = vs1; const int kc = sc * 2; \
    *(bf16x8*)((char*)K_lds + (b) * SHM_K + KSWZ(sr, kc)) = ks0; *(bf16x8*)((char*)K_lds + (b) * SHM_K + KSWZ(32 + sr, kc)) = ks1; } while (0)
  f32x16 p0, p1; bf16x8 pa0, pa1, pa2, pa3;
#define TILE(cur, j) do { if ((j) + 1 < NT) SWRITE((cur) ^ 1); if ((j) + 2 < NT) SLOAD((j) + 2); SBAR(); \
    qkt(p0, p1, (bf16*)((char*)K_lds + (cur) * SHM_K), qr, r32, hi, mapoff, negoff); sm_first(p0, p1, negoff); \
    sm_finish(p0, p1, l_reg, pa0, pa1, pa2, pa3); SBAR(); \
    pv_d0(o, vb0 + (cur) * (int)SHM_V, pa0, pa1, pa2, pa3); __syncthreads(); } while (0)
  SLOAD(0); asm volatile("s_waitcnt vmcnt(0)" ::: "memory"); SWRITE(0); __syncthreads();
  SLOAD(1);
  for (int j = 0; j < NT; j += 2) { TILE(0, j); TILE(1, j + 1); }
#undef TILE
#if EN_ATTEPI
  { auto rr = __builtin_amdgcn_permlane32_swap(__float_as_uint(l_reg), __float_as_uint(l_reg), false, false); l_reg = __uint_as_float(rr[0]) + __uint_as_float(rr[1]); }
  if (hi == 0) li_l[r32] = l_reg;
  asm volatile("s_waitcnt lgkmcnt(0)" ::: "memory");
  const float fm = map ? lam : 1.f;
#pragma unroll
  for (int r = 0; r < 16; ++r) { const float rl = __builtin_amdgcn_rcpf(li_l[crow(r, hi)]) * fm;
#pragma unroll
    for (int d0 = 0; d0 < 4; ++d0) o[d0][r] *= rl; }
  __syncthreads();
  float* X = (float*)lds + qsub * 4096 + lane;
  if (map == 1) {
#pragma unroll
    for (int d0 = 0; d0 < 4; ++d0)
#pragma unroll
      for (int r = 0; r < 16; ++r) X[(d0 * 16 + r) * 64] = o[d0][r];
  }
  __syncthreads();
  if (map == 0) {
    float sg[4];
#pragma unroll
    for (int d0 = 0; d0 < 4; ++d0) sg[d0] = subg[d0 * 32 + r32] * oscale;
    bf16* Ow = Oh + (qrow0 + qsub * 32) * 1024 + r32;
#pragma unroll
    for (int r = 0; r < 16; ++r) {
      float ss = 0.f;
#pragma unroll
      for (int d0 = 0; d0 < 4; ++d0) { o[d0][r] -= X[(d0 * 16 + r) * 64]; ss += o[d0][r] * o[d0][r]; }
      ss += __shfl_xor(ss, 1); ss += __shfl_xor(ss, 2); ss += __shfl_xor(ss, 4); ss += __shfl_xor(ss, 8); ss += __shfl_xor(ss, 16);
      const float rn = 1.0f / sqrtf(ss * (1.0f / 128.0f) + 1e-6f);
      const int orow = crow(r, hi);
#pragma unroll
      for (int d0 = 0; d0 < 4; ++d0) { const unsigned w = cvtpk(o[d0][r] * rn * sg[d0], 0.f); Ow[(long)orow * 1024 + d0 * 32] = (bf16)(w & 0xffffu); }
    }
  }
  __syncthreads();
#else
  { float s = l_reg; for (int d0 = 0; d0 < 4; ++d0) for (int r = 0; r < 16; ++r) s += o[d0][r]; Oh[qrow0 * 1024 + tid] = (bf16)(int)s; }
#endif
#undef KROW
#undef SLOAD
#undef SWRITE
}
#undef KSWZ
#undef SBAR
}
#ifndef EN_ALL
#define EN_ALL 1
#endif
#ifndef EN_PH0
#define EN_PH0 EN_ALL
#endif
#ifndef EN_PH1
#define EN_PH1 EN_ALL
#endif
#ifndef EN_P1
#define EN_P1 EN_ALL
#endif
#ifndef EN_P2A
#define EN_P2A EN_ALL
#endif
#ifndef EN_P2B
#define EN_P2B EN_ALL
#endif
#ifndef EN_P3
#define EN_P3 EN_ALL
#endif
#ifndef EN_P4
#define EN_P4 EN_ALL
#endif
#ifndef EN_P5
#define EN_P5 EN_ALL
#endif
#ifndef EN_ATT
#define EN_ATT 1
#endif
#ifndef EN_DFT
#define EN_DFT 1
#endif
#ifndef EN_ATTC
#define EN_ATTC 1
#endif
constexpr int NWAVES = 8;
constexpr int DM = 1024, NBATCH = 8, SEQ = 2048, CTXL = 256, M_LAT = NBATCH * SEQ, M_CTX = NBATCH * CTXL, M_ALL = M_LAT + M_CTX, NIN = 2560, NINSRC = 2048, FFD = 2816, NGU = 5632, NLAYER = 2;
constexpr size_t MiB = 1u << 20;
constexpr size_t WS_CTL = 0, CTL_ZERO_BYTES = 1 * MiB;
constexpr size_t WS_MOD = 1 * MiB;
constexpr size_t WS_BIN = WS_MOD + 512 * 1024;
constexpr size_t WS_BGU = WS_BIN + 256 * 1024;
constexpr size_t WS_ROPE = WS_BGU + 512 * 1024;
constexpr size_t WS_DFT = WS_ROPE + 512 * 1024;
constexpr size_t WS_TF = 4 * MiB;
constexpr size_t WS_SSQ = 5 * MiB;
constexpr size_t WS_WIN = 8 * MiB;
constexpr size_t WS_WOUT = 18 * MiB;
constexpr size_t WS_WGU = 22 * MiB;
constexpr size_t WS_WDN = 44 * MiB;
constexpr size_t WS_A = 56 * MiB;
constexpr size_t WS_XC = 92 * MiB;
constexpr size_t WS_QB = 100 * MiB, WS_KB = 118 * MiB, WS_VB = 136 * MiB;
constexpr size_t WS_Y = 154 * MiB;
constexpr size_t WS_TC = 186 * MiB;
constexpr size_t WS_MIX = 190 * MiB;
constexpr size_t WS_T = WS_MIX;
constexpr size_t WS_H = 100 * MiB;
constexpr size_t WS_END = 226 * MiB;
static_assert(WS_DFT + 256 * 512 * 2 <= WS_TF && WS_SSQ + (size_t)M_ALL * 64 <= WS_WIN && WS_H + (size_t)M_ALL * FFD * 2 <= WS_END && WS_MIX + (size_t)M_ALL * DM * 2 <= WS_END, "d_ws map");
constexpr int CW_TMO = 0, CW_BAR = 4096;
constexpr int RING_BYTES = 131072, RTAB_OFF = RING_BYTES, RTAB_BYTES = 8192, LDSCTL_OFF = RTAB_OFF + RTAB_BYTES, MISC_OFF = LDSCTL_OFF + 320, LDS_BYTES = 147456;
static_assert(MISC_OFF + 128 <= LDS_BYTES, "LDS map");
constexpr int N_PHASES = 2 + 6 * NLAYER;

#define GAS __attribute__((address_space(1)))
#define LAS __attribute__((address_space(3)))
typedef unsigned short bf16;
typedef unsigned v4u __attribute__((ext_vector_type(4)));
typedef unsigned v2u __attribute__((ext_vector_type(2)));
typedef float f32x4 __attribute__((ext_vector_type(4)));
#define LDS_WAIT() asm volatile("s_waitcnt lgkmcnt(0)" ::: "memory")
#define VM_WAIT() asm volatile("s_waitcnt vmcnt(0)" ::: "memory")
__device__ __forceinline__ unsigned f2bf(float f) { unsigned u = __builtin_bit_cast(unsigned, f); return (u + 0x7fffu + ((u >> 16) & 1u)) >> 16; }
__device__ __forceinline__ unsigned pk2(float lo, float hi) { return f2bf(lo) | (f2bf(hi) << 16); }
__device__ __forceinline__ float bf2f(unsigned short h) { return __builtin_bit_cast(float, (unsigned)h << 16); }
__device__ __forceinline__ float wave_sum(float v) {
#pragma unroll
    for (int o = 1; o < 64; o <<= 1) v += __shfl_xor(v, o);
    return v;
}

#define XB_TMO      128
#define XB_XCNT(j)  (256  + 64 * (j))
#define XB_XSUB(j)  (1280 + 64 * (j))
#define XB_XGEN(j)  (2304 + 64 * (j))
#define XB_TOP      3328
#define XB_TOPGEN   3392
#define XCD_BAR_WORDS 3456
#define XB_SPIN_CAP (1u << 18)

__device__ __forceinline__ unsigned xb_ld(unsigned* p)              { return __hip_atomic_load(p, __ATOMIC_RELAXED, __HIP_MEMORY_SCOPE_AGENT); }
__device__ __forceinline__ unsigned xb_add(unsigned* p, unsigned v) { return __hip_atomic_fetch_add(p, v, __ATOMIC_RELAXED, __HIP_MEMORY_SCOPE_AGENT); }
__device__ __forceinline__ unsigned xb_xcc_id() { return (unsigned)__builtin_amdgcn_s_getreg((3 << 11) | 20) & 0xFu; }
#define XB_SPIN(cond, bar) do { unsigned _sp = 0; while (cond) { __builtin_amdgcn_s_sleep(1); \
    if ((++_sp & 255u) == 0u) { if (xb_ld(&(bar)[XB_TMO])) break; if (_sp > XB_SPIN_CAP) { atomicAdd(&(bar)[XB_TMO], 1u); break; } } } } while (0)

struct XcdBarrier {
    unsigned* bar; unsigned x;
    volatile LAS unsigned* st;
};

__device__ __forceinline__ XcdBarrier xcd_barrier_post(unsigned* bar, volatile LAS unsigned* st) {
    XcdBarrier b; b.bar = bar; b.x = xb_xcc_id(); b.st = st;
    if (threadIdx.x == 0) (void)xb_add(&bar[XB_XCNT(b.x)], 1u);
    return b;
}
__device__ __forceinline__ void xcd_barrier_complete(unsigned* bar, unsigned x, unsigned& nloc, unsigned& nx) {
    const unsigned G = gridDim.x * gridDim.y * gridDim.z;
    unsigned sum, cnt, mine, sp = 0u;
    for (;;) {
        sum = 0u; cnt = 0u; mine = 0u;
#pragma unroll
        for (unsigned j = 0; j < 16; ++j) { const unsigned c = xb_ld(&bar[XB_XCNT(j)]); sum += c; cnt += (c > 0u) ? 1u : 0u; mine = (j == x) ? c : mine; }
        if (sum == G) break;
        __builtin_amdgcn_s_sleep(1);
        if ((++sp & 255u) == 0u) { if (xb_ld(&bar[XB_TMO])) break; if (sp > XB_SPIN_CAP) { atomicAdd(&bar[XB_TMO], 1u); break; } }
    }
    nloc = mine > 0u ? mine : 1u; nx = cnt > 0u ? cnt : 1u;
}

__device__ __forceinline__ void xcd_barrier(const XcdBarrier& b) {
    asm volatile("s_waitcnt vmcnt(0)" ::: "memory");
    __syncthreads();
    if (threadIdx.x == 0) {
        unsigned* bar = b.bar;
        __builtin_amdgcn_s_waitcnt(0);
        unsigned nloc = b.st[0], nx = b.st[1];
        if (nloc == 0u) { xcd_barrier_complete(bar, b.x, nloc, nx); b.st[0] = nloc; b.st[1] = nx; }
        const unsigned old = xb_add(&bar[XB_XSUB(b.x)], 1u);
        const unsigned gen = old / nloc;
        if (old + 1u == (gen + 1u) * nloc) {
            __builtin_amdgcn_fence(__ATOMIC_RELEASE, "agent");
            asm volatile("s_waitcnt vmcnt(0)" ::: "memory");
            const unsigned og = xb_add(&bar[XB_TOP], 1u);
            const unsigned tg = og / nx;
            if (og + 1u == (tg + 1u) * nx) xb_add(&bar[XB_TOPGEN], 1u);
            else XB_SPIN(xb_ld(&bar[XB_TOPGEN]) == tg, bar);
            __builtin_amdgcn_fence(__ATOMIC_ACQUIRE, "agent");
            xb_add(&bar[XB_XGEN(b.x)], 1u);
            asm volatile("s_waitcnt vmcnt(0)" ::: "memory");
        } else {
            XB_SPIN(xb_ld(&bar[XB_XGEN(b.x)]) == gen, bar);
            __builtin_amdgcn_fence(__ATOMIC_ACQUIRE, "agent");
            asm volatile("s_waitcnt vmcnt(0)" ::: "memory");
        }
    }
    __syncthreads();
}


struct Args { const float* in[21]; float* out; unsigned char* ws; int ph_lo, ph_hi; };
struct Frame {
    LAS unsigned char* lds; int wave, vcu, G;
};

__device__ __forceinline__ void transpose_item(const float* W, int ldn, bf16* WT, int ldk, int k0, int n0, int drow0, LAS float* scr, int lane) {
#pragma unroll 8
    for (int i = 0; i < 32; ++i) { const int kk = 2 * i + (lane >> 5); scr[kk * 33 + (lane & 31)] = W[(size_t)(k0 + kk) * ldn + n0 + (lane & 31)]; }
    LDS_WAIT(); asm volatile("" ::: "memory");
    const int c = lane & 7;
#pragma unroll
    for (int j = 0; j < 4; ++j) { const int n = (lane >> 3) + 8 * j; const LAS float* s = scr + (8 * c) * 33 + n;
        v4u o; o.x = pk2(s[0 * 33], s[1 * 33]); o.y = pk2(s[2 * 33], s[3 * 33]); o.z = pk2(s[4 * 33], s[5 * 33]); o.w = pk2(s[6 * 33], s[7 * 33]);
        *(GAS v4u*)(WT + (size_t)(drow0 + n) * ldk + k0 + 8 * c) = o; }
    LDS_WAIT(); asm volatile("" ::: "memory");
}
__device__ __forceinline__ void ph0(Frame& F, const Args& A, unsigned char* ws) {
    LAS float* scr = (LAS float*)(F.lds + F.wave * 16384);
    const int gw = F.vcu * NWAVES + F.wave, NGW = F.G * NWAVES;
    constexpr int I_IN = 16 * 48, I_OUT = 16 * 32, I_G = 16 * 88, I_D = 44 * 32, I_LAYER = I_IN + I_OUT + 2 * I_G + I_D;
    for (int it = gw; it < NLAYER * I_LAYER; it += NGW) {
        const int l = it / I_LAYER; int r = it % I_LAYER;
        if (r < I_IN) { const int kb = r / 48, nb = r % 48, n0 = nb * 32, pn = n0 >> 8, cc = n0 & 255; const int drow = pn < 4 ? pn * 256 + ((cc >> 5) & 1) * 128 + (cc >> 6) * 32 : n0;
            transpose_item(A.in[8] + (size_t)l * DM * NINSRC, NINSRC, (bf16*)(ws + WS_WIN) + (size_t)l * NIN * DM, DM, kb * 64, n0, drow, scr, ((int)threadIdx.x & 63)); continue; } r -= I_IN;
        if (r < I_OUT) { const int kb = r / 32, nb = r % 32; transpose_item(A.in[17] + (size_t)l * DM * DM, DM, (bf16*)(ws + WS_WOUT) + (size_t)l * DM * DM, DM, kb * 64, nb * 32, nb * 32, scr, ((int)threadIdx.x & 63)); continue; } r -= I_OUT;
        if (r < 2 * I_G) { const int up = r >= I_G; if (up) r -= I_G; const int kb = r / 88, nb = r % 88, n0 = nb * 32; const int drow = (n0 >> 7) * 256 + up * 128 + (n0 & 127);
            transpose_item((up ? A.in[19] : A.in[18]) + (size_t)l * DM * FFD, FFD, (bf16*)(ws + WS_WGU) + (size_t)l * NGU * DM, DM, kb * 64, n0, drow, scr, ((int)threadIdx.x & 63)); continue; } r -= 2 * I_G;
        { const int kb = r / 32, nb = r % 32; transpose_item(A.in[20] + (size_t)l * FFD * DM, DM, (bf16*)(ws + WS_WDN) + (size_t)l * DM * FFD, FFD, kb * 64, nb * 32, nb * 32, scr, ((int)threadIdx.x & 63)); }
    }
    __syncthreads();
    LAS float* sl = (LAS float*)F.lds;
    LAS float* red = (LAS float*)(F.lds + 40960);
    for (int i = ((int)threadIdx.x); i < 9 * DM; i += NWAVES * 64) { const int j = i >> 10, k = i & 1023; const float v = (j < 8) ? A.in[1][j * DM + k] : A.in[3][k]; sl[i] = v / (1.f + __expf(-v)); }
    __syncthreads();
    for (int it = F.vcu; it < NLAYER * 96; it += F.G) {
        const int l = it / 96, n = (it % 96) * 64 + ((int)threadIdx.x & 63); const float* W = A.in[4] + (size_t)l * DM * 6144 + n;
        float acc[9];
#pragma unroll
        for (int j = 0; j < 9; ++j) acc[j] = 0.f;
        const int kb = F.wave * 128;
#pragma unroll 4
        for (int k = 0; k < 128; k += 4) { float w0 = W[(size_t)(kb + k) * 6144], w1 = W[(size_t)(kb + k + 1) * 6144], w2 = W[(size_t)(kb + k + 2) * 6144], w3 = W[(size_t)(kb + k + 3) * 6144];
#pragma unroll
            for (int j = 0; j < 9; ++j) { const f32x4 s = *(const LAS f32x4*)(sl + j * DM + kb + k); acc[j] += s[0] * w0 + s[1] * w1 + s[2] * w2 + s[3] * w3; } }
#pragma unroll
        for (int j = 0; j < 9; ++j) red[(F.wave * 9 + j) * 64 + ((int)threadIdx.x & 63)] = acc[j];
        __syncthreads();
        for (int i = ((int)threadIdx.x); i < 9 * 64; i += NWAVES * 64) { const int j = i >> 6, ln = i & 63; float s = 0.f;
#pragma unroll
            for (int w = 0; w < 8; ++w) s += red[(w * 9 + j) * 64 + ln];
            const int nn = (it % 96) * 64 + ln; ((float*)(ws + WS_MOD))[(l * 9 + j) * 6144 + nn] = s + A.in[5][l * 6144 + nn]; }
        __syncthreads();
    }
    const int gt = F.vcu * (NWAVES * 64) + ((int)threadIdx.x), NGT = F.G * NWAVES * 64;
    for (int i = gt; i < 2048 * 32; i += NGT) { const int pos = i >> 5, j = i & 31; const float inv = powf(10000.0f, -(float)(j & 15) * (1.0f / 16.0f)); const float ang = (float)((j < 16) ? (pos >> 6) : (pos & 63)) * inv;
        float sn, cs; sincosf(ang, &sn, &cs); ((float*)(ws + WS_ROPE))[i] = cs; ((float*)(ws + WS_ROPE))[65536 + i] = sn; }
    for (int i = gt; i < 256 * 512; i += NGT) { const int m = i >> 9, kk = i & 511, n = kk & 255; const int p = (m * n) & 255; float sn, cs; sincospif((float)p * (1.0f / 128.0f), &sn, &cs);
        ((bf16*)(ws + WS_DFT))[i] = (bf16)f2bf(kk < 256 ? cs : sn); }
    for (int i = gt; i < NLAYER * 4 * 128 * 256; i += NGT) { const int d = i & 127, ri = (i >> 7) & 1, cch = (i >> 8) & 127, lg = i >> 15; const float* w = A.in[16] + (size_t)lg * 128 * 128 + d; float s = 0.f;
        for (int c2 = 0; c2 < 128; ++c2) { const int p = (cch * c2) & 127; float sn, cs; sincospif((float)p * (1.0f / 64.0f), &sn, &cs); s += (ri ? -sn : cs) * w[c2 * 128]; }
        ((float*)(ws + WS_TF))[i] = s; }
}
__device__ __forceinline__ void ph1(Frame& F, const Args& A, unsigned char* ws) {
    const float* mod = (const float*)(ws + WS_MOD);
    { const int gw = F.vcu * NWAVES + F.wave, NGW = F.G * NWAVES;
      for (int row = gw; row < M_ALL; row += NGW) {
          const bool lat = row < M_LAT; const int bm = lat ? (row >> 11) : 8; const float* xr = lat ? A.in[0] + (size_t)row * DM : A.in[2] + (size_t)(row - M_LAT) * DM;
          const float* sc = mod + bm * 6144 + 1024; float s = 0.f; f32x4 v[4];
#pragma unroll
          for (int j = 0; j < 4; ++j) { v[j] = *(const f32x4*)(xr + 256 * j + 4 * ((int)threadIdx.x & 63)); s += (v[j][0] * v[j][0] + v[j][1] * v[j][1]) + (v[j][2] * v[j][2] + v[j][3] * v[j][3]); }
          s = wave_sum(s);
          bf16* ar = (bf16*)(ws + WS_A) + (size_t)row * DM;
#pragma unroll
          for (int j = 0; j < 4; ++j) { const int k = 256 * j + 4 * ((int)threadIdx.x & 63); const f32x4 g = *(const f32x4*)(A.in[6] + k) * (*(const f32x4*)(sc + k) + 1.0f); const f32x4 a = v[j] * g; v2u w; w.x = pk2(a[0], a[1]); w.y = pk2(a[2], a[3]); *(v2u*)(ar + k) = w; }
          if (((int)threadIdx.x & 63) < 16) ((float*)(ws + WS_SSQ))[(size_t)row * 16 + ((int)threadIdx.x & 63)] = ((int)threadIdx.x & 63) == 0 ? s : 0.f;
      } }
    __syncthreads();
    { LAS float* wl = (LAS float*)F.lds;
      LAS float* tl = (LAS float*)(F.lds + 128 * 132 * 4);
      for (int it = F.vcu; it < NLAYER * 4 * 4 * 8; it += F.G) {
          const int kb = it & 7, q = (it >> 3) & 3, g = (it >> 5) & 3, l = it >> 7;
          const float* wsrc = A.in[8] + (size_t)l * DM * NINSRC + (size_t)(kb * 128) * NINSRC + 1536 + g * 128;
          for (int i = ((int)threadIdx.x); i < 128 * 32; i += NWAVES * 64) { const int k = i >> 5, c4 = (i & 31) * 4; *(LAS f32x4*)(wl + k * 132 + c4) = *(const f32x4*)(wsrc + (size_t)k * NINSRC + c4); }
          const float* tsrc = (const float*)(ws + WS_TF) + (size_t)(l * 4 + g) * 128 * 256 + q * 64;
          for (int i = ((int)threadIdx.x); i < 128 * 16; i += NWAVES * 64) { const int cch = i >> 4, d4 = (i & 15) * 4; *(LAS f32x4*)(tl + cch * 64 + d4) = *(const f32x4*)(tsrc + (size_t)cch * 256 + d4); }
          __syncthreads();
          const int dcol = ((int)threadIdx.x) & 63, kg = ((int)threadIdx.x) >> 6; float acc[16];
#pragma unroll
          for (int i = 0; i < 16; ++i) acc[i] = 0.f;
          for (int c4 = 0; c4 < 128; c4 += 4) { const float t0 = tl[c4 * 64 + dcol], t1 = tl[(c4 + 1) * 64 + dcol], t2 = tl[(c4 + 2) * 64 + dcol], t3 = tl[(c4 + 3) * 64 + dcol];
#pragma unroll
              for (int i = 0; i < 16; ++i) { const f32x4 w = *(const LAS f32x4*)(wl + (kg * 16 + i) * 132 + c4); acc[i] += w[0] * t0 + w[1] * t1 + w[2] * t2 + w[3] * t3; } }
          bf16* dst = (bf16*)(ws + WS_WIN) + (size_t)l * NIN * DM + (size_t)(1536 + g * 256 + q * 64 + dcol) * DM + kb * 128 + kg * 16;
          v4u o0, o1; o0.x = pk2(acc[0], acc[1]); o0.y = pk2(acc[2], acc[3]); o0.z = pk2(acc[4], acc[5]); o0.w = pk2(acc[6], acc[7]); o1.x = pk2(acc[8], acc[9]); o1.y = pk2(acc[10], acc[11]); o1.z = pk2(acc[12], acc[13]); o1.w = pk2(acc[14], acc[15]);
          *(v4u*)dst = o0; *(v4u*)(dst + 8) = o1;
          __syncthreads();
      } }
    { LAS float* sh = (LAS float*)F.lds;
      const int gw = F.vcu * NWAVES + F.wave, NGW = F.G * NWAVES;
      for (int st = 0; st < 2 * NLAYER; ++st) {
          const int l = st >> 1, gu = st & 1;
          for (int i = ((int)threadIdx.x); i < 9 * DM; i += NWAVES * 64) sh[i] = mod[(l * 9 + (i >> 10)) * 6144 + (gu ? 3072 : 0) + (i & 1023)];
          __syncthreads();
          const int nrow = gu ? NGU : 1536; const bf16* WT = gu ? (const bf16*)(ws + WS_WGU) + (size_t)l * NGU * DM : (const bf16*)(ws + WS_WIN) + (size_t)l * NIN * DM;
          float* bo = gu ? (float*)(ws + WS_BGU) + l * 9 * NGU : (float*)(ws + WS_BIN) + l * 9 * NIN; const int ldb = gu ? NGU : NIN;
          for (int n = gw; n < nrow; n += NGW) {
              float wv[16]; { const v4u a = *(const v4u*)(WT + (size_t)n * DM + ((int)threadIdx.x & 63) * 16), b = *(const v4u*)(WT + (size_t)n * DM + ((int)threadIdx.x & 63) * 16 + 8);
                  const unsigned u[8] = {a.x, a.y, a.z, a.w, b.x, b.y, b.z, b.w};
#pragma unroll
                  for (int i = 0; i < 8; ++i) { wv[2 * i] = __builtin_bit_cast(float, u[i] << 16); wv[2 * i + 1] = __builtin_bit_cast(float, u[i] & 0xffff0000u); } }
#pragma unroll
              for (int j = 0; j < 9; ++j) { float s = 0.f;
#pragma unroll
                  for (int i4 = 0; i4 < 4; ++i4) { const f32x4 sv = *(const LAS f32x4*)(sh + j * DM + ((int)threadIdx.x & 63) * 16 + i4 * 4); s += sv[0] * wv[4 * i4] + sv[1] * wv[4 * i4 + 1] + sv[2] * wv[4 * i4 + 2] + sv[3] * wv[4 * i4 + 3]; }
                  s = wave_sum(s); if (((int)threadIdx.x & 63) == 0) bo[j * ldb + n] = s; }
          }
          __syncthreads();
      } }
    if (F.vcu < NLAYER * 4) {
        const int l = F.vcu >> 2, g = F.vcu & 3; LAS float* sh = (LAS float*)F.lds; LAS float* part = (LAS float*)(F.lds + 36864); LAS float* bf = (LAS float*)(F.lds + 36864 + 4 * 9 * 128 * 4);
        for (int i = ((int)threadIdx.x); i < 9 * DM; i += NWAVES * 64) sh[i] = mod[(l * 9 + (i >> 10)) * 6144 + (i & 1023)];
        __syncthreads();
        { const int col = ((int)threadIdx.x) & 127, kq = ((int)threadIdx.x) >> 7; const float* w = A.in[8] + (size_t)l * DM * NINSRC + 1536 + g * 128 + col; float acc[9];
#pragma unroll
          for (int j = 0; j < 9; ++j) acc[j] = 0.f;
          for (int k = kq * 256; k < kq * 256 + 256; ++k) { const float wv = w[(size_t)k * NINSRC];
#pragma unroll
              for (int j = 0; j < 9; ++j) acc[j] += sh[j * DM + k] * wv; }
#pragma unroll
          for (int j = 0; j < 9; ++j) part[(kq * 9 + j) * 128 + col] = acc[j]; }
        __syncthreads();
        for (int i = ((int)threadIdx.x); i < 9 * 128; i += NWAVES * 64) bf[i] = part[i] + part[9 * 128 + i] + part[2 * 9 * 128 + i] + part[3 * 9 * 128 + i];
        __syncthreads();
        if (((int)threadIdx.x) < 256) { const float* tf = (const float*)(ws + WS_TF) + (size_t)(l * 4 + g) * 128 * 256 + ((int)threadIdx.x); float acc[9];
#pragma unroll
            for (int j = 0; j < 9; ++j) acc[j] = 0.f;
            for (int cch = 0; cch < 128; ++cch) { const float t = tf[cch * 256];
#pragma unroll
                for (int j = 0; j < 9; ++j) acc[j] += bf[j * 128 + cch] * t; }
#pragma unroll
            for (int j = 0; j < 9; ++j) ((float*)(ws + WS_BIN))[(l * 9 + j) * NIN + 1536 + g * 256 + ((int)threadIdx.x)] = acc[j]; }
        __syncthreads();
    }
}
__device__ __forceinline__ void fft8(float (&xr)[8], float (&xi)[8]) {
    const float S = 0.70710678118654752f;
    const float u0r = xr[0] + xr[4], u0i = xi[0] + xi[4], d0r = xr[0] - xr[4], d0i = xi[0] - xi[4];
    const float u1r = xr[1] + xr[5], u1i = xi[1] + xi[5], d1r = xr[1] - xr[5], d1i = xi[1] - xi[5];
    const float u2r = xr[2] + xr[6], u2i = xi[2] + xi[6], d2r = xr[2] - xr[6], d2i = xi[2] - xi[6];
    const float u3r = xr[3] + xr[7], u3i = xi[3] + xi[7], d3r = xr[3] - xr[7], d3i = xi[3] - xi[7];
    const float v0r = d0r, v0i = d0i;
    const float v1r = (d1r + d1i) * S, v1i = (d1i - d1r) * S;
    const float v2r = d2i, v2i = -d2r;
    const float v3r = (d3i - d3r) * S, v3i = -(d3r + d3i) * S;
    { const float p0r = u0r + u2r, p0i = u0i + u2i, p1r = u1r + u3r, p1i = u1i + u3i, p2r = u0r - u2r, p2i = u0i - u2i, qr = u1r - u3r, qi = u1i - u3i; const float p3r = qi, p3i = -qr;
      xr[0] = p0r + p1r; xi[0] = p0i + p1i; xr[4] = p0r - p1r; xi[4] = p0i - p1i; xr[2] = p2r + p3r; xi[2] = p2i + p3i; xr[6] = p2r - p3r; xi[6] = p2i - p3i; }
    { const float p0r = v0r + v2r, p0i = v0i + v2i, p1r = v1r + v3r, p1i = v1i + v3i, p2r = v0r - v2r, p2i = v0i - v2i, qr = v1r - v3r, qi = v1i - v3i; const float p3r = qi, p3i = -qr;
      xr[1] = p0r + p1r; xi[1] = p0i + p1i; xr[5] = p0r - p1r; xi[5] = p0i - p1i; xr[3] = p2r + p3r; xi[3] = p2i + p3i; xr[7] = p2r - p3r; xi[7] = p2i - p3i; }
}
__device__ __forceinline__ void butterfly_phase(Frame& F, unsigned char* ws) {
    const bf16* T = (const bf16*)(ws + WS_T); bf16* Y = (bf16*)(ws + WS_Y);
    int tid_ = threadIdx.x; asm volatile("" : "+v"(tid_));
    const int gt = F.vcu * (NWAVES * 64) + tid_, NGT = F.G * NWAVES * 64;
    for (int it = gt; it < NBATCH * 512 * 128; it += NGT) {
        const int n0 = (it & 127) * 2, bc = it >> 7; const bf16* tp = T + (size_t)bc * 2 * 2048 + n0;
        unsigned pr[8], pi[8];
        pr[0] = *(const unsigned*)(tp); pr[1] = *(const unsigned*)(tp + 256); pr[2] = *(const unsigned*)(tp + 512); pr[3] = *(const unsigned*)(tp + 768);
        pr[4] = *(const unsigned*)(tp + 1024); pr[5] = *(const unsigned*)(tp + 1280); pr[6] = *(const unsigned*)(tp + 1536); pr[7] = *(const unsigned*)(tp + 1792);
        pi[0] = *(const unsigned*)(tp + 2048); pi[1] = *(const unsigned*)(tp + 2304); pi[2] = *(const unsigned*)(tp + 2560); pi[3] = *(const unsigned*)(tp + 2816);
        pi[4] = *(const unsigned*)(tp + 3072); pi[5] = *(const unsigned*)(tp + 3328); pi[6] = *(const unsigned*)(tp + 3584); pi[7] = *(const unsigned*)(tp + 3840);
        float ar[8], ai[8], br[8], bi[8];
#define BF_UNP(k) ar[k] = __builtin_bit_cast(float, pr[k] << 16); br[k] = __builtin_bit_cast(float, pr[k] & 0xffff0000u); ai[k] = __builtin_bit_cast(float, pi[k] << 16); bi[k] = __builtin_bit_cast(float, pi[k] & 0xffff0000u);
        BF_UNP(0) BF_UNP(1) BF_UNP(2) BF_UNP(3) BF_UNP(4) BF_UNP(5) BF_UNP(6) BF_UNP(7)
#undef BF_UNP
        fft8(ar, ai); fft8(br, bi);
        const int b = bc >> 9, ch = bc & 511;
        bf16* yp = Y + ((size_t)(b * 8) * 512 + ch) * 512 + n0;
        const float th0 = (float)n0 * (1.0f / 1024.0f), th1 = (float)(n0 + 1) * (1.0f / 1024.0f);
#define BF_OUT(r) { float s0, c0, s1, c1; sincospif(th0 * (float)(r), &s0, &c0); sincospif(th1 * (float)(r), &s1, &c1); \
          *(unsigned*)(yp + (size_t)(r) * 512 * 512) = pk2(ar[r] * c0 + ai[r] * s0, br[r] * c1 + bi[r] * s1); *(unsigned*)(yp + (size_t)(r) * 512 * 512 + 256) = pk2(ai[r] * c0 - ar[r] * s0, bi[r] * c1 - br[r] * s1); }
        BF_OUT(0) BF_OUT(1) BF_OUT(2) BF_OUT(3) BF_OUT(4) BF_OUT(5) BF_OUT(6) BF_OUT(7)
#undef BF_OUT
    }
}
template <class S> __device__ __forceinline__ void compute_rtab(Frame& F, unsigned char* ws, const S& sched) {
    LAS float* rt = (LAS float*)(F.lds + RTAB_OFF); pg8::Unit u;
    int tid_ = threadIdx.x; asm volatile("" : "+v"(tid_));
    const int t = tid_ & 255, par = tid_ >> 8;
    for (int i = 0; i < 8 && sched.next(i, u); ++i) if ((i & 1) == par) { const float* p = (const float*)(ws + WS_SSQ) + ((size_t)u.pm * 256 + t) * 16; float s = 0.f;
#pragma unroll
        for (int q = 0; q < 4; ++q) { const f32x4 a = *(const f32x4*)(p + 4 * q); s += (a[0] + a[1]) + (a[2] + a[3]); }
        rt[i * 256 + t] = __builtin_amdgcn_rsqf(s * (1.0f / 1024.0f) + 1e-6f); }
    __syncthreads();
}
__device__ __forceinline__ void attn_phase(Frame& F, const Args& A, unsigned char* ws, int l, char* lds) {
    const float lambda_init = l == 0 ? 0.2f : 0.355509068f;
    const float lam = expf(wave_sum(A.in[11][l * 64 + ((int)threadIdx.x & 63)] * A.in[12][l * 64 + ((int)threadIdx.x & 63)])) - expf(wave_sum(A.in[13][l * 64 + ((int)threadIdx.x & 63)] * A.in[14][l * 64 + ((int)threadIdx.x & 63)])) + lambda_init;
    float gq = fabsf(A.in[9][l * 64 + ((int)threadIdx.x & 63)]), gk = fabsf(A.in[10][l * 64 + ((int)threadIdx.x & 63)]);
#pragma unroll
    for (int o = 1; o < 64; o <<= 1) { gq = fmaxf(gq, __shfl_xor(gq, o)); gk = fmaxf(gk, __shfl_xor(gk, o)); }
    const float negoff = -fmaxf(0.f, 8.0f * 1.4426950408889634f * gq * gk * 1.0001f - 40.0f);
    const att::bf16* QB = (const att::bf16*)(ws + WS_QB); const att::bf16* KB = (const att::bf16*)(ws + WS_KB); const att::bf16* VB = (const att::bf16*)(ws + WS_VB); att::bf16* MIX = (att::bf16*)(ws + WS_MIX);
    const float* subg = A.in[15] + l * 128;
    const int per = (512 + F.G - 1) / F.G;
    for (int u = F.vcu * per; u < (F.vcu + 1) * per && u < 512; ++u) {
        const int qblk = u & 15, bh = u >> 4, b = bh >> 2, h = bh & 3;
        att::attn_unit(QB + h * 128, KB + h * 128, VB + h * 128, MIX + h * 128, (long)b * SEQ + qblk * 128, (long)M_LAT + b * CTXL, 4, (long)b * SEQ, 36, lam, 1.0f - lambda_init, subg, negoff, lds);
    }
#if EN_ATTC
    if (l == 0) for (int u = F.vcu; u < 64; u += F.G) {
        const int qblk = u & 1, bh = u >> 1, b = bh >> 2, h = bh & 3;
        att::attn_unit(QB + h * 128, KB + h * 128, VB + h * 128, MIX + h * 128, (long)M_LAT + b * CTXL + qblk * 128, (long)M_LAT + b * CTXL, 4, 0, 4, lam, 1.0f - lambda_init, subg, negoff, lds);
    }
#endif
}

__global__ void __launch_bounds__(NWAVES * 64, 2) fwd_kernel(const Args args) {
    extern __shared__ __attribute__((aligned(16))) unsigned char lds[];
    Frame F;
    F.lds = (LAS unsigned char*)lds;
    F.wave = __builtin_amdgcn_readfirstlane((int)threadIdx.x >> 6);
    F.G = gridDim.x; { const int bx = blockIdx.x; F.vcu = (F.G % 8 == 0) ? (bx % 8) * (F.G / 8) + bx / 8 : bx; }
    for (int u = ((int)threadIdx.x); u < (LDS_BYTES - LDSCTL_OFF) / 4; u += NWAVES * 64) ((LAS unsigned*)(F.lds + LDSCTL_OFF))[u] = 0u;
    __syncthreads();
    volatile LAS unsigned* MISC = (volatile LAS unsigned*)(F.lds + MISC_OFF);
    XcdBarrier bar = xcd_barrier_post((unsigned*)(args.ws + WS_CTL) + CW_BAR, MISC + 8);
    const int lo = args.ph_lo, hi = args.ph_hi;
#define IN(k) (lo <= (k) && (k) < hi)
#define SEAM(k) do { if (IN((k) + 1)) xcd_barrier(bar); } while (0)
#define PHASE_VARS unsigned char* ws = args.ws; asm volatile("" : "+s"(ws)); const Args& A = args; const pg8::bf16_t* ABUF = (const pg8::bf16_t*)(ws + WS_A); (void)ABUF; (void)A
    const LAS float* rtab = (const LAS float*)(F.lds + RTAB_OFF);
    const int cid = (int)blockIdx.x;
    #if EN_PH0
    if (IN(0)) { PHASE_VARS; ph0(F, A, ws); SEAM(0); }
#endif
    #if EN_PH1
    if (IN(1)) { PHASE_VARS; ph1(F, A, ws); SEAM(1); }
#endif
#pragma unroll 1
    for (int l = 0; l < NLAYER; ++l) {
        const int base = 2 + 6 * l; const int nM = l == 0 ? 72 : 64;
#if EN_P1
        if (IN(base + 0)) {
            PHASE_VARS;
            pg8::Sched2 S; if (l == 0) S.init(72, 10, 0, 0, 0, 0, F.G, cid, 0); else S.init(64, 10, 64, 8, 2, 4, F.G, cid, 0);
            compute_rtab(F, ws, S);
            pg8::Gemm g{ABUF, (const pg8::bf16_t*)(ws + WS_WIN) + (size_t)l * NIN * DM, M_ALL, NIN, DM};
            pg8::EpiIn E{ws, l, A.in[9] + l * 64, A.in[10] + l * 64, rtab};
            pg8::gemm_phase<pg8::EpiIn, pg8::Sched2, true, true>(F.lds, g, S, E);
            SEAM(base + 0);
        }
#endif
#if EN_P2A
        if (IN(base + 1)) { PHASE_VARS; butterfly_phase(F, ws); SEAM(base + 1); }
#endif
#if EN_P2B
        if (IN(base + 2)) {
            PHASE_VARS;
#if EN_ATT
            attn_phase(F, A, ws, l, (char*)lds);
#endif
#if EN_DFT
            pg8::Sched2 S; S.init(1, l == 0 ? 144 : 128, 0, 0, 0, 0, F.G, cid, F.G - 64);
            pg8::Gemm g{(const pg8::bf16_t*)(ws + WS_DFT), (const pg8::bf16_t*)(ws + WS_Y), 256, 36864, 512};
            pg8::EpiDft E{(pg8::bf16_t*)(ws + WS_MIX)};
            pg8::gemm_phase<pg8::EpiDft, pg8::Sched2, true, true>(F.lds, g, S, E);
#endif
            SEAM(base + 2);
        }
#endif
#if EN_P3
        if (IN(base + 3)) {
            PHASE_VARS;
            pg8::Sched2 S; S.init(nM, 4, 0, 0, 0, 0, F.G, cid, 0);
            pg8::Gemm g{(const pg8::bf16_t*)(ws + WS_MIX), (const pg8::bf16_t*)(ws + WS_WOUT) + (size_t)l * DM * DM, M_ALL, DM, DM};
            pg8::EpiRes<true> E{l == 0 ? A.in[0] : A.out, A.in[2], A.out, ws, l * 9 * 6144 + 2048, A.in[7] + l * DM, l * 9 * 6144 + 4096};
            pg8::gemm_phase<pg8::EpiRes<true>, pg8::Sched2, true, true>(F.lds, g, S, E);
            SEAM(base + 3);
        }
#endif
#if EN_P4
        if (IN(base + 4)) {
            PHASE_VARS;
            pg8::Sched2 S; S.init(nM, 22, 0, 0, 0, 0, F.G, cid, 0);
            compute_rtab(F, ws, S);
            pg8::Gemm g{ABUF, (const pg8::bf16_t*)(ws + WS_WGU) + (size_t)l * NGU * DM, M_ALL, NGU, DM};
            pg8::EpiGU E{ws, l, rtab};
            pg8::gemm_phase<pg8::EpiGU, pg8::Sched2, true, true>(F.lds, g, S, E);
            SEAM(base + 4);
        }
#endif
#if EN_P5
        if (IN(base + 5)) {
            PHASE_VARS;
            pg8::Sched2 S; S.init(nM, 4, 0, 0, 0, 0, F.G, cid, 0);
            pg8::Gemm g{(const pg8::bf16_t*)(ws + WS_H), (const pg8::bf16_t*)(ws + WS_WDN) + (size_t)l * DM * FFD, M_ALL, DM, FFD};
            if (l == 0) { pg8::EpiRes<true> E{A.out, (const float*)(ws + WS_XC), A.out, ws, 5120, A.in[6] + DM, 9 * 6144 + 1024};
                pg8::gemm_phase<pg8::EpiRes<true>, pg8::Sched2, true, true>(F.lds, g, S, E); }
            else { pg8::EpiRes<false> E{A.out, (const float*)(ws + WS_XC), A.out, ws, 9 * 6144 + 5120, nullptr, 0};
                pg8::gemm_phase<pg8::EpiRes<false>, pg8::Sched2, true, true>(F.lds, g, S, E); }
            SEAM(base + 5);
        }
#endif
    }
#undef IN
#undef SEAM
}
static_assert(EWS_MOD == WS_MOD && EWS_BIN == WS_BIN && EWS_BGU == WS_BGU && EWS_ROPE == WS_ROPE && EWS_SSQ == WS_SSQ && EWS_A == WS_A && EWS_XC == WS_XC && EWS_QB == WS_QB && EWS_KB == WS_KB && EWS_VB == WS_VB && EWS_TC == WS_TC && EWS_T == WS_T && EWS_H == WS_H, "epilogue offsets vs d_ws map");
#ifndef MK_PER_PHASE
#define MK_PER_PHASE 0
#endif
extern "C" void kernel_launch(void* const* d_in, const int* in_sizes, int n_in, void* d_out, int out_size, void* d_ws, size_t ws_size, hipStream_t stream) {
    static int grid = 0;
    if (grid == 0) {
        if (n_in != 21 || in_sizes[0] != M_LAT * DM || out_size != M_LAT * DM || ws_size < WS_END) { fprintf(stderr, "kernel_launch: unexpected shapes (n_in %d, in0 %d, out %d, ws %zu)\n", n_in, n_in > 0 ? in_sizes[0] : -1, out_size, ws_size); grid = -1; return; }
        int dev = 0, cus = 0, per_cu = 0;
        if (hipGetDevice(&dev) != hipSuccess || hipDeviceGetAttribute(&cus, hipDeviceAttributeMultiprocessorCount, dev) != hipSuccess) { grid = -1; return; }
        if (hipFuncSetAttribute((const void*)fwd_kernel, hipFuncAttributeMaxDynamicSharedMemorySize, LDS_BYTES) != hipSuccess) { fprintf(stderr, "kernel_launch: hipFuncSetAttribute failed\n"); grid = -1; return; }
        if (hipOccupancyMaxActiveBlocksPerMultiprocessor(&per_cu, (const void*)fwd_kernel, NWAVES * 64, LDS_BYTES) != hipSuccess || per_cu < 1) { fprintf(stderr, "kernel_launch: occupancy query reports %d\n", per_cu); }
        (void)hipGetLastError();
        grid = cus;
    }
    if (grid < 0) return;
    (void)hipMemsetAsync((char*)d_ws + WS_CTL, 0, CTL_ZERO_BYTES, stream);
    Args a{};
    for (int i = 0; i < 21; ++i) a.in[i] = (const float*)d_in[i];
    a.out = (float*)d_out; a.ws = (unsigned char*)d_ws;
#if MK_PER_PHASE
    for (int ph = 0; ph < N_PHASES; ++ph) { a.ph_lo = ph; a.ph_hi = ph + 1; hipLaunchKernelGGL(fwd_kernel, dim3(grid), dim3(NWAVES * 64), LDS_BYTES, stream, a); }
#else
    a.ph_lo = 0; a.ph_hi = N_PHASES; hipLaunchKernelGGL(fwd_kernel, dim3(grid), dim3(NWAVES * 64), LDS_BYTES, stream, a);
#endif
    const hipError_t le = hipPeekAtLastError();
    if (le != hipSuccess) fprintf(stderr, "kernel_launch: launch failed: %s\n", hipGetErrorName(le));
}
```

```cpp
#define MK_PER_PHASE 0
#include <hip/hip_runtime.h>
#include <cstdio>
#include <cstdint>
#include <math.h>
constexpr size_t EWS_MOD = 1u << 20, EWS_BIN = EWS_MOD + 512 * 1024, EWS_BGU = EWS_BIN + 256 * 1024, EWS_ROPE = EWS_BGU + 512 * 1024, EWS_SSQ = 5u << 20, EWS_A = 56u << 20, EWS_XC = 92u << 20,
                 EWS_QB = 100u << 20, EWS_KB = 118u << 20, EWS_VB = 136u << 20, EWS_TC = 186u << 20, EWS_T = 190u << 20, EWS_H = 100u << 20;
namespace pg8 {
#define PG8_LAS __attribute__((address_space(3)))
typedef unsigned short bf16_t;
typedef short bf16x8 __attribute__((ext_vector_type(8)));
typedef float f32x4 __attribute__((ext_vector_type(4)));
typedef unsigned u32x4 __attribute__((ext_vector_type(4)));
constexpr int BM = 256, BK = 64, HALF = 128, HTB = HALF * BK * 2  , STAGE_BYTES = 8 * HTB, NXCD = 8, WGM = 8;

__host__ __device__ __forceinline__ int lds_byte(int r, int c) { const int st = (r >> 4) * 2 + (c >> 5), rr = r & 15, cc = c & 31, ob = rr * 64 + cc * 2; return st * 1024 + (ob ^ (((ob >> 9) & 1) << 5)); }
__host__ __device__ __forceinline__ void stage_rc(int b, int& R, int& C) { const int st = b / 1024, sb = b % 1024, swz = sb ^ (((sb >> 9) & 1) << 5); R = (st >> 1) * 16 + swz / 64; C = (st & 1) * 32 + (swz % 64) / 2; }
__host__ __device__ __forceinline__ int perm32(int rho) { const int n = rho >> 4, i = rho & 15; return 8 * (i >> 2) + 4 * n + (i & 3); }

struct Unit { int pm, pn; };
struct Gemm { const bf16_t* A; const bf16_t* Bt; int M, N, K; };

struct StaticOrder {
    int nM, nN, nwg, G, c;
    __host__ __device__ void init(int M, int N, int G_, int c_) { nM = M / BM; nN = N / BM; nwg = nM * nN; G = G_; c = c_; }
    __host__ __device__ bool next(int i, Unit& u) const {
        const long L = (long)i * G + c; if (L >= nwg) return false;
        int wgid = (int)L; { const int q = nwg / NXCD, r = nwg % NXCD, xcd = wgid % NXCD, off = wgid / NXCD; wgid = (xcd < r ? xcd * (q + 1) : r * (q + 1) + (xcd - r) * q) + off; }
        const int nig = WGM * nN, gid = wgid / nig, fm = gid * WGM, gsz = (nM - fm) < WGM ? (nM - fm) : WGM;
        u.pm = fm + ((wgid % nig) % gsz); u.pn = (wgid % nig) / gsz; return true;
    }
    __device__ __forceinline__ void a_ready(const Unit&) const {}
    __device__ __forceinline__ void done(const Unit&) const {}
};

struct Sched2 {
    int nMa, nNa, nA, pmB, nMb, pnB, nNb, nB, G, c;
    __device__ void init(int nMa_, int nNa_, int pmB_, int nMb_, int pnB_, int nNb_, int G_, int c_, int rot) { nMa = nMa_; nNa = nNa_; nA = nMa * nNa; pmB = pmB_; nMb = nMb_; pnB = pnB_; nNb = nNb_; nB = nMb * nNb; G = G_; c = (c_ + rot) % G_; }
    __device__ bool next(int i, Unit& u) const {
        const long L = (long)i * G + c; if (L >= nA + nB) return false;
        if (L < nA) {
            int wgid = (int)L; { const int q = nA / NXCD, r = nA % NXCD, xcd = wgid % NXCD, off = wgid / NXCD; wgid = (xcd < r ? xcd * (q + 1) : r * (q + 1) + (xcd - r) * q) + off; }
            const int nig = WGM * nNa, gid = wgid / nig, fm = gid * WGM, gsz = (nMa - fm) < WGM ? (nMa - fm) : WGM;
            u.pm = fm + ((wgid % nig) % gsz); u.pn = (wgid % nig) / gsz;
        } else { const int r = (int)L - nA; u.pm = pmB + r % nMb; u.pn = pnB + r / nMb; }
        return true;
    }
    __device__ __forceinline__ void a_ready(const Unit&) const {}
    __device__ __forceinline__ void done(const Unit&) const {}
};
__device__ __forceinline__ unsigned cvt_pk_bf16(float lo, float hi) { unsigned r; asm volatile("v_cvt_pk_bf16_f32 %0, %1, %2" : "=v"(r) : "v"(lo), "v"(hi)); return r; }
typedef unsigned u32x2 __attribute__((ext_vector_type(2)));
__device__ __forceinline__ u32x2 pk4(f32x4 v) { u32x2 w; w.x = cvt_pk_bf16(v[0], v[1]); w.y = cvt_pk_bf16(v[2], v[3]); return w; }
__device__ __forceinline__ float dot4(f32x4 v) { return (v[0] * v[0] + v[1] * v[1]) + (v[2] * v[2] + v[3] * v[3]); }
constexpr int M_LAT_TILES = 64;
constexpr float QSCALE = 0.125f * 1.4426950408889634f;
constexpr float ZS_LAT = 1.0f / 512.0f;
constexpr float ZS_CTX = 0.005524271728019903f;

struct EpiIn {
    static constexpr bool PERM = false, AFTER_DRAIN = false;
    unsigned char* ws; int layer; const float* qg; const float* kg; const PG8_LAS float* rtab;
    __device__ __forceinline__ void operator()(const f32x4 (&acc)[2][2][4][2], const Unit& u, int ui, int wr, int wc, int fr, int fq) const {
        const int pm = u.pm, pn = u.pn; const bool lat = pm < M_LAT_TILES; const int bm = lat ? (pm >> 3) : 8;
        const float* bias = (const float*)(ws + EWS_BIN) + layer * 9 * 2560; const float* rope = (const float*)(ws + EWS_ROPE);
        bf16_t* QB = (bf16_t*)(ws + EWS_QB); bf16_t* KB = (bf16_t*)(ws + EWS_KB); bf16_t* VB = (bf16_t*)(ws + EWS_VB); bf16_t* T = (bf16_t*)(ws + EWS_T); bf16_t* Tc = (bf16_t*)(ws + EWS_TC);
        const float* bp = bias + bm * 2560 + pn * 256 + wc * 32 + fq * 4;
        f32x4 bv[2][2];
#pragma unroll
        for (int bj = 0; bj < 2; ++bj)
#pragma unroll
            for (int n = 0; n < 2; ++n) bv[bj][n] = *(const f32x4*)(bp + bj * 128 + n * 16);
        const PG8_LAS float* rt = rtab + ui * 256 + wr * 64 + fr;
        if (pn < 4) {
            const float* gp = (pn < 2 ? qg : kg) + fq * 4; const float qs = pn < 2 ? QSCALE : 1.f;
            f32x4 gv[2][2];
#pragma unroll
            for (int bj = 0; bj < 2; ++bj)
#pragma unroll
                for (int n = 0; n < 2; ++n) gv[bj][n] = *(const f32x4*)(gp + bj * 32 + n * 16) * qs;
            bf16_t* dst = (pn < 2 ? QB : KB) + (pn & 1) * 256 + wc * 64 + fq * 4;
#pragma unroll
            for (int ai = 0; ai < 2; ++ai)
#pragma unroll
                for (int m = 0; m < 4; ++m) {
                    const int rl = ai * 128 + wr * 64 + m * 16 + fr, row = pm * 256 + rl; const float r = rt[ai * 128 + m * 16];
                    f32x4 v[2][2]; float ssq = 0.f;
#pragma unroll
                    for (int bj = 0; bj < 2; ++bj)
#pragma unroll
                        for (int n = 0; n < 2; ++n) { v[bj][n] = acc[ai][bj][m][n] * r + bv[bj][n]; ssq += dot4(v[bj][n]); }
                    ssq += __shfl_xor(ssq, 16); ssq += __shfl_xor(ssq, 32);
                    const float rn = 1.0f / sqrtf(ssq * (1.0f / 64.0f) + 1e-6f);
#pragma unroll
                    for (int bj = 0; bj < 2; ++bj)
#pragma unroll
                        for (int n = 0; n < 2; ++n) v[bj][n] = v[bj][n] * rn * gv[bj][n];
                    if (lat) { const float* cp = rope + (row & 2047) * 32 + fq * 4;
#pragma unroll
                        for (int bj = 0; bj < 2; ++bj) { const f32x4 c4 = *(const f32x4*)(cp + bj * 16), s4 = *(const f32x4*)(cp + 65536 + bj * 16); const f32x4 t1 = v[bj][0], t2 = v[bj][1];
                            v[bj][0] = t1 * c4 - t2 * s4; v[bj][1] = t2 * c4 + t1 * s4; } }
#pragma unroll
                    for (int bj = 0; bj < 2; ++bj)
#pragma unroll
                        for (int n = 0; n < 2; ++n) *(u32x2*)(dst + (size_t)row * 512 + bj * 32 + n * 16) = pk4(v[bj][n]);
                }
        } else if (pn < 6) {
            bf16_t* dst = VB + (pn - 4) * 256 + wc * 32 + fq * 4;
#pragma unroll
            for (int ai = 0; ai < 2; ++ai)
#pragma unroll
                for (int m = 0; m < 4; ++m) {
                    const int rl = ai * 128 + wr * 64 + m * 16 + fr, row = pm * 256 + rl; const float r = rt[ai * 128 + m * 16];
#pragma unroll
                    for (int bj = 0; bj < 2; ++bj)
#pragma unroll
                        for (int n = 0; n < 2; ++n) *(u32x2*)(dst + (size_t)row * 512 + bj * 128 + n * 16) = pk4(acc[ai][bj][m][n] * r + bv[bj][n]);
                }
        } else {
            const int g = pn - 6; const float zs = lat ? ZS_LAT : ZS_CTX;
            const int b = lat ? (pm >> 3) : (pm - M_LAT_TILES); const int L = lat ? 2048 : 256; const int pos0 = lat ? (pm & 7) * 256 : 0;
            bf16_t* tb = (lat ? T : Tc) + (size_t)(b * 512 + g * 128 + wc * 32 + fq * 4) * 2 * L;
#pragma unroll
            for (int ai = 0; ai < 2; ++ai)
#pragma unroll
                for (int m = 0; m < 4; ++m) {
                    const int rl = ai * 128 + wr * 64 + m * 16 + fr, pos = pos0 + rl; const float r = rt[ai * 128 + m * 16];
#pragma unroll
                    for (int bj = 0; bj < 2; ++bj)
#pragma unroll
                        for (int n = 0; n < 2; ++n) { const f32x4 v = (acc[ai][bj][m][n] * r + bv[bj][n]) * zs; const u32x2 w = pk4(v);
                            bf16_t* p = tb + ((size_t)(n * 16) * 2 + bj) * L + pos;
                            p[0] = (bf16_t)(w.x & 0xffffu); p[(size_t)2 * L] = (bf16_t)(w.x >> 16); p[(size_t)4 * L] = (bf16_t)(w.y & 0xffffu); p[(size_t)6 * L] = (bf16_t)(w.y >> 16); }
                }
        }
    }
};
template <bool NEXT> struct EpiRes {
    static constexpr bool PERM = false, AFTER_DRAIN = false;
    const float* xl_in; const float* xc_in; float* xl_out;
    unsigned char* ws; int gate_off;
    const float* ng; int nsc_off;
    __device__ __forceinline__ void operator()(const f32x4 (&acc)[2][2][4][2], const Unit& u, int ui, int wr, int wc, int fr, int fq) const {
        const int pm = u.pm, pn = u.pn; const bool lat = pm < M_LAT_TILES; const int bm = lat ? (pm >> 3) : 8; const int col0 = pn * 256 + wc * 32 + fq * 4;
        const float* gate = (const float*)(ws + EWS_MOD) + gate_off; const float* nsc = (const float*)(ws + EWS_MOD) + nsc_off; bf16_t* A = (bf16_t*)(ws + EWS_A); float* ssq = (float*)(ws + EWS_SSQ); float* xc_out = (float*)(ws + EWS_XC);
        f32x4 ga[2][2], gv[2][2];
#pragma unroll
        for (int bj = 0; bj < 2; ++bj)
#pragma unroll
            for (int n = 0; n < 2; ++n) { const int c = col0 + bj * 128 + n * 16; ga[bj][n] = *(const f32x4*)(gate + bm * 6144 + c);
                if (NEXT) gv[bj][n] = *(const f32x4*)(ng + c) * (*(const f32x4*)(nsc + bm * 6144 + c) + 1.0f); }
        const float* xin = lat ? xl_in + (size_t)pm * 256 * 1024 : xc_in + (size_t)(pm - M_LAT_TILES) * 256 * 1024;
        float* xout = lat ? xl_out + (size_t)pm * 256 * 1024 : xc_out + (size_t)(pm - M_LAT_TILES) * 256 * 1024;
#pragma unroll
        for (int ai = 0; ai < 2; ++ai)
#pragma unroll
            for (int m = 0; m < 4; ++m) {
                const int rl = ai * 128 + wr * 64 + m * 16 + fr; const size_t row = (size_t)pm * 256 + rl; float ssq_ = 0.f;
#pragma unroll
                for (int bj = 0; bj < 2; ++bj)
#pragma unroll
                    for (int n = 0; n < 2; ++n) { const size_t off = (size_t)rl * 1024 + col0 + bj * 128 + n * 16; const f32x4 xo = *(const f32x4*)(xin + off); const f32x4 xn = xo + ga[bj][n] * acc[ai][bj][m][n];
                        *(f32x4*)(xout + off) = xn;
                        if (NEXT) { ssq_ += dot4(xn); *(u32x2*)(A + row * 1024 + col0 + bj * 128 + n * 16) = pk4(xn * gv[bj][n]); } }
                if (NEXT) { ssq_ += __shfl_xor(ssq_, 16); ssq_ += __shfl_xor(ssq_, 32); if (fq == 0) ssq[row * 16 + pn * 4 + wc] = ssq_; }
                asm volatile("" ::: "memory");
            }
    }
};
struct EpiGU {
    static constexpr bool PERM = false, AFTER_DRAIN = false;
    unsigned char* ws; int layer; const PG8_LAS float* rtab;
    __device__ __forceinline__ void operator()(const f32x4 (&acc)[2][2][4][2], const Unit& u, int ui, int wr, int wc, int fr, int fq) const {
        const int pm = u.pm, pn = u.pn; const int bm = pm < M_LAT_TILES ? (pm >> 3) : 8;
        const float* bias = (const float*)(ws + EWS_BGU) + layer * 9 * 5632; bf16_t* H = (bf16_t*)(ws + EWS_H);
        const float* bp = bias + bm * 5632 + pn * 256 + wc * 32 + fq * 4;
        f32x4 bg[2], bu[2];
#pragma unroll
        for (int n = 0; n < 2; ++n) { bg[n] = *(const f32x4*)(bp + n * 16); bu[n] = *(const f32x4*)(bp + 128 + n * 16); }
        const PG8_LAS float* rt = rtab + ui * 256 + wr * 64 + fr;
        bf16_t* dst = H + pn * 128 + wc * 32 + fq * 4;
#pragma unroll
        for (int ai = 0; ai < 2; ++ai)
#pragma unroll
            for (int m = 0; m < 4; ++m) {
                const int rl = ai * 128 + wr * 64 + m * 16 + fr; const size_t row = (size_t)pm * 256 + rl; const float r = rt[ai * 128 + m * 16];
#pragma unroll
                for (int n = 0; n < 2; ++n) { const f32x4 gg = acc[ai][0][m][n] * r + bg[n], uu = acc[ai][1][m][n] * r + bu[n]; f32x4 h;
#pragma unroll
                    for (int i = 0; i < 4; ++i) h[i] = gg[i] * __builtin_amdgcn_rcpf(1.0f + __builtin_amdgcn_exp2f(-1.4426950408889634f * gg[i])) * uu[i];
                    *(u32x2*)(dst + row * 2816 + n * 16) = pk4(h); }
            }
    }
};
struct EpiDft {
    static constexpr bool PERM = true, AFTER_DRAIN = false;
    bf16_t* MIX;
    __device__ __forceinline__ void operator()(const f32x4 (&acc)[2][2][4][2], const Unit& u, int ui, int wr, int wc, int fr, int fq) const {
        const int pn = u.pn;
#pragma unroll
        for (int bj = 0; bj < 2; ++bj) {
            const int c = pn * 256 + bj * 128 + wc * 32 + fq * 8; int rowbase, rstride, ch;
            if (pn < 128) { const int b = c >> 12, r = (c >> 9) & 7; ch = c & 511; rowbase = b * 2048 + r; rstride = 8; }
            else { const int c2 = c - 32768; const int b = c2 >> 9; ch = c2 & 511; rowbase = 16384 + b * 256; rstride = 1; }
#pragma unroll
            for (int ai = 0; ai < 2; ++ai)
#pragma unroll
                for (int m = 0; m < 4; ++m) { const int mm = ai * 128 + wr * 64 + m * 16 + fr; const size_t row = (size_t)rowbase + (size_t)mm * rstride;
                    const f32x4 v0 = acc[ai][bj][m][0], v1 = acc[ai][bj][m][1]; u32x4 w; w.x = cvt_pk_bf16(v0[0], v0[1]); w.y = cvt_pk_bf16(v0[2], v0[3]); w.z = cvt_pk_bf16(v1[0], v1[1]); w.w = cvt_pk_bf16(v1[2], v1[3]);
                    *(u32x4*)(MIX + row * 1024 + 512 + ch) = w; }
        }
    }
};
template <class Epi, class Sched, bool ALIGN_EPI = false, bool SP2 = false>
__device__ __forceinline__ void gemm_phase(PG8_LAS unsigned char* lds, const Gemm g, const Sched& S, const Epi& E) {
    int tid_ = threadIdx.x; asm volatile("" : "+v"(tid_));
    const int tid = tid_, wid = __builtin_amdgcn_readfirstlane(tid >> 6), lane = tid & 63, wr = wid >> 2, wc = wid & 3, fr = lane & 15, fq = lane >> 4;
    const int K = g.K, nt = K / BK;
    unsigned voffA[2], voffB[2];
#pragma unroll
    for (int i = 0; i < 2; ++i) { int R, C; stage_rc(tid * 16 + i * 8192, R, C); const int Rb = Epi::PERM ? ((R & ~31) + perm32(R & 31)) : R;
        voffA[i] = (unsigned)(R * K + C) * 2u; voffB[i] = (unsigned)(Rb * K + C) * 2u; }
    const size_t kstep = (size_t)(BK * 2);
    const size_t hstep = (size_t)HALF * K * 2;
    const size_t tstep = 2 * hstep;
    const unsigned ldsw = (unsigned)wid * 1024u;
    const int aoff = lds_byte(wr * 64 + fr, fq * 8), boff = lds_byte(wc * 32 + fr, fq * 8);
#define PG8_SA(b, h) (((b) * 2 + (h)) * HTB)
#define PG8_SB(b, h) ((4 + (b) * 2 + (h)) * HTB)
#define PG8_STAGE(bufoff, gbase, voff) do { _Pragma("unroll") for (int _i = 0; _i < 2; ++_i) \
        __builtin_amdgcn_global_load_lds((const unsigned*)((const char*)(gbase) + (voff)[_i]), (PG8_LAS unsigned*)(lds + (bufoff) + ldsw + _i * 8192), 16, 0, 0); } while (0)
#define PG8_LDA(dst, b, h) do { _Pragma("unroll") for (int m = 0; m < 4; ++m) _Pragma("unroll") for (int k = 0; k < 2; ++k) dst[m][k] = *(const PG8_LAS bf16x8*)(lds + PG8_SA(b, h) + aoff + m * 2048 + k * 1024); } while (0)
#define PG8_LDB(dst, b, h) do { _Pragma("unroll") for (int n = 0; n < 2; ++n) _Pragma("unroll") for (int k = 0; k < 2; ++k) dst[n][k] = *(const PG8_LAS bf16x8*)(lds + PG8_SB(b, h) + boff + n * 2048 + k * 1024); } while (0)
#define PG8_MMA(ai, bj, At, Bt) do { __builtin_amdgcn_s_setprio(1); _Pragma("unroll") for (int m = 0; m < 4; ++m) _Pragma("unroll") for (int n = 0; n < 2; ++n) _Pragma("unroll") for (int k = 0; k < 2; ++k) \
        acc[ai][bj][m][n] = __builtin_amdgcn_mfma_f32_16x16x32_bf16(Bt[n][k], At[m][k], acc[ai][bj][m][n], 0, 0, 0); __builtin_amdgcn_s_setprio(0); } while (0)
#define PG8_WAIT_V(n) asm volatile("s_waitcnt vmcnt(" #n ")" ::: "memory")
#define PG8_WAIT_L(n) asm volatile("s_waitcnt lgkmcnt(" #n ")" ::: "memory")
#define PG8_BAR __builtin_amdgcn_s_barrier()
#define PG8_SCHED __builtin_amdgcn_sched_barrier(0)
    Unit cur, nxt; int ui = 0;
    if (!S.next(0, cur)) return;
    f32x4 acc[2][2][4][2];
#pragma unroll
    for (int a = 0; a < 2; ++a)
#pragma unroll
        for (int b = 0; b < 2; ++b)
#pragma unroll
            for (int m = 0; m < 4; ++m)
#pragma unroll
                for (int n = 0; n < 2; ++n) acc[a][b][m][n] = (f32x4){0.f, 0.f, 0.f, 0.f};
    bf16x8 At[4][2], B0[2][2], B1[2][2];
    const char* cA = (const char*)g.A + (size_t)cur.pm * tstep; const char* cB = (const char*)g.Bt + (size_t)cur.pn * tstep;
    S.a_ready(cur);
    if constexpr (SP2) {
        PG8_STAGE(PG8_SB(0, 0), cB, voffB); PG8_STAGE(PG8_SB(0, 1), cB + hstep, voffB); PG8_STAGE(PG8_SA(0, 0), cA, voffA); PG8_STAGE(PG8_SA(0, 1), cA + hstep, voffA);
        if (wr == 1) PG8_BAR;
        PG8_WAIT_V(2); PG8_BAR;
        PG8_STAGE(PG8_SB(1, 0), cB + kstep, voffB); PG8_STAGE(PG8_SA(1, 0), cA + kstep, voffA); PG8_STAGE(PG8_SB(1, 1), cB + hstep + kstep, voffB);
        PG8_WAIT_V(6); PG8_BAR;
    } else {
        PG8_STAGE(PG8_SB(0, 0), cB, voffB); PG8_STAGE(PG8_SA(0, 0), cA, voffA); PG8_STAGE(PG8_SB(0, 1), cB + hstep, voffB); PG8_STAGE(PG8_SA(0, 1), cA + hstep, voffA);
        if (wr == 1) PG8_BAR;
        PG8_WAIT_V(4); PG8_BAR;
        PG8_STAGE(PG8_SB(1, 0), cB + kstep, voffB); PG8_STAGE(PG8_SA(1, 0), cA + kstep, voffA); PG8_STAGE(PG8_SB(1, 1), cB + hstep + kstep, voffB);
        PG8_WAIT_V(6); PG8_BAR;
    }
    for (;;) {
        const bool has_next = S.next(ui + 1, nxt);
        const char* nA = has_next ? (const char*)g.A + (size_t)nxt.pm * tstep : cA; const char* nB = has_next ? (const char*)g.Bt + (size_t)nxt.pn * tstep : cB;
        for (int t = 0; t < nt; t += 2) {
            const bool last = (t == nt - 2);
            const char* a1 = cA + (size_t)(t + 1) * kstep;
            const char* a2 = last ? nA : cA + (size_t)(t + 2) * kstep; const char* b2 = last ? nB : cB + (size_t)(t + 2) * kstep;
            const char* a3 = a2 + kstep; const char* b3 = b2 + kstep;
            if (last && has_next) S.a_ready(nxt);
            if constexpr (SP2) {
            PG8_LDB(B0, 0, 0); PG8_LDB(B1, 0, 1); PG8_SCHED; PG8_LDA(At, 0, 0); PG8_STAGE(PG8_SA(1, 1), a1 + hstep, voffA);
            PG8_WAIT_V(8); PG8_WAIT_L(0); PG8_BAR; PG8_MMA(0, 0, At, B0); PG8_MMA(0, 1, At, B1); PG8_BAR; PG8_SCHED;
            PG8_LDA(At, 0, 1); PG8_STAGE(PG8_SB(0, 0), b2, voffB); PG8_STAGE(PG8_SB(0, 1), b2 + hstep, voffB); PG8_STAGE(PG8_SA(0, 0), a2, voffA);
            PG8_WAIT_V(8); PG8_WAIT_L(0); PG8_BAR; PG8_MMA(1, 0, At, B0); PG8_MMA(1, 1, At, B1); PG8_BAR; PG8_SCHED;
            PG8_LDB(B0, 1, 0); PG8_LDB(B1, 1, 1); PG8_SCHED; PG8_LDA(At, 1, 0); PG8_STAGE(PG8_SA(0, 1), a2 + hstep, voffA);
            PG8_WAIT_V(8); PG8_WAIT_L(0); PG8_BAR; PG8_MMA(0, 0, At, B0); PG8_MMA(0, 1, At, B1); PG8_BAR; PG8_SCHED;
            PG8_LDA(At, 1, 1); PG8_STAGE(PG8_SB(1, 0), b3, voffB); PG8_STAGE(PG8_SB(1, 1), b3 + hstep, voffB); PG8_STAGE(PG8_SA(1, 0), a3, voffA);
            PG8_WAIT_V(8); PG8_WAIT_L(0); PG8_BAR; PG8_MMA(1, 0, At, B0); PG8_MMA(1, 1, At, B1); PG8_BAR; PG8_SCHED;
            } else {
            PG8_LDB(B0, 0, 0); PG8_SCHED; PG8_LDA(At, 0, 0); PG8_STAGE(PG8_SA(1, 1), a1 + hstep, voffA);
            PG8_WAIT_L(8); PG8_BAR; PG8_WAIT_L(0); PG8_MMA(0, 0, At, B0); PG8_BAR; PG8_SCHED;
            PG8_LDB(B1, 0, 1); PG8_STAGE(PG8_SB(0, 0), b2, voffB);
            PG8_BAR; PG8_WAIT_L(0); PG8_MMA(0, 1, At, B1); PG8_BAR;
            PG8_LDA(At, 0, 1); PG8_STAGE(PG8_SA(0, 0), a2, voffA);
            PG8_BAR; PG8_WAIT_L(0); PG8_MMA(1, 0, At, B0); PG8_BAR; PG8_SCHED;
            PG8_STAGE(PG8_SB(0, 1), b2 + hstep, voffB);
            PG8_WAIT_V(6); PG8_BAR; PG8_MMA(1, 1, At, B1); PG8_BAR;
            PG8_LDB(B0, 1, 0); PG8_SCHED; PG8_LDA(At, 1, 0); PG8_STAGE(PG8_SA(0, 1), a2 + hstep, voffA);
            PG8_WAIT_L(8); PG8_BAR; PG8_WAIT_L(0); PG8_MMA(0, 0, At, B0); PG8_BAR; PG8_SCHED;
            PG8_LDB(B1, 1, 1); PG8_STAGE(PG8_SB(1, 0), b3, voffB);
            PG8_BAR; PG8_WAIT_L(0); PG8_MMA(0, 1, At, B1); PG8_BAR;
            PG8_LDA(At, 1, 1); PG8_STAGE(PG8_SA(1, 0), a3, voffA);
            PG8_BAR; PG8_WAIT_L(0); PG8_MMA(1, 0, At, B0); PG8_BAR; PG8_SCHED;
            PG8_STAGE(PG8_SB(1, 1), b3 + hstep, voffB);
            PG8_WAIT_V(6); PG8_BAR; PG8_MMA(1, 1, At, B1); PG8_BAR;
            }
        }
        if constexpr (ALIGN_EPI) { if (wr == 0) PG8_BAR; }
        if constexpr (!Epi::AFTER_DRAIN) { E(acc, cur, ui, wr, wc, fr, fq); S.done(cur); }
        if (!has_next) break;
#pragma unroll
        for (int a = 0; a < 2; ++a)
#pragma unroll
            for (int b = 0; b < 2; ++b)
#pragma unroll
                for (int m = 0; m < 4; ++m)
#pragma unroll
                    for (int n = 0; n < 2; ++n) acc[a][b][m][n] = (f32x4){0.f, 0.f, 0.f, 0.f};
        cur = nxt; cA = nA; cB = nB; ++ui;
        if constexpr (ALIGN_EPI) { if (wr == 1) PG8_BAR; }
    }
    PG8_WAIT_V(0);
    if constexpr (!ALIGN_EPI) { if (wr == 0) PG8_BAR; }
    PG8_BAR;
    if constexpr (Epi::AFTER_DRAIN) { E.fused(acc, cur, wr, wc, fr, fq, lds, wid, lane); S.done(cur); }
#undef PG8_SA
#undef PG8_SB
#undef PG8_STAGE
#undef PG8_LDA
#undef PG8_LDB
#undef PG8_MMA
#undef PG8_WAIT_V
#undef PG8_WAIT_L
#undef PG8_BAR
#undef PG8_SCHED
}
}
#ifndef EN_ATTEPI
#define EN_ATTEPI 1
#endif
namespace att {
typedef unsigned short bf16;
using bf16x8 = __attribute__((ext_vector_type(8))) short;
using s16x4  = __attribute__((ext_vector_type(4))) short;
using f32x16 = __attribute__((ext_vector_type(16))) float;
using u32x4  = __attribute__((ext_vector_type(4))) unsigned;
constexpr int KVBLK = 64;
constexpr size_t SHM_V = KVBLK * 128 * 2, SHM_K = KVBLK * 128 * 2, SHM_ATTN = 2 * SHM_V + 2 * SHM_K + 8 * 64 * 4;
#define KSWZ(row, colB) ((row) * 256 + ((colB) ^ (((row) & 7) << 4)))
#define SBAR() __builtin_amdgcn_sched_barrier(0)
__device__ __forceinline__ int crow(int r, int hi) { return (r & 3) + 8 * (r >> 2) + 4 * hi; }
__device__ __forceinline__ unsigned cvtpk(float lo, float hi) { unsigned r; asm volatile("v_cvt_pk_bf16_f32 %0, %1, %2" : "=v"(r) : "v"(lo), "v"(hi)); return r; }
__device__ __forceinline__ bf16x8 ld8(const bf16* p) { return *reinterpret_cast<const bf16x8*>(p); }
__device__ __forceinline__ void sm_first(f32x16& p0, f32x16& p1, float negoff) {
  (void)p1; (void)negoff;
#pragma unroll
  for (int r = 0; r < 16; ++r) p0[r] = __builtin_amdgcn_exp2f(p0[r]);
}
__device__ __forceinline__ void sm_finish(f32x16& p0, f32x16& p1, float& l_reg, bf16x8& pa0, bf16x8& pa1, bf16x8& pa2, bf16x8& pa3) {
#pragma unroll
  for (int r = 0; r < 16; ++r) p1[r] = __builtin_amdgcn_exp2f(p1[r]);
  float ps = 0;
#pragma unroll
  for (int r = 0; r < 16; ++r) ps += p0[r];
#pragma unroll
  for (int r = 0; r < 16; ++r) ps += p1[r];
  l_reg += ps;
#define PK4(P, BASE, OUT) do { unsigned a0 = cvtpk(P[BASE + 0], P[BASE + 1]), a1 = cvtpk(P[BASE + 2], P[BASE + 3]);   \
    unsigned b0 = cvtpk(P[BASE + 4], P[BASE + 5]), b1 = cvtpk(P[BASE + 6], P[BASE + 7]);                              \
    auto r0 = __builtin_amdgcn_permlane32_swap(a0, b0, false, false); auto r1 = __builtin_amdgcn_permlane32_swap(a1, b1, false, false); \
    u32x4 w = {r0[0], r1[0], r0[1], r1[1]}; OUT = *reinterpret_cast<bf16x8*>(&w); } while (0)
  PK4(p0, 0, pa0); PK4(p0, 8, pa1); PK4(p1, 0, pa2); PK4(p1, 8, pa3);
#undef PK4
}
__device__ __forceinline__ void qkt(f32x16& p0, f32x16& p1, const bf16* Ks, const bf16x8* qr, int r32, int hi, int mapoff, float negoff) {
  p0 = f32x16{}; p1 = f32x16{}; (void)negoff;
#pragma unroll
  for (int d0 = 0; d0 < 4; ++d0) { const int cb = (mapoff + d0 * 16 + hi * 8) * 2;
    bf16x8 b0 = *reinterpret_cast<const bf16x8*>((const char*)Ks + KSWZ(r32, cb));
    bf16x8 b1 = *reinterpret_cast<const bf16x8*>((const char*)Ks + KSWZ(32 + r32, cb));
    p0 = __builtin_amdgcn_mfma_f32_32x32x16_bf16(b0, qr[d0], p0, 0, 0, 0);
    p1 = __builtin_amdgcn_mfma_f32_32x32x16_bf16(b1, qr[d0], p1, 0, 0, 0); }
}
__device__ __forceinline__ int v_st(int k, int c) { const int kk = (k & ~0xC) | ((k & 4) << 1) | ((k & 8) >> 1); return ((kk >> 3) * 4 + (c >> 5)) * 512 + ((kk & 7) * 32 + (c & 31)) * 2; }
__device__ __forceinline__ int v_rd_base(int lane) { return ((lane & 3) << 3) | (((lane >> 2) & 3) << 6) | (((lane >> 4) & 1) << 5) | (((lane >> 5) & 1) << 8); }
constexpr int v_rd_off(int d0, int ks, int half) { return d0 * 512 + ks * 4096 + half * 2048; }
template <int OFF> __device__ __forceinline__ s16x4 tr_read(int vb) { s16x4 r; asm volatile("ds_read_b64_tr_b16 %0, %1 offset:%2" : "=&v"(r) : "v"(vb), "i"(OFF) : "memory"); return r; }
template <int D0> __device__ __forceinline__ void pv_one(f32x16& od, int vb, bf16x8 pa0, bf16x8 pa1, bf16x8 pa2, bf16x8 pa3) {
  const s16x4 l0 = tr_read<v_rd_off(D0, 0, 0)>(vb), h0 = tr_read<v_rd_off(D0, 0, 1)>(vb), l1 = tr_read<v_rd_off(D0, 1, 0)>(vb), h1 = tr_read<v_rd_off(D0, 1, 1)>(vb);
  const s16x4 l2 = tr_read<v_rd_off(D0, 2, 0)>(vb), h2 = tr_read<v_rd_off(D0, 2, 1)>(vb), l3 = tr_read<v_rd_off(D0, 3, 0)>(vb), h3 = tr_read<v_rd_off(D0, 3, 1)>(vb);
  asm volatile("s_waitcnt lgkmcnt(0)" ::: "memory"); SBAR();
#define PK(L, H) (bf16x8){L[0], L[1], L[2], L[3], H[0], H[1], H[2], H[3]}
  od = __builtin_amdgcn_mfma_f32_32x32x16_bf16(pa0, PK(l0, h0), od, 0, 0, 0);
  od = __builtin_amdgcn_mfma_f32_32x32x16_bf16(pa1, PK(l1, h1), od, 0, 0, 0);
  od = __builtin_amdgcn_mfma_f32_32x32x16_bf16(pa2, PK(l2, h2), od, 0, 0, 0);
  od = __builtin_amdgcn_mfma_f32_32x32x16_bf16(pa3, PK(l3, h3), od, 0, 0, 0);
#undef PK
}
__device__ __forceinline__ void pv_d0(f32x16* o, int vb, bf16x8 pa0, bf16x8 pa1, bf16x8 pa2, bf16x8 pa3) {
  pv_one<0>(o[0], vb, pa0, pa1, pa2, pa3); pv_one<1>(o[1], vb, pa0, pa1, pa2, pa3); pv_one<2>(o[2], vb, pa0, pa1, pa2, pa3); pv_one<3>(o[3], vb, pa0, pa1, pa2, pa3);
}
__device__ __forceinline__ void attn_unit(const bf16* __restrict__ Qh, const bf16* __restrict__ Kh, const bf16* __restrict__ Vh, bf16* __restrict__ Oh, long qrow0, long k0a, int nt0, long k0b, int NT,
                                          float lam, float oscale, const float* __restrict__ subg, float negoff, char* lds) {
  int tid_ = threadIdx.x; asm volatile("" : "+v"(tid_));
  const int tid = tid_, wid = tid >> 6, lane = tid & 63, r32 = lane & 31, hi = lane >> 5, qsub = wid >> 1, map = wid & 1, mapoff = map * 64;
  bf16* V_lds = (bf16*)lds; bf16* K_lds = (bf16*)(lds + 2 * SHM_V);
  float* ws = (float*)(lds + 2 * SHM_V + 2 * SHM_K) + wid * 64; float* li_l = ws;
  float l_reg = 0; f32x16 o[4] = {}; bf16x8 qr[4];
  const bf16* Qw = Qh + (qrow0 + qsub * 32 + r32) * 512 + mapoff + hi * 8;
#pragma unroll
  for (int d0 = 0; d0 < 4; ++d0) qr[d0] = ld8(Qw + d0 * 16);
  const int sr = tid >> 4, sc = (tid & 15) * 8, vst0 = v_st(sr, sc), vst1 = v_st(32 + sr, sc);
  const int vb0 = (int)(uintptr_t)V_lds + v_rd_base(lane);
  bf16x8 vs0, vs1, ks0, ks1;
#define KROW(j) (((j) < nt0) ? (k0a + (long)(j) * KVBLK) : (k0b + (long)((j) - nt0) * KVBLK))
#define SLOAD(j) do { const long kr_ = KROW(j); vs0 = ld8(&Vh[(kr_ + sr) * 512 + sc]); vs1 = ld8(&Vh[(kr_ + 32 + sr) * 512 + sc]); \
    ks0 = ld8(&Kh[(kr_ + sr) * 512 + sc]); ks1 = ld8(&Kh[(kr_ + 32 + sr) * 512 + sc]); } while (0)
#define SWRITE(b) do { *(bf16x8*)((char*)V_lds + (b) * SHM_V + vst0) = vs0; *(bf16x8*)((char*)V_lds + (b) * SHM_V + vst1) = vs1; const int kc = sc * 2; \
    *(bf16x8*)((char*)K_lds + (b) * SHM_K + KSWZ(sr, kc)) = ks0; *(bf16x8*)((char*)K_lds + (b) * SHM_K + KSWZ(32 + sr, kc)) = ks1; } while (0)
  f32x16 p0, p1; bf16x8 pa0, pa1, pa2, pa3;
#define TILE(cur, j) do { if ((j) + 1 < NT) SWRITE((cur) ^ 1); if ((j) + 2 < NT) SLOAD((j) + 2); SBAR(); \
    qkt(p0, p1, (bf16*)((char*)K_lds + (cur) * SHM_K), qr, r32, hi, mapoff, negoff); sm_first(p0, p1, negoff); \
    sm_finish(p0, p1, l_reg, pa0, pa1, pa2, pa3); SBAR(); \
    pv_d0(o, vb0 + (cur) * (int)SHM_V, pa0, pa1, pa2, pa3); __syncthreads(); } while (0)
  SLOAD(0); asm volatile("s_waitcnt vmcnt(0)" ::: "memory"); SWRITE(0); __syncthreads();
  SLOAD(1);
  for (int j = 0; j < NT; j += 2) { TILE(0, j); TILE(1, j + 1); }
#undef TILE
#if EN_ATTEPI
  { auto rr = __builtin_amdgcn_permlane32_swap(__float_as_uint(l_reg), __float_as_uint(l_reg), false, false); l_reg = __uint_as_float(rr[0]) + __uint_as_float(rr[1]); }
  if (hi == 0) li_l[r32] = l_reg;
  asm volatile("s_waitcnt lgkmcnt(0)" ::: "memory");
  const float fm = map ? lam : 1.f;
#pragma unroll
  for (int r = 0; r < 16; ++r) { const float rl = __builtin_amdgcn_rcpf(li_l[crow(r, hi)]) * fm;
#pragma unroll
    for (int d0 = 0; d0 < 4; ++d0) o[d0][r] *= rl; }
  __syncthreads();
  float* X = (float*)lds + qsub * 4096 + lane;
  if (map == 1) {
#pragma unroll
    for (int d0 = 0; d0 < 4; ++d0)
#pragma unroll
      for (int r = 0; r < 16; ++r) X[(d0 * 16 + r) * 64] = o[d0][r];
  }
  __syncthreads();
  if (map == 0) {
    float sg[4];
#pragma unroll
    for (int d0 = 0; d0 < 4; ++d0) sg[d0] = subg[d0 * 32 + r32] * oscale;
    bf16* Ow = Oh + (qrow0 + qsub * 32) * 1024 + r32;
#pragma unroll
    for (int r = 0; r < 16; ++r) {
      float ss = 0.f;
#pragma unroll
      for (int d0 = 0; d0 < 4; ++d0) { o[d0][r] -= X[(d0 * 16 + r) * 64]; ss += o[d0][r] * o[d0][r]; }
      ss += __shfl_xor(ss, 1); ss += __shfl_xor(ss, 2); ss += __shfl_xor(ss, 4); ss += __shfl_xor(ss, 8); ss += __shfl_xor(ss, 16);
      const float rn = 1.0f / sqrtf(ss * (1.0f / 128.0f) + 1e-6f);
      const int orow = crow(r, hi);
#pragma unroll
      for (int d0 = 0; d0 < 4; ++d0) { const unsigned w = cvtpk(o[d0][r] * rn * sg[d0], 0.f); Ow[(long)orow * 1024 + d0 * 32] = (bf16)(w & 0xffffu); }
    }
  }
  __syncthreads();
#else
  { float s = l_reg; for (int d0 = 0; d0 < 4; ++d0) for (int r = 0; r < 16; ++r) s += o[d0][r]; Oh[qrow0 * 1024 + tid] = (bf16)(int)s; }
#endif
#undef KROW
#undef SLOAD
#undef SWRITE
}
#undef KSWZ
#undef SBAR
}
#ifndef EN_ALL
#define EN_ALL 1
#endif
#ifndef EN_PH0
#define EN_PH0 EN_ALL
#endif
#ifndef EN_PH1
#define EN_PH1 EN_ALL
#endif
#ifndef EN_P1
#define EN_P1 EN_ALL
#endif
#ifndef EN_P2A
#define EN_P2A EN_ALL
#endif
#ifndef EN_P2B
#define EN_P2B EN_ALL
#endif
#ifndef EN_P3
#define EN_P3 EN_ALL
#endif
#ifndef EN_P4
#define EN_P4 EN_ALL
#endif
#ifndef EN_P5
#define EN_P5 EN_ALL
#endif
#ifndef EN_ATT
#define EN_ATT 1
#endif
#ifndef EN_DFT
#define EN_DFT 1
#endif
#ifndef EN_ATTC
#define EN_ATTC 1
#endif
constexpr int NWAVES = 8;
constexpr int DM = 1024, NBATCH = 8, SEQ = 2048, CTXL = 256, M_LAT = NBATCH * SEQ, M_CTX = NBATCH * CTXL, M_ALL = M_LAT + M_CTX, NIN = 2560, NINSRC = 2048, FFD = 2816, NGU = 5632, NLAYER = 2;
constexpr size_t MiB = 1u << 20;
constexpr size_t WS_CTL = 0, CTL_ZERO_BYTES = 1 * MiB;
constexpr size_t WS_MOD = 1 * MiB;
constexpr size_t WS_BIN = WS_MOD + 512 * 1024;
constexpr size_t WS_BGU = WS_BIN + 256 * 1024;
constexpr size_t WS_ROPE = WS_BGU + 512 * 1024;
constexpr size_t WS_DFT = WS_ROPE + 512 * 1024;
constexpr size_t WS_TF = 4 * MiB;
constexpr size_t WS_SSQ = 5 * MiB;
constexpr size_t WS_WIN = 8 * MiB;
constexpr size_t WS_WOUT = 18 * MiB;
constexpr size_t WS_WGU = 22 * MiB;
constexpr size_t WS_WDN = 44 * MiB;
constexpr size_t WS_A = 56 * MiB;
constexpr size_t WS_XC = 92 * MiB;
constexpr size_t WS_QB = 100 * MiB, WS_KB = 118 * MiB, WS_VB = 136 * MiB;
constexpr size_t WS_Y = 154 * MiB;
constexpr size_t WS_TC = 186 * MiB;
constexpr size_t WS_MIX = 190 * MiB;
constexpr size_t WS_T = WS_MIX;
constexpr size_t WS_H = 100 * MiB;
constexpr size_t WS_END = 226 * MiB;
static_assert(WS_DFT + 256 * 512 * 2 <= WS_TF && WS_SSQ + (size_t)M_ALL * 64 <= WS_WIN && WS_H + (size_t)M_ALL * FFD * 2 <= WS_END && WS_MIX + (size_t)M_ALL * DM * 2 <= WS_END, "d_ws map");
constexpr int CW_TMO = 0, CW_BAR = 4096;
constexpr int RING_BYTES = 131072, RTAB_OFF = RING_BYTES, RTAB_BYTES = 8192, LDSCTL_OFF = RTAB_OFF + RTAB_BYTES, MISC_OFF = LDSCTL_OFF + 320, LDS_BYTES = 147456;
static_assert(MISC_OFF + 128 <= LDS_BYTES, "LDS map");
constexpr int N_PHASES = 2 + 6 * NLAYER;

#define GAS __attribute__((address_space(1)))
#define LAS __attribute__((address_space(3)))
typedef unsigned short bf16;
typedef unsigned v4u __attribute__((ext_vector_type(4)));
typedef unsigned v2u __attribute__((ext_vector_type(2)));
typedef float f32x4 __attribute__((ext_vector_type(4)));
#define LDS_WAIT() asm volatile("s_waitcnt lgkmcnt(0)" ::: "memory")
#define VM_WAIT() asm volatile("s_waitcnt vmcnt(0)" ::: "memory")
__device__ __forceinline__ unsigned f2bf(float f) { unsigned u = __builtin_bit_cast(unsigned, f); return (u + 0x7fffu + ((u >> 16) & 1u)) >> 16; }
__device__ __forceinline__ unsigned pk2(float lo, float hi) { return f2bf(lo) | (f2bf(hi) << 16); }
__device__ __forceinline__ float bf2f(unsigned short h) { return __builtin_bit_cast(float, (unsigned)h << 16); }
__device__ __forceinline__ float wave_sum(float v) {
#pragma unroll
    for (int o = 1; o < 64; o <<= 1) v += __shfl_xor(v, o);
    return v;
}

#define XB_TMO      128
#define XB_XCNT(j)  (256  + 64 * (j))
#define XB_XSUB(j)  (1280 + 64 * (j))
#define XB_XGEN(j)  (2304 + 64 * (j))
#define XB_TOP      3328
#define XB_TOPGEN   3392
#define XCD_BAR_WORDS 3456
#define XB_SPIN_CAP (1u << 18)

__device__ __forceinline__ unsigned xb_ld(unsigned* p)              { return __hip_atomic_load(p, __ATOMIC_RELAXED, __HIP_MEMORY_SCOPE_AGENT); }
__device__ __forceinline__ unsigned xb_add(unsigned* p, unsigned v) { return __hip_atomic_fetch_add(p, v, __ATOMIC_RELAXED, __HIP_MEMORY_SCOPE_AGENT); }
__device__ __forceinline__ unsigned xb_xcc_id() { return (unsigned)__builtin_amdgcn_s_getreg((3 << 11) | 20) & 0xFu; }
#define XB_SPIN(cond, bar) do { unsigned _sp = 0; while (cond) { __builtin_amdgcn_s_sleep(1); \
    if ((++_sp & 255u) == 0u) { if (xb_ld(&(bar)[XB_TMO])) break; if (_sp > XB_SPIN_CAP) { atomicAdd(&(bar)[XB_TMO], 1u); break; } } } } while (0)

struct XcdBarrier {
    unsigned* bar; unsigned x;
    volatile LAS unsigned* st;
};

__device__ __forceinline__ XcdBarrier xcd_barrier_post(unsigned* bar, volatile LAS unsigned* st) {
    XcdBarrier b; b.bar = bar; b.x = xb_xcc_id(); b.st = st;
    if (threadIdx.x == 0) (void)xb_add(&bar[XB_XCNT(b.x)], 1u);
    return b;
}
__device__ __forceinline__ void xcd_barrier_complete(unsigned* bar, unsigned x, unsigned& nloc, unsigned& nx) {
    const unsigned G = gridDim.x * gridDim.y * gridDim.z;
    unsigned sum, cnt, mine, sp = 0u;
    for (;;) {
        sum = 0u; cnt = 0u; mine = 0u;
#pragma unroll
        for (unsigned j = 0; j < 16; ++j) { const unsigned c = xb_ld(&bar[XB_XCNT(j)]); sum += c; cnt += (c > 0u) ? 1u : 0u; mine = (j == x) ? c : mine; }
        if (sum == G) break;
        __builtin_amdgcn_s_sleep(1);
        if ((++sp & 255u) == 0u) { if (xb_ld(&bar[XB_TMO])) break; if (sp > XB_SPIN_CAP) { atomicAdd(&bar[XB_TMO], 1u); break; } }
    }
    nloc = mine > 0u ? mine : 1u; nx = cnt > 0u ? cnt : 1u;
}

__device__ __forceinline__ void xcd_barrier(const XcdBarrier& b) {
    asm volatile("s_waitcnt vmcnt(0)" ::: "memory");
    __syncthreads();
    if (threadIdx.x == 0) {
        unsigned* bar = b.bar;
        __builtin_amdgcn_s_waitcnt(0);
        unsigned nloc = b.st[0], nx = b.st[1];
        if (nloc == 0u) { xcd_barrier_complete(bar, b.x, nloc, nx); b.st[0] = nloc; b.st[1] = nx; }
        const unsigned old = xb_add(&bar[XB_XSUB(b.x)], 1u);
        const unsigned gen = old / nloc;
        if (old + 1u == (gen + 1u) * nloc) {
            __builtin_amdgcn_fence(__ATOMIC_RELEASE, "agent");
            asm volatile("s_waitcnt vmcnt(0)" ::: "memory");
            const unsigned og = xb_add(&bar[XB_TOP], 1u);
            const unsigned tg = og / nx;
            if (og + 1u == (tg + 1u) * nx) xb_add(&bar[XB_TOPGEN], 1u);
            else XB_SPIN(xb_ld(&bar[XB_TOPGEN]) == tg, bar);
            __builtin_amdgcn_fence(__ATOMIC_ACQUIRE, "agent");
            xb_add(&bar[XB_XGEN(b.x)], 1u);
            asm volatile("s_waitcnt vmcnt(0)" ::: "memory");
        } else {
            XB_SPIN(xb_ld(&bar[XB_XGEN(b.x)]) == gen, bar);
            __builtin_amdgcn_fence(__ATOMIC_ACQUIRE, "agent");
            asm volatile("s_waitcnt vmcnt(0)" ::: "memory");
        }
    }
    __syncthreads();
}


struct Args { const float* in[21]; float* out; unsigned char* ws; int ph_lo, ph_hi; };
struct Frame {
    LAS unsigned char* lds; int wave, vcu, G;
};

__device__ __forceinline__ void transpose_item(const float* W, int ldn, bf16* WT, int ldk, int k0, int n0, int drow0, LAS float* scr, int lane) {
#pragma unroll 8
    for (int i = 0; i < 32; ++i) { const int kk = 2 * i + (lane >> 5); scr[kk * 33 + (lane & 31)] = W[(size_t)(k0 + kk) * ldn + n0 + (lane & 31)]; }
    LDS_WAIT(); asm volatile("" ::: "memory");
    const int c = lane & 7;
#pragma unroll
    for (int j = 0; j < 4; ++j) { const int n = (lane >> 3) + 8 * j; const LAS float* s = scr + (8 * c) * 33 + n;
        v4u o; o.x = pk2(s[0 * 33], s[1 * 33]); o.y = pk2(s[2 * 33], s[3 * 33]); o.z = pk2(s[4 * 33], s[5 * 33]); o.w = pk2(s[6 * 33], s[7 * 33]);
        *(GAS v4u*)(WT + (size_t)(drow0 + n) * ldk + k0 + 8 * c) = o; }
    LDS_WAIT(); asm volatile("" ::: "memory");
}
__device__ __forceinline__ void ph0(Frame& F, const Args& A, unsigned char* ws) {
    LAS float* scr = (LAS float*)(F.lds + F.wave * 16384);
    const int gw = F.vcu * NWAVES + F.wave, NGW = F.G * NWAVES;
    constexpr int I_IN = 16 * 48, I_OUT = 16 * 32, I_G = 16 * 88, I_D = 44 * 32, I_LAYER = I_IN + I_OUT + 2 * I_G + I_D;
    for (int it = gw; it < NLAYER * I_LAYER; it += NGW) {
        const int l = it / I_LAYER; int r = it % I_LAYER;
        if (r < I_IN) { const int kb = r / 48, nb = r % 48, n0 = nb * 32, pn = n0 >> 8, cc = n0 & 255; const int drow = pn < 4 ? pn * 256 + ((cc >> 5) & 1) * 128 + (cc >> 6) * 32 : n0;
            transpose_item(A.in[8] + (size_t)l * DM * NINSRC, NINSRC, (bf16*)(ws + WS_WIN) + (size_t)l * NIN * DM, DM, kb * 64, n0, drow, scr, ((int)threadIdx.x & 63)); continue; } r -= I_IN;
        if (r < I_OUT) { const int kb = r / 32, nb = r % 32; transpose_item(A.in[17] + (size_t)l * DM * DM, DM, (bf16*)(ws + WS_WOUT) + (size_t)l * DM * DM, DM, kb * 64, nb * 32, nb * 32, scr, ((int)threadIdx.x & 63)); continue; } r -= I_OUT;
        if (r < 2 * I_G) { const int up = r >= I_G; if (up) r -= I_G; const int kb = r / 88, nb = r % 88, n0 = nb * 32; const int drow = (n0 >> 7) * 256 + up * 128 + (n0 & 127);
            transpose_item((up ? A.in[19] : A.in[18]) + (size_t)l * DM * FFD, FFD, (bf16*)(ws + WS_WGU) + (size_t)l * NGU * DM, DM, kb * 64, n0, drow, scr, ((int)threadIdx.x & 63)); continue; } r -= 2 * I_G;
        { const int kb = r / 32, nb = r % 32; transpose_item(A.in[20] + (size_t)l * FFD * DM, DM, (bf16*)(ws + WS_WDN) + (size_t)l * DM * FFD, FFD, kb * 64, nb * 32, nb * 32, scr, ((int)threadIdx.x & 63)); }
    }
    __syncthreads();
    LAS float* sl = (LAS float*)F.lds;
    LAS float* red = (LAS float*)(F.lds + 40960);
    for (int i = ((int)threadIdx.x); i < 9 * DM; i += NWAVES * 64) { const int j = i >> 10, k = i & 1023; const float v = (j < 8) ? A.in[1][j * DM + k] : A.in[3][k]; sl[i] = v / (1.f + __expf(-v)); }
    __syncthreads();
    for (int it = F.vcu; it < NLAYER * 96; it += F.G) {
        const int l = it / 96, n = (it % 96) * 64 + ((int)threadIdx.x & 63); const float* W = A.in[4] + (size_t)l * DM * 6144 + n;
        float acc[9];
#pragma unroll
        for (int j = 0; j < 9; ++j) acc[j] = 0.f;
        const int kb = F.wave * 128;
#pragma unroll 4
        for (int k = 0; k < 128; k += 4) { float w0 = W[(size_t)(kb + k) * 6144], w1 = W[(size_t)(kb + k + 1) * 6144], w2 = W[(size_t)(kb + k + 2) * 6144], w3 = W[(size_t)(kb + k + 3) * 6144];
#pragma unroll
            for (int j = 0; j < 9; ++j) { const f32x4 s = *(const LAS f32x4*)(sl + j * DM + kb + k); acc[j] += s[0] * w0 + s[1] * w1 + s[2] * w2 + s[3] * w3; } }
#pragma unroll
        for (int j = 0; j < 9; ++j) red[(F.wave * 9 + j) * 64 + ((int)threadIdx.x & 63)] = acc[j];
        __syncthreads();
        for (int i = ((int)threadIdx.x); i < 9 * 64; i += NWAVES * 64) { const int j = i >> 6, ln = i & 63; float s = 0.f;
#pragma unroll
            for (int w = 0; w < 8; ++w) s += red[(w * 9 + j) * 64 + ln];
            const int nn = (it % 96) * 64 + ln; ((float*)(ws + WS_MOD))[(l * 9 + j) * 6144 + nn] = s + A.in[5][l * 6144 + nn]; }
        __syncthreads();
    }
    const int gt = F.vcu * (NWAVES * 64) + ((int)threadIdx.x), NGT = F.G * NWAVES * 64;
    for (int i = gt; i < 2048 * 32; i += NGT) { const int pos = i >> 5, j = i & 31; const float inv = powf(10000.0f, -(float)(j & 15) * (1.0f / 16.0f)); const float ang = (float)((j < 16) ? (pos >> 6) : (pos & 63)) * inv;
        float sn, cs; sincosf(ang, &sn, &cs); ((float*)(ws + WS_ROPE))[i] = cs; ((float*)(ws + WS_ROPE))[65536 + i] = sn; }
    for (int i = gt; i < 256 * 512; i += NGT) { const int m = i >> 9, kk = i & 511, n = kk & 255; const int p = (m * n) & 255; float sn, cs; sincospif((float)p * (1.0f / 128.0f), &sn, &cs);
        ((bf16*)(ws + WS_DFT))[i] = (bf16)f2bf(kk < 256 ? cs : sn); }
    for (int i = gt; i < NLAYER * 4 * 128 * 256; i += NGT) { const int d = i & 127, ri = (i >> 7) & 1, cch = (i >> 8) & 127, lg = i >> 15; const float* w = A.in[16] + (size_t)lg * 128 * 128 + d; float s = 0.f;
        for (int c2 = 0; c2 < 128; ++c2) { const int p = (cch * c2) & 127; float sn, cs; sincospif((float)p * (1.0f / 64.0f), &sn, &cs); s += (ri ? -sn : cs) * w[c2 * 128]; }
        ((float*)(ws + WS_TF))[i] = s; }
}
__device__ __forceinline__ void ph1(Frame& F, const Args& A, unsigned char* ws) {
    const float* mod = (const float*)(ws + WS_MOD);
    { const int gw = F.vcu * NWAVES + F.wave, NGW = F.G * NWAVES;
      for (int row = gw; row < M_ALL; row += NGW) {
          const bool lat = row < M_LAT; const int bm = lat ? (row >> 11) : 8; const float* xr = lat ? A.in[0] + (size_t)row * DM : A.in[2] + (size_t)(row - M_LAT) * DM;
          const float* sc = mod + bm * 6144 + 1024; float s = 0.f; f32x4 v[4];
#pragma unroll
          for (int j = 0; j < 4; ++j) { v[j] = *(const f32x4*)(xr + 256 * j + 4 * ((int)threadIdx.x & 63)); s += (v[j][0] * v[j][0] + v[j][1] * v[j][1]) + (v[j][2] * v[j][2] + v[j][3] * v[j][3]); }
          s = wave_sum(s);
          bf16* ar = (bf16*)(ws + WS_A) + (size_t)row * DM;
#pragma unroll
          for (int j = 0; j < 4; ++j) { const int k = 256 * j + 4 * ((int)threadIdx.x & 63); const f32x4 g = *(const f32x4*)(A.in[6] + k) * (*(const f32x4*)(sc + k) + 1.0f); const f32x4 a = v[j] * g; v2u w; w.x = pk2(a[0], a[1]); w.y = pk2(a[2], a[3]); *(v2u*)(ar + k) = w; }
          if (((int)threadIdx.x & 63) < 16) ((float*)(ws + WS_SSQ))[(size_t)row * 16 + ((int)threadIdx.x & 63)] = ((int)threadIdx.x & 63) == 0 ? s : 0.f;
      } }
    __syncthreads();
    { LAS float* wl = (LAS float*)F.lds;
      LAS float* tl = (LAS float*)(F.lds + 128 * 132 * 4);
      for (int it = F.vcu; it < NLAYER * 4 * 4 * 8; it += F.G) {
          const int kb = it & 7, q = (it >> 3) & 3, g = (it >> 5) & 3, l = it >> 7;
          const float* wsrc = A.in[8] + (size_t)l * DM * NINSRC + (size_t)(kb * 128) * NINSRC + 1536 + g * 128;
          for (int i = ((int)threadIdx.x); i < 128 * 32; i += NWAVES * 64) { const int k = i >> 5, c4 = (i & 31) * 4; *(LAS f32x4*)(wl + k * 132 + c4) = *(const f32x4*)(wsrc + (size_t)k * NINSRC + c4); }
          const float* tsrc = (const float*)(ws + WS_TF) + (size_t)(l * 4 + g) * 128 * 256 + q * 64;
          for (int i = ((int)threadIdx.x); i < 128 * 16; i += NWAVES * 64) { const int cch = i >> 4, d4 = (i & 15) * 4; *(LAS f32x4*)(tl + cch * 64 + d4) = *(const f32x4*)(tsrc + (size_t)cch * 256 + d4); }
          __syncthreads();
          const int dcol = ((int)threadIdx.x) & 63, kg = ((int)threadIdx.x) >> 6; float acc[16];
#pragma unroll
          for (int i = 0; i < 16; ++i) acc[i] = 0.f;
          for (int c4 = 0; c4 < 128; c4 += 4) { const float t0 = tl[c4 * 64 + dcol], t1 = tl[(c4 + 1) * 64 + dcol], t2 = tl[(c4 + 2) * 64 + dcol], t3 = tl[(c4 + 3) * 64 + dcol];
#pragma unroll
              for (int i = 0; i < 16; ++i) { const f32x4 w = *(const LAS f32x4*)(wl + (kg * 16 + i) * 132 + c4); acc[i] += w[0] * t0 + w[1] * t1 + w[2] * t2 + w[3] * t3; } }
          bf16* dst = (bf16*)(ws + WS_WIN) + (size_t)l * NIN * DM + (size_t)(1536 + g * 256 + q * 64 + dcol) * DM + kb * 128 + kg * 16;
          v4u o0, o1; o0.x = pk2(acc[0], acc[1]); o0.y = pk2(acc[2], acc[3]); o0.z = pk2(acc[4], acc[5]); o0.w = pk2(acc[6], acc[7]); o1.x = pk2(acc[8], acc[9]); o1.y = pk2(acc[10], acc[11]); o1.z = pk2(acc[12], acc[13]); o1.w = pk2(acc[14], acc[15]);
          *(v4u*)dst = o0; *(v4u*)(dst + 8) = o1;
          __syncthreads();
      } }
    { LAS float* sh = (LAS float*)F.lds;
      const int gw = F.vcu * NWAVES + F.wave, NGW = F.G * NWAVES;
      for (int st = 0; st < 2 * NLAYER; ++st) {
          const int l = st >> 1, gu = st & 1;
          for (int i = ((int)threadIdx.x); i < 9 * DM; i += NWAVES * 64) sh[i] = mod[(l * 9 + (i >> 10)) * 6144 + (gu ? 3072 : 0) + (i & 1023)];
          __syncthreads();
          const int nrow = gu ? NGU : 1536; const bf16* WT = gu ? (const bf16*)(ws + WS_WGU) + (size_t)l * NGU * DM : (const bf16*)(ws + WS_WIN) + (size_t)l * NIN * DM;
          float* bo = gu ? (float*)(ws + WS_BGU) + l * 9 * NGU : (float*)(ws + WS_BIN) + l * 9 * NIN; const int ldb = gu ? NGU : NIN;
          for (int n = gw; n < nrow; n += NGW) {
              float wv[16]; { const v4u a = *(const v4u*)(WT + (size_t)n * DM + ((int)threadIdx.x & 63) * 16), b = *(const v4u*)(WT + (size_t)n * DM + ((int)threadIdx.x & 63) * 16 + 8);
                  const unsigned u[8] = {a.x, a.y, a.z, a.w, b.x, b.y, b.z, b.w};
#pragma unroll
                  for (int i = 0; i < 8; ++i) { wv[2 * i] = __builtin_bit_cast(float, u[i] << 16); wv[2 * i + 1] = __builtin_bit_cast(float, u[i] & 0xffff0000u); } }
#pragma unroll
              for (int j = 0; j < 9; ++j) { float s = 0.f;
#pragma unroll
                  for (int i4 = 0; i4 < 4; ++i4) { const f32x4 sv = *(const LAS f32x4*)(sh + j * DM + ((int)threadIdx.x & 63) * 16 + i4 * 4); s += sv[0] * wv[4 * i4] + sv[1] * wv[4 * i4 + 1] + sv[2] * wv[4 * i4 + 2] + sv[3] * wv[4 * i4 + 3]; }
                  s = wave_sum(s); if (((int)threadIdx.x & 63) == 0) bo[j * ldb + n] = s; }
          }
          __syncthreads();
      } }
    if (F.vcu < NLAYER * 4) {
        const int l = F.vcu >> 2, g = F.vcu & 3; LAS float* sh = (LAS float*)F.lds; LAS float* part = (LAS float*)(F.lds + 36864); LAS float* bf = (LAS float*)(F.lds + 36864 + 4 * 9 * 128 * 4);
        for (int i = ((int)threadIdx.x); i < 9 * DM; i += NWAVES * 64) sh[i] = mod[(l * 9 + (i >> 10)) * 6144 + (i & 1023)];
        __syncthreads();
        { const int col = ((int)threadIdx.x) & 127, kq = ((int)threadIdx.x) >> 7; const float* w = A.in[8] + (size_t)l * DM * NINSRC + 1536 + g * 128 + col; float acc[9];
#pragma unroll
          for (int j = 0; j < 9; ++j) acc[j] = 0.f;
          for (int k = kq * 256; k < kq * 256 + 256; ++k) { const float wv = w[(size_t)k * NINSRC];
#pragma unroll
              for (int j = 0; j < 9; ++j) acc[j] += sh[j * DM + k] * wv; }
#pragma unroll
          for (int j = 0; j < 9; ++j) part[(kq * 9 + j) * 128 + col] = acc[j]; }
        __syncthreads();
        for (int i = ((int)threadIdx.x); i < 9 * 128; i += NWAVES * 64) bf[i] = part[i] + part[9 * 128 + i] + part[2 * 9 * 128 + i] + part[3 * 9 * 128 + i];
        __syncthreads();
        if (((int)threadIdx.x) < 256) { const float* tf = (const float*)(ws + WS_TF) + (size_t)(l * 4 + g) * 128 * 256 + ((int)threadIdx.x); float acc[9];
#pragma unroll
            for (int j = 0; j < 9; ++j) acc[j] = 0.f;
            for (int cch = 0; cch < 128; ++cch) { const float t = tf[cch * 256];
#pragma unroll
                for (int j = 0; j < 9; ++j) acc[j] += bf[j * 128 + cch] * t; }
#pragma unroll
            for (int j = 0; j < 9; ++j) ((float*)(ws + WS_BIN))[(l * 9 + j) * NIN + 1536 + g * 256 + ((int)threadIdx.x)] = acc[j]; }
        __syncthreads();
    }
}
__device__ __forceinline__ void fft8(float (&xr)[8], float (&xi)[8]) {
    const float S = 0.70710678118654752f;
    const float u0r = xr[0] + xr[4], u0i = xi[0] + xi[4], d0r = xr[0] - xr[4], d0i = xi[0] - xi[4];
    const float u1r = xr[1] + xr[5], u1i = xi[1] + xi[5], d1r = xr[1] - xr[5], d1i = xi[1] - xi[5];
    const float u2r = xr[2] + xr[6], u2i = xi[2] + xi[6], d2r = xr[2] - xr[6], d2i = xi[2] - xi[6];
    const float u3r = xr[3] + xr[7], u3i = xi[3] + xi[7], d3r = xr[3] - xr[7], d3i = xi[3] - xi[7];
    const float v0r = d0r, v0i = d0i;
    const float v1r = (d1r + d1i) * S, v1i = (d1i - d1r) * S;
    const float v2r = d2i, v2i = -d2r;
    const float v3r = (d3i - d3r) * S, v3i = -(d3r + d3i) * S;
    { const float p0r = u0r + u2r, p0i = u0i + u2i, p1r = u1r + u3r, p1i = u1i + u3i, p2r = u0r - u2r, p2i = u0i - u2i, qr = u1r - u3r, qi = u1i - u3i; const float p3r = qi, p3i = -qr;
      xr[0] = p0r + p1r; xi[0] = p0i + p1i; xr[4] = p0r - p1r; xi[4] = p0i - p1i; xr[2] = p2r + p3r; xi[2] = p2i + p3i; xr[6] = p2r - p3r; xi[6] = p2i - p3i; }
    { const float p0r = v0r + v2r, p0i = v0i + v2i, p1r = v1r + v3r, p1i = v1i + v3i, p2r = v0r - v2r, p2i = v0i - v2i, qr = v1r - v3r, qi = v1i - v3i; const float p3r = qi, p3i = -qr;
      xr[1] = p0r + p1r; xi[1] = p0i + p1i; xr[5] = p0r - p1r; xi[5] = p0i - p1i; xr[3] = p2r + p3r; xi[3] = p2i + p3i; xr[7] = p2r - p3r; xi[7] = p2i - p3i; }
}
__device__ __forceinline__ void butterfly_phase(Frame& F, unsigned char* ws) {
    const bf16* T = (const bf16*)(ws + WS_T); bf16* Y = (bf16*)(ws + WS_Y);
    int tid_ = threadIdx.x; asm volatile("" : "+v"(tid_));
    const int gt = F.vcu * (NWAVES * 64) + tid_, NGT = F.G * NWAVES * 64;
    for (int it = gt; it < NBATCH * 512 * 128; it += NGT) {
        const int n0 = (it & 127) * 2, bc = it >> 7; const bf16* tp = T + (size_t)bc * 2 * 2048 + n0;
        unsigned pr[8], pi[8];
        pr[0] = *(const unsigned*)(tp); pr[1] = *(const unsigned*)(tp + 256); pr[2] = *(const unsigned*)(tp + 512); pr[3] = *(const unsigned*)(tp + 768);
        pr[4] = *(const unsigned*)(tp + 1024); pr[5] = *(const unsigned*)(tp + 1280); pr[6] = *(const unsigned*)(tp + 1536); pr[7] = *(const unsigned*)(tp + 1792);
        pi[0] = *(const unsigned*)(tp + 2048); pi[1] = *(const unsigned*)(tp + 2304); pi[2] = *(const unsigned*)(tp + 2560); pi[3] = *(const unsigned*)(tp + 2816);
        pi[4] = *(const unsigned*)(tp + 3072); pi[5] = *(const unsigned*)(tp + 3328); pi[6] = *(const unsigned*)(tp + 3584); pi[7] = *(const unsigned*)(tp + 3840);
        float ar[8], ai[8], br[8], bi[8];
#define BF_UNP(k) ar[k] = __builtin_bit_cast(float, pr[k] << 16); br[k] = __builtin_bit_cast(float, pr[k] & 0xffff0000u); ai[k] = __builtin_bit_cast(float, pi[k] << 16); bi[k] = __builtin_bit_cast(float, pi[k] & 0xffff0000u);
        BF_UNP(0) BF_UNP(1) BF_UNP(2) BF_UNP(3) BF_UNP(4) BF_UNP(5) BF_UNP(6) BF_UNP(7)
#undef BF_UNP
        fft8(ar, ai); fft8(br, bi);
        const int b = bc >> 9, ch = bc & 511;
        bf16* yp = Y + ((size_t)(b * 8) * 512 + ch) * 512 + n0;
        const float th0 = (float)n0 * (1.0f / 1024.0f), th1 = (float)(n0 + 1) * (1.0f / 1024.0f);
#define BF_OUT(r) { float s0, c0, s1, c1; sincospif(th0 * (float)(r), &s0, &c0); sincospif(th1 * (float)(r), &s1, &c1); \
          *(unsigned*)(yp + (size_t)(r) * 512 * 512) = pk2(ar[r] * c0 + ai[r] * s0, br[r] * c1 + bi[r] * s1); *(unsigned*)(yp + (size_t)(r) * 512 * 512 + 256) = pk2(ai[r] * c0 - ar[r] * s0, bi[r] * c1 - br[r] * s1); }
        BF_OUT(0) BF_OUT(1) BF_OUT(2) BF_OUT(3) BF_OUT(4) BF_OUT(5) BF_OUT(6) BF_OUT(7)
#undef BF_OUT
    }
}
template <class S> __device__ __forceinline__ void compute_rtab(Frame& F, unsigned char* ws, const S& sched) {
    LAS float* rt = (LAS float*)(F.lds + RTAB_OFF); pg8::Unit u;
    int tid_ = threadIdx.x; asm volatile("" : "+v"(tid_));
    const int t = tid_ & 255, par = tid_ >> 8;
    for (int i = 0; i < 8 && sched.next(i, u); ++i) if ((i & 1) == par) { const float* p = (const float*)(ws + WS_SSQ) + ((size_t)u.pm * 256 + t) * 16; float s = 0.f;
#pragma unroll
        for (int q = 0; q < 4; ++q) { const f32x4 a = *(const f32x4*)(p + 4 * q); s += (a[0] + a[1]) + (a[2] + a[3]); }
        rt[i * 256 + t] = __builtin_amdgcn_rsqf(s * (1.0f / 1024.0f) + 1e-6f); }
    __syncthreads();
}
__device__ __forceinline__ void attn_phase(Frame& F, const Args& A, unsigned char* ws, int l, char* lds) {
    const float lambda_init = l == 0 ? 0.2f : 0.355509068f;
    const float lam = expf(wave_sum(A.in[11][l * 64 + ((int)threadIdx.x & 63)] * A.in[12][l * 64 + ((int)threadIdx.x & 63)])) - expf(wave_sum(A.in[13][l * 64 + ((int)threadIdx.x & 63)] * A.in[14][l * 64 + ((int)threadIdx.x & 63)])) + lambda_init;
    float gq = fabsf(A.in[9][l * 64 + ((int)threadIdx.x & 63)]), gk = fabsf(A.in[10][l * 64 + ((int)threadIdx.x & 63)]);
#pragma unroll
    for (int o = 1; o < 64; o <<= 1) { gq = fmaxf(gq, __shfl_xor(gq, o)); gk = fmaxf(gk, __shfl_xor(gk, o)); }
    const float negoff = -fmaxf(0.f, 8.0f * 1.4426950408889634f * gq * gk * 1.0001f - 40.0f);
    const att::bf16* QB = (const att::bf16*)(ws + WS_QB); const att::bf16* KB = (const att::bf16*)(ws + WS_KB); const att::bf16* VB = (const att::bf16*)(ws + WS_VB); att::bf16* MIX = (att::bf16*)(ws + WS_MIX);
    const float* subg = A.in[15] + l * 128;
    const int per = (512 + F.G - 1) / F.G;
    for (int u = F.vcu * per; u < (F.vcu + 1) * per && u < 512; ++u) {
        const int qblk = u & 15, bh = u >> 4, b = bh >> 2, h = bh & 3;
        att::attn_unit(QB + h * 128, KB + h * 128, VB + h * 128, MIX + h * 128, (long)b * SEQ + qblk * 128, (long)M_LAT + b * CTXL, 4, (long)b * SEQ, 36, lam, 1.0f - lambda_init, subg, negoff, lds);
    }
#if EN_ATTC
    if (l == 0) for (int u = F.vcu; u < 64; u += F.G) {
        const int qblk = u & 1, bh = u >> 1, b = bh >> 2, h = bh & 3;
        att::attn_unit(QB + h * 128, KB + h * 128, VB + h * 128, MIX + h * 128, (long)M_LAT + b * CTXL + qblk * 128, (long)M_LAT + b * CTXL, 4, 0, 4, lam, 1.0f - lambda_init, subg, negoff, lds);
    }
#endif
}

__global__ void __launch_bounds__(NWAVES * 64, 2) fwd_kernel(const Args args) {
    extern __shared__ __attribute__((aligned(16))) unsigned char lds[];
    Frame F;
    F.lds = (LAS unsigned char*)lds;
    F.wave = __builtin_amdgcn_readfirstlane((int)threadIdx.x >> 6);
    F.G = gridDim.x; { const int bx = blockIdx.x; F.vcu = (F.G % 8 == 0) ? (bx % 8) * (F.G / 8) + bx / 8 : bx; }
    for (int u = ((int)threadIdx.x); u < (LDS_BYTES - LDSCTL_OFF) / 4; u += NWAVES * 64) ((LAS unsigned*)(F.lds + LDSCTL_OFF))[u] = 0u;
    __syncthreads();
    volatile LAS unsigned* MISC = (volatile LAS unsigned*)(F.lds + MISC_OFF);
    XcdBarrier bar = xcd_barrier_post((unsigned*)(args.ws + WS_CTL) + CW_BAR, MISC + 8);
    const int lo = args.ph_lo, hi = args.ph_hi;
#define IN(k) (lo <= (k) && (k) < hi)
#define SEAM(k) do { if (IN((k) + 1)) xcd_barrier(bar); } while (0)
#define PHASE_VARS unsigned char* ws = args.ws; asm volatile("" : "+s"(ws)); const Args& A = args; const pg8::bf16_t* ABUF = (const pg8::bf16_t*)(ws + WS_A); (void)ABUF; (void)A
    const LAS float* rtab = (const LAS float*)(F.lds + RTAB_OFF);
    const int cid = (int)blockIdx.x;
    #if EN_PH0
    if (IN(0)) { PHASE_VARS; ph0(F, A, ws); SEAM(0); }
#endif
    #if EN_PH1
    if (IN(1)) { PHASE_VARS; ph1(F, A, ws); SEAM(1); }
#endif
#pragma unroll 1
    for (int l = 0; l < NLAYER; ++l) {
        const int base = 2 + 6 * l; const int nM = l == 0 ? 72 : 64;
#if EN_P1
        if (IN(base + 0)) {
            PHASE_VARS;
            pg8::Sched2 S; if (l == 0) S.init(72, 10, 0, 0, 0, 0, F.G, cid, 0); else S.init(64, 10, 64, 8, 2, 4, F.G, cid, 0);
            compute_rtab(F, ws, S);
            pg8::Gemm g{ABUF, (const pg8::bf16_t*)(ws + WS_WIN) + (size_t)l * NIN * DM, M_ALL, NIN, DM};
            pg8::EpiIn E{ws, l, A.in[9] + l * 64, A.in[10] + l * 64, rtab};
            pg8::gemm_phase<pg8::EpiIn, pg8::Sched2, true, true>(F.lds, g, S, E);
            SEAM(base + 0);
        }
#endif
#if EN_P2A
        if (IN(base + 1)) { PHASE_VARS; butterfly_phase(F, ws); SEAM(base + 1); }
#endif
#if EN_P2B
        if (IN(base + 2)) {
            PHASE_VARS;
#if EN_ATT
            attn_phase(F, A, ws, l, (char*)lds);
#endif
#if EN_DFT
            pg8::Sched2 S; S.init(1, l == 0 ? 144 : 128, 0, 0, 0, 0, F.G, cid, F.G - 64);
            pg8::Gemm g{(const pg8::bf16_t*)(ws + WS_DFT), (const pg8::bf16_t*)(ws + WS_Y), 256, 36864, 512};
            pg8::EpiDft E{(pg8::bf16_t*)(ws + WS_MIX)};
            pg8::gemm_phase<pg8::EpiDft, pg8::Sched2, true, true>(F.lds, g, S, E);
#endif
            SEAM(base + 2);
        }
#endif
#if EN_P3
        if (IN(base + 3)) {
            PHASE_VARS;
            pg8::Sched2 S; S.init(nM, 4, 0, 0, 0, 0, F.G, cid, 0);
            pg8::Gemm g{(const pg8::bf16_t*)(ws + WS_MIX), (const pg8::bf16_t*)(ws + WS_WOUT) + (size_t)l * DM * DM, M_ALL, DM, DM};
            pg8::EpiRes<true> E{l == 0 ? A.in[0] : A.out, A.in[2], A.out, ws, l * 9 * 6144 + 2048, A.in[7] + l * DM, l * 9 * 6144 + 4096};
            pg8::gemm_phase<pg8::EpiRes<true>, pg8::Sched2, true, true>(F.lds, g, S, E);
            SEAM(base + 3);
        }
#endif
#if EN_P4
        if (IN(base + 4)) {
            PHASE_VARS;
            pg8::Sched2 S; S.init(nM, 22, 0, 0, 0, 0, F.G, cid, 0);
            compute_rtab(F, ws, S);
            pg8::Gemm g{ABUF, (const pg8::bf16_t*)(ws + WS_WGU) + (size_t)l * NGU * DM, M_ALL, NGU, DM};
            pg8::EpiGU E{ws, l, rtab};
            pg8::gemm_phase<pg8::EpiGU, pg8::Sched2, true, true>(F.lds, g, S, E);
            SEAM(base + 4);
        }
#endif
#if EN_P5
        if (IN(base + 5)) {
            PHASE_VARS;
            pg8::Sched2 S; S.init(nM, 4, 0, 0, 0, 0, F.G, cid, 0);
            pg8::Gemm g{(const pg8::bf16_t*)(ws + WS_H), (const pg8::bf16_t*)(ws + WS_WDN) + (size_t)l * DM * FFD, M_ALL, DM, FFD};
            if (l == 0) { pg8::EpiRes<true> E{A.out, (const float*)(ws + WS_XC), A.out, ws, 5120, A.in[6] + DM, 9 * 6144 + 1024};
                pg8::gemm_phase<pg8::EpiRes<true>, pg8::Sched2, true, true>(F.lds, g, S, E); }
            else { pg8::EpiRes<false> E{A.out, (const float*)(ws + WS_XC), A.out, ws, 9 * 6144 + 5120, nullptr, 0};
                pg8::gemm_phase<pg8::EpiRes<false>, pg8::Sched2, true, true>(F.lds, g, S, E); }
            SEAM(base + 5);
        }
#endif
    }
#undef IN
#undef SEAM
}
static_assert(EWS_MOD == WS_MOD && EWS_BIN == WS_BIN && EWS_BGU == WS_BGU && EWS_ROPE == WS_ROPE && EWS_SSQ == WS_SSQ && EWS_A == WS_A && EWS_XC == WS_XC && EWS_QB == WS_QB && EWS_KB == WS_KB && EWS_VB == WS_VB && EWS_TC == WS_TC && EWS_T == WS_T && EWS_H == WS_H, "epilogue offsets vs d_ws map");
#ifndef MK_PER_PHASE
#define MK_PER_PHASE 0
#endif
extern "C" void kernel_launch(void* const* d_in, const int* in_sizes, int n_in, void* d_out, int out_size, void* d_ws, size_t ws_size, hipStream_t stream) {
    static int grid = 0;
    if (grid == 0) {
        if (n_in != 21 || in_sizes[0] != M_LAT * DM || out_size != M_LAT * DM || ws_size < WS_END) { fprintf(stderr, "kernel_launch: unexpected shapes (n_in %d, in0 %d, out %d, ws %zu)\n", n_in, n_in > 0 ? in_sizes[0] : -1, out_size, ws_size); grid = -1; return; }
        int dev = 0, cus = 0, per_cu = 0;
        if (hipGetDevice(&dev) != hipSuccess || hipDeviceGetAttribute(&cus, hipDeviceAttributeMultiprocessorCount, dev) != hipSuccess) { grid = -1; return; }
        if (hipFuncSetAttribute((const void*)fwd_kernel, hipFuncAttributeMaxDynamicSharedMemorySize, LDS_BYTES) != hipSuccess) { fprintf(stderr, "kernel_launch: hipFuncSetAttribute failed\n"); grid = -1; return; }
        if (hipOccupancyMaxActiveBlocksPerMultiprocessor(&per_cu, (const void*)fwd_kernel, NWAVES * 64, LDS_BYTES) != hipSuccess || per_cu < 1) { fprintf(stderr, "kernel_launch: occupancy query reports %d\n", per_cu); }
        (void)hipGetLastError();
        grid = cus;
    }
    if (grid < 0) return;
    (void)hipMemsetAsync((char*)d_ws + WS_CTL, 0, CTL_ZERO_BYTES, stream);
    Args a{};
    for (int i = 0; i < 21; ++i) a.in[i] = (const float*)d_in[i];
    a.out = (float*)d_out; a.ws = (unsigned char*)d_ws;
#if MK_PER_PHASE
    for (int ph = 0; ph < N_PHASES; ++ph) { a.ph_lo = ph; a.ph_hi = ph + 1; hipLaunchKernelGGL(fwd_kernel, dim3(grid), dim3(NWAVES * 64), LDS_BYTES, stream, a); }
#else
    a.ph_lo = 0; a.ph_hi = N_PHASES; hipLaunchKernelGGL(fwd_kernel, dim3(grid), dim3(NWAVES * 64), LDS_BYTES, stream, a);
#endif
    const hipError_t le = hipPeekAtLastError();
    if (le != hipSuccess) fprintf(stderr, "kernel_launch: launch failed: %s\n", hipGetErrorName(le));
}
```

```cpp
#define MK_PER_PHASE 0
#include <hip/hip_runtime.h>
#include <cstdio>
#include <cstdint>
#include <math.h>
constexpr size_t EWS_MOD = 1u << 20, EWS_BIN = 512 * 1024, EWS_BGU = EWS_MOD + 768 * 1024, EWS_ROPE = EWS_BGU + 512 * 1024, EWS_SSQ = 5u << 20, EWS_A = 56u << 20, EWS_XC = 92u << 20,
                 EWS_QB = 100u << 20, EWS_KB = 118u << 20, EWS_VB = 136u << 20, EWS_TC = 186u << 20, EWS_T = 190u << 20, EWS_H = 100u << 20;
namespace pg8 {
#define PG8_LAS __attribute__((address_space(3)))
typedef unsigned short bf16_t;
typedef short bf16x8 __attribute__((ext_vector_type(8)));
typedef float f32x4 __attribute__((ext_vector_type(4)));
typedef unsigned u32x4 __attribute__((ext_vector_type(4)));
constexpr int BM = 256, BK = 64, HALF = 128, HTB = HALF * BK * 2  , STAGE_BYTES = 8 * HTB, NXCD = 8, WGM = 8;

__host__ __device__ __forceinline__ int lds_byte(int r, int c) { const int st = (r >> 4) * 2 + (c >> 5), rr = r & 15, cc = c & 31, ob = rr * 64 + cc * 2; return st * 1024 + (ob ^ (((ob >> 9) & 1) << 5)); }
__host__ __device__ __forceinline__ void stage_rc(int b, int& R, int& C) { const int st = b / 1024, sb = b % 1024, swz = sb ^ (((sb >> 9) & 1) << 5); R = (st >> 1) * 16 + swz / 64; C = (st & 1) * 32 + (swz % 64) / 2; }
__host__ __device__ __forceinline__ int perm32(int rho) { const int n = rho >> 4, i = rho & 15; return 8 * (i >> 2) + 4 * n + (i & 3); }

struct Unit { int pm, pn; };
struct Gemm { const bf16_t* A; const bf16_t* Bt; int M, N, K; };

struct StaticOrder {
    int nM, nN, nwg, G, c;
    __host__ __device__ void init(int M, int N, int G_, int c_) { nM = M / BM; nN = N / BM; nwg = nM * nN; G = G_; c = c_; }
    __host__ __device__ bool next(int i, Unit& u) const {
        const long L = (long)i * G + c; if (L >= nwg) return false;
        int wgid = (int)L; { const int q = nwg / NXCD, r = nwg % NXCD, xcd = wgid % NXCD, off = wgid / NXCD; wgid = (xcd < r ? xcd * (q + 1) : r * (q + 1) + (xcd - r) * q) + off; }
        const int nig = WGM * nN, gid = wgid / nig, fm = gid * WGM, gsz = (nM - fm) < WGM ? (nM - fm) : WGM;
        u.pm = fm + ((wgid % nig) % gsz); u.pn = (wgid % nig) / gsz; return true;
    }
    __device__ __forceinline__ void a_ready(const Unit&) const {}
    __device__ __forceinline__ void done(const Unit&) const {}
};

struct Sched2 {
    int nMa, nNa, nA, pmB, nMb, pnB, nNb, nB, G, c;
    __device__ void init(int nMa_, int nNa_, int pmB_, int nMb_, int pnB_, int nNb_, int G_, int c_, int rot) { nMa = nMa_; nNa = nNa_; nA = nMa * nNa; pmB = pmB_; nMb = nMb_; pnB = pnB_; nNb = nNb_; nB = nMb * nNb; G = G_; c = (c_ + rot) % G_; }
    __device__ bool next(int i, Unit& u) const {
        const long L = (long)i * G + c; if (L >= nA + nB) return false;
        if (L < nA) {
            int wgid = (int)L; { const int q = nA / NXCD, r = nA % NXCD, xcd = wgid % NXCD, off = wgid / NXCD; wgid = (xcd < r ? xcd * (q + 1) : r * (q + 1) + (xcd - r) * q) + off; }
            const int nig = WGM * nNa, gid = wgid / nig, fm = gid * WGM, gsz = (nMa - fm) < WGM ? (nMa - fm) : WGM;
            u.pm = fm + ((wgid % nig) % gsz); u.pn = (wgid % nig) / gsz;
        } else { const int r = (int)L - nA; u.pm = pmB + r % nMb; u.pn = pnB + r / nMb; }
        return true;
    }
    __device__ __forceinline__ void a_ready(const Unit&) const {}
    __device__ __forceinline__ void done(const Unit&) const {}
};
__device__ __forceinline__ unsigned cvt_pk_bf16(float lo, float hi) { unsigned r; asm volatile("v_cvt_pk_bf16_f32 %0, %1, %2" : "=v"(r) : "v"(lo), "v"(hi)); return r; }
typedef unsigned u32x2 __attribute__((ext_vector_type(2)));
__device__ __forceinline__ u32x2 pk4(f32x4 v) { u32x2 w; w.x = cvt_pk_bf16(v[0], v[1]); w.y = cvt_pk_bf16(v[2], v[3]); return w; }
__device__ __forceinline__ float dot4(f32x4 v) { return (v[0] * v[0] + v[1] * v[1]) + (v[2] * v[2] + v[3] * v[3]); }
constexpr int M_LAT_TILES = 64;
constexpr float QSCALE = 0.125f * 1.4426950408889634f;
constexpr float ZS_LAT = 1.0f / 512.0f;
constexpr float ZS_CTX = 0.005524271728019903f;

struct EpiIn {
    static constexpr bool PERM = false, AFTER_DRAIN = false;
    unsigned char* ws; int layer; const float* qg; const float* kg; const PG8_LAS float* rtab;
    __device__ __forceinline__ void operator()(const f32x4 (&acc)[2][2][4][2], const Unit& u, int ui, int wr, int wc, int fr, int fq) const {
        const int pm = u.pm, pn = u.pn; const bool lat = pm < M_LAT_TILES; const int bm = lat ? (pm >> 3) : 8;
        const float* bias = (const float*)(ws + EWS_BIN) + layer * 9 * 2560; const float* rope = (const float*)(ws + EWS_ROPE);
        bf16_t* QB = (bf16_t*)(ws + EWS_QB); bf16_t* KB = (bf16_t*)(ws + EWS_KB); bf16_t* VB = (bf16_t*)(ws + EWS_VB); bf16_t* T = (bf16_t*)(ws + EWS_T); bf16_t* Tc = (bf16_t*)(ws + EWS_TC);
        const float* bp = bias + bm * 2560 + pn * 256 + wc * 32 + fq * 4;
        f32x4 bv[2][2];
#pragma unroll
        for (int bj = 0; bj < 2; ++bj)
#pragma unroll
            for (int n = 0; n < 2; ++n) bv[bj][n] = *(const f32x4*)(bp + bj * 128 + n * 16);
        const PG8_LAS float* rt = rtab + ui * 256 + wr * 64 + fr;
        if (pn < 4) {
            const float* gp = (pn < 2 ? qg : kg) + fq * 4; const float qs = pn < 2 ? QSCALE : 1.f;
            f32x4 gv[2][2];
#pragma unroll
            for (int bj = 0; bj < 2; ++bj)
#pragma unroll
                for (int n = 0; n < 2; ++n) gv[bj][n] = *(const f32x4*)(gp + bj * 32 + n * 16) * qs;
            bf16_t* dst = (pn < 2 ? QB : KB) + (pn & 1) * 256 + wc * 64 + fq * 4;
#pragma unroll
            for (int ai = 0; ai < 2; ++ai)
#pragma unroll
                for (int m = 0; m < 4; ++m) {
                    const int rl = ai * 128 + wr * 64 + m * 16 + fr, row = pm * 256 + rl; const float r = rt[ai * 128 + m * 16];
                    f32x4 v[2][2]; float ssq = 0.f;
#pragma unroll
                    for (int bj = 0; bj < 2; ++bj)
#pragma unroll
                        for (int n = 0; n < 2; ++n) { v[bj][n] = acc[ai][bj][m][n] * r + bv[bj][n]; ssq += dot4(v[bj][n]); }
                    ssq += __shfl_xor(ssq, 16); ssq += __shfl_xor(ssq, 32);
                    const float rn = 1.0f / sqrtf(ssq * (1.0f / 64.0f) + 1e-6f);
#pragma unroll
                    for (int bj = 0; bj < 2; ++bj)
#pragma unroll
                        for (int n = 0; n < 2; ++n) v[bj][n] = v[bj][n] * rn * gv[bj][n];
                    if (lat) { const float* cp = rope + (row & 2047) * 32 + fq * 4;
#pragma unroll
                        for (int bj = 0; bj < 2; ++bj) { const f32x4 c4 = *(const f32x4*)(cp + bj * 16), s4 = *(const f32x4*)(cp + 65536 + bj * 16); const f32x4 t1 = v[bj][0], t2 = v[bj][1];
                            v[bj][0] = t1 * c4 - t2 * s4; v[bj][1] = t2 * c4 + t1 * s4; } }
#pragma unroll
                    for (int bj = 0; bj < 2; ++bj)
#pragma unroll
                        for (int n = 0; n < 2; ++n) *(u32x2*)(dst + (size_t)row * 512 + bj * 32 + n * 16) = pk4(v[bj][n]);
                }
        } else if (pn < 6) {
            bf16_t* dst = VB + (pn - 4) * 256 + wc * 32 + fq * 4;
#pragma unroll
            for (int ai = 0; ai < 2; ++ai)
#pragma unroll
                for (int m = 0; m < 4; ++m) {
                    const int rl = ai * 128 + wr * 64 + m * 16 + fr, row = pm * 256 + rl; const float r = rt[ai * 128 + m * 16];
#pragma unroll
                    for (int bj = 0; bj < 2; ++bj)
#pragma unroll
                        for (int n = 0; n < 2; ++n) *(u32x2*)(dst + (size_t)row * 512 + bj * 128 + n * 16) = pk4(acc[ai][bj][m][n] * r + bv[bj][n]);
                }
        } else {
            const int g = pn - 6; const float zs = lat ? ZS_LAT : ZS_CTX;
            const int b = lat ? (pm >> 3) : (pm - M_LAT_TILES); const int L = lat ? 2048 : 256; const int pos0 = lat ? (pm & 7) * 256 : 0;
            bf16_t* tb = (lat ? T : Tc) + (size_t)(b * 512 + g * 128 + wc * 32 + fq * 4) * 2 * L;
#pragma unroll
            for (int ai = 0; ai < 2; ++ai)
#pragma unroll
                for (int m = 0; m < 4; ++m) {
                    const int rl = ai * 128 + wr * 64 + m * 16 + fr, pos = pos0 + rl; const float r = rt[ai * 128 + m * 16];
#pragma unroll
                    for (int bj = 0; bj < 2; ++bj)
#pragma unroll
                        for (int n = 0; n < 2; ++n) { const f32x4 v = (acc[ai][bj][m][n] * r + bv[bj][n]) * zs; const u32x2 w = pk4(v);
                            bf16_t* p = tb + ((size_t)(n * 16) * 2 + bj) * L + pos;
                            p[0] = (bf16_t)(w.x & 0xffffu); p[(size_t)2 * L] = (bf16_t)(w.x >> 16); p[(size_t)4 * L] = (bf16_t)(w.y & 0xffffu); p[(size_t)6 * L] = (bf16_t)(w.y >> 16); }
                }
        }
    }
};
template <bool NEXT> struct EpiRes {
    static constexpr bool PERM = false, AFTER_DRAIN = false;
    const float* xl_in; const float* xc_in; float* xl_out;
    unsigned char* ws; int gate_off;
    const float* ng; int nsc_off;
    __device__ __forceinline__ void operator()(const f32x4 (&acc)[2][2][4][2], const Unit& u, int ui, int wr, int wc, int fr, int fq) const {
        const int pm = u.pm, pn = u.pn; const bool lat = pm < M_LAT_TILES; const int bm = lat ? (pm >> 3) : 8; const int col0 = pn * 256 + wc * 32 + fq * 4;
        const float* gate = (const float*)(ws + EWS_MOD) + gate_off; const float* nsc = (const float*)(ws + EWS_MOD) + nsc_off; bf16_t* A = (bf16_t*)(ws + EWS_A); float* ssq = (float*)(ws + EWS_SSQ); float* xc_out = (float*)(ws + EWS_XC);
        f32x4 ga[2][2], gv[2][2];
#pragma unroll
        for (int bj = 0; bj < 2; ++bj)
#pragma unroll
            for (int n = 0; n < 2; ++n) { const int c = col0 + bj * 128 + n * 16; ga[bj][n] = *(const f32x4*)(gate + bm * 6144 + c);
                if (NEXT) gv[bj][n] = *(const f32x4*)(ng + c) * (*(const f32x4*)(nsc + bm * 6144 + c) + 1.0f); }
        const float* xin = lat ? xl_in + (size_t)pm * 256 * 1024 : xc_in + (size_t)(pm - M_LAT_TILES) * 256 * 1024;
        float* xout = lat ? xl_out + (size_t)pm * 256 * 1024 : xc_out + (size_t)(pm - M_LAT_TILES) * 256 * 1024;
#pragma unroll
        for (int ai = 0; ai < 2; ++ai)
#pragma unroll
            for (int m = 0; m < 4; ++m) {
                const int rl = ai * 128 + wr * 64 + m * 16 + fr; const size_t row = (size_t)pm * 256 + rl; float ssq_ = 0.f;
#pragma unroll
                for (int bj = 0; bj < 2; ++bj)
#pragma unroll
                    for (int n = 0; n < 2; ++n) { const size_t off = (size_t)rl * 1024 + col0 + bj * 128 + n * 16; const f32x4 xo = *(const f32x4*)(xin + off); const f32x4 xn = xo + ga[bj][n] * acc[ai][bj][m][n];
                        *(f32x4*)(xout + off) = xn;
                        if (NEXT) { ssq_ += dot4(xn); *(u32x2*)(A + row * 1024 + col0 + bj * 128 + n * 16) = pk4(xn * gv[bj][n]); } }
                if (NEXT) { ssq_ += __shfl_xor(ssq_, 16); ssq_ += __shfl_xor(ssq_, 32); if (fq == 0) ssq[row * 16 + pn * 4 + wc] = ssq_; }
                asm volatile("" ::: "memory");
            }
    }
};
struct EpiGU {
    static constexpr bool PERM = false, AFTER_DRAIN = false;
    unsigned char* ws; int layer; const PG8_LAS float* rtab;
    __device__ __forceinline__ void operator()(const f32x4 (&acc)[2][2][4][2], const Unit& u, int ui, int wr, int wc, int fr, int fq) const {
        const int pm = u.pm, pn = u.pn; const int bm = pm < M_LAT_TILES ? (pm >> 3) : 8;
        const float* bias = (const float*)(ws + EWS_BGU) + layer * 9 * 5632; bf16_t* H = (bf16_t*)(ws + EWS_H);
        const float* bp = bias + bm * 5632 + pn * 256 + wc * 32 + fq * 4;
        f32x4 bg[2], bu[2];
#pragma unroll
        for (int n = 0; n < 2; ++n) { bg[n] = *(const f32x4*)(bp + n * 16); bu[n] = *(const f32x4*)(bp + 128 + n * 16); }
        const PG8_LAS float* rt = rtab + ui * 256 + wr * 64 + fr;
        bf16_t* dst = H + pn * 128 + wc * 32 + fq * 4;
#pragma unroll
        for (int ai = 0; ai < 2; ++ai)
#pragma unroll
            for (int m = 0; m < 4; ++m) {
                const int rl = ai * 128 + wr * 64 + m * 16 + fr; const size_t row = (size_t)pm * 256 + rl; const float r = rt[ai * 128 + m * 16];
#pragma unroll
                for (int n = 0; n < 2; ++n) { const f32x4 gg = acc[ai][0][m][n] * r + bg[n], uu = acc[ai][1][m][n] * r + bu[n]; f32x4 h;
#pragma unroll
                    for (int i = 0; i < 4; ++i) h[i] = gg[i] * __builtin_amdgcn_rcpf(1.0f + __builtin_amdgcn_exp2f(-1.4426950408889634f * gg[i])) * uu[i];
                    *(u32x2*)(dst + row * 2816 + n * 16) = pk4(h); }
            }
    }
};
struct EpiDft {
    static constexpr bool PERM = true, AFTER_DRAIN = false;
    bf16_t* MIX;
    __device__ __forceinline__ void operator()(const f32x4 (&acc)[2][2][4][2], const Unit& u, int ui, int wr, int wc, int fr, int fq) const {
        const int pn = u.pn;
#pragma unroll
        for (int bj = 0; bj < 2; ++bj) {
            const int c = pn * 256 + bj * 128 + wc * 32 + fq * 8; int rowbase, rstride, ch;
            if (pn < 128) { const int b = c >> 12, r = (c >> 9) & 7; ch = c & 511; rowbase = b * 2048 + r; rstride = 8; }
            else { const int c2 = c - 32768; const int b = c2 >> 9; ch = c2 & 511; rowbase = 16384 + b * 256; rstride = 1; }
#pragma unroll
            for (int ai = 0; ai < 2; ++ai)
#pragma unroll
                for (int m = 0; m < 4; ++m) { const int mm = ai * 128 + wr * 64 + m * 16 + fr; const size_t row = (size_t)rowbase + (size_t)mm * rstride;
                    const f32x4 v0 = acc[ai][bj][m][0], v1 = acc[ai][bj][m][1]; u32x4 w; w.x = cvt_pk_bf16(v0[0], v0[1]); w.y = cvt_pk_bf16(v0[2], v0[3]); w.z = cvt_pk_bf16(v1[0], v1[1]); w.w = cvt_pk_bf16(v1[2], v1[3]);
                    *(u32x4*)(MIX + row * 1024 + 512 + ch) = w; }
        }
    }
};
template <class Epi, class Sched, bool ALIGN_EPI = false, bool SP2 = false>
__device__ __forceinline__ void gemm_phase(PG8_LAS unsigned char* lds, const Gemm g, const Sched& S, const Epi& E) {
    int tid_ = threadIdx.x; asm volatile("" : "+v"(tid_));
    const int tid = tid_, wid = __builtin_amdgcn_readfirstlane(tid >> 6), lane = tid & 63, wr = wid >> 2, wc = wid & 3, fr = lane & 15, fq = lane >> 4;
    const int K = g.K, nt = K / BK;
    unsigned voffA[2], voffB[2];
#pragma unroll
    for (int i = 0; i < 2; ++i) { int R, C; stage_rc(tid * 16 + i * 8192, R, C); const int Rb = Epi::PERM ? ((R & ~31) + perm32(R & 31)) : R;
        voffA[i] = (unsigned)(R * K + C) * 2u; voffB[i] = (unsigned)(Rb * K + C) * 2u; }
    const size_t kstep = (size_t)(BK * 2);
    const size_t hstep = (size_t)HALF * K * 2;
    const size_t tstep = 2 * hstep;
    const unsigned ldsw = (unsigned)wid * 1024u;
    const int aoff = lds_byte(wr * 64 + fr, fq * 8), boff = lds_byte(wc * 32 + fr, fq * 8);
#define PG8_SA(b, h) (((b) * 2 + (h)) * HTB)
#define PG8_SB(b, h) ((4 + (b) * 2 + (h)) * HTB)
#define PG8_STAGE(bufoff, gbase, voff) do { _Pragma("unroll") for (int _i = 0; _i < 2; ++_i) \
        __builtin_amdgcn_global_load_lds((const unsigned*)((const char*)(gbase) + (voff)[_i]), (PG8_LAS unsigned*)(lds + (bufoff) + ldsw + _i * 8192), 16, 0, 0); } while (0)
#define PG8_LDA(dst, b, h) do { _Pragma("unroll") for (int m = 0; m < 4; ++m) _Pragma("unroll") for (int k = 0; k < 2; ++k) dst[m][k] = *(const PG8_LAS bf16x8*)(lds + PG8_SA(b, h) + aoff + m * 2048 + k * 1024); } while (0)
#define PG8_LDB(dst, b, h) do { _Pragma("unroll") for (int n = 0; n < 2; ++n) _Pragma("unroll") for (int k = 0; k < 2; ++k) dst[n][k] = *(const PG8_LAS bf16x8*)(lds + PG8_SB(b, h) + boff + n * 2048 + k * 1024); } while (0)
#define PG8_MMA(ai, bj, At, Bt) do { __builtin_amdgcn_s_setprio(1); _Pragma("unroll") for (int m = 0; m < 4; ++m) _Pragma("unroll") for (int n = 0; n < 2; ++n) _Pragma("unroll") for (int k = 0; k < 2; ++k) \
        acc[ai][bj][m][n] = __builtin_amdgcn_mfma_f32_16x16x32_bf16(Bt[n][k], At[m][k], acc[ai][bj][m][n], 0, 0, 0); __builtin_amdgcn_s_setprio(0); } while (0)
#define PG8_WAIT_V(n) asm volatile("s_waitcnt vmcnt(" #n ")" ::: "memory")
#define PG8_WAIT_L(n) asm volatile("s_waitcnt lgkmcnt(" #n ")" ::: "memory")
#define PG8_BAR __builtin_amdgcn_s_barrier()
#define PG8_SCHED __builtin_amdgcn_sched_barrier(0)
    Unit cur, nxt; int ui = 0;
    if (!S.next(0, cur)) return;
    f32x4 acc[2][2][4][2];
#pragma unroll
    for (int a = 0; a < 2; ++a)
#pragma unroll
        for (int b = 0; b < 2; ++b)
#pragma unroll
            for (int m = 0; m < 4; ++m)
#pragma unroll
                for (int n = 0; n < 2; ++n) acc[a][b][m][n] = (f32x4){0.f, 0.f, 0.f, 0.f};
    bf16x8 At[4][2], B0[2][2], B1[2][2];
    const char* cA = (const char*)g.A + (size_t)cur.pm * tstep; const char* cB = (const char*)g.Bt + (size_t)cur.pn * tstep;
    S.a_ready(cur);
    if constexpr (SP2) {
        PG8_STAGE(PG8_SB(0, 0), cB, voffB); PG8_STAGE(PG8_SB(0, 1), cB + hstep, voffB); PG8_STAGE(PG8_SA(0, 0), cA, voffA); PG8_STAGE(PG8_SA(0, 1), cA + hstep, voffA);
        if (wr == 1) PG8_BAR;
        PG8_WAIT_V(2); PG8_BAR;
        PG8_STAGE(PG8_SB(1, 0), cB + kstep, voffB); PG8_STAGE(PG8_SA(1, 0), cA + kstep, voffA); PG8_STAGE(PG8_SB(1, 1), cB + hstep + kstep, voffB);
        PG8_WAIT_V(6); PG8_BAR;
    } else {
        PG8_STAGE(PG8_SB(0, 0), cB, voffB); PG8_STAGE(PG8_SA(0, 0), cA, voffA); PG8_STAGE(PG8_SB(0, 1), cB + hstep, voffB); PG8_STAGE(PG8_SA(0, 1), cA + hstep, voffA);
        if (wr == 1) PG8_BAR;
        PG8_WAIT_V(4); PG8_BAR;
        PG8_STAGE(PG8_SB(1, 0), cB + kstep, voffB); PG8_STAGE(PG8_SA(1, 0), cA + kstep, voffA); PG8_STAGE(PG8_SB(1, 1), cB + hstep + kstep, voffB);
        PG8_WAIT_V(6); PG8_BAR;
    }
    for (;;) {
        const bool has_next = S.next(ui + 1, nxt);
        const char* nA = has_next ? (const char*)g.A + (size_t)nxt.pm * tstep : cA; const char* nB = has_next ? (const char*)g.Bt + (size_t)nxt.pn * tstep : cB;
        for (int t = 0; t < nt; t += 2) {
            const bool last = (t == nt - 2);
            const char* a1 = cA + (size_t)(t + 1) * kstep;
            const char* a2 = last ? nA : cA + (size_t)(t + 2) * kstep; const char* b2 = last ? nB : cB + (size_t)(t + 2) * kstep;
            const char* a3 = a2 + kstep; const char* b3 = b2 + kstep;
            if (last && has_next) S.a_ready(nxt);
            if constexpr (SP2) {
            PG8_LDB(B0, 0, 0); PG8_LDB(B1, 0, 1); PG8_SCHED; PG8_LDA(At, 0, 0); PG8_STAGE(PG8_SA(1, 1), a1 + hstep, voffA);
            PG8_WAIT_V(8); PG8_WAIT_L(0); PG8_BAR; PG8_MMA(0, 0, At, B0); PG8_MMA(0, 1, At, B1); PG8_BAR; PG8_SCHED;
            PG8_LDA(At, 0, 1); PG8_STAGE(PG8_SB(0, 0), b2, voffB); PG8_STAGE(PG8_SB(0, 1), b2 + hstep, voffB); PG8_STAGE(PG8_SA(0, 0), a2, voffA);
            PG8_WAIT_V(8); PG8_WAIT_L(0); PG8_BAR; PG8_MMA(1, 0, At, B0); PG8_MMA(1, 1, At, B1); PG8_BAR; PG8_SCHED;
            PG8_LDB(B0, 1, 0); PG8_LDB(B1, 1, 1); PG8_SCHED; PG8_LDA(At, 1, 0); PG8_STAGE(PG8_SA(0, 1), a2 + hstep, voffA);
            PG8_WAIT_V(8); PG8_WAIT_L(0); PG8_BAR; PG8_MMA(0, 0, At, B0); PG8_MMA(0, 1, At, B1); PG8_BAR; PG8_SCHED;
            PG8_LDA(At, 1, 1); PG8_STAGE(PG8_SB(1, 0), b3, voffB); PG8_STAGE(PG8_SB(1, 1), b3 + hstep, voffB); PG8_STAGE(PG8_SA(1, 0), a3, voffA);
            PG8_WAIT_V(8); PG8_WAIT_L(0); PG8_BAR; PG8_MMA(1, 0, At, B0); PG8_MMA(1, 1, At, B1); PG8_BAR; PG8_SCHED;
            } else {
            PG8_LDB(B0, 0, 0); PG8_SCHED; PG8_LDA(At, 0, 0); PG8_STAGE(PG8_SA(1, 1), a1 + hstep, voffA);
            PG8_WAIT_L(8); PG8_BAR; PG8_WAIT_L(0); PG8_MMA(0, 0, At, B0); PG8_BAR; PG8_SCHED;
            PG8_LDB(B1, 0, 1); PG8_STAGE(PG8_SB(0, 0), b2, voffB);
            PG8_BAR; PG8_WAIT_L(0); PG8_MMA(0, 1, At, B1); PG8_BAR;
            PG8_LDA(At, 0, 1); PG8_STAGE(PG8_SA(0, 0), a2, voffA);
            PG8_BAR; PG8_WAIT_L(0); PG8_MMA(1, 0, At, B0); PG8_BAR; PG8_SCHED;
            PG8_STAGE(PG8_SB(0, 1), b2 + hstep, voffB);
            PG8_WAIT_V(6); PG8_BAR; PG8_MMA(1, 1, At, B1); PG8_BAR;
            PG8_LDB(B0, 1, 0); PG8_SCHED; PG8_LDA(At, 1, 0); PG8_STAGE(PG8_SA(0, 1), a2 + hstep, voffA);
            PG8_WAIT_L(8); PG8_BAR; PG8_WAIT_L(0); PG8_MMA(0, 0, At, B0); PG8_BAR; PG8_SCHED;
            PG8_LDB(B1, 1, 1); PG8_STAGE(PG8_SB(1, 0), b3, voffB);
            PG8_BAR; PG8_WAIT_L(0); PG8_MMA(0, 1, At, B1); PG8_BAR;
            PG8_LDA(At, 1, 1); PG8_STAGE(PG8_SA(1, 0), a3, voffA);
            PG8_BAR; PG8_WAIT_L(0); PG8_MMA(1, 0, At, B0); PG8_BAR; PG8_SCHED;
            PG8_STAGE(PG8_SB(1, 1), b3 + hstep, voffB);
            PG8_WAIT_V(6); PG8_BAR; PG8_MMA(1, 1, At, B1); PG8_BAR;
            }
        }
        if constexpr (ALIGN_EPI) { if (wr == 0) PG8_BAR; }
        if constexpr (!Epi::AFTER_DRAIN) { E(acc, cur, ui, wr, wc, fr, fq); S.done(cur); }
        if (!has_next) break;
#pragma unroll
        for (int a = 0; a < 2; ++a)
#pragma unroll
            for (int b = 0; b < 2; ++b)
#pragma unroll
                for (int m = 0; m < 4; ++m)
#pragma unroll
                    for (int n = 0; n < 2; ++n) acc[a][b][m][n] = (f32x4){0.f, 0.f, 0.f, 0.f};
        cur = nxt; cA = nA; cB = nB; ++ui;
        if constexpr (ALIGN_EPI) { if (wr == 1) PG8_BAR; }
    }
    PG8_WAIT_V(0);
    if constexpr (!ALIGN_EPI) { if (wr == 0) PG8_BAR; }
    PG8_BAR;
    if constexpr (Epi::AFTER_DRAIN) { E.fused(acc, cur, wr, wc, fr, fq, lds, wid, lane); S.done(cur); }
#undef PG8_SA
#undef PG8_SB
#undef PG8_STAGE
#undef PG8_LDA
#undef PG8_LDB
#undef PG8_MMA
#undef PG8_WAIT_V
#undef PG8_WAIT_L
#undef PG8_BAR
#undef PG8_SCHED
}
}
#ifndef EN_ATTEPI
#define EN_ATTEPI 1
#endif
namespace att {
typedef unsigned short bf16;
using bf16x8 = __attribute__((ext_vector_type(8))) short;
using s16x4  = __attribute__((ext_vector_type(4))) short;
using f32x16 = __attribute__((ext_vector_type(16))) float;
using u32x4  = __attribute__((ext_vector_type(4))) unsigned;
constexpr int KVBLK = 64;
constexpr size_t SHM_V = KVBLK * 128 * 2, SHM_K = KVBLK * 128 * 2, SHM_ATTN = 2 * SHM_V + 2 * SHM_K + 8 * 64 * 4;
#define KSWZ(row, colB) ((row) * 256 + ((colB) ^ (((row) & 7) << 4)))
#define SBAR() __builtin_amdgcn_sched_barrier(0)
__device__ __forceinline__ int crow(int r, int hi) { return (r & 3) + 8 * (r >> 2) + 4 * hi; }
__device__ __forceinline__ unsigned cvtpk(float lo, float hi) { unsigned r; asm volatile("v_cvt_pk_bf16_f32 %0, %1, %2" : "=v"(r) : "v"(lo), "v"(hi)); return r; }
__device__ __forceinline__ bf16x8 ld8(const bf16* p) { return *reinterpret_cast<const bf16x8*>(p); }
__device__ __forceinline__ void sm_first(f32x16& p0, f32x16& p1, float negoff) {
  (void)p1; (void)negoff;
#pragma unroll
  for (int r = 0; r < 16; ++r) p0[r] = __builtin_amdgcn_exp2f(p0[r]);
}
__device__ __forceinline__ void sm_finish(f32x16& p0, f32x16& p1, float& l_reg, bf16x8& pa0, bf16x8& pa1, bf16x8& pa2, bf16x8& pa3) {
#pragma unroll
  for (int r = 0; r < 16; ++r) p1[r] = __builtin_amdgcn_exp2f(p1[r]);
  float ps = 0;
#pragma unroll
  for (int r = 0; r < 16; ++r) ps += p0[r];
#pragma unroll
  for (int r = 0; r < 16; ++r) ps += p1[r];
  l_reg += ps;
#define PK4(P, BASE, OUT) do { unsigned a0 = cvtpk(P[BASE + 0], P[BASE + 1]), a1 = cvtpk(P[BASE + 2], P[BASE + 3]);   \
    unsigned b0 = cvtpk(P[BASE + 4], P[BASE + 5]), b1 = cvtpk(P[BASE + 6], P[BASE + 7]);                              \
    auto r0 = __builtin_amdgcn_permlane32_swap(a0, b0, false, false); auto r1 = __builtin_amdgcn_permlane32_swap(a1, b1, false, false); \
    u32x4 w = {r0[0], r1[0], r0[1], r1[1]}; OUT = *reinterpret_cast<bf16x8*>(&w); } while (0)
  PK4(p0, 0, pa0); PK4(p0, 8, pa1); PK4(p1, 0, pa2); PK4(p1, 8, pa3);
#undef PK4
}
__device__ __forceinline__ void qkt(f32x16& p0, f32x16& p1, const bf16* Ks, const bf16x8* qr, int r32, int hi, int mapoff, float negoff) {
  p0 = f32x16{}; p1 = f32x16{}; (void)negoff;
#pragma unroll
  for (int d0 = 0; d0 < 4; ++d0) { const int cb = (mapoff + d0 * 16 + hi * 8) * 2;
    bf16x8 b0 = *reinterpret_cast<const bf16x8*>((const char*)Ks + KSWZ(r32, cb));
    bf16x8 b1 = *reinterpret_cast<const bf16x8*>((const char*)Ks + KSWZ(32 + r32, cb));
    p0 = __builtin_amdgcn_mfma_f32_32x32x16_bf16(b0, qr[d0], p0, 0, 0, 0);
    p1 = __builtin_amdgcn_mfma_f32_32x32x16_bf16(b1, qr[d0], p1, 0, 0, 0); }
}
__device__ __forceinline__ int v_st(int k, int c) { const int kk = (k & ~0xC) | ((k & 4) << 1) | ((k & 8) >> 1); return ((kk >> 3) * 4 + (c >> 5)) * 512 + ((kk & 7) * 32 + (c & 31)) * 2; }
__device__ __forceinline__ int v_rd_base(int lane) { return ((lane & 3) << 3) | (((lane >> 2) & 3) << 6) | (((lane >> 4) & 1) << 5) | (((lane >> 5) & 1) << 8); }
constexpr int v_rd_off(int d0, int ks, int half) { return d0 * 512 + ks * 4096 + half * 2048; }
template <int OFF> __device__ __forceinline__ s16x4 tr_read(int vb) { s16x4 r; asm volatile("ds_read_b64_tr_b16 %0, %1 offset:%2" : "=&v"(r) : "v"(vb), "i"(OFF) : "memory"); return r; }
template <int D0> __device__ __forceinline__ void pv_one(f32x16& od, int vb, bf16x8 pa0, bf16x8 pa1, bf16x8 pa2, bf16x8 pa3) {
  const s16x4 l0 = tr_read<v_rd_off(D0, 0, 0)>(vb), h0 = tr_read<v_rd_off(D0, 0, 1)>(vb), l1 = tr_read<v_rd_off(D0, 1, 0)>(vb), h1 = tr_read<v_rd_off(D0, 1, 1)>(vb);
  const s16x4 l2 = tr_read<v_rd_off(D0, 2, 0)>(vb), h2 = tr_read<v_rd_off(D0, 2, 1)>(vb), l3 = tr_read<v_rd_off(D0, 3, 0)>(vb), h3 = tr_read<v_rd_off(D0, 3, 1)>(vb);
  asm volatile("s_waitcnt lgkmcnt(0)" ::: "memory"); SBAR();
#define PK(L, H) (bf16x8){L[0], L[1], L[2], L[3], H[0], H[1], H[2], H[3]}
  od = __builtin_amdgcn_mfma_f32_32x32x16_bf16(pa0, PK(l0, h0), od, 0, 0, 0);
  od = __builtin_amdgcn_mfma_f32_32x32x16_bf16(pa1, PK(l1, h1), od, 0, 0, 0);
  od = __builtin_amdgcn_mfma_f32_32x32x16_bf16(pa2, PK(l2, h2), od, 0, 0, 0);
  od = __builtin_amdgcn_mfma_f32_32x32x16_bf16(pa3, PK(l3, h3), od, 0, 0, 0);
#undef PK
}
__device__ __forceinline__ void pv_d0(f32x16* o, int vb, bf16x8 pa0, bf16x8 pa1, bf16x8 pa2, bf16x8 pa3) {
  pv_one<0>(o[0], vb, pa0, pa1, pa2, pa3); pv_one<1>(o[1], vb, pa0, pa1, pa2, pa3); pv_one<2>(o[2], vb, pa0, pa1, pa2, pa3); pv_one<3>(o[3], vb, pa0, pa1, pa2, pa3);
}
__device__ __forceinline__ void attn_unit(const bf16* __restrict__ Qh, const bf16* __restrict__ Kh, const bf16* __restrict__ Vh, bf16* __restrict__ Oh, long qrow0, long k0a, int nt0, long k0b, int NT,
                                          float lam, float oscale, const float* __restrict__ subg, float negoff, char* lds) {
  int tid_ = threadIdx.x; asm volatile("" : "+v"(tid_));
  const int tid = tid_, wid = tid >> 6, lane = tid & 63, r32 = lane & 31, hi = lane >> 5, qsub = wid >> 1, map = wid & 1, mapoff = map * 64;
  bf16* V_lds = (bf16*)lds; bf16* K_lds = (bf16*)(lds + 2 * SHM_V);
  float* ws = (float*)(lds + 2 * SHM_V + 2 * SHM_K) + wid * 64; float* li_l = ws;
  float l_reg = 0; f32x16 o[4] = {}; bf16x8 qr[4];
  const bf16* Qw = Qh + (qrow0 + qsub * 32 + r32) * 512 + mapoff + hi * 8;
#pragma unroll
  for (int d0 = 0; d0 < 4; ++d0) qr[d0] = ld8(Qw + d0 * 16);
  const int sr = tid >> 4, sc = (tid & 15) * 8, vst0 = v_st(sr, sc), vst1 = v_st(32 + sr, sc);
  const int vb0 = (int)(uintptr_t)V_lds + v_rd_base(lane);
  bf16x8 vs0, vs1, ks0, ks1;
#define KROW(j) (((j) < nt0) ? (k0a + (long)(j) * KVBLK) : (k0b + (long)((j) - nt0) * KVBLK))
#define SLOAD(j) do { const long kr_ = KROW(j); vs0 = ld8(&Vh[(kr_ + sr) * 512 + sc]); vs1 = ld8(&Vh[(kr_ + 32 + sr) * 512 + sc]); \
    ks0 = ld8(&Kh[(kr_ + sr) * 512 + sc]); ks1 = ld8(&Kh[(kr_ + 32 + sr) * 512 + sc]); } while (0)
#define SWRITE(b) do { *(bf16x8*)((char*)V_lds + (b) * SHM_V + vst0) = vs0; *(bf16x8*)((char*)V_lds + (b) * SHM_V + vst1) = vs1; const int kc = sc * 2; \
    *(bf16x8*)((char*)K_lds + (b) * SHM_K + KSWZ(sr, kc)) = ks0; *(bf16x8*)((char*)K_lds + (b) * SHM_K + KSWZ(32 + sr, kc)) = ks1; } while (0)
  f32x16 p0, p1; bf16x8 pa0, pa1, pa2, pa3;
#define TILE(cur, j) do { if ((j) + 1 < NT) SWRITE((cur) ^ 1); if ((j) + 2 < NT) SLOAD((j) + 2); SBAR(); \
    qkt(p0, p1, (bf16*)((char*)K_lds + (cur) * SHM_K), qr, r32, hi, mapoff, negoff); sm_first(p0, p1, negoff); \
    sm_finish(p0, p1, l_reg, pa0, pa1, pa2, pa3); SBAR(); \
    pv_d0(o, vb0 + (cur) * (int)SHM_V, pa0, pa1, pa2, pa3); __syncthreads(); } while (0)
  SLOAD(0); asm volatile("s_waitcnt vmcnt(0)" ::: "memory"); SWRITE(0); __syncthreads();
  SLOAD(1);
  for (int j = 0; j < NT; j += 2) { TILE(0, j); TILE(1, j + 1); }
#undef TILE
#if EN_ATTEPI
  { auto rr = __builtin_amdgcn_permlane32_swap(__float_as_uint(l_reg), __float_as_uint(l_reg), false, false); l_reg = __uint_as_float(rr[0]) + __uint_as_float(rr[1]); }
  if (hi == 0) li_l[r32] = l_reg;
  asm volatile("s_waitcnt lgkmcnt(0)" ::: "memory");
  const float fm = map ? lam : 1.f;
#pragma unroll
  for (int r = 0; r < 16; ++r) { const float rl = __builtin_amdgcn_rcpf(li_l[crow(r, hi)]) * fm;
#pragma unroll
    for (int d0 = 0; d0 < 4; ++d0) o[d0][r] *= rl; }
  __syncthreads();
  float* X = (float*)lds + qsub * 4096 + lane;
  if (map == 1) {
#pragma unroll
    for (int d0 = 0; d0 < 4; ++d0)
#pragma unroll
      for (int r = 0; r < 16; ++r) X[(d0 * 16 + r) * 64] = o[d0][r];
  }
  __syncthreads();
  if (map == 0) {
    float sg[4];
#pragma unroll
    for (int d0 = 0; d0 < 4; ++d0) sg[d0] = subg[d0 * 32 + r32] * oscale;
    bf16* Ow = Oh + (qrow0 + qsub * 32) * 1024 + r32;
#pragma unroll
    for (int r = 0; r < 16; ++r) {
      float ss = 0.f;
#pragma unroll
      for (int d0 = 0; d0 < 4; ++d0) { o[d0][r] -= X[(d0 * 16 + r) * 64]; ss += o[d0][r] * o[d0][r]; }
      ss += __shfl_xor(ss, 1); ss += __shfl_xor(ss, 2); ss += __shfl_xor(ss, 4); ss += __shfl_xor(ss, 8); ss += __shfl_xor(ss, 16);
      const float rn = 1.0f / sqrtf(ss * (1.0f / 128.0f) + 1e-6f);
      const int orow = crow(r, hi);
#pragma unroll
      for (int d0 = 0; d0 < 4; ++d0) { const unsigned w = cvtpk(o[d0][r] * rn * sg[d0], 0.f); Ow[(long)orow * 1024 + d0 * 32] = (bf16)(w & 0xffffu); }
    }
  }
  __syncthreads();
#else
  { float s = l_reg; for (int d0 = 0; d0 < 4; ++d0) for (int r = 0; r < 16; ++r) s += o[d0][r]; Oh[qrow0 * 1024 + tid] = (bf16)(int)s; }
#endif
#undef KROW
#undef SLOAD
#undef SWRITE
}
#undef KSWZ
#undef SBAR
}
#ifndef EN_ALL
#define EN_ALL 1
#endif
#ifndef EN_PH0
#define EN_PH0 EN_ALL
#endif
#ifndef EN_PH1
#define EN_PH1 EN_ALL
#endif
#ifndef EN_P1
#define EN_P1 EN_ALL
#endif
#ifndef EN_P2A
#define EN_P2A EN_ALL
#endif
#ifndef EN_P2B
#define EN_P2B EN_ALL
#endif
#ifndef EN_P3
#define EN_P3 EN_ALL
#endif
#ifndef EN_P4
#define EN_P4 EN_ALL
#endif
#ifndef EN_P5
#define EN_P5 EN_ALL
#endif
#ifndef EN_ATT
#define EN_ATT 1
#endif
#ifndef EN_DFT
#define EN_DFT 1
#endif
#ifndef EN_ATTC
#define EN_ATTC 1
#endif
constexpr int NWAVES = 8;
constexpr int DM = 1024, NBATCH = 8, SEQ = 2048, CTXL = 256, M_LAT = NBATCH * SEQ, M_CTX = NBATCH * CTXL, M_ALL = M_LAT + M_CTX, NIN = 2560, NINSRC = 2048, FFD = 2816, NGU = 5632, NLAYER = 2;
constexpr size_t MiB = 1u << 20;
constexpr size_t WS_CTL = 0, CTL_ZERO_BYTES = 1 * MiB;
constexpr size_t WS_MOD = 1 * MiB;
constexpr size_t WS_BIN = 512 * 1024;
constexpr size_t WS_BGU = WS_MOD + 768 * 1024;
constexpr size_t WS_ROPE = WS_BGU + 512 * 1024;
constexpr size_t WS_DFT = WS_ROPE + 512 * 1024;
constexpr size_t WS_TF = 4 * MiB;
constexpr size_t WS_SSQ = 5 * MiB;
constexpr size_t WS_WIN = 8 * MiB;
constexpr size_t WS_WOUT = 18 * MiB;
constexpr size_t WS_WGU = 22 * MiB;
constexpr size_t WS_WDN = 44 * MiB;
constexpr size_t WS_A = 56 * MiB;
constexpr size_t WS_XC = 92 * MiB;
constexpr size_t WS_QB = 100 * MiB, WS_KB = 118 * MiB, WS_VB = 136 * MiB;
constexpr size_t WS_Y = 154 * MiB;
constexpr size_t WS_TC = 186 * MiB;
constexpr size_t WS_MIX = 190 * MiB;
constexpr size_t WS_T = WS_MIX;
constexpr size_t WS_H = 100 * MiB;
constexpr size_t WS_END = 226 * MiB;
static_assert(WS_DFT + 256 * 512 * 2 <= WS_TF && WS_SSQ + (size_t)M_ALL * 64 <= WS_WIN && WS_H + (size_t)M_ALL * FFD * 2 <= WS_END && WS_MIX + (size_t)M_ALL * DM * 2 <= WS_END, "d_ws map");
constexpr int CW_TMO = 0, CW_BAR = 4096;
constexpr int RING_BYTES = 131072, RTAB_OFF = RING_BYTES, RTAB_BYTES = 8192, LDSCTL_OFF = RTAB_OFF + RTAB_BYTES, MISC_OFF = LDSCTL_OFF + 320, LDS_BYTES = 147456;
static_assert(MISC_OFF + 128 <= LDS_BYTES, "LDS map");
constexpr int N_PHASES = 2 + 6 * NLAYER;

#define GAS __attribute__((address_space(1)))
#define LAS __attribute__((address_space(3)))
typedef unsigned short bf16;
typedef unsigned v4u __attribute__((ext_vector_type(4)));
typedef unsigned v2u __attribute__((ext_vector_type(2)));
typedef float f32x4 __attribute__((ext_vector_type(4)));
#define LDS_WAIT() asm volatile("s_waitcnt lgkmcnt(0)" ::: "memory")
#define VM_WAIT() asm volatile("s_waitcnt vmcnt(0)" ::: "memory")
__device__ __forceinline__ unsigned f2bf(float f) { unsigned u = __builtin_bit_cast(unsigned, f); return (u + 0x7fffu + ((u >> 16) & 1u)) >> 16; }
__device__ __forceinline__ unsigned pk2(float lo, float hi) { return f2bf(lo) | (f2bf(hi) << 16); }
__device__ __forceinline__ float bf2f(unsigned short h) { return __builtin_bit_cast(float, (unsigned)h << 16); }
__device__ __forceinline__ float wave_sum(float v) {
#pragma unroll
    for (int o = 1; o < 64; o <<= 1) v += __shfl_xor(v, o);
    return v;
}

#define XB_TMO      128
#define XB_XCNT(j)  (256  + 64 * (j))
#define XB_XSUB(j)  (1280 + 64 * (j))
#define XB_XGEN(j)  (2304 + 64 * (j))
#define XB_TOP      3328
#define XB_TOPGEN   3392
#define XCD_BAR_WORDS 3456
#define XB_SPIN_CAP (1u << 18)

__device__ __forceinline__ unsigned xb_ld(unsigned* p)              { return __hip_atomic_load(p, __ATOMIC_RELAXED, __HIP_MEMORY_SCOPE_AGENT); }
__device__ __forceinline__ unsigned xb_add(unsigned* p, unsigned v) { return __hip_atomic_fetch_add(p, v, __ATOMIC_RELAXED, __HIP_MEMORY_SCOPE_AGENT); }
__device__ __forceinline__ unsigned xb_xcc_id() { return (unsigned)__builtin_amdgcn_s_getreg((3 << 11) | 20) & 0xFu; }
#define XB_SPIN(cond, bar) do { unsigned _sp = 0; while (cond) { __builtin_amdgcn_s_sleep(1); \
    if ((++_sp & 255u) == 0u) { if (xb_ld(&(bar)[XB_TMO])) break; if (_sp > XB_SPIN_CAP) { atomicAdd(&(bar)[XB_TMO], 1u); break; } } } } while (0)

struct XcdBarrier {
    unsigned* bar; unsigned x;
    volatile LAS unsigned* st;
};

__device__ __forceinline__ XcdBarrier xcd_barrier_post(unsigned* bar, volatile LAS unsigned* st) {
    XcdBarrier b; b.bar = bar; b.x = xb_xcc_id(); b.st = st;
    if (threadIdx.x == 0) (void)xb_add(&bar[XB_XCNT(b.x)], 1u);
    return b;
}
__device__ __forceinline__ void xcd_barrier_complete(unsigned* bar, unsigned x, unsigned& nloc, unsigned& nx) {
    const unsigned G = gridDim.x * gridDim.y * gridDim.z;
    unsigned sum, cnt, mine, sp = 0u;
    for (;;) {
        sum = 0u; cnt = 0u; mine = 0u;
#pragma unroll
        for (unsigned j = 0; j < 16; ++j) { const unsigned c = xb_ld(&bar[XB_XCNT(j)]); sum += c; cnt += (c > 0u) ? 1u : 0u; mine = (j == x) ? c : mine; }
        if (sum == G) break;
        __builtin_amdgcn_s_sleep(1);
        if ((++sp & 255u) == 0u) { if (xb_ld(&bar[XB_TMO])) break; if (sp > XB_SPIN_CAP) { atomicAdd(&bar[XB_TMO], 1u); break; } }
    }
    nloc = mine > 0u ? mine : 1u; nx = cnt > 0u ? cnt : 1u;
}

__device__ __forceinline__ void xcd_barrier(const XcdBarrier& b) {
    asm volatile("s_waitcnt vmcnt(0)" ::: "memory");
    __syncthreads();
    if (threadIdx.x == 0) {
        unsigned* bar = b.bar;
        __builtin_amdgcn_s_waitcnt(0);
        unsigned nloc = b.st[0], nx = b.st[1];
        if (nloc == 0u) { xcd_barrier_complete(bar, b.x, nloc, nx); b.st[0] = nloc; b.st[1] = nx; }
        const unsigned old = xb_add(&bar[XB_XSUB(b.x)], 1u);
        const unsigned gen = old / nloc;
        if (old + 1u == (gen + 1u) * nloc) {
            __builtin_amdgcn_fence(__ATOMIC_RELEASE, "agent");
            asm volatile("s_waitcnt vmcnt(0)" ::: "memory");
            const unsigned og = xb_add(&bar[XB_TOP], 1u);
            const unsigned tg = og / nx;
            if (og + 1u == (tg + 1u) * nx) xb_add(&bar[XB_TOPGEN], 1u);
            else XB_SPIN(xb_ld(&bar[XB_TOPGEN]) == tg, bar);
            __builtin_amdgcn_fence(__ATOMIC_ACQUIRE, "agent");
            xb_add(&bar[XB_XGEN(b.x)], 1u);
            asm volatile("s_waitcnt vmcnt(0)" ::: "memory");
        } else {
            XB_SPIN(xb_ld(&bar[XB_XGEN(b.x)]) == gen, bar);
            __builtin_amdgcn_fence(__ATOMIC_ACQUIRE, "agent");
            asm volatile("s_waitcnt vmcnt(0)" ::: "memory");
        }
    }
    __syncthreads();
}


struct Args { const float* in[21]; float* out; unsigned char* ws; int ph_lo, ph_hi; };
struct Frame {
    LAS unsigned char* lds; int wave, vcu, G;
};

__device__ __forceinline__ void transpose_item(const float* W, int ldn, bf16* WT, int ldk, int k0, int n0, int drow0, LAS float* scr, int lane) {
#pragma unroll 8
    for (int i = 0; i < 32; ++i) { const int kk = 2 * i + (lane >> 5); scr[kk * 33 + (lane & 31)] = W[(size_t)(k0 + kk) * ldn + n0 + (lane & 31)]; }
    LDS_WAIT(); asm volatile("" ::: "memory");
    const int c = lane & 7;
#pragma unroll
    for (int j = 0; j < 4; ++j) { const int n = (lane >> 3) + 8 * j; const LAS float* s = scr + (8 * c) * 33 + n;
        v4u o; o.x = pk2(s[0 * 33], s[1 * 33]); o.y = pk2(s[2 * 33], s[3 * 33]); o.z = pk2(s[4 * 33], s[5 * 33]); o.w = pk2(s[6 * 33], s[7 * 33]);
        *(GAS v4u*)(WT + (size_t)(drow0 + n) * ldk + k0 + 8 * c) = o; }
    LDS_WAIT(); asm volatile("" ::: "memory");
}
__device__ __forceinline__ void ph0(Frame& F, const Args& A, unsigned char* ws) {
    LAS float* scr = (LAS float*)(F.lds + F.wave * 16384);
    const int gw = F.vcu * NWAVES + F.wave, NGW = F.G * NWAVES;
    constexpr int I_IN = 16 * 48, I_OUT = 16 * 32, I_G = 16 * 88, I_D = 44 * 32, I_LAYER = I_IN + I_OUT + 2 * I_G + I_D;
    for (int it = gw; it < NLAYER * I_LAYER; it += NGW) {
        const int l = it / I_LAYER; int r = it % I_LAYER;
        if (r < I_IN) { const int kb = r / 48, nb = r % 48, n0 = nb * 32, pn = n0 >> 8, cc = n0 & 255; const int drow = pn < 4 ? pn * 256 + ((cc >> 5) & 1) * 128 + (cc >> 6) * 32 : n0;
            transpose_item(A.in[8] + (size_t)l * DM * NINSRC, NINSRC, (bf16*)(ws + WS_WIN) + (size_t)l * NIN * DM, DM, kb * 64, n0, drow, scr, ((int)threadIdx.x & 63)); continue; } r -= I_IN;
        if (r < I_OUT) { const int kb = r / 32, nb = r % 32; transpose_item(A.in[17] + (size_t)l * DM * DM, DM, (bf16*)(ws + WS_WOUT) + (size_t)l * DM * DM, DM, kb * 64, nb * 32, nb * 32, scr, ((int)threadIdx.x & 63)); continue; } r -= I_OUT;
        if (r < 2 * I_G) { const int up = r >= I_G; if (up) r -= I_G; const int kb = r / 88, nb = r % 88, n0 = nb * 32; const int drow = (n0 >> 7) * 256 + up * 128 + (n0 & 127);
            transpose_item((up ? A.in[19] : A.in[18]) + (size_t)l * DM * FFD, FFD, (bf16*)(ws + WS_WGU) + (size_t)l * NGU * DM, DM, kb * 64, n0, drow, scr, ((int)threadIdx.x & 63)); continue; } r -= 2 * I_G;
        { const int kb = r / 32, nb = r % 32; transpose_item(A.in[20] + (size_t)l * FFD * DM, DM, (bf16*)(ws + WS_WDN) + (size_t)l * DM * FFD, FFD, kb * 64, nb * 32, nb * 32, scr, ((int)threadIdx.x & 63)); }
    }
    __syncthreads();
    LAS float* sl = (LAS float*)F.lds;
    LAS float* red = (LAS float*)(F.lds + 40960);
    for (int i = ((int)threadIdx.x); i < 9 * DM; i += NWAVES * 64) { const int j = i >> 10, k = i & 1023; const float v = (j < 8) ? A.in[1][j * DM + k] : A.in[3][k]; sl[i] = v / (1.f + __expf(-v)); }
    __syncthreads();
    for (int it = F.vcu; it < NLAYER * 96; it += F.G) {
        const int l = it / 96, n = (it % 96) * 64 + ((int)threadIdx.x & 63); const float* W = A.in[4] + (size_t)l * DM * 6144 + n;
        float acc[9];
#pragma unroll
        for (int j = 0; j < 9; ++j) acc[j] = 0.f;
        const int kb = F.wave * 128;
#pragma unroll 4
        for (int k = 0; k < 128; k += 4) { float w0 = W[(size_t)(kb + k) * 6144], w1 = W[(size_t)(kb + k + 1) * 6144], w2 = W[(size_t)(kb + k + 2) * 6144], w3 = W[(size_t)(kb + k + 3) * 6144];
#pragma unroll
            for (int j = 0; j < 9; ++j) { const f32x4 s = *(const LAS f32x4*)(sl + j * DM + kb + k); acc[j] += s[0] * w0 + s[1] * w1 + s[2] * w2 + s[3] * w3; } }
#pragma unroll
        for (int j = 0; j < 9; ++j) red[(F.wave * 9 + j) * 64 + ((int)threadIdx.x & 63)] = acc[j];
        __syncthreads();
        for (int i = ((int)threadIdx.x); i < 9 * 64; i += NWAVES * 64) { const int j = i >> 6, ln = i & 63; float s = 0.f;
#pragma unroll
            for (int w = 0; w < 8; ++w) s += red[(w * 9 + j) * 64 + ln];
            const int nn = (it % 96) * 64 + ln; ((float*)(ws + WS_MOD))[(l * 9 + j) * 6144 + nn] = s + A.in[5][l * 6144 + nn]; }
        __syncthreads();
    }
    const int gt = F.vcu * (NWAVES * 64) + ((int)threadIdx.x), NGT = F.G * NWAVES * 64;
    for (int i = gt; i < 2048 * 32; i += NGT) { const int pos = i >> 5, j = i & 31; const float inv = powf(10000.0f, -(float)(j & 15) * (1.0f / 16.0f)); const float ang = (float)((j < 16) ? (pos >> 6) : (pos & 63)) * inv;
        float sn, cs; sincosf(ang, &sn, &cs); ((float*)(ws + WS_ROPE))[i] = cs; ((float*)(ws + WS_ROPE))[65536 + i] = sn; }
    for (int i = gt; i < 256 * 512; i += NGT) { const int m = i >> 9, kk = i & 511, n = kk & 255; const int p = (m * n) & 255; float sn, cs; sincospif((float)p * (1.0f / 128.0f), &sn, &cs);
        ((bf16*)(ws + WS_DFT))[i] = (bf16)f2bf(kk < 256 ? cs : sn); }
    { LAS float* ct = (LAS float*)(F.lds + 65536); LAS float* st = ct + 128;
      if ((int)threadIdx.x < 128) { float sn, cs; sincospif((float)(int)threadIdx.x * (1.0f / 64.0f), &sn, &cs); ct[threadIdx.x] = cs; st[threadIdx.x] = sn; }
      __syncthreads();
      for (int i = gt; i < NLAYER * 4 * 128 * 256; i += NGT) { const int d = i & 127, ri = (i >> 7) & 1, cch = (i >> 8) & 127, lg = i >> 15; const float* w = A.in[16] + (size_t)lg * 128 * 128 + d; float s = 0.f;
#pragma unroll 8
          for (int c2 = 0; c2 < 128; ++c2) { const int p = (cch * c2) & 127; s += (ri ? -st[p] : ct[p]) * w[c2 * 128]; }
          ((float*)(ws + WS_TF))[i] = s; } }
}
__device__ __forceinline__ void ph1(Frame& F, const Args& A, unsigned char* ws) {
    const float* mod = (const float*)(ws + WS_MOD);
    { const int gw = F.vcu * NWAVES + F.wave, NGW = F.G * NWAVES;
      for (int row = gw; row < M_ALL; row += NGW) {
          const bool lat = row < M_LAT; const int bm = lat ? (row >> 11) : 8; const float* xr = lat ? A.in[0] + (size_t)row * DM : A.in[2] + (size_t)(row - M_LAT) * DM;
          const float* sc = mod + bm * 6144 + 1024; float s = 0.f; f32x4 v[4];
#pragma unroll
          for (int j = 0; j < 4; ++j) { v[j] = *(const f32x4*)(xr + 256 * j + 4 * ((int)threadIdx.x & 63)); s += (v[j][0] * v[j][0] + v[j][1] * v[j][1]) + (v[j][2] * v[j][2] + v[j][3] * v[j][3]); }
          s = wave_sum(s);
          bf16* ar = (bf16*)(ws + WS_A) + (size_t)row * DM;
#pragma unroll
          for (int j = 0; j < 4; ++j) { const int k = 256 * j + 4 * ((int)threadIdx.x & 63); const f32x4 g = *(const f32x4*)(A.in[6] + k) * (*(const f32x4*)(sc + k) + 1.0f); const f32x4 a = v[j] * g; v2u w; w.x = pk2(a[0], a[1]); w.y = pk2(a[2], a[3]); *(v2u*)(ar + k) = w; }
          if (((int)threadIdx.x & 63) < 16) ((float*)(ws + WS_SSQ))[(size_t)row * 16 + ((int)threadIdx.x & 63)] = ((int)threadIdx.x & 63) == 0 ? s : 0.f;
      } }
    __syncthreads();
    { LAS float* wl = (LAS float*)F.lds;
      LAS float* tl = (LAS float*)(F.lds + 128 * 132 * 4);
      LAS float* shl = (LAS float*)(F.lds + 128 * 132 * 4 + 128 * 64 * 4);
      LAS float* redl = shl + 9 * 128;
      for (int it = F.vcu; it < NLAYER * 4 * 4 * 8; it += F.G) {
          const int kb = it & 7, q = (it >> 3) & 3, g = (it >> 5) & 3, l = it >> 7;
          const float* wsrc = A.in[8] + (size_t)l * DM * NINSRC + (size_t)(kb * 128) * NINSRC + 1536 + g * 128;
          for (int i = ((int)threadIdx.x); i < 128 * 32; i += NWAVES * 64) { const int k = i >> 5, c4 = (i & 31) * 4; *(LAS f32x4*)(wl + k * 132 + c4) = *(const f32x4*)(wsrc + (size_t)k * NINSRC + c4); }
          const float* tsrc = (const float*)(ws + WS_TF) + (size_t)(l * 4 + g) * 128 * 256 + q * 64;
          for (int i = ((int)threadIdx.x); i < 128 * 16; i += NWAVES * 64) { const int cch = i >> 4, d4 = (i & 15) * 4; *(LAS f32x4*)(tl + cch * 64 + d4) = *(const f32x4*)(tsrc + (size_t)cch * 256 + d4); }
          for (int i = ((int)threadIdx.x); i < 9 * 128; i += NWAVES * 64) shl[i] = mod[(l * 9 + (i >> 7)) * 6144 + kb * 128 + (i & 127)];
          __syncthreads();
          const int dcol = ((int)threadIdx.x) & 63, kg = ((int)threadIdx.x) >> 6; float acc[16];
#pragma unroll
          for (int i = 0; i < 16; ++i) acc[i] = 0.f;
          for (int c4 = 0; c4 < 128; c4 += 4) { const float t0 = tl[c4 * 64 + dcol], t1 = tl[(c4 + 1) * 64 + dcol], t2 = tl[(c4 + 2) * 64 + dcol], t3 = tl[(c4 + 3) * 64 + dcol];
#pragma unroll
              for (int i = 0; i < 16; ++i) { const f32x4 w = *(const LAS f32x4*)(wl + (kg * 16 + i) * 132 + c4); acc[i] += w[0] * t0 + w[1] * t1 + w[2] * t2 + w[3] * t3; } }
          bf16* dst = (bf16*)(ws + WS_WIN) + (size_t)l * NIN * DM + (size_t)(1536 + g * 256 + q * 64 + dcol) * DM + kb * 128 + kg * 16;
          v4u o0, o1; o0.x = pk2(acc[0], acc[1]); o0.y = pk2(acc[2], acc[3]); o0.z = pk2(acc[4], acc[5]); o0.w = pk2(acc[6], acc[7]); o1.x = pk2(acc[8], acc[9]); o1.y = pk2(acc[10], acc[11]); o1.z = pk2(acc[12], acc[13]); o1.w = pk2(acc[14], acc[15]);
          *(v4u*)dst = o0; *(v4u*)(dst + 8) = o1;
          { float bs[9];
#pragma unroll
            for (int j = 0; j < 9; ++j) { float s = 0.f;
#pragma unroll
                for (int i4 = 0; i4 < 4; ++i4) { const f32x4 sv = *(const LAS f32x4*)(shl + j * 128 + kg * 16 + i4 * 4); s += sv[0] * acc[4 * i4] + sv[1] * acc[4 * i4 + 1] + sv[2] * acc[4 * i4 + 2] + sv[3] * acc[4 * i4 + 3]; }
                bs[j] = s; }
#pragma unroll
            for (int j = 0; j < 9; ++j) redl[(kg * 9 + j) * 64 + dcol] = bs[j]; }
          __syncthreads();
          for (int i = (int)threadIdx.x; i < 9 * 64; i += NWAVES * 64) { const int j = i >> 6, dc = i & 63; float s = 0.f;
#pragma unroll
              for (int w = 0; w < 8; ++w) s += redl[(w * 9 + j) * 64 + dc];
              atomicAdd((float*)(ws + WS_BIN) + (l * 9 + j) * NIN + 1536 + g * 256 + q * 64 + dc, s); }
          __syncthreads();
      } }
    { LAS float* sh = (LAS float*)F.lds;
      const int gw = F.vcu * NWAVES + F.wave, NGW = F.G * NWAVES;
      for (int st = 0; st < 2 * NLAYER; ++st) {
          const int l = st >> 1, gu = st & 1;
          for (int i = ((int)threadIdx.x); i < 9 * DM; i += NWAVES * 64) sh[i] = mod[(l * 9 + (i >> 10)) * 6144 + (gu ? 3072 : 0) + (i & 1023)];
          __syncthreads();
          const int nrow = gu ? NGU : 1536; const bf16* WT = gu ? (const bf16*)(ws + WS_WGU) + (size_t)l * NGU * DM : (const bf16*)(ws + WS_WIN) + (size_t)l * NIN * DM;
          float* bo = gu ? (float*)(ws + WS_BGU) + l * 9 * NGU : (float*)(ws + WS_BIN) + l * 9 * NIN; const int ldb = gu ? NGU : NIN;
          for (int n = gw; n < nrow; n += NGW) {
              float wv[16]; { const v4u a = *(const v4u*)(WT + (size_t)n * DM + ((int)threadIdx.x & 63) * 16), b = *(const v4u*)(WT + (size_t)n * DM + ((int)threadIdx.x & 63) * 16 + 8);
                  const unsigned u[8] = {a.x, a.y, a.z, a.w, b.x, b.y, b.z, b.w};
#pragma unroll
                  for (int i = 0; i < 8; ++i) { wv[2 * i] = __builtin_bit_cast(float, u[i] << 16); wv[2 * i + 1] = __builtin_bit_cast(float, u[i] & 0xffff0000u); } }
#pragma unroll
              for (int j = 0; j < 9; ++j) { float s = 0.f;
#pragma unroll
                  for (int i4 = 0; i4 < 4; ++i4) { const f32x4 sv = *(const LAS f32x4*)(sh + j * DM + ((int)threadIdx.x & 63) * 16 + i4 * 4); s += sv[0] * wv[4 * i4] + sv[1] * wv[4 * i4 + 1] + sv[2] * wv[4 * i4 + 2] + sv[3] * wv[4 * i4 + 3]; }
                  s = wave_sum(s); if (((int)threadIdx.x & 63) == 0) bo[j * ldb + n] = s; }
          }
          __syncthreads();
      } }
}
__device__ __forceinline__ void fft8(float (&xr)[8], float (&xi)[8]) {
    const float S = 0.70710678118654752f;
    const float u0r = xr[0] + xr[4], u0i = xi[0] + xi[4], d0r = xr[0] - xr[4], d0i = xi[0] - xi[4];
    const float u1r = xr[1] + xr[5], u1i = xi[1] + xi[5], d1r = xr[1] - xr[5], d1i = xi[1] - xi[5];
    const float u2r = xr[2] + xr[6], u2i = xi[2] + xi[6], d2r = xr[2] - xr[6], d2i = xi[2] - xi[6];
    const float u3r = xr[3] + xr[7], u3i = xi[3] + xi[7], d3r = xr[3] - xr[7], d3i = xi[3] - xi[7];
    const float v0r = d0r, v0i = d0i;
    const float v1r = (d1r + d1i) * S, v1i = (d1i - d1r) * S;
    const float v2r = d2i, v2i = -d2r;
    const float v3r = (d3i - d3r) * S, v3i = -(d3r + d3i) * S;
    { const float p0r = u0r + u2r, p0i = u0i + u2i, p1r = u1r + u3r, p1i = u1i + u3i, p2r = u0r - u2r, p2i = u0i - u2i, qr = u1r - u3r, qi = u1i - u3i; const float p3r = qi, p3i = -qr;
      xr[0] = p0r + p1r; xi[0] = p0i + p1i; xr[4] = p0r - p1r; xi[4] = p0i - p1i; xr[2] = p2r + p3r; xi[2] = p2i + p3i; xr[6] = p2r - p3r; xi[6] = p2i - p3i; }
    { const float p0r = v0r + v2r, p0i = v0i + v2i, p1r = v1r + v3r, p1i = v1i + v3i, p2r = v0r - v2r, p2i = v0i - v2i, qr = v1r - v3r, qi = v1i - v3i; const float p3r = qi, p3i = -qr;
      xr[1] = p0r + p1r; xi[1] = p0i + p1i; xr[5] = p0r - p1r; xi[5] = p0i - p1i; xr[3] = p2r + p3r; xi[3] = p2i + p3i; xr[7] = p2r - p3r; xi[7] = p2i - p3i; }
}
__device__ __forceinline__ void butterfly_phase(Frame& F, unsigned char* ws) {
    const bf16* T = (const bf16*)(ws + WS_T); bf16* Y = (bf16*)(ws + WS_Y);
    int tid_ = threadIdx.x; asm volatile("" : "+v"(tid_));
    const int gt = F.vcu * (NWAVES * 64) + tid_, NGT = F.G * NWAVES * 64;
    for (int it = gt; it < NBATCH * 512 * 128; it += NGT) {
        const int n0 = (it & 127) * 2, bc = it >> 7; const bf16* tp = T + (size_t)bc * 2 * 2048 + n0;
        unsigned pr[8], pi[8];
        pr[0] = *(const unsigned*)(tp); pr[1] = *(const unsigned*)(tp + 256); pr[2] = *(const unsigned*)(tp + 512); pr[3] = *(const unsigned*)(tp + 768);
        pr[4] = *(const unsigned*)(tp + 1024); pr[5] = *(const unsigned*)(tp + 1280); pr[6] = *(const unsigned*)(tp + 1536); pr[7] = *(const unsigned*)(tp + 1792);
        pi[0] = *(const unsigned*)(tp + 2048); pi[1] = *(const unsigned*)(tp + 2304); pi[2] = *(const unsigned*)(tp + 2560); pi[3] = *(const unsigned*)(tp + 2816);
        pi[4] = *(const unsigned*)(tp + 3072); pi[5] = *(const unsigned*)(tp + 3328); pi[6] = *(const unsigned*)(tp + 3584); pi[7] = *(const unsigned*)(tp + 3840);
        float ar[8], ai[8], br[8], bi[8];
#define BF_UNP(k) ar[k] = __builtin_bit_cast(float, pr[k] << 16); br[k] = __builtin_bit_cast(float, pr[k] & 0xffff0000u); ai[k] = __builtin_bit_cast(float, pi[k] << 16); bi[k] = __builtin_bit_cast(float, pi[k] & 0xffff0000u);
        BF_UNP(0) BF_UNP(1) BF_UNP(2) BF_UNP(3) BF_UNP(4) BF_UNP(5) BF_UNP(6) BF_UNP(7)
#undef BF_UNP
        fft8(ar, ai); fft8(br, bi);
        const int b = bc >> 9, ch = bc & 511;
        bf16* yp = Y + ((size_t)(b * 8) * 512 + ch) * 512 + n0;
        const float th0 = (float)n0 * (1.0f / 1024.0f), th1 = (float)(n0 + 1) * (1.0f / 1024.0f);
#define BF_OUT(r) { float s0, c0, s1, c1; sincospif(th0 * (float)(r), &s0, &c0); sincospif(th1 * (float)(r), &s1, &c1); \
          *(unsigned*)(yp + (size_t)(r) * 512 * 512) = pk2(ar[r] * c0 + ai[r] * s0, br[r] * c1 + bi[r] * s1); *(unsigned*)(yp + (size_t)(r) * 512 * 512 + 256) = pk2(ai[r] * c0 - ar[r] * s0, bi[r] * c1 - br[r] * s1); }
        BF_OUT(0) BF_OUT(1) BF_OUT(2) BF_OUT(3) BF_OUT(4) BF_OUT(5) BF_OUT(6) BF_OUT(7)
#undef BF_OUT
    }
}
template <class S> __device__ __forceinline__ void compute_rtab(Frame& F, unsigned char* ws, const S& sched) {
    LAS float* rt = (LAS float*)(F.lds + RTAB_OFF); pg8::Unit u;
    int tid_ = threadIdx.x; asm volatile("" : "+v"(tid_));
    const int t = tid_ & 255, par = tid_ >> 8;
    for (int i = 0; i < 8 && sched.next(i, u); ++i) if ((i & 1) == par) { const float* p = (const float*)(ws + WS_SSQ) + ((size_t)u.pm * 256 + t) * 16; float s = 0.f;
#pragma unroll
        for (int q = 0; q < 4; ++q) { const f32x4 a = *(const f32x4*)(p + 4 * q); s += (a[0] + a[1]) + (a[2] + a[3]); }
        rt[i * 256 + t] = __builtin_amdgcn_rsqf(s * (1.0f / 1024.0f) + 1e-6f); }
    __syncthreads();
}
__device__ __forceinline__ void attn_phase(Frame& F, const Args& A, unsigned char* ws, int l, char* lds) {
    const float lambda_init = l == 0 ? 0.2f : 0.355509068f;
    const float lam = expf(wave_sum(A.in[11][l * 64 + ((int)threadIdx.x & 63)] * A.in[12][l * 64 + ((int)threadIdx.x & 63)])) - expf(wave_sum(A.in[13][l * 64 + ((int)threadIdx.x & 63)] * A.in[14][l * 64 + ((int)threadIdx.x & 63)])) + lambda_init;
    float gq = fabsf(A.in[9][l * 64 + ((int)threadIdx.x & 63)]), gk = fabsf(A.in[10][l * 64 + ((int)threadIdx.x & 63)]);
#pragma unroll
    for (int o = 1; o < 64; o <<= 1) { gq = fmaxf(gq, __shfl_xor(gq, o)); gk = fmaxf(gk, __shfl_xor(gk, o)); }
    const float negoff = -fmaxf(0.f, 8.0f * 1.4426950408889634f * gq * gk * 1.0001f - 40.0f);
    const att::bf16* QB = (const att::bf16*)(ws + WS_QB); const att::bf16* KB = (const att::bf16*)(ws + WS_KB); const att::bf16* VB = (const att::bf16*)(ws + WS_VB); att::bf16* MIX = (att::bf16*)(ws + WS_MIX);
    const float* subg = A.in[15] + l * 128;
    const int per = (512 + F.G - 1) / F.G;
    for (int u = F.vcu * per; u < (F.vcu + 1) * per && u < 512; ++u) {
        const int qblk = u & 15, bh = u >> 4, b = bh >> 2, h = bh & 3;
        att::attn_unit(QB + h * 128, KB + h * 128, VB + h * 128, MIX + h * 128, (long)b * SEQ + qblk * 128, (long)M_LAT + b * CTXL, 4, (long)b * SEQ, 36, lam, 1.0f - lambda_init, subg, negoff, lds);
    }
#if EN_ATTC
    if (l == 0) for (int u = F.vcu; u < 64; u += F.G) {
        const int qblk = u & 1, bh = u >> 1, b = bh >> 2, h = bh & 3;
        att::attn_unit(QB + h * 128, KB + h * 128, VB + h * 128, MIX + h * 128, (long)M_LAT + b * CTXL + qblk * 128, (long)M_LAT + b * CTXL, 4, 0, 4, lam, 1.0f - lambda_init, subg, negoff, lds);
    }
#endif
}

__global__ void __launch_bounds__(NWAVES * 64, 2) fwd_kernel(const Args args) {
    extern __shared__ __attribute__((aligned(16))) unsigned char lds[];
    Frame F;
    F.lds = (LAS unsigned char*)lds;
    F.wave = __builtin_amdgcn_readfirstlane((int)threadIdx.x >> 6);
    F.G = gridDim.x; { const int bx = blockIdx.x; F.vcu = (F.G % 8 == 0) ? (bx % 8) * (F.G / 8) + bx / 8 : bx; }
    for (int u = ((int)threadIdx.x); u < (LDS_BYTES - LDSCTL_OFF) / 4; u += NWAVES * 64) ((LAS unsigned*)(F.lds + LDSCTL_OFF))[u] = 0u;
    __syncthreads();
    volatile LAS unsigned* MISC = (volatile LAS unsigned*)(F.lds + MISC_OFF);
    XcdBarrier bar = xcd_barrier_post((unsigned*)(args.ws + WS_CTL) + CW_BAR, MISC + 8);
    const int lo = args.ph_lo, hi = args.ph_hi;
#define IN(k) (lo <= (k) && (k) < hi)
#define SEAM(k) do { if (IN((k) + 1)) xcd_barrier(bar); } while (0)
#define PHASE_VARS unsigned char* ws = args.ws; asm volatile("" : "+s"(ws)); const Args& A = args; const pg8::bf16_t* ABUF = (const pg8::bf16_t*)(ws + WS_A); (void)ABUF; (void)A
    const LAS float* rtab = (const LAS float*)(F.lds + RTAB_OFF);
    const int cid = (int)blockIdx.x;
    #if EN_PH0
    if (IN(0)) { PHASE_VARS; ph0(F, A, ws); SEAM(0); }
#endif
    #if EN_PH1
    if (IN(1)) { PHASE_VARS; ph1(F, A, ws); SEAM(1); }
#endif
#pragma unroll 1
    for (int l = 0; l < NLAYER; ++l) {
        const int base = 2 + 6 * l; const int nM = l == 0 ? 72 : 64;
#if EN_P1
        if (IN(base + 0)) {
            PHASE_VARS;
            pg8::Sched2 S; if (l == 0) S.init(72, 10, 0, 0, 0, 0, F.G, cid, 0); else S.init(64, 10, 64, 8, 2, 4, F.G, cid, 0);
            compute_rtab(F, ws, S);
            pg8::Gemm g{ABUF, (const pg8::bf16_t*)(ws + WS_WIN) + (size_t)l * NIN * DM, M_ALL, NIN, DM};
            pg8::EpiIn E{ws, l, A.in[9] + l * 64, A.in[10] + l * 64, rtab};
            pg8::gemm_phase<pg8::EpiIn, pg8::Sched2, true, true>(F.lds, g, S, E);
            SEAM(base + 0);
        }
#endif
#if EN_P2A
        if (IN(base + 1)) { PHASE_VARS; butterfly_phase(F, ws); SEAM(base + 1); }
#endif
#if EN_P2B
        if (IN(base + 2)) {
            PHASE_VARS;
#if EN_ATT
            attn_phase(F, A, ws, l, (char*)lds);
#endif
#if EN_DFT
            pg8::Sched2 S; S.init(1, l == 0 ? 144 : 128, 0, 0, 0, 0, F.G, cid, F.G - 64);
            pg8::Gemm g{(const pg8::bf16_t*)(ws + WS_DFT), (const pg8::bf16_t*)(ws + WS_Y), 256, 36864, 512};
            pg8::EpiDft E{(pg8::bf16_t*)(ws + WS_MIX)};
            pg8::gemm_phase<pg8::EpiDft, pg8::Sched2, true, true>(F.lds, g, S, E);
#endif
            SEAM(base + 2);
        }
#endif
#if EN_P3
        if (IN(base + 3)) {
            PHASE_VARS;
            pg8::Sched2 S; S.init(nM, 4, 0, 0, 0, 0, F.G, cid, 0);
            pg8::Gemm g{(const pg8::bf16_t*)(ws + WS_MIX), (const pg8::bf16_t*)(ws + WS_WOUT) + (size_t)l * DM * DM, M_ALL, DM, DM};
            pg8::EpiRes<true> E{l == 0 ? A.in[0] : A.out, A.in[2], A.out, ws, l * 9 * 6144 + 2048, A.in[7] + l * DM, l * 9 * 6144 + 4096};
            pg8::gemm_phase<pg8::EpiRes<true>, pg8::Sched2, true, true>(F.lds, g, S, E);
            SEAM(base + 3);
        }
#endif
#if EN_P4
        if (IN(base + 4)) {
            PHASE_VARS;
            pg8::Sched2 S; S.init(nM, 22, 0, 0, 0, 0, F.G, cid, 0);
            compute_rtab(F, ws, S);
            pg8::Gemm g{ABUF, (const pg8::bf16_t*)(ws + WS_WGU) + (size_t)l * NGU * DM, M_ALL, NGU, DM};
            pg8::EpiGU E{ws, l, rtab};
            pg8::gemm_phase<pg8::EpiGU, pg8::Sched2, true, true>(F.lds, g, S, E);
            SEAM(base + 4);
        }
#endif
#if EN_P5
        if (IN(base + 5)) {
            PHASE_VARS;
            pg8::Sched2 S; S.init(nM, 4, 0, 0, 0, 0, F.G, cid, 0);
            pg8::Gemm g{(const pg8::bf16_t*)(ws + WS_H), (const pg8::bf16_t*)(ws + WS_WDN) + (size_t)l * DM * FFD, M_ALL, DM, FFD};
            if (l == 0) { pg8::EpiRes<true> E{A.out, (const float*)(ws + WS_XC), A.out, ws, 5120, A.in[6] + DM, 9 * 6144 + 1024};
                pg8::gemm_phase<pg8::EpiRes<true>, pg8::Sched2, true, true>(F.lds, g, S, E); }
            else { pg8::EpiRes<false> E{A.out, (const float*)(ws + WS_XC), A.out, ws, 9 * 6144 + 5120, nullptr, 0};
                pg8::gemm_phase<pg8::EpiRes<false>, pg8::Sched2, true, true>(F.lds, g, S, E); }
            SEAM(base + 5);
        }
#endif
    }
#undef IN
#undef SEAM
}
static_assert(EWS_MOD == WS_MOD && EWS_BIN == WS_BIN && EWS_BGU == WS_BGU && EWS_ROPE == WS_ROPE && EWS_SSQ == WS_SSQ && EWS_A == WS_A && EWS_XC == WS_XC && EWS_QB == WS_QB && EWS_KB == WS_KB && EWS_VB == WS_VB && EWS_TC == WS_TC && EWS_T == WS_T && EWS_H == WS_H, "epilogue offsets vs d_ws map");
#ifndef MK_PER_PHASE
#define MK_PER_PHASE 0
#endif
extern "C" void kernel_launch(void* const* d_in, const int* in_sizes, int n_in, void* d_out, int out_size, void* d_ws, size_t ws_size, hipStream_t stream) {
    static int grid = 0;
    if (grid == 0) {
        if (n_in != 21 || in_sizes[0] != M_LAT * DM || out_size != M_LAT * DM || ws_size < WS_END) { fprintf(stderr, "kernel_launch: unexpected shapes (n_in %d, in0 %d, out %d, ws %zu)\n", n_in, n_in > 0 ? in_sizes[0] : -1, out_size, ws_size); grid = -1; return; }
        int dev = 0, cus = 0, per_cu = 0;
        if (hipGetDevice(&dev) != hipSuccess || hipDeviceGetAttribute(&cus, hipDeviceAttributeMultiprocessorCount, dev) != hipSuccess) { grid = -1; return; }
        if (hipFuncSetAttribute((const void*)fwd_kernel, hipFuncAttributeMaxDynamicSharedMemorySize, LDS_BYTES) != hipSuccess) { fprintf(stderr, "kernel_launch: hipFuncSetAttribute failed\n"); grid = -1; return; }
        if (hipOccupancyMaxActiveBlocksPerMultiprocessor(&per_cu, (const void*)fwd_kernel, NWAVES * 64, LDS_BYTES) != hipSuccess || per_cu < 1) { fprintf(stderr, "kernel_launch: occupancy query reports %d\n", per_cu); }
        (void)hipGetLastError();
        grid = cus;
    }
    if (grid < 0) return;
    (void)hipMemsetAsync((char*)d_ws + WS_CTL, 0, CTL_ZERO_BYTES, stream);
    Args a{};
    for (int i = 0; i < 21; ++i) a.in[i] = (const float*)d_in[i];
    a.out = (float*)d_out; a.ws = (unsigned char*)d_ws;
#if MK_PER_PHASE
#ifndef REP_MASK
#define REP_MASK 0
#endif
    for (int ph = 0; ph < N_PHASES; ++ph) { a.ph_lo = ph; a.ph_hi = ph + 1; for (int rep = 0; rep < (((REP_MASK) >> ph) & 1) + 1; ++rep) hipLaunchKernelGGL(fwd_kernel, dim3(grid), dim3(NWAVES * 64), LDS_BYTES, stream, a); }
#else
    a.ph_lo = 0; a.ph_hi = N_PHASES; hipLaunchKernelGGL(fwd_kernel, dim3(grid), dim3(NWAVES * 64), LDS_BYTES, stream, a);
#endif
    const hipError_t le = hipPeekAtLastError();
    if (le != hipSuccess) fprintf(stderr, "kernel_launch: launch failed: %s\n", hipGetErrorName(le));
}
```

```cpp
#define MK_PER_PHASE 0
#include <hip/hip_runtime.h>
#include <cstdio>
#include <cstdint>
#include <math.h>
constexpr size_t EWS_MOD = 64 * 1024, EWS_BIN = 512 * 1024, EWS_BGU = (1u << 20) + 768 * 1024, EWS_ROPE = EWS_BGU + 512 * 1024, EWS_SSQ = 5u << 20, EWS_A = 56u << 20, EWS_XC = 92u << 20,
                 EWS_QB = 100u << 20, EWS_KB = 118u << 20, EWS_VB = 136u << 20, EWS_TC = 186u << 20, EWS_T = 154u << 20, EWS_H = 100u << 20, EWS_HC = 226u << 20;
namespace pg8 {
#define PG8_LAS __attribute__((address_space(3)))
typedef unsigned short bf16_t;
typedef short bf16x8 __attribute__((ext_vector_type(8)));
typedef float f32x4 __attribute__((ext_vector_type(4)));
typedef unsigned u32x4 __attribute__((ext_vector_type(4)));
constexpr int BM = 256, BK = 64, HALF = 128, HTB = HALF * BK * 2  , STAGE_BYTES = 8 * HTB, NXCD = 8, WGM = 2;

__host__ __device__ __forceinline__ int lds_byte(int r, int c) { const int st = (r >> 4) * 2 + (c >> 5), rr = r & 15, cc = c & 31, ob = rr * 64 + cc * 2; return st * 1024 + (ob ^ (((ob >> 9) & 1) << 5)); }
__host__ __device__ __forceinline__ void stage_rc(int b, int& R, int& C) { const int st = b / 1024, sb = b % 1024, swz = sb ^ (((sb >> 9) & 1) << 5); R = (st >> 1) * 16 + swz / 64; C = (st & 1) * 32 + (swz % 64) / 2; }
__host__ __device__ __forceinline__ int perm32(int rho) { const int n = rho >> 4, i = rho & 15; return 8 * (i >> 2) + 4 * n + (i & 3); }

struct Unit { int pm, pn; };
struct Gemm { const bf16_t* A; const bf16_t* Bt; int M, N, K; };

struct StaticOrder {
    int nM, nN, nwg, G, c;
    __host__ __device__ void init(int M, int N, int G_, int c_) { nM = M / BM; nN = N / BM; nwg = nM * nN; G = G_; c = c_; }
    __host__ __device__ bool next(int i, Unit& u) const {
        const long L = (long)i * G + c; if (L >= nwg) return false;
        int wgid = (int)L; { const int q = nwg / NXCD, r = nwg % NXCD, xcd = wgid % NXCD, off = wgid / NXCD; wgid = (xcd < r ? xcd * (q + 1) : r * (q + 1) + (xcd - r) * q) + off; }
        const int nig = WGM * nN, gid = wgid / nig, fm = gid * WGM, gsz = (nM - fm) < WGM ? (nM - fm) : WGM;
        u.pm = fm + ((wgid % nig) % gsz); u.pn = (wgid % nig) / gsz; return true;
    }
    __device__ __forceinline__ void a_ready(const Unit&) const {}
    __device__ __forceinline__ void done(const Unit&) const {}
};

struct Sched2 {
    int nMa, nNa, nA, pmB, nMb, pnB, nNb, nB, G, c, ns = 0, is = 0, wgm = WGM;
    __device__ void init(int nMa_, int nNa_, int pmB_, int nMb_, int pnB_, int nNb_, int G_, int c_, int rot) { nMa = nMa_; nNa = nNa_; nA = nMa * nNa; pmB = pmB_; nMb = nMb_; pnB = pnB_; nNb = nNb_; nB = nMb * nNb; G = G_; c = (c_ + rot) % G_; }
    __device__ bool next(int i, Unit& u) const {
        long L;
        if (ns == 0 || i < is) { if (ns != 0 && i >= is && c < ns) return false; L = (long)i * G + c; }
        else { if (c < ns) return false; L = (long)is * G + (long)(i - is) * (G - ns) + (c - ns); }
        if (L >= nA + nB) return false;
        if (L < nA) {
            int wgid = (int)L; { const int q = nA / NXCD, r = nA % NXCD, xcd = wgid % NXCD, off = wgid / NXCD; wgid = (xcd < r ? xcd * (q + 1) : r * (q + 1) + (xcd - r) * q) + off; }
            const int nig = wgm * nNa, gid = wgid / nig, fm = gid * wgm, gsz = (nMa - fm) < wgm ? (nMa - fm) : wgm;
            u.pm = fm + ((wgid % nig) % gsz); u.pn = (wgid % nig) / gsz;
        } else { const int r = (int)L - nA; u.pm = pmB + r % nMb; u.pn = pnB + r / nMb; }
        return true;
    }
    __device__ __forceinline__ void a_ready(const Unit&) const {}
    __device__ __forceinline__ void done(const Unit&) const {}
};
__device__ __forceinline__ unsigned cvt_pk_bf16(float lo, float hi) { unsigned r; asm volatile("v_cvt_pk_bf16_f32 %0, %1, %2" : "=v"(r) : "v"(lo), "v"(hi)); return r; }
typedef unsigned u32x2 __attribute__((ext_vector_type(2)));
__device__ __forceinline__ u32x2 pk4(f32x4 v) { u32x2 w; w.x = cvt_pk_bf16(v[0], v[1]); w.y = cvt_pk_bf16(v[2], v[3]); return w; }
#ifndef WT_STORES
#define WT_STORES 0
#endif
__device__ __forceinline__ void st8(void* p, u32x2 v) {
#if WT_STORES
    __hip_atomic_store((unsigned long long*)p, ((unsigned long long)v.y << 32) | v.x, __ATOMIC_RELAXED, __HIP_MEMORY_SCOPE_AGENT);
#else
    *(u32x2*)p = v;
#endif
}
__device__ __forceinline__ float rowsum4(float s) {
    { const unsigned u = __builtin_bit_cast(unsigned, s); auto a = __builtin_amdgcn_permlane16_swap(u, u, false, false); const unsigned a0 = a[0], a1 = a[1]; s = __builtin_bit_cast(float, a0) + __builtin_bit_cast(float, a1); }
    { const unsigned u = __builtin_bit_cast(unsigned, s); auto b = __builtin_amdgcn_permlane32_swap(u, u, false, false); const unsigned b0 = b[0], b1 = b[1]; s = __builtin_bit_cast(float, b0) + __builtin_bit_cast(float, b1); }
    return s;
}
__device__ __forceinline__ float dot4(f32x4 v) { return (v[0] * v[0] + v[1] * v[1]) + (v[2] * v[2] + v[3] * v[3]); }
constexpr int BT_F = (140288 - 131072) / 4, ET_F = (147456 - 131072) / 4;
constexpr int M_LAT_TILES = 64;
constexpr float QSCALE = 0.125f * 1.4426950408889634f;
constexpr float ZS_LAT = 1.0f / 512.0f;
constexpr float ZS_CTX = 0.005524271728019903f;

struct EpiIn {
    static constexpr bool PERM = false, AFTER_DRAIN = false;
    unsigned char* ws; const PG8_LAS float* rtab;
    __device__ __forceinline__ void operator()(const f32x4 (&acc)[2][2][4][2], const Unit& u, int ui, int wr, int wc, int fr, int fq) const {
        const int pm = u.pm, pn = u.pn; const bool lat = pm < M_LAT_TILES; const int bm = lat ? (pm >> 3) : 8;
        const PG8_LAS float* rope = rtab + ET_F;
        bf16_t* QB = (bf16_t*)(ws + EWS_QB); bf16_t* KB = (bf16_t*)(ws + EWS_KB); bf16_t* VB = (bf16_t*)(ws + EWS_VB); bf16_t* T = (bf16_t*)(ws + EWS_T); bf16_t* Tc = (bf16_t*)(ws + EWS_TC);
        const PG8_LAS float* bp = rtab + BT_F + ui * 256 + wc * 32 + fq * 4;
        f32x4 bv[2][2];
#pragma unroll
        for (int bj = 0; bj < 2; ++bj)
#pragma unroll
            for (int n = 0; n < 2; ++n) bv[bj][n] = *(const PG8_LAS f32x4*)(bp + bj * 128 + n * 16);
        const PG8_LAS float* rt = rtab + ui * 256 + wr * 64 + fr;
        if (pn < 4) {
            const PG8_LAS float* gp = rope + 3072 + (pn < 2 ? 0 : 64) + fq * 4; const float qs = pn < 2 ? QSCALE : 1.f;
            f32x4 gv[2][2];
#pragma unroll
            for (int bj = 0; bj < 2; ++bj)
#pragma unroll
                for (int n = 0; n < 2; ++n) gv[bj][n] = *(const PG8_LAS f32x4*)(gp + bj * 32 + n * 16) * qs;
            bf16_t* dst = (pn < 2 ? QB : KB) + (pn & 1) * 256 + wc * 64 + fq * 4;
#pragma unroll
            for (int ai = 0; ai < 2; ++ai)
#pragma unroll
                for (int m = 0; m < 4; ++m) {
                    const int rl = ai * 128 + wr * 64 + m * 16 + fr, row = pm * 256 + rl; const float r = rt[ai * 128 + m * 16];
                    f32x4 v[2][2]; float ssq = 0.f;
#pragma unroll
                    for (int bj = 0; bj < 2; ++bj)
#pragma unroll
                        for (int n = 0; n < 2; ++n) { v[bj][n] = acc[ai][bj][m][n] * r + bv[bj][n]; ssq += dot4(v[bj][n]); }
                    ssq = rowsum4(ssq);
                    const float rn = __builtin_amdgcn_rsqf(ssq * (1.0f / 64.0f) + 1e-6f);
#pragma unroll
                    for (int bj = 0; bj < 2; ++bj)
#pragma unroll
                        for (int n = 0; n < 2; ++n) v[bj][n] = v[bj][n] * rn * gv[bj][n];
                    if (lat) { const int pos = row & 2047;
#pragma unroll
                        for (int bj = 0; bj < 2; ++bj) { const PG8_LAS float* cp = rope + (bj == 0 ? (pos >> 6) : 32 + (pos & 63)) * 16 + fq * 4; const f32x4 c4 = *(const PG8_LAS f32x4*)cp, s4 = *(const PG8_LAS f32x4*)(cp + 1536); const f32x4 t1 = v[bj][0], t2 = v[bj][1];
                            v[bj][0] = t1 * c4 - t2 * s4; v[bj][1] = t2 * c4 + t1 * s4; } }
#pragma unroll
                    for (int bj = 0; bj < 2; ++bj)
#pragma unroll
                        for (int n = 0; n < 2; ++n) *(u32x2*)(dst + (size_t)row * 512 + bj * 32 + n * 16) = pk4(v[bj][n]);
                }
        } else if (pn < 6) {
            bf16_t* dst = VB + (pn - 4) * 256 + wc * 32 + fq * 4;
#pragma unroll
            for (int ai = 0; ai < 2; ++ai)
#pragma unroll
                for (int m = 0; m < 4; ++m) {
                    const int rl = ai * 128 + wr * 64 + m * 16 + fr, row = pm * 256 + rl; const float r = rt[ai * 128 + m * 16];
#pragma unroll
                    for (int bj = 0; bj < 2; ++bj)
#pragma unroll
                        for (int n = 0; n < 2; ++n) *(u32x2*)(dst + (size_t)row * 512 + bj * 128 + n * 16) = pk4(acc[ai][bj][m][n] * r + bv[bj][n]);
                }
        } else {
            const int g = pn - 6; const float zs = lat ? ZS_LAT : ZS_CTX;
            const int b = lat ? (pm >> 3) : (pm - M_LAT_TILES);
            bf16_t* tb = (lat ? T + (size_t)((b * 8 + (pm & 7)) * 512) * 512 : Tc + (size_t)(b * 512) * 512) + (size_t)(g * 128 + wc * 32 + fq * 4) * 512;
#pragma unroll
            for (int ai = 0; ai < 2; ++ai)
#pragma unroll
                for (int m = 0; m < 4; ++m) {
                    const int rl = ai * 128 + wr * 64 + m * 16 + fr; const float r = rt[ai * 128 + m * 16];
#pragma unroll
                    for (int n = 0; n < 2; ++n) { const f32x4 re = (acc[ai][0][m][n] * r + bv[0][n]) * zs, im = (acc[ai][1][m][n] * r + bv[1][n]) * zs;
#pragma unroll
                        for (int i = 0; i < 4; ++i) *(unsigned*)(tb + (size_t)(n * 16 + i) * 512 + rl * 2) = cvt_pk_bf16(re[i], im[i]); }
                }
        }
    }
};
typedef _Float16 h16x2 __attribute__((ext_vector_type(2)));
__device__ __forceinline__ unsigned pkh2(float a, float b) { const h16x2 h = {(_Float16)a, (_Float16)b}; return __builtin_bit_cast(unsigned, h); }
__device__ __forceinline__ u32x2 pkh4(f32x4 v) { u32x2 w; w.x = pkh2(v[0], v[1]); w.y = pkh2(v[2], v[3]); return w; }
__device__ __forceinline__ f32x4 unh4(u32x2 w) { const unsigned lo = w.x, hi = w.y; const h16x2 a = __builtin_bit_cast(h16x2, lo), b = __builtin_bit_cast(h16x2, hi);     return (f32x4){(float)a[0], (float)a[1], (float)b[0], (float)b[1]}; }
template <bool NEXT> struct EpiRes {
    static constexpr bool PERM = false, AFTER_DRAIN = false;
    const void* xl_in; void* xl_out;
    unsigned char* ws; int gate_off;
    const float* ng; int nsc_off;
    __device__ __forceinline__ void operator()(const f32x4 (&acc)[2][2][4][2], const Unit& u, int ui, int wr, int wc, int fr, int fq) const {
        const int pm = u.pm, pn = u.pn; const bool lat = pm < M_LAT_TILES; const int bm = lat ? (pm >> 3) : 8; const int col0 = pn * 256 + wc * 32 + fq * 4;
        const float* gate = (const float*)(ws + EWS_MOD) + gate_off; const float* nsc = (const float*)(ws + EWS_MOD) + nsc_off; bf16_t* A = (bf16_t*)(ws + EWS_A); float* ssq = (float*)(ws + EWS_SSQ);
        const _Float16* xin = lat ? (const _Float16*)xl_in + (size_t)pm * 256 * 1024 : (const _Float16*)(ws + EWS_XC) + (size_t)(pm - M_LAT_TILES) * 256 * 1024;
        _Float16* xout = lat ? (_Float16*)xl_out + (size_t)pm * 256 * 1024 : (_Float16*)(ws + EWS_XC) + (size_t)(pm - M_LAT_TILES) * 256 * 1024;
        float* xoutf = (float*)xl_out + (size_t)pm * 256 * 1024;
        float ssq_[2][4];
#pragma unroll
        for (int ai = 0; ai < 2; ++ai)
#pragma unroll
            for (int m = 0; m < 4; ++m) ssq_[ai][m] = 0.f;
        f32x4 ga[2][2], gv[2][2]; u32x2 preA[4][2], preB[4][2];
        auto loadx = [&](int g, u32x2 (&p)[4][2]) __attribute__((always_inline)) { const int bj = g >> 1, ai = g & 1;
#pragma unroll
            for (int m = 0; m < 4; ++m)
#pragma unroll
                for (int n = 0; n < 2; ++n) p[m][n] = *(const u32x2*)(xin + (size_t)(ai * 128 + wr * 64 + m * 16 + fr) * 1024 + col0 + bj * 128 + n * 16); };
        auto loadg = [&](int bj) __attribute__((always_inline)) {
#pragma unroll
            for (int n = 0; n < 2; ++n) { const int c = col0 + bj * 128 + n * 16; ga[bj][n] = *(const f32x4*)(gate + bm * 6144 + c);
                if (NEXT) gv[bj][n] = *(const f32x4*)(ng + c) * (*(const f32x4*)(nsc + bm * 6144 + c) + 1.0f); } };
        auto proc = [&](int g, const u32x2 (&p)[4][2]) __attribute__((always_inline)) { const int bj = g >> 1, ai = g & 1;
#pragma unroll
            for (int m = 0; m < 4; ++m) {
                const int rl = ai * 128 + wr * 64 + m * 16 + fr; const size_t row = (size_t)pm * 256 + rl;
#pragma unroll
                for (int n = 0; n < 2; ++n) { const size_t off = (size_t)rl * 1024 + col0 + bj * 128 + n * 16; const f32x4 xn = unh4(p[m][n]) + ga[bj][n] * acc[ai][bj][m][n];
                    if (NEXT) *(u32x2*)(xout + off) = pkh4(xn); else *(f32x4*)(xoutf + off) = xn;
                    if (NEXT) { ssq_[ai][m] += dot4(xn); *(u32x2*)(A + row * 1024 + col0 + bj * 128 + n * 16) = pk4(xn * gv[bj][n]); } }
            }
            asm volatile("" ::: "memory"); };
        loadx(0, preA); loadg(0); loadx(1, preB); asm volatile("" ::: "memory");
        proc(0, preA); loadg(1); loadx(2, preA); asm volatile("" ::: "memory");
        proc(1, preB); loadx(3, preB); asm volatile("" ::: "memory");
        proc(2, preA); proc(3, preB);
        if (NEXT) {
#pragma unroll
            for (int ai = 0; ai < 2; ++ai)
#pragma unroll
                for (int m = 0; m < 4; ++m) { const float s = rowsum4(ssq_[ai][m]); if (fq == 0) ssq[((size_t)pm * 256 + ai * 128 + wr * 64 + m * 16 + fr) * 16 + pn * 4 + wc] = s; }
        }
    }
};
struct EpiGU {
    static constexpr bool PERM = false, AFTER_DRAIN = false;
    unsigned char* ws; const PG8_LAS float* rtab;
    __device__ __forceinline__ void operator()(const f32x4 (&acc)[2][2][4][2], const Unit& u, int ui, int wr, int wc, int fr, int fq) const {
        const int pm = u.pm, pn = u.pn; const int bm = pm < M_LAT_TILES ? (pm >> 3) : 8;
        bf16_t* H = (bf16_t*)(ws + EWS_H);
        const PG8_LAS float* bp = rtab + BT_F + ui * 256 + wc * 32 + fq * 4;
        f32x4 bg[2], bu[2];
#pragma unroll
        for (int n = 0; n < 2; ++n) { bg[n] = *(const PG8_LAS f32x4*)(bp + n * 16); bu[n] = *(const PG8_LAS f32x4*)(bp + 128 + n * 16); }
        const PG8_LAS float* rt = rtab + ui * 256 + wr * 64 + fr;
        if (pm >= M_LAT_TILES) H = (bf16_t*)(ws + EWS_HC) - (size_t)16384 * 2816;
        bf16_t* dst = H + pn * 128 + wc * 32 + fq * 4;
#pragma unroll
        for (int ai = 0; ai < 2; ++ai)
#pragma unroll
            for (int m = 0; m < 4; ++m) {
                const int rl = ai * 128 + wr * 64 + m * 16 + fr; const size_t row = (size_t)pm * 256 + rl; const float r = rt[ai * 128 + m * 16];
#pragma unroll
                for (int n = 0; n < 2; ++n) { const f32x4 gg = acc[ai][0][m][n] * r + bg[n], uu = acc[ai][1][m][n] * r + bu[n]; f32x4 h;
#pragma unroll
                    for (int i = 0; i < 4; ++i) h[i] = gg[i] * __builtin_amdgcn_rcpf(1.0f + __builtin_amdgcn_exp2f(-1.4426950408889634f * gg[i])) * uu[i];
                    st8(dst + row * 2816 + n * 16, pk4(h)); }
            }
    }
};
struct EpiDft {
    static constexpr bool PERM = true, AFTER_DRAIN = false;
    bf16_t* MIX;
    __device__ __forceinline__ void operator()(const f32x4 (&acc)[2][2][4][2], const Unit& u, int ui, int wr, int wc, int fr, int fq) const {
        const int pn = u.pn;
#pragma unroll
        for (int bj = 0; bj < 2; ++bj) {
            const int c = pn * 256 + bj * 128 + wc * 32 + fq * 8; int rowbase, rstride, ch;
            if (pn < 128) { const int b = c >> 12, r = (c >> 9) & 7; ch = c & 511; rowbase = b * 2048 + r; rstride = 8; }
            else { const int c2 = c - 32768; const int b = c2 >> 9; ch = c2 & 511; rowbase = 16384 + b * 256; rstride = 1; }
#pragma unroll
            for (int ai = 0; ai < 2; ++ai)
#pragma unroll
                for (int m = 0; m < 4; ++m) { const int mm = ai * 128 + wr * 64 + m * 16 + fr; const size_t row = (size_t)rowbase + (size_t)mm * rstride;
                    const f32x4 v0 = acc[ai][bj][m][0], v1 = acc[ai][bj][m][1]; u32x4 w; w.x = cvt_pk_bf16(v0[0], v0[1]); w.y = cvt_pk_bf16(v0[2], v0[3]); w.z = cvt_pk_bf16(v1[0], v1[1]); w.w = cvt_pk_bf16(v1[2], v1[3]);
                    *(u32x4*)(MIX + row * 1024 + 512 + ch) = w; }
        }
    }
};
template <class Epi, class Sched, bool ALIGN_EPI = false, bool SP2 = false>
__device__ __forceinline__ void gemm_phase(PG8_LAS unsigned char* lds, const Gemm g, const Sched& S, const Epi& E, int wave_) {
    unsigned z_ = 0u; asm volatile("" : "+v"(z_)); int tid_ = wave_ * 64 + (int)__builtin_amdgcn_mbcnt_hi(~0u, __builtin_amdgcn_mbcnt_lo(~0u, z_)); asm volatile("" : "+v"(tid_));
    const int tid = tid_, wid = __builtin_amdgcn_readfirstlane(tid >> 6), lane = tid & 63, wr = wid >> 2, wc = wid & 3, fr = lane & 15, fq = lane >> 4;
    const int K = g.K, nt = K / BK;
    unsigned voffA[2], voffB[2];
#pragma unroll
    for (int i = 0; i < 2; ++i) { int R, C; stage_rc(tid * 16 + i * 8192, R, C); const int Rb = Epi::PERM ? ((R & ~31) + perm32(R & 31)) : R;
        voffA[i] = (unsigned)(R * K + C) * 2u; voffB[i] = (unsigned)(Rb * K + C) * 2u; }
    const size_t kstep = (size_t)(BK * 2);
    const size_t hstep = (size_t)HALF * K * 2;
    const size_t tstep = 2 * hstep;
    const unsigned ldsw = (unsigned)wid * 1024u;
    const int aoff = lds_byte(wr * 64 + fr, fq * 8), boff = lds_byte(wc * 32 + fr, fq * 8);
#define PG8_SA(b, h) (((b) * 2 + (h)) * HTB)
#define PG8_SB(b, h) ((4 + (b) * 2 + (h)) * HTB)
#define PG8_STAGE(bufoff, gbase, voff) do { _Pragma("unroll") for (int _i = 0; _i < 2; ++_i) \
        __builtin_amdgcn_global_load_lds((const unsigned*)((const char*)(gbase) + (voff)[_i]), (PG8_LAS unsigned*)(lds + (bufoff) + ldsw + _i * 8192), 16, 0, 0); } while (0)
#define PG8_LDA(dst, b, h) do { _Pragma("unroll") for (int m = 0; m < 4; ++m) _Pragma("unroll") for (int k = 0; k < 2; ++k) dst[m][k] = *(const PG8_LAS bf16x8*)(lds + PG8_SA(b, h) + aoff + m * 2048 + k * 1024); } while (0)
#define PG8_LDB(dst, b, h) do { _Pragma("unroll") for (int n = 0; n < 2; ++n) _Pragma("unroll") for (int k = 0; k < 2; ++k) dst[n][k] = *(const PG8_LAS bf16x8*)(lds + PG8_SB(b, h) + boff + n * 2048 + k * 1024); } while (0)
#define PG8_MMA(ai, bj, At, Bt) do { __builtin_amdgcn_s_setprio(1); _Pragma("unroll") for (int m = 0; m < 4; ++m) _Pragma("unroll") for (int n = 0; n < 2; ++n) _Pragma("unroll") for (int k = 0; k < 2; ++k) \
        acc[ai][bj][m][n] = __builtin_amdgcn_mfma_f32_16x16x32_bf16(Bt[n][k], At[m][k], acc[ai][bj][m][n], 0, 0, 0); __builtin_amdgcn_s_setprio(0); } while (0)
#define PG8_WAIT_V(n) asm volatile("s_waitcnt vmcnt(" #n ")" ::: "memory")
#define PG8_WAIT_L(n) asm volatile("s_waitcnt lgkmcnt(" #n ")" ::: "memory")
#define PG8_BAR __builtin_amdgcn_s_barrier()
#define PG8_SCHED __builtin_amdgcn_sched_barrier(0)
    Unit cur, nxt; int ui = 0;
    if (!S.next(0, cur)) return;
    f32x4 acc[2][2][4][2];
#pragma unroll
    for (int a = 0; a < 2; ++a)
#pragma unroll
        for (int b = 0; b < 2; ++b)
#pragma unroll
            for (int m = 0; m < 4; ++m)
#pragma unroll
                for (int n = 0; n < 2; ++n) acc[a][b][m][n] = (f32x4){0.f, 0.f, 0.f, 0.f};
    bf16x8 At[4][2], B0[2][2], B1[2][2];
    const char* cA = (const char*)g.A + (size_t)cur.pm * tstep; const char* cB = (const char*)g.Bt + (size_t)cur.pn * tstep;
    S.a_ready(cur);
    if constexpr (SP2) {
        PG8_STAGE(PG8_SB(0, 0), cB, voffB); PG8_STAGE(PG8_SB(0, 1), cB + hstep, voffB); PG8_STAGE(PG8_SA(0, 0), cA, voffA); PG8_STAGE(PG8_SA(0, 1), cA + hstep, voffA);
        if (wr == 1) PG8_BAR;
        PG8_WAIT_V(2); PG8_BAR;
        PG8_STAGE(PG8_SB(1, 0), cB + kstep, voffB); PG8_STAGE(PG8_SA(1, 0), cA + kstep, voffA); PG8_STAGE(PG8_SB(1, 1), cB + hstep + kstep, voffB);
        PG8_WAIT_V(6); PG8_BAR;
    } else {
        PG8_STAGE(PG8_SB(0, 0), cB, voffB); PG8_STAGE(PG8_SA(0, 0), cA, voffA); PG8_STAGE(PG8_SB(0, 1), cB + hstep, voffB); PG8_STAGE(PG8_SA(0, 1), cA + hstep, voffA);
        if (wr == 1) PG8_BAR;
        PG8_WAIT_V(4); PG8_BAR;
        PG8_STAGE(PG8_SB(1, 0), cB + kstep, voffB); PG8_STAGE(PG8_SA(1, 0), cA + kstep, voffA); PG8_STAGE(PG8_SB(1, 1), cB + hstep + kstep, voffB);
        PG8_WAIT_V(6); PG8_BAR;
    }
    for (;;) {
        const bool has_next = S.next(ui + 1, nxt);
        const char* nA = has_next ? (const char*)g.A + (size_t)nxt.pm * tstep : cA; const char* nB = has_next ? (const char*)g.Bt + (size_t)nxt.pn * tstep : cB;
        for (int t = 0; t < nt; t += 2) {
            const bool last = (t == nt - 2);
            const char* a1 = cA + (size_t)(t + 1) * kstep;
            const char* a2 = last ? nA : cA + (size_t)(t + 2) * kstep; const char* b2 = last ? nB : cB + (size_t)(t + 2) * kstep;
            const char* a3 = a2 + kstep; const char* b3 = b2 + kstep;
            if (last && has_next) S.a_ready(nxt);
            if constexpr (SP2) {
            PG8_LDB(B0, 0, 0); PG8_LDB(B1, 0, 1); PG8_SCHED; PG8_LDA(At, 0, 0); PG8_STAGE(PG8_SA(1, 1), a1 + hstep, voffA);
            PG8_WAIT_V(8); PG8_WAIT_L(0); PG8_BAR; PG8_MMA(0, 0, At, B0); PG8_MMA(0, 1, At, B1); PG8_BAR; PG8_SCHED;
            PG8_LDA(At, 0, 1); PG8_STAGE(PG8_SB(0, 0), b2, voffB); PG8_STAGE(PG8_SB(0, 1), b2 + hstep, voffB); PG8_STAGE(PG8_SA(0, 0), a2, voffA);
            PG8_WAIT_V(8); PG8_WAIT_L(0); PG8_BAR; PG8_MMA(1, 0, At, B0); PG8_MMA(1, 1, At, B1); PG8_BAR; PG8_SCHED;
            PG8_LDB(B0, 1, 0); PG8_LDB(B1, 1, 1); PG8_SCHED; PG8_LDA(At, 1, 0); PG8_STAGE(PG8_SA(0, 1), a2 + hstep, voffA);
            PG8_WAIT_V(8); PG8_WAIT_L(0); PG8_BAR; PG8_MMA(0, 0, At, B0); PG8_MMA(0, 1, At, B1); PG8_BAR; PG8_SCHED;
            PG8_LDA(At, 1, 1); PG8_STAGE(PG8_SB(1, 0), b3, voffB); PG8_STAGE(PG8_SB(1, 1), b3 + hstep, voffB); PG8_STAGE(PG8_SA(1, 0), a3, voffA);
            PG8_WAIT_V(8); PG8_WAIT_L(0); PG8_BAR; PG8_MMA(1, 0, At, B0); PG8_MMA(1, 1, At, B1); PG8_BAR; PG8_SCHED;
            } else {
            PG8_LDB(B0, 0, 0); PG8_SCHED; PG8_LDA(At, 0, 0); PG8_STAGE(PG8_SA(1, 1), a1 + hstep, voffA);
            PG8_WAIT_L(8); PG8_BAR; PG8_WAIT_L(0); PG8_MMA(0, 0, At, B0); PG8_BAR; PG8_SCHED;
            PG8_LDB(B1, 0, 1); PG8_STAGE(PG8_SB(0, 0), b2, voffB);
            PG8_BAR; PG8_WAIT_L(0); PG8_MMA(0, 1, At, B1); PG8_BAR;
            PG8_LDA(At, 0, 1); PG8_STAGE(PG8_SA(0, 0), a2, voffA);
            PG8_BAR; PG8_WAIT_L(0); PG8_MMA(1, 0, At, B0); PG8_BAR; PG8_SCHED;
            PG8_STAGE(PG8_SB(0, 1), b2 + hstep, voffB);
            PG8_WAIT_V(6); PG8_BAR; PG8_MMA(1, 1, At, B1); PG8_BAR;
            PG8_LDB(B0, 1, 0); PG8_SCHED; PG8_LDA(At, 1, 0); PG8_STAGE(PG8_SA(0, 1), a2 + hstep, voffA);
            PG8_WAIT_L(8); PG8_BAR; PG8_WAIT_L(0); PG8_MMA(0, 0, At, B0); PG8_BAR; PG8_SCHED;
            PG8_LDB(B1, 1, 1); PG8_STAGE(PG8_SB(1, 0), b3, voffB);
            PG8_BAR; PG8_WAIT_L(0); PG8_MMA(0, 1, At, B1); PG8_BAR;
            PG8_LDA(At, 1, 1); PG8_STAGE(PG8_SA(1, 0), a3, voffA);
            PG8_BAR; PG8_WAIT_L(0); PG8_MMA(1, 0, At, B0); PG8_BAR; PG8_SCHED;
            PG8_STAGE(PG8_SB(1, 1), b3 + hstep, voffB);
            PG8_WAIT_V(6); PG8_BAR; PG8_MMA(1, 1, At, B1); PG8_BAR;
            }
        }
        if constexpr (ALIGN_EPI) { if (wr == 0) PG8_BAR; }
        if constexpr (!Epi::AFTER_DRAIN) { int fr_ = fr, fq_ = fq; asm volatile("" : "+v"(fr_), "+v"(fq_)); E(acc, cur, ui, wr, wc, fr_, fq_); S.done(cur); }
        if (!has_next) break;
#pragma unroll
        for (int a = 0; a < 2; ++a)
#pragma unroll
            for (int b = 0; b < 2; ++b)
#pragma unroll
                for (int m = 0; m < 4; ++m)
#pragma unroll
                    for (int n = 0; n < 2; ++n) acc[a][b][m][n] = (f32x4){0.f, 0.f, 0.f, 0.f};
        cur = nxt; cA = nA; cB = nB; ++ui;
        if constexpr (ALIGN_EPI) { if (wr == 1) PG8_BAR; }
    }
    PG8_WAIT_V(0);
    if constexpr (!ALIGN_EPI) { if (wr == 0) PG8_BAR; }
    PG8_BAR;
    if constexpr (Epi::AFTER_DRAIN) { E.fused(acc, cur, wr, wc, fr, fq, lds, wid, lane); S.done(cur); }
#undef PG8_SA
#undef PG8_SB
#undef PG8_STAGE
#undef PG8_LDA
#undef PG8_LDB
#undef PG8_MMA
#undef PG8_WAIT_V
#undef PG8_WAIT_L
#undef PG8_BAR
#undef PG8_SCHED
}
}
#ifndef EN_ATTEPI
#define EN_ATTEPI 1
#endif
namespace att {
typedef unsigned short bf16;
using bf16x8 = __attribute__((ext_vector_type(8))) short;
using s16x4  = __attribute__((ext_vector_type(4))) short;
using f32x16 = __attribute__((ext_vector_type(16))) float;
using u32x4  = __attribute__((ext_vector_type(4))) unsigned;
constexpr int KVBLK = 64;
constexpr int NBUF = 3;
constexpr size_t SHM_V = KVBLK * 128 * 2, SHM_K = KVBLK * 128 * 2, SHM_ATTN = NBUF * SHM_V + NBUF * SHM_K + 8 * 64 * 4;
#define KSWZ(row, colB) ((row) * 256 + ((colB) ^ (((row) & 7) << 4)))
#define SBAR() __builtin_amdgcn_sched_barrier(0)
__device__ __forceinline__ int crow(int r, int hi) { return (r & 3) + 8 * (r >> 2) + 4 * hi; }
__device__ __forceinline__ unsigned cvtpk(float lo, float hi) { unsigned r; asm volatile("v_cvt_pk_bf16_f32 %0, %1, %2" : "=v"(r) : "v"(lo), "v"(hi)); return r; }
__device__ __forceinline__ bf16x8 ld8(const bf16* p) { return *reinterpret_cast<const bf16x8*>(p); }
__device__ __forceinline__ void sm_first(f32x16& p0, f32x16& p1, float negoff) {
  (void)p1; (void)negoff;
#pragma unroll
  for (int r = 0; r < 16; ++r) p0[r] = __builtin_amdgcn_exp2f(p0[r]);
}
__device__ __forceinline__ void sm_finish(f32x16& p0, f32x16& p1, float& l_reg, bf16x8& pa0, bf16x8& pa1, bf16x8& pa2, bf16x8& pa3) {
#pragma unroll
  for (int r = 0; r < 16; ++r) p1[r] = __builtin_amdgcn_exp2f(p1[r]);
  float ps = 0;
#pragma unroll
  for (int r = 0; r < 16; ++r) ps += p0[r];
#pragma unroll
  for (int r = 0; r < 16; ++r) ps += p1[r];
  l_reg += ps;
#define PK4(P, BASE, OUT) do { unsigned a0 = cvtpk(P[BASE + 0], P[BASE + 1]), a1 = cvtpk(P[BASE + 2], P[BASE + 3]);   \
    unsigned b0 = cvtpk(P[BASE + 4], P[BASE + 5]), b1 = cvtpk(P[BASE + 6], P[BASE + 7]);                              \
    auto r0 = __builtin_amdgcn_permlane32_swap(a0, b0, false, false); auto r1 = __builtin_amdgcn_permlane32_swap(a1, b1, false, false); \
    u32x4 w = {r0[0], r1[0], r0[1], r1[1]}; OUT = *reinterpret_cast<bf16x8*>(&w); } while (0)
  PK4(p0, 0, pa0); PK4(p0, 8, pa1); PK4(p1, 0, pa2); PK4(p1, 8, pa3);
#undef PK4
}
__device__ __forceinline__ void qkt(f32x16& p0, f32x16& p1, const bf16* Ks, const bf16x8* qr, int r32, int hi, int mapoff, float negoff) {
  p0 = f32x16{}; p1 = f32x16{}; (void)negoff;
#pragma unroll
  for (int d0 = 0; d0 < 4; ++d0) { const int cb = (mapoff + d0 * 16 + hi * 8) * 2;
    bf16x8 b0 = *reinterpret_cast<const bf16x8*>((const char*)Ks + KSWZ(r32, cb));
    bf16x8 b1 = *reinterpret_cast<const bf16x8*>((const char*)Ks + KSWZ(32 + r32, cb));
    p0 = __builtin_amdgcn_mfma_f32_32x32x16_bf16(b0, qr[d0], p0, 0, 0, 0);
    p1 = __builtin_amdgcn_mfma_f32_32x32x16_bf16(b1, qr[d0], p1, 0, 0, 0); }
}
__device__ __forceinline__ int v_st(int k, int c) { const int kk = (k & ~0xC) | ((k & 4) << 1) | ((k & 8) >> 1); return ((kk >> 3) * 4 + (c >> 5)) * 512 + ((kk & 7) * 32 + (c & 31)) * 2; }
__device__ __forceinline__ int v_rd_base(int lane) { return ((lane & 3) << 3) | (((lane >> 2) & 3) << 6) | (((lane >> 4) & 1) << 5) | (((lane >> 5) & 1) << 8); }
constexpr int v_rd_off(int d0, int ks, int half) { return d0 * 512 + ks * 4096 + half * 2048; }
typedef short v4i16_t __attribute__((ext_vector_type(4)));
template <int OFF> __device__ __forceinline__ s16x4 tr_read(int vb) {
  return __builtin_bit_cast(s16x4, __builtin_amdgcn_ds_read_tr16_b64_v4i16((__attribute__((address_space(3))) v4i16_t*)(uintptr_t)(unsigned)(vb + OFF)));
}
template <int D0> __device__ __forceinline__ void pv_one(f32x16& od, int vb, bf16x8 pa0, bf16x8 pa1, bf16x8 pa2, bf16x8 pa3) {
  const s16x4 l0 = tr_read<v_rd_off(D0, 0, 0)>(vb), h0 = tr_read<v_rd_off(D0, 0, 1)>(vb), l1 = tr_read<v_rd_off(D0, 1, 0)>(vb), h1 = tr_read<v_rd_off(D0, 1, 1)>(vb);
  const s16x4 l2 = tr_read<v_rd_off(D0, 2, 0)>(vb), h2 = tr_read<v_rd_off(D0, 2, 1)>(vb), l3 = tr_read<v_rd_off(D0, 3, 0)>(vb), h3 = tr_read<v_rd_off(D0, 3, 1)>(vb);
#define PK(L, H) (bf16x8){L[0], L[1], L[2], L[3], H[0], H[1], H[2], H[3]}
  od = __builtin_amdgcn_mfma_f32_32x32x16_bf16(pa0, PK(l0, h0), od, 0, 0, 0);
  od = __builtin_amdgcn_mfma_f32_32x32x16_bf16(pa1, PK(l1, h1), od, 0, 0, 0);
  od = __builtin_amdgcn_mfma_f32_32x32x16_bf16(pa2, PK(l2, h2), od, 0, 0, 0);
  od = __builtin_amdgcn_mfma_f32_32x32x16_bf16(pa3, PK(l3, h3), od, 0, 0, 0);
#undef PK
}
__device__ __forceinline__ void pv_d0(f32x16* o, int vb, bf16x8 pa0, bf16x8 pa1, bf16x8 pa2, bf16x8 pa3) {
  pv_one<0>(o[0], vb, pa0, pa1, pa2, pa3); pv_one<1>(o[1], vb, pa0, pa1, pa2, pa3); pv_one<2>(o[2], vb, pa0, pa1, pa2, pa3); pv_one<3>(o[3], vb, pa0, pa1, pa2, pa3);
}
__device__ __forceinline__ void attn_unit(const bf16* __restrict__ Qh, const bf16* __restrict__ Kh, const bf16* __restrict__ Vh, bf16* __restrict__ Oh, long qrow0, long k0a, int nt0, long k0b, int NT,
                                          float lam, float oscale, const float* __restrict__ subg, float negoff, char* lds, int wave_, unsigned lds3) {
  unsigned z_ = 0u; asm volatile("" : "+v"(z_)); int tid_ = wave_ * 64 + (int)__builtin_amdgcn_mbcnt_hi(~0u, __builtin_amdgcn_mbcnt_lo(~0u, z_)); asm volatile("" : "+v"(tid_));
  const int tid = tid_, wid = __builtin_amdgcn_readfirstlane(tid >> 6), lane = tid & 63, r32 = lane & 31, hi = lane >> 5, qsub = wid >> 1, map = wid & 1, mapoff = map * 64;
  bf16* V_lds = (bf16*)lds; bf16* K_lds = (bf16*)(lds + NBUF * SHM_V);
  float* ws = (float*)(lds + NBUF * SHM_V + NBUF * SHM_K) + wid * 64; float* li_l = ws;
  float l_reg = 0; f32x16 o[4] = {}; bf16x8 qr[4];
  const bf16* Qw = Qh + (qrow0 + qsub * 32 + r32) * 512 + mapoff + hi * 8;
#pragma unroll
  for (int d0 = 0; d0 < 4; ++d0) qr[d0] = ld8(Qw + d0 * 16);
  const int vb0 = (int)(uintptr_t)V_lds + v_rd_base(lane);
  int koff[2], voff[2];
#pragma unroll
  for (int i = 0; i < 2; ++i) { const int o = (wid + 8 * i) * 1024 + lane * 16;
    { const int row = o >> 8, cB = (o & 255) ^ ((row & 7) << 4); koff[i] = row * 512 + (cB >> 1); }
    { const int sub = o >> 9, kkhi = sub >> 2, cg = sub & 3, q = (o & 511) >> 1, kklo = q >> 5, cin = q & 31, kk = kkhi * 8 + kklo; voff[i] = kk * 512 + cg * 32 + cin; } }
  typedef __attribute__((address_space(3))) unsigned lds_u32;
  const unsigned ldsK = lds3 + NBUF * (unsigned)SHM_V + (unsigned)wid * 1024u, ldsV = lds3 + (unsigned)wid * 1024u;
#define KROW(j) (((j) < nt0) ? (k0a + (long)(j) * KVBLK) : (k0b + (long)((j) - nt0) * KVBLK))
#define DMAK(b, j) do { const long kr_ = KROW(j) * 512; _Pragma("unroll") for (int i_ = 0; i_ < 2; ++i_) \
    __builtin_amdgcn_global_load_lds((const unsigned*)(Kh + kr_ + koff[i_]), (lds_u32*)(uintptr_t)(ldsK + (b) * (unsigned)SHM_K + i_ * 8192u), 16, 0, 0); } while (0)
#define DMAV(b, j) do { const long kr_ = KROW(j) * 512; _Pragma("unroll") for (int i_ = 0; i_ < 2; ++i_) \
    __builtin_amdgcn_global_load_lds((const unsigned*)(Vh + kr_ + voff[i_]), (lds_u32*)(uintptr_t)(ldsV + (b) * (unsigned)SHM_V + i_ * 8192u), 16, 0, 0); } while (0)
  f32x16 p0, p1; bf16x8 pa0, pa1, pa2 = {}, pa3 = {};
#define KFR(kb, d0, half) (*reinterpret_cast<const bf16x8*>((const char*)K_lds + (kb) * (int)SHM_K + KSWZ((half) * 32 + r32, (mapoff + (d0) * 16 + hi * 8) * 2)))
#define VRD4(S, vbuf, D0, KS) do { const int vb_ = vb0 + (vbuf) * (int)SHM_V; S##a = tr_read<v_rd_off(D0, KS, 0)>(vb_); S##b = tr_read<v_rd_off(D0, KS, 1)>(vb_); S##c = tr_read<v_rd_off(D0, (KS) + 1, 0)>(vb_); S##d = tr_read<v_rd_off(D0, (KS) + 1, 1)>(vb_); } while (0)
#define PKV(L, H) (bf16x8){L[0], L[1], L[2], L[3], H[0], H[1], H[2], H[3]}
#define MM(ACC, A_, B_) ACC = __builtin_amdgcn_mfma_f32_32x32x16_bf16(A_, B_, ACC, 0, 0, 0)
#define FADD(D, S) asm volatile("v_add_f32 %0, %0, %1" : "+v"(D) : "v"(S))
#define SMA(P, c) do { P[2 * (c)] = __builtin_amdgcn_exp2f(P[2 * (c)]); P[2 * (c) + 1] = __builtin_amdgcn_exp2f(P[2 * (c) + 1]); FADD(ls0, P[2 * (c)]); FADD(ls1, P[2 * (c) + 1]); } while (0)
#define SMB_CVT(P, BASE) do { ca0 = cvtpk(P[BASE + 0], P[BASE + 1]); ca1 = cvtpk(P[BASE + 2], P[BASE + 3]); cb0 = cvtpk(P[BASE + 4], P[BASE + 5]); cb1 = cvtpk(P[BASE + 6], P[BASE + 7]); } while (0)
#define SMB_PERM(OUT) do { u32x4 w_ = {ca0, ca1, cb0, cb1}; OUT = *reinterpret_cast<bf16x8*>(&w_); } while (0)
#define STAGE_PV(PA, PB, P, KLD_STMT) do { KLD_STMT; \
    MM(o[0], PA, PKV(vAa, vAb)); SMA(P, 0); SBAR(); MM(o[0], PB, PKV(vAc, vAd)); SMA(P, 1); SBAR(); \
    MM(o[1], PA, PKV(vBa, vBb)); SMA(P, 2); SBAR(); MM(o[1], PB, PKV(vBc, vBd)); SMA(P, 3); SBAR(); \
    MM(o[2], PA, PKV(vCa, vCb)); SMA(P, 4); SBAR(); MM(o[2], PB, PKV(vCc, vCd)); SMA(P, 5); SBAR(); \
    MM(o[3], PA, PKV(vDa, vDb)); SMA(P, 6); SBAR(); MM(o[3], PB, PKV(vDc, vDd)); SMA(P, 7); SBAR(); } while (0)
#define VRD16(vbuf, KS) do { VRD4(vA, vbuf, 0, KS); VRD4(vB, vbuf, 1, KS); VRD4(vC, vbuf, 2, KS); VRD4(vD, vbuf, 3, KS); } while (0)
#define STAGE_QK(PD, P, OUT0, OUT1, vbuf, KS) do { VRD16(vbuf, KS); \
    PD = __builtin_amdgcn_mfma_f32_32x32x16_bf16(kf0, qr[0], f32x16{}, 0, 0, 0); SMB_CVT(P, 0); SBAR(); \
    MM(PD, kf1, qr[1]); SMB_PERM(OUT0); SBAR(); MM(PD, kf2, qr[2]); SMB_CVT(P, 8); SBAR(); MM(PD, kf3, qr[3]); SMB_PERM(OUT1); SBAR(); } while (0)
#define KLD4(kb, half) do { kf0 = KFR(kb, 0, half); kf1 = KFR(kb, 1, half); kf2 = KFR(kb, 2, half); kf3 = KFR(kb, 3, half); } while (0)
  s16x4 vAa, vAb, vAc, vAd, vBa, vBb, vBc, vBd, vCa, vCb, vCc, vCd, vDa, vDb, vDc, vDd; bf16x8 kf0, kf1, kf2, kf3; unsigned ca0, ca1, cb0, cb1; float ls0 = 0.f, ls1 = 0.f;
  DMAK(0, 0); DMAK(1, 1); DMAV(0, 0); asm volatile("s_waitcnt vmcnt(0)" ::: "memory"); __syncthreads();
  KLD4(0, 0); p0 = __builtin_amdgcn_mfma_f32_32x32x16_bf16(kf0, qr[0], f32x16{}, 0, 0, 0); MM(p0, kf1, qr[1]); MM(p0, kf2, qr[2]); MM(p0, kf3, qr[3]);
  VRD16(0, 2);
  int bp = 0, bc = 0, bn = 1, bnn = 2;
#pragma unroll 1
  for (int j = 0; j < NT; ++j) {
    asm volatile("s_waitcnt vmcnt(0)" ::: "memory"); SBAR(); __builtin_amdgcn_s_barrier(); SBAR();
    if (j + 2 < NT) DMAK(bnn, j + 2);
    if (j + 1 < NT) DMAV(bn, j + 1);
    STAGE_PV(pa2, pa3, p0, KLD4(bc, 1));
    STAGE_QK(p1, p0, pa0, pa1, bc, 0);
    const int kbn = (j + 1 < NT) ? bn : bc;
    STAGE_PV(pa0, pa1, p1, KLD4(kbn, 0));
    STAGE_QK(p0, p1, pa2, pa3, bc, 2);
    bp = bc; bc = bn; bn = bnn; bnn = bp;
  }
  MM(o[0], pa2, PKV(vAa, vAb)); MM(o[0], pa3, PKV(vAc, vAd)); MM(o[1], pa2, PKV(vBa, vBb)); MM(o[1], pa3, PKV(vBc, vBd));
  MM(o[2], pa2, PKV(vCa, vCb)); MM(o[2], pa3, PKV(vCc, vCd)); MM(o[3], pa2, PKV(vDa, vDb)); MM(o[3], pa3, PKV(vDc, vDd));
  l_reg = ls0 + ls1;
#undef KLD4
#undef STAGE_QK
#undef VRD16
#undef FADD
#undef STAGE_PV
#undef SMB_PERM
#undef SMB_CVT
#undef SMA
#undef MM
#undef VRD4
#undef PKV
#undef KFR
#undef DMAK
#undef DMAV
#if EN_ATTEPI
  { auto rr = __builtin_amdgcn_permlane32_swap(__float_as_uint(l_reg), __float_as_uint(l_reg), false, false); l_reg = __uint_as_float(rr[0]) + __uint_as_float(rr[1]); }
  if (hi == 0) li_l[r32] = l_reg;
  asm volatile("s_waitcnt lgkmcnt(0)" ::: "memory");
  const float fm = map ? lam : 1.f;
#pragma unroll
  for (int r = 0; r < 16; ++r) { const float rl = __builtin_amdgcn_rcpf(li_l[crow(r, hi)]) * fm;
#pragma unroll
    for (int d0 = 0; d0 < 4; ++d0) o[d0][r] *= rl; }
  __syncthreads();
  float* X = (float*)lds + qsub * 4096 + lane;
  if (map == 1) {
#pragma unroll
    for (int d0 = 0; d0 < 4; ++d0)
#pragma unroll
      for (int r = 0; r < 16; ++r) X[(d0 * 16 + r) * 64] = o[d0][r];
  }
  __syncthreads();
  if (map == 0) {
    float sg[4];
#pragma unroll
    for (int d0 = 0; d0 < 4; ++d0) sg[d0] = subg[d0 * 32 + r32] * oscale;
    bf16* Ow = Oh + (qrow0 + qsub * 32) * 1024 + r32;
#pragma unroll
    for (int r = 0; r < 16; ++r) {
      float ss = 0.f;
#pragma unroll
      for (int d0 = 0; d0 < 4; ++d0) { o[d0][r] -= X[(d0 * 16 + r) * 64]; ss += o[d0][r] * o[d0][r]; }
      ss += __shfl_xor(ss, 1); ss += __shfl_xor(ss, 2); ss += __shfl_xor(ss, 4); ss += __shfl_xor(ss, 8); ss += __shfl_xor(ss, 16);
      const float rn = 1.0f / sqrtf(ss * (1.0f / 128.0f) + 1e-6f);
      const int orow = crow(r, hi);
#pragma unroll
      for (int d0 = 0; d0 < 4; ++d0) { const unsigned w = cvtpk(o[d0][r] * rn * sg[d0], 0.f); Ow[(long)orow * 1024 + d0 * 32] = (bf16)(w & 0xffffu); }
    }
  }
  __syncthreads();
#else
  { float s = l_reg; for (int d0 = 0; d0 < 4; ++d0) for (int r = 0; r < 16; ++r) s += o[d0][r]; Oh[qrow0 * 1024 + tid] = (bf16)(int)s; }
#endif
#undef KROW
}
#undef KSWZ
#undef SBAR
}
#ifndef EN_ALL
#define EN_ALL 1
#endif
#ifndef EN_PH0
#define EN_PH0 EN_ALL
#endif
#ifndef EN_PH1
#define EN_PH1 EN_ALL
#endif
#ifndef EN_P1
#define EN_P1 EN_ALL
#endif
#ifndef EN_P2A
#define EN_P2A EN_ALL
#endif
#ifndef EN_P2B
#define EN_P2B EN_ALL
#endif
#ifndef EN_P3
#define EN_P3 EN_ALL
#endif
#ifndef EN_P4
#define EN_P4 EN_ALL
#endif
#ifndef EN_P5
#define EN_P5 EN_ALL
#endif
#ifndef EN_ATT
#define EN_ATT 1
#endif
#ifndef EN_DFT
#define EN_DFT 1
#endif
#ifndef EN_ATTC
#define EN_ATTC 1
#endif
#ifndef SCHED_OLD
#define SCHED_OLD 0
#endif
#ifndef PROBE_A
#define PROBE_A 0
#endif
#ifndef PROBE_S
#define PROBE_S 0
#endif
#if PROBE_S
#define SUBSTAMP(i) do { if (blockIdx.x == 0 && F.wave == 0) ((volatile LAS unsigned*)(F.lds + MISC_OFF))[40 + (i)] = (unsigned)__builtin_amdgcn_s_memrealtime(); } while (0)
#else
#define SUBSTAMP(i) do {} while (0)
#endif
#ifndef PROBE_B
#define PROBE_B 0
#endif
#ifndef WGM_WIDE
#define WGM_WIDE 2
#endif
#ifndef WGM_MID
#define WGM_MID 2
#endif
constexpr int NWAVES = 8;
constexpr int DM = 1024, NBATCH = 8, SEQ = 2048, CTXL = 256, M_LAT = NBATCH * SEQ, M_CTX = NBATCH * CTXL, M_ALL = M_LAT + M_CTX, NIN = 2560, NINSRC = 2048, FFD = 2816, NGU = 5632, NLAYER = 2;
constexpr size_t MiB = 1u << 20;
constexpr size_t WS_CTL = 0, CTL_ZERO_BYTES = 1 * MiB;
constexpr size_t WS_MOD = 64 * 1024;
constexpr size_t WS_BIN = 512 * 1024;
constexpr size_t WS_BGU = 1 * MiB + 768 * 1024;
constexpr size_t WS_ROPE = WS_BGU + 512 * 1024;
constexpr size_t WS_DFT = WS_ROPE + 512 * 1024;
constexpr size_t WS_TF = 4 * MiB;
constexpr size_t WS_SSQ = 5 * MiB;
constexpr size_t WS_WIN = 8 * MiB;
constexpr size_t WS_WOUT = 18 * MiB;
constexpr size_t WS_WGU = 22 * MiB;
constexpr size_t WS_WDN = 44 * MiB;
constexpr size_t WS_A = 56 * MiB;
constexpr size_t WS_XC = 92 * MiB;
constexpr size_t WS_QB = 100 * MiB, WS_KB = 118 * MiB, WS_VB = 136 * MiB;
constexpr size_t WS_T = 154 * MiB;
constexpr size_t WS_TC = 186 * MiB;
constexpr size_t WS_MIX = 190 * MiB;
constexpr size_t WS_H = 100 * MiB;
constexpr size_t WS_HC = 226 * MiB;
constexpr size_t WS_END = 238 * MiB;
constexpr size_t WS_XB2 = 222 * MiB;
static_assert(WS_DFT + 256 * 512 * 2 <= WS_TF && WS_SSQ + (size_t)M_ALL * 64 <= WS_WIN && WS_H + (size_t)M_ALL * FFD * 2 <= WS_END && WS_MIX + (size_t)M_ALL * DM * 2 <= WS_END, "d_ws map");
constexpr int CW_TMO = 0, CW_BAR = 4096, CW_CTXCNT = 8192, CW_BFCNT = 8192 + 512, CW_C3CNT = 8192 + 1024;
constexpr int RING_BYTES = 131072, RTAB_OFF = RING_BYTES, RTAB_BYTES = 8192, LDSCTL_OFF = RTAB_OFF + RTAB_BYTES, MISC_OFF = LDSCTL_OFF + 320, BTAB_OFF = 140288, ETAB_OFF = 147456, LDS_BYTES = ETAB_OFF + 12288 + 512;
static_assert(MISC_OFF + 512 <= BTAB_OFF && BTAB_OFF + 7 * 1024 == ETAB_OFF && BTAB_OFF == RTAB_OFF + 4 * pg8::BT_F && ETAB_OFF == RTAB_OFF + 4 * pg8::ET_F && LDS_BYTES <= 160 * 1024, "LDS map");
constexpr int N_PHASES = 2 + 6 * NLAYER;

#define GAS __attribute__((address_space(1)))
#define LAS __attribute__((address_space(3)))
typedef unsigned short bf16;
typedef unsigned v4u __attribute__((ext_vector_type(4)));
typedef unsigned v2u __attribute__((ext_vector_type(2)));
typedef float f32x4 __attribute__((ext_vector_type(4)));
#define LDS_WAIT() asm volatile("s_waitcnt lgkmcnt(0)" ::: "memory")
#define VM_WAIT() asm volatile("s_waitcnt vmcnt(0)" ::: "memory")
__device__ __forceinline__ unsigned f2bf(float f) { unsigned u = __builtin_bit_cast(unsigned, f); return (u + 0x7fffu + ((u >> 16) & 1u)) >> 16; }
__device__ __forceinline__ unsigned pk2(float lo, float hi) { return f2bf(lo) | (f2bf(hi) << 16); }
__device__ __forceinline__ float bf2f(unsigned short h) { return __builtin_bit_cast(float, (unsigned)h << 16); }
__device__ __forceinline__ int lane_id() { unsigned z = 0u; asm volatile("" : "+v"(z)); return (int)__builtin_amdgcn_mbcnt_hi(~0u, __builtin_amdgcn_mbcnt_lo(~0u, z)); }
__device__ __forceinline__ float wave_sum(float v) {
#pragma unroll
    for (int o = 1; o < 64; o <<= 1) v += __shfl_xor(v, o);
    return v;
}

#define XB_TMO      128
#define XB_XCNT(j)  (256  + 64 * (j))
#define XB_XSUB(j)  (1280 + 64 * (j))
#define XB_XGEN(j)  (2304 + 64 * (j))
#define XB_TOP      3328
#define XB_TOPGEN   3392
#define XCD_BAR_WORDS 3456
#define XB_SPIN_CAP (1u << 18)

__device__ __forceinline__ unsigned xb_ld(unsigned* p)              { return __hip_atomic_load(p, __ATOMIC_RELAXED, __HIP_MEMORY_SCOPE_AGENT); }
__device__ __forceinline__ unsigned xb_add(unsigned* p, unsigned v) { return __hip_atomic_fetch_add(p, v, __ATOMIC_RELAXED, __HIP_MEMORY_SCOPE_AGENT); }
__device__ __forceinline__ unsigned xb_xcc_id() { return (unsigned)__builtin_amdgcn_s_getreg((3 << 11) | 20) & 0xFu; }
#define XB_SPIN(cond, bar) do { unsigned _sp = 0; while (cond) { __builtin_amdgcn_s_sleep(1); \
    if ((++_sp & 255u) == 0u) { if (xb_ld(&(bar)[XB_TMO])) break; if (_sp > XB_SPIN_CAP) { atomicAdd(&(bar)[XB_TMO], 1u); break; } } } } while (0)

struct XcdBarrier {
    unsigned* bar; unsigned x;
    volatile LAS unsigned* st;
};

__device__ __forceinline__ XcdBarrier xcd_barrier_post(unsigned* bar, volatile LAS unsigned* st) {
    XcdBarrier b; b.bar = bar; b.x = xb_xcc_id(); b.st = st;
    if (threadIdx.x == 0) (void)xb_add(&bar[XB_XCNT(b.x)], 1u);
    return b;
}
__device__ __forceinline__ void xcd_barrier_complete(unsigned* bar, unsigned x, unsigned& nloc, unsigned& nx) {
    const unsigned G = gridDim.x * gridDim.y * gridDim.z;
    unsigned sum, cnt, mine, sp = 0u;
    for (;;) {
        sum = 0u; cnt = 0u; mine = 0u;
#pragma unroll
        for (unsigned j = 0; j < 16; ++j) { const unsigned c = xb_ld(&bar[XB_XCNT(j)]); sum += c; cnt += (c > 0u) ? 1u : 0u; mine = (j == x) ? c : mine; }
        if (sum == G) break;
        __builtin_amdgcn_s_sleep(1);
        if ((++sp & 255u) == 0u) { if (xb_ld(&bar[XB_TMO])) break; if (sp > XB_SPIN_CAP) { atomicAdd(&bar[XB_TMO], 1u); break; } }
    }
    nloc = mine > 0u ? mine : 1u; nx = cnt > 0u ? cnt : 1u;
}

__device__ __forceinline__ void xcd_barrier(const XcdBarrier& b) {
    asm volatile("s_waitcnt vmcnt(0)" ::: "memory");
    __syncthreads();
    if (threadIdx.x == 0) {
        unsigned* bar = b.bar;
        __builtin_amdgcn_s_waitcnt(0);
        unsigned nloc = b.st[0], nx = b.st[1];
        if (nloc == 0u) { xcd_barrier_complete(bar, b.x, nloc, nx); b.st[0] = nloc; b.st[1] = nx; }
        const unsigned old = xb_add(&bar[XB_XSUB(b.x)], 1u);
        const unsigned gen = old / nloc;
        if (old + 1u == (gen + 1u) * nloc) {
            __builtin_amdgcn_fence(__ATOMIC_RELEASE, "agent");
            asm volatile("s_waitcnt vmcnt(0)" ::: "memory");
            const unsigned og = xb_add(&bar[XB_TOP], 1u);
            const unsigned tg = og / nx;
            if (og + 1u == (tg + 1u) * nx) xb_add(&bar[XB_TOPGEN], 1u);
            else XB_SPIN(xb_ld(&bar[XB_TOPGEN]) == tg, bar);
            __builtin_amdgcn_fence(__ATOMIC_ACQUIRE, "agent");
            xb_add(&bar[XB_XGEN(b.x)], 1u);
            asm volatile("s_waitcnt vmcnt(0)" ::: "memory");
        } else {
            XB_SPIN(xb_ld(&bar[XB_XGEN(b.x)]) == gen, bar);
            __builtin_amdgcn_fence(__ATOMIC_ACQUIRE, "agent");
            asm volatile("s_waitcnt vmcnt(0)" ::: "memory");
        }
    }
    __syncthreads();
}


struct Args { const float* in[21]; float* out; unsigned char* ws; int ph_lo, ph_hi; };
struct Frame {
    LAS unsigned char* lds; int wave, vcu, G;
};

__device__ __forceinline__ void transpose_item(const float* W, int ldn, bf16* WT, int ldk, int k0, int n0, int drow0, LAS float* scr, int lane) {
    const int r = lane >> 3, c4 = (lane & 7) * 4; f32x4 v[8];
#pragma unroll
    for (int j = 0; j < 8; ++j) v[j] = *(const f32x4*)(W + (size_t)(k0 + 8 * j + r) * ldn + n0 + c4);
#pragma unroll
    for (int j = 0; j < 8; ++j) { LAS float* d = scr + (8 * j + r) * 33 + c4; d[0] = v[j][0]; d[1] = v[j][1]; d[2] = v[j][2]; d[3] = v[j][3]; }
    LDS_WAIT(); asm volatile("" ::: "memory");
    const int c = lane & 7;
#pragma unroll
    for (int j = 0; j < 4; ++j) { const int n = (lane >> 3) + 8 * j; const LAS float* s = scr + (8 * c) * 33 + n;
        v4u o; o.x = pk2(s[0 * 33], s[1 * 33]); o.y = pk2(s[2 * 33], s[3 * 33]); o.z = pk2(s[4 * 33], s[5 * 33]); o.w = pk2(s[6 * 33], s[7 * 33]);
        *(GAS v4u*)(WT + (size_t)(drow0 + n) * ldk + k0 + 8 * c) = o; }
    LDS_WAIT(); asm volatile("" ::: "memory");
}
__device__ __forceinline__ void ph0(Frame& F, const Args& A, unsigned char* ws) {
    int tid_ = F.wave * 64 + lane_id(); asm volatile("" : "+v"(tid_));
    LAS float* scr = (LAS float*)(F.lds + F.wave * 16384);
    const int gw = F.vcu * NWAVES + F.wave, NGW = F.G * NWAVES;
    SUBSTAMP(0);
    constexpr int I_IN = 16 * 48, I_OUT = 16 * 32, I_G = 16 * 88, I_D = 44 * 32, I_LAYER = I_IN + I_OUT + 2 * I_G + I_D;
    for (int it = gw; it < NLAYER * I_LAYER; it += NGW) {
        const int l = it / I_LAYER; int r = it % I_LAYER;
        if (r < I_IN) { const int kb = r / 48, nb = r % 48, n0 = nb * 32, pn = n0 >> 8, cc = n0 & 255; const int drow = pn < 4 ? pn * 256 + ((cc >> 5) & 1) * 128 + (cc >> 6) * 32 : n0;
            transpose_item(A.in[8] + (size_t)l * DM * NINSRC, NINSRC, (bf16*)(ws + WS_WIN) + (size_t)l * NIN * DM, DM, kb * 64, n0, drow, scr, (tid_ & 63)); continue; } r -= I_IN;
        if (r < I_OUT) { const int kb = r / 32, nb = r % 32; transpose_item(A.in[17] + (size_t)l * DM * DM, DM, (bf16*)(ws + WS_WOUT) + (size_t)l * DM * DM, DM, kb * 64, nb * 32, nb * 32, scr, (tid_ & 63)); continue; } r -= I_OUT;
        if (r < 2 * I_G) { const int up = r >= I_G; if (up) r -= I_G; const int kb = r / 88, nb = r % 88, n0 = nb * 32; const int drow = (n0 >> 7) * 256 + up * 128 + (n0 & 127);
            transpose_item((up ? A.in[19] : A.in[18]) + (size_t)l * DM * FFD, FFD, (bf16*)(ws + WS_WGU) + (size_t)l * NGU * DM, DM, kb * 64, n0, drow, scr, (tid_ & 63)); continue; } r -= 2 * I_G;
        { const int kb = r / 32, nb = r % 32; transpose_item(A.in[20] + (size_t)l * FFD * DM, DM, (bf16*)(ws + WS_WDN) + (size_t)l * DM * FFD, FFD, kb * 64, nb * 32, nb * 32, scr, (tid_ & 63)); }
    }
    __syncthreads();
    SUBSTAMP(1);
    LAS float* sl = (LAS float*)F.lds;
    LAS float* red = (LAS float*)(F.lds + 40960);
    { f32x4 v[5];
#pragma unroll
      for (int q = 0; q < 5; ++q) { const int i4 = tid_ + q * (NWAVES * 64); const int j = i4 >> 8, k4 = (i4 & 255) * 4; v[q] = (i4 < 9 * 256) ? *(const f32x4*)((j < 8) ? A.in[1] + j * DM + k4 : A.in[3] + k4) : (f32x4){0.f, 0.f, 0.f, 0.f}; }
#pragma unroll
      for (int q = 0; q < 5; ++q) { const int i4 = tid_ + q * (NWAVES * 64); if (i4 < 9 * 256) { f32x4 s; for (int e = 0; e < 4; ++e) s[e] = v[q][e] / (1.f + __expf(-v[q][e])); *(LAS f32x4*)(sl + i4 * 4) = s; } } }
    __syncthreads();
    { const int lane = tid_ & 63; const int NIT = NLAYER * 24 * 16;
      f32x4 w[8];
#define MOD_LOAD(it_) do { const int kb_ = (it_) & 15, cb_ = ((it_) >> 4) % 24, l_ = (it_) / (24 * 16); const float* W_ = A.in[4] + (size_t)l_ * DM * 6144 + (size_t)(kb_ * 64 + F.wave * 8) * 6144 + cb_ * 256 + lane * 4; \
        _Pragma("unroll") for (int r = 0; r < 8; ++r) w[r] = *(const f32x4*)(W_ + (size_t)r * 6144); } while (0)
      if (F.vcu < NIT) MOD_LOAD(F.vcu);
      for (int it = F.vcu; it < NIT; it += F.G) {
        const int kb = it & 15, cb = (it >> 4) % 24, l = it / (24 * 16);
        f32x4 acc[9];
#pragma unroll
        for (int j = 0; j < 9; ++j) acc[j] = (f32x4){0.f, 0.f, 0.f, 0.f};
#pragma unroll
        for (int r4 = 0; r4 < 8; r4 += 4)
#pragma unroll
            for (int j = 0; j < 9; ++j) { const f32x4 s = *(const LAS f32x4*)(sl + j * DM + kb * 64 + F.wave * 8 + r4); acc[j] += w[r4] * s[0] + w[r4 + 1] * s[1] + w[r4 + 2] * s[2] + w[r4 + 3] * s[3]; }
        if (it + F.G < NIT) MOD_LOAD(it + F.G);
#pragma unroll
        for (int j = 0; j < 9; ++j) *(LAS f32x4*)(red + (F.wave * 9 + j) * 256 + lane * 4) = acc[j];
        __syncthreads();
        for (int i = tid_; i < 9 * 256; i += NWAVES * 64) { const int j = i >> 8, cn = i & 255; float s = 0.f;
#pragma unroll
            for (int w8 = 0; w8 < 8; ++w8) s += red[(w8 * 9 + j) * 256 + cn];
            const int nn = cb * 256 + cn; if (kb == 0) s += A.in[5][l * 6144 + nn];
            atomicAdd((float*)(ws + WS_MOD) + (l * 9 + j) * 6144 + nn, s); }
        __syncthreads();
      }
#undef MOD_LOAD
    }
    SUBSTAMP(2);
    const int gt = F.vcu * (NWAVES * 64) + tid_, NGT = F.G * NWAVES * 64;
    for (int i = gt; i < 96 * 16; i += NGT) { const int p = i >> 4, j = i & 15; const float inv = powf(10000.0f, -(float)j * (1.0f / 16.0f)); const float ang = (float)(p < 32 ? p : p - 32) * inv;
        float sn, cs; sincosf(ang, &sn, &cs); ((float*)(ws + WS_ROPE))[i] = cs; ((float*)(ws + WS_ROPE))[1536 + i] = sn; }
    for (int i = gt; i < 256 * 512; i += NGT) { const int m = i >> 9, kk = i & 511, n = kk >> 1; const int p = (m * n) & 255; float sn, cs; sincospif((float)p * (1.0f / 128.0f), &sn, &cs);
        ((bf16*)(ws + WS_DFT))[i] = (bf16)f2bf((kk & 1) ? sn : cs); }
    SUBSTAMP(3);
    __syncthreads();
    if (F.vcu < NLAYER * 4 * 32) {
        const int lg = F.vcu >> 5, c0 = (F.vcu & 31) * 4;
        LAS float* wl = (LAS float*)F.lds; LAS float* ct = (LAS float*)(F.lds + 65536); LAS float* st = ct + 128;
        { f32x4 wv[8];
#pragma unroll
          for (int q = 0; q < 8; ++q) wv[q] = *(const f32x4*)(A.in[16] + (size_t)lg * 128 * 128 + (tid_ + q * (NWAVES * 64)) * 4);
#pragma unroll
          for (int q = 0; q < 8; ++q) *(LAS f32x4*)(wl + (tid_ + q * (NWAVES * 64)) * 4) = wv[q]; }
        if (tid_ < 128) { float sn, cs; sincospif((float)tid_ * (1.0f / 64.0f), &sn, &cs); ct[tid_] = cs; st[tid_] = sn; }
        __syncthreads();
        for (int o = tid_; o < 4 * 256; o += NWAVES * 64) { const int d = o & 127, ri = (o >> 7) & 1, cch = c0 + (o >> 8); float s = 0.f;
#pragma unroll 8
            for (int c2 = 0; c2 < 128; ++c2) { const int p = (cch * c2) & 127; s += (ri ? -st[p] : ct[p]) * wl[c2 * 128 + d]; }
            ((float*)(ws + WS_TF))[(size_t)lg * 32768 + cch * 256 + ri * 128 + d] = s; }
    }
    SUBSTAMP(4);
}
__device__ __forceinline__ void ph1(Frame& F, const Args& A, unsigned char* ws) {
    int tid_ = F.wave * 64 + lane_id(); asm volatile("" : "+v"(tid_));
    const float* mod = (const float*)(ws + WS_MOD);
    SUBSTAMP(5);
    { const int gw = F.vcu * NWAVES + F.wave, NGW = F.G * NWAVES; const int lane = tid_ & 63;
      for (int row0 = gw; row0 < M_ALL; row0 += 2 * NGW) {
          const int row1 = row0 + NGW; const bool two = row1 < M_ALL;
          f32x4 v[2][4]; float s[2] = {0.f, 0.f};
#pragma unroll
          for (int q = 0; q < 2; ++q) { const int row = q ? (two ? row1 : row0) : row0; const float* xr = row < M_LAT ? A.in[0] + (size_t)row * DM : A.in[2] + (size_t)(row - M_LAT) * DM;
#pragma unroll
              for (int j = 0; j < 4; ++j) v[q][j] = *(const f32x4*)(xr + 256 * j + 4 * lane); }
#pragma unroll
          for (int q = 0; q < 2; ++q) {
#pragma unroll
              for (int j = 0; j < 4; ++j) s[q] += (v[q][j][0] * v[q][j][0] + v[q][j][1] * v[q][j][1]) + (v[q][j][2] * v[q][j][2] + v[q][j][3] * v[q][j][3]);
              s[q] = wave_sum(s[q]); }
#pragma unroll
          for (int q = 0; q < 2; ++q) { if (q == 1 && !two) break; const int row = q ? row1 : row0; const int bm = row < M_LAT ? (row >> 11) : 8; const float* sc = mod + bm * 6144 + 1024;
              bf16* ar = (bf16*)(ws + WS_A) + (size_t)row * DM;
              _Float16* hr = row < M_LAT ? (_Float16*)A.out + (size_t)row * DM : (_Float16*)(ws + WS_XC) + (size_t)(row - M_LAT) * DM;
#pragma unroll
              for (int j = 0; j < 4; ++j) { v2u h; h.x = pg8::pkh2(v[q][j][0], v[q][j][1]); h.y = pg8::pkh2(v[q][j][2], v[q][j][3]); *(v2u*)(hr + 256 * j + 4 * lane) = h; }
#pragma unroll
              for (int j = 0; j < 4; ++j) { const int k = 256 * j + 4 * lane; const f32x4 g = *(const f32x4*)(A.in[6] + k) * (*(const f32x4*)(sc + k) + 1.0f); const f32x4 a = v[q][j] * g; v2u w; w.x = pk2(a[0], a[1]); w.y = pk2(a[2], a[3]); *(v2u*)(ar + k) = w; }
              if (lane < 16) ((float*)(ws + WS_SSQ))[(size_t)row * 16 + lane] = lane == 0 ? s[q] : 0.f; }
      } }
    __syncthreads();
    SUBSTAMP(6);
    { LAS float* wl = (LAS float*)F.lds;
      LAS float* tl = (LAS float*)(F.lds + 128 * 132 * 4);
      LAS float* shl = (LAS float*)(F.lds + 128 * 132 * 4 + 128 * 64 * 4);
      LAS float* redl = shl + 9 * 128;
      for (int it = F.vcu; it < NLAYER * 4 * 4 * 8; it += F.G) {
          const int kb = it & 7, q = (it >> 3) & 3, g = (it >> 5) & 3, l = it >> 7;
          const float* wsrc = A.in[8] + (size_t)l * DM * NINSRC + (size_t)(kb * 128) * NINSRC + 1536 + g * 128;
          f32x4 wv[8], tv[4];
#pragma unroll
          for (int q = 0; q < 8; ++q) { const int i = tid_ + q * (NWAVES * 64); wv[q] = *(const f32x4*)(wsrc + (size_t)(i >> 5) * NINSRC + (i & 31) * 4); }
          const float* tsrc = (const float*)(ws + WS_TF) + (size_t)(l * 4 + g) * 128 * 256 + q * 64;
#pragma unroll
          for (int q = 0; q < 4; ++q) { const int i = tid_ + q * (NWAVES * 64); tv[q] = *(const f32x4*)(tsrc + (size_t)(i >> 4) * 256 + (i & 15) * 4); }
#pragma unroll
          for (int q = 0; q < 8; ++q) { const int i = tid_ + q * (NWAVES * 64); *(LAS f32x4*)(wl + (i >> 5) * 132 + (i & 31) * 4) = wv[q]; }
#pragma unroll
          for (int q = 0; q < 4; ++q) { const int i = tid_ + q * (NWAVES * 64); *(LAS f32x4*)(tl + (i >> 4) * 64 + (i & 15) * 4) = tv[q]; }
          if (tid_ < 9 * 32) *(LAS f32x4*)(shl + tid_ * 4) = *(const f32x4*)(mod + (l * 9 + (tid_ >> 5)) * 6144 + kb * 128 + (tid_ & 31) * 4);
          __syncthreads();
          const int dcol = tid_ & 63, kg = tid_ >> 6; float acc[16];
#pragma unroll
          for (int i = 0; i < 16; ++i) acc[i] = 0.f;
          for (int c4 = 0; c4 < 128; c4 += 4) { const float t0 = tl[c4 * 64 + dcol], t1 = tl[(c4 + 1) * 64 + dcol], t2 = tl[(c4 + 2) * 64 + dcol], t3 = tl[(c4 + 3) * 64 + dcol];
#pragma unroll
              for (int i = 0; i < 16; ++i) { const f32x4 w = *(const LAS f32x4*)(wl + (kg * 16 + i) * 132 + c4); acc[i] += w[0] * t0 + w[1] * t1 + w[2] * t2 + w[3] * t3; } }
          bf16* dst = (bf16*)(ws + WS_WIN) + (size_t)l * NIN * DM + (size_t)(1536 + g * 256 + q * 64 + dcol) * DM + kb * 128 + kg * 16;
          v4u o0, o1; o0.x = pk2(acc[0], acc[1]); o0.y = pk2(acc[2], acc[3]); o0.z = pk2(acc[4], acc[5]); o0.w = pk2(acc[6], acc[7]); o1.x = pk2(acc[8], acc[9]); o1.y = pk2(acc[10], acc[11]); o1.z = pk2(acc[12], acc[13]); o1.w = pk2(acc[14], acc[15]);
          *(v4u*)dst = o0; *(v4u*)(dst + 8) = o1;
          { float bs[9];
#pragma unroll
            for (int j = 0; j < 9; ++j) { float s = 0.f;
#pragma unroll
                for (int i4 = 0; i4 < 4; ++i4) { const f32x4 sv = *(const LAS f32x4*)(shl + j * 128 + kg * 16 + i4 * 4); s += sv[0] * acc[4 * i4] + sv[1] * acc[4 * i4 + 1] + sv[2] * acc[4 * i4 + 2] + sv[3] * acc[4 * i4 + 3]; }
                bs[j] = s; }
#pragma unroll
            for (int j = 0; j < 9; ++j) redl[(kg * 9 + j) * 64 + dcol] = bs[j]; }
          __syncthreads();
          for (int i = tid_; i < 9 * 64; i += NWAVES * 64) { const int j = i >> 6, dc = i & 63; float s = 0.f;
#pragma unroll
              for (int w = 0; w < 8; ++w) s += redl[(w * 9 + j) * 64 + dc];
              atomicAdd((float*)(ws + WS_BIN) + (l * 9 + j) * NIN + 1536 + g * 256 + q * 64 + dc, s); }
          __syncthreads();
      } }
    SUBSTAMP(7);
    { LAS unsigned short* sh16 = (LAS unsigned short*)F.lds;
      for (int i = tid_; i < 4 * 16 * 256; i += NWAVES * 64) { const int set = i >> 12, row = (i >> 8) & 15, k4 = (i & 255) * 4; v2u o = {0u, 0u};
          if (row < 9) { const f32x4 v = *(const f32x4*)(mod + ((set >> 1) * 9 + row) * 6144 + ((set & 1) ? 3072 : 0) + k4); o.x = pk2(v[0], v[1]); o.y = pk2(v[2], v[3]); }
          *(LAS v2u*)(sh16 + (size_t)i * 4) = o; }
      __syncthreads();
      typedef short bf8 __attribute__((ext_vector_type(8)));
      const int lane = tid_ & 63, fr = lane & 15, fq = lane >> 4;
      const int gw = F.vcu * NWAVES + F.wave, NGW = F.G * NWAVES;
      for (int t = gw; t < 896; t += NGW) {
          int set, n0; if (t < 96) { set = 0; n0 = t * 16; } else if (t < 448) { set = 1; n0 = (t - 96) * 16; } else if (t < 544) { set = 2; n0 = (t - 448) * 16; } else { set = 3; n0 = (t - 544) * 16; }
          const int l = set >> 1, gu = set & 1;
          const bf16* WT = gu ? (const bf16*)(ws + WS_WGU) + (size_t)l * NGU * DM : (const bf16*)(ws + WS_WIN) + (size_t)l * NIN * DM;
          const bf16* wrow = WT + (size_t)(n0 + fr) * DM + fq * 8; const LAS unsigned short* arow = sh16 + (size_t)set * 16 * 1024 + fr * 1024 + fq * 8;
          pg8::f32x4 acc = {0.f, 0.f, 0.f, 0.f};
#pragma unroll
          for (int s8 = 0; s8 < 32; s8 += 8) { bf8 b[8];
#pragma unroll
              for (int q = 0; q < 8; ++q) b[q] = *(const bf8*)(wrow + (s8 + q) * 32);
#pragma unroll
              for (int q = 0; q < 8; ++q) { const bf8 a = *(const LAS bf8*)(arow + (s8 + q) * 32); acc = __builtin_amdgcn_mfma_f32_16x16x32_bf16(a, b[q], acc, 0, 0, 0); } }
          float* bo = gu ? (float*)(ws + WS_BGU) + l * 9 * NGU : (float*)(ws + WS_BIN) + l * 9 * NIN; const int ldb = gu ? NGU : NIN;
#pragma unroll
          for (int r = 0; r < 4; ++r) { const int j = fq * 4 + r; if (j < 9) bo[j * ldb + n0 + fr] = acc[r]; }
      }
    }
    SUBSTAMP(8);
}
__device__ __forceinline__ void fft8(float (&xr)[8], float (&xi)[8]) {
    const float S = 0.70710678118654752f;
    const float u0r = xr[0] + xr[4], u0i = xi[0] + xi[4], d0r = xr[0] - xr[4], d0i = xi[0] - xi[4];
    const float u1r = xr[1] + xr[5], u1i = xi[1] + xi[5], d1r = xr[1] - xr[5], d1i = xi[1] - xi[5];
    const float u2r = xr[2] + xr[6], u2i = xi[2] + xi[6], d2r = xr[2] - xr[6], d2i = xi[2] - xi[6];
    const float u3r = xr[3] + xr[7], u3i = xi[3] + xi[7], d3r = xr[3] - xr[7], d3i = xi[3] - xi[7];
    const float v0r = d0r, v0i = d0i;
    const float v1r = (d1r + d1i) * S, v1i = (d1i - d1r) * S;
    const float v2r = d2i, v2i = -d2r;
    const float v3r = (d3i - d3r) * S, v3i = -(d3r + d3i) * S;
    { const float p0r = u0r + u2r, p0i = u0i + u2i, p1r = u1r + u3r, p1i = u1i + u3i, p2r = u0r - u2r, p2i = u0i - u2i, qr = u1r - u3r, qi = u1i - u3i; const float p3r = qi, p3i = -qr;
      xr[0] = p0r + p1r; xi[0] = p0i + p1i; xr[4] = p0r - p1r; xi[4] = p0i - p1i; xr[2] = p2r + p3r; xi[2] = p2i + p3i; xr[6] = p2r - p3r; xi[6] = p2i - p3i; }
    { const float p0r = v0r + v2r, p0i = v0i + v2i, p1r = v1r + v3r, p1i = v1i + v3i, p2r = v0r - v2r, p2i = v0i - v2i, qr = v1r - v3r, qi = v1i - v3i; const float p3r = qi, p3i = -qr;
      xr[1] = p0r + p1r; xi[1] = p0i + p1i; xr[5] = p0r - p1r; xi[5] = p0i - p1i; xr[3] = p2r + p3r; xi[3] = p2i + p3i; xr[7] = p2r - p3r; xi[7] = p2i - p3i; }
}
__device__ __forceinline__ void butterfly_phase(Frame& F, unsigned char* ws) {
    bf16* T = (bf16*)(ws + WS_T);
    int tid_ = F.wave * 64 + lane_id(); asm volatile("" : "+v"(tid_));
    const int gt = F.vcu * (NWAVES * 64) + tid_, NGT = F.G * NWAVES * 64;
    for (int it = gt; it < NBATCH * 512 * 128; it += NGT) {
        const int n0 = (it & 127) * 2, bc = it >> 7, b = bc >> 9, ch = bc & 511; bf16* tp = T + ((size_t)(b * 8) * 512 + ch) * 512 + n0 * 2;
        v2u q[8];
#pragma unroll
        for (int j = 0; j < 8; ++j) q[j] = *(const v2u*)(tp + (size_t)j * 512 * 512);
        float ar[8], ai[8], br[8], bi[8];
#define BF_UNP(k) ar[k] = __builtin_bit_cast(float, q[k].x << 16); ai[k] = __builtin_bit_cast(float, q[k].x & 0xffff0000u); br[k] = __builtin_bit_cast(float, q[k].y << 16); bi[k] = __builtin_bit_cast(float, q[k].y & 0xffff0000u);
        BF_UNP(0) BF_UNP(1) BF_UNP(2) BF_UNP(3) BF_UNP(4) BF_UNP(5) BF_UNP(6) BF_UNP(7)
#undef BF_UNP
        fft8(ar, ai); fft8(br, bi);
        const float th0 = (float)n0 * (1.0f / 1024.0f), th1 = (float)(n0 + 1) * (1.0f / 1024.0f);
#define BF_OUT(r) { float s0, c0, s1, c1; sincospif(th0 * (float)(r), &s0, &c0); sincospif(th1 * (float)(r), &s1, &c1); v2u o_; \
          o_.x = pk2(ar[r] * c0 + ai[r] * s0, ai[r] * c0 - ar[r] * s0); o_.y = pk2(br[r] * c1 + bi[r] * s1, bi[r] * c1 - br[r] * s1); *(v2u*)(tp + (size_t)(r) * 512 * 512) = o_; }
        BF_OUT(0) BF_OUT(1) BF_OUT(2) BF_OUT(3) BF_OUT(4) BF_OUT(5) BF_OUT(6) BF_OUT(7)
#undef BF_OUT
    }
}
template <class S> __device__ __forceinline__ void compute_rtab(Frame& F, unsigned char* ws, const S& sched, const float* bias, int NC) {
    LAS float* rt = (LAS float*)(F.lds + RTAB_OFF); LAS float* bt = (LAS float*)(F.lds + BTAB_OFF); pg8::Unit u;
    int tid_ = F.wave * 64 + lane_id(); asm volatile("" : "+v"(tid_));
    const int t = tid_ & 255, par = tid_ >> 8;
    for (int i = 0; i < 7 && sched.next(i, u); ++i) if ((i & 1) == par) { const float* p = (const float*)(ws + WS_SSQ) + ((size_t)u.pm * 256 + t) * 16; float s = 0.f;
        const float bvv = bias[(u.pm < 64 ? (u.pm >> 3) : 8) * NC + u.pn * 256 + t];
#pragma unroll
        for (int q = 0; q < 4; ++q) { const f32x4 a = *(const f32x4*)(p + 4 * q); s += (a[0] + a[1]) + (a[2] + a[3]); }
        rt[i * 256 + t] = __builtin_amdgcn_rsqf(s * (1.0f / 1024.0f) + 1e-6f); bt[i * 256 + t] = bvv; }
    __syncthreads();
}
__device__ __forceinline__ void attn_phase(Frame& F, const Args& A, unsigned char* ws, int l, char* lds) {
    int tid_ = F.wave * 64 + lane_id(); asm volatile("" : "+v"(tid_));
    const float lambda_init = l == 0 ? 0.2f : 0.355509068f;
    const float lam = expf(wave_sum(A.in[11][l * 64 + (tid_ & 63)] * A.in[12][l * 64 + (tid_ & 63)])) - expf(wave_sum(A.in[13][l * 64 + (tid_ & 63)] * A.in[14][l * 64 + (tid_ & 63)])) + lambda_init;
    float gq = fabsf(A.in[9][l * 64 + (tid_ & 63)]), gk = fabsf(A.in[10][l * 64 + (tid_ & 63)]);
#pragma unroll
    for (int o = 1; o < 64; o <<= 1) { gq = fmaxf(gq, __shfl_xor(gq, o)); gk = fmaxf(gk, __shfl_xor(gk, o)); }
    const float negoff = -fmaxf(0.f, 8.0f * 1.4426950408889634f * gq * gk * 1.0001f - 40.0f);
    const att::bf16* QB = (const att::bf16*)(ws + WS_QB); const att::bf16* KB = (const att::bf16*)(ws + WS_KB); const att::bf16* VB = (const att::bf16*)(ws + WS_VB); att::bf16* MIX = (att::bf16*)(ws + WS_MIX);
    const float* subg = A.in[15] + l * 128;
    const int per = (512 + F.G - 1) / F.G;
    for (int u = F.vcu * per; u < (F.vcu + 1) * per && u < 512; ++u) {
        const int qblk = u & 15, bh = u >> 4, b = bh >> 2, h = bh & 3;
        att::attn_unit(QB + h * 128, KB + h * 128, VB + h * 128, MIX + h * 128, (long)b * SEQ + qblk * 128, (long)M_LAT + b * CTXL, 4, (long)b * SEQ, 36, lam, 1.0f - lambda_init, subg, negoff, lds, F.wave, (unsigned)(uintptr_t)F.lds);
    }
#if EN_ATTC
    if (l == 0) for (int u = F.vcu; u < 64; u += F.G) {
        const int qblk = u & 1, bh = u >> 1, b = bh >> 2, h = bh & 3;
        att::attn_unit(QB + h * 128, KB + h * 128, VB + h * 128, MIX + h * 128, (long)M_LAT + b * CTXL + qblk * 128, (long)M_LAT + b * CTXL, 4, 0, 4, lam, 1.0f - lambda_init, subg, negoff, lds, F.wave, (unsigned)(uintptr_t)F.lds);
    }
#endif
}

__global__ void __launch_bounds__(NWAVES * 64, 2) fwd_kernel(const Args args) {
    extern __shared__ __attribute__((aligned(16))) unsigned char lds[];
    Frame F0;
    F0.lds = (LAS unsigned char*)lds;
    F0.wave = __builtin_amdgcn_readfirstlane((int)threadIdx.x >> 6);
    F0.G = gridDim.x; { const int bx = blockIdx.x; F0.vcu = (F0.G % 8 == 0) ? (bx % 8) * (F0.G / 8) + bx / 8 : bx; }
    for (int u = ((int)threadIdx.x); u < (LDS_BYTES - LDSCTL_OFF) / 4; u += NWAVES * 64) ((LAS unsigned*)(F0.lds + LDSCTL_OFF))[u] = 0u;
    __syncthreads();
    volatile LAS unsigned* MISC = (volatile LAS unsigned*)(F0.lds + MISC_OFF);
    (void)xcd_barrier_post((unsigned*)(args.ws + WS_CTL) + CW_BAR, MISC + 8);
    const int lo = args.ph_lo, hi = args.ph_hi;
    const int cid = (int)blockIdx.x;
    const LAS float* rtab = (const LAS float*)(F0.lds + RTAB_OFF);
#pragma unroll 1
    for (int ph = lo; ph < hi; ++ph) {
#if PROBE_A
        if (blockIdx.x == 0 && F0.wave == 0) MISC[16 + ph] = (unsigned)__builtin_amdgcn_s_memrealtime();
#endif
        unsigned char* ws = args.ws; asm volatile("" : "+s"(ws)); const Args& A = args;
        Frame F = F0; asm volatile("" : "+s"(F.G), "+s"(F.vcu), "+s"(F.wave));
        int l = 0, k = -1; if (ph >= 2) { l = (ph - 2) / 6; k = (ph - 2) % 6; }
        if (ph == 0) ph0(F, A, ws);
        else if (ph == 1) ph1(F, A, ws);
        else if (k == 1) continue;
        else if (k == 2) {
            butterfly_phase(F, ws);
            asm volatile("s_waitcnt vmcnt(0)" ::: "memory"); __syncthreads();
            if (F.wave == 0 && lane_id() == 0) { __builtin_amdgcn_fence(__ATOMIC_RELEASE, "agent"); asm volatile("s_waitcnt vmcnt(0)" ::: "memory");
                __hip_atomic_fetch_add((unsigned*)(ws + WS_CTL) + CW_BFCNT + 64 * l, 1u, __ATOMIC_RELAXED, __HIP_MEMORY_SCOPE_AGENT); }
            attn_phase(F, A, ws, l, (char*)lds);
        }
#pragma unroll 1
        for (int ci = 0; ci < 2; ++ci) {
            enum { T_NONE = 0, T_IN = 1, T_DFT = 2, T_RESN = 3, T_RESL = 4, T_GU = 5 };
            int type = T_NONE, nMa = 0, nNa = 0, pmB = 0, nMb = 0, pnB = 0, nNb = 0, Gs = F.G, cs = cid, rot = 0, K = DM, el = l, nshort = 0, ishort = 0; bool ctxdown = false; int sigw = -1, waitw = -1;
#if SCHED_OLD
            const int nM = l == 0 ? 72 : 64;
            if (ci == 0) {
                if (k == 0) { type = T_IN; if (l == 0) { nMa = 72; nNa = 10; } else { nMa = 64; nNa = 10; pmB = 64; nMb = 8; pnB = 2; nNb = 4; } }
                else if (k == 2) { type = T_DFT; nMa = 1; nNa = l == 0 ? 144 : 128; rot = F.G - 64; K = 512; }
                else if (k == 3) { type = T_RESN; nMa = nM; nNa = 4; }
                else if (k == 4) { type = T_GU; nMa = nM; nNa = 22; }
                else if (k == 5) { type = l == NLAYER - 1 ? T_RESL : T_RESN; nMa = nM; nNa = 4; K = FFD; }
            }
#else
            if (k == 0) {
                if (l == 0) { if (ci == 0) { type = T_IN; nMa = 72; nNa = 10; } }
                else if (ci == 0) { type = T_RESN; pmB = 64; nMb = 8; pnB = 0; nNb = 4; K = FFD; el = 0; ctxdown = true; sigw = CW_CTXCNT; }
                else if (cid >= 32) { type = T_IN; nMa = 64; nNa = 10; Gs = F.G - 32; cs = cid - 32; }
                else if (l == NLAYER - 1) { type = T_IN; pmB = 64; nMb = 8; pnB = 2; nNb = 4; waitw = CW_CTXCNT; }
            }
            else if (k == 2) { if (ci == 0) { type = T_DFT; nMa = 1; nNa = l == 0 ? 144 : 128; rot = F.G - 64; K = 512; } }
            else if (k == 3) { if (ci == 0) { type = T_RESN; nMa = 64; nNa = 4; } }
            else if (k == 4) { if (l == 0 && ci == 0) { type = T_RESN; pmB = 64; nMb = 8; pnB = 0; nNb = 4; }
                               else if (ci == (l == 0 ? 1 : 0)) { type = T_GU; nMa = 64; nNa = 22; if (l == 0) { nshort = 32; ishort = 4; } } }
            else if (k == 5) { const int cdn = (l == 0) ? 1 : 0;
                               if (ci == cdn) { type = l == NLAYER - 1 ? T_RESL : T_RESN; nMa = 64; nNa = 4; K = FFD; } else if (l == 0 && ci == 0) { type = T_GU; pmB = 64; nMb = 8; pnB = 0; nNb = 22; } }
#endif
            if (type == T_NONE) continue;
            pg8::Sched2 S; S.init(nMa, nNa, pmB, nMb, pnB, nNb, Gs, cs, rot); S.ns = nshort; S.is = ishort;
            if (waitw >= 0) {
                pg8::Unit u0; if (!S.next(0, u0)) continue;
                if (F.wave == 0) { unsigned* cw = (unsigned*)(ws + WS_CTL) + waitw + 64 * (cid & 7); unsigned sp = 0;
                    while (__hip_atomic_load(cw, __ATOMIC_RELAXED, __HIP_MEMORY_SCOPE_AGENT) < 4u) { __builtin_amdgcn_s_sleep(8); if (++sp > (1u << 22)) break; }
                    __builtin_amdgcn_fence(__ATOMIC_ACQUIRE, "agent"); asm volatile("s_waitcnt vmcnt(0)" ::: "memory"); }
                __syncthreads();
            } S.wgm = (nNa >= 16) ? WGM_WIDE : ((nNa >= 8) ? WGM_MID : 2);
            if (type == T_IN) {
                {
                    int t_ = F.wave * 64 + lane_id(); asm volatile("" : "+v"(t_)); LAS float* et = (LAS float*)(F.lds + ETAB_OFF);
                    for (int i = t_; i < 3072 + 128; i += NWAVES * 64) et[i] = i < 3072 ? ((const float*)(ws + WS_ROPE))[i] : (i < 3136 ? A.in[9][l * 64 + i - 3072] : A.in[10][l * 64 + i - 3136]);
                }
                compute_rtab(F, ws, S, (const float*)(ws + WS_BIN) + l * 9 * NIN, NIN);
                pg8::Gemm g{(const pg8::bf16_t*)(ws + WS_A), (const pg8::bf16_t*)(ws + WS_WIN) + (size_t)l * NIN * DM, M_ALL, NIN, DM};
                pg8::EpiIn E{ws, rtab};
                pg8::gemm_phase<pg8::EpiIn, pg8::Sched2, true, true>(F.lds, g, S, E, F.wave);
            } else if (type == T_DFT) {
                {
                    if (F.wave == 0) { unsigned* cw = (unsigned*)(ws + WS_CTL) + CW_BFCNT + 64 * l; unsigned sp = 0;
                        while (__hip_atomic_load(cw, __ATOMIC_RELAXED, __HIP_MEMORY_SCOPE_AGENT) < (unsigned)F.G) { __builtin_amdgcn_s_sleep(8); if (++sp > (1u << 22)) break; }
                        __builtin_amdgcn_fence(__ATOMIC_ACQUIRE, "agent"); asm volatile("s_waitcnt vmcnt(0)" ::: "memory"); }
                    __syncthreads();
                }
                pg8::Gemm g{(const pg8::bf16_t*)(ws + WS_DFT), (const pg8::bf16_t*)(ws + WS_T), 256, 36864, 512};
                pg8::EpiDft E{(pg8::bf16_t*)(ws + WS_MIX)};
                pg8::gemm_phase<pg8::EpiDft, pg8::Sched2, true, true>(F.lds, g, S, E, F.wave);
            } else if (type == T_GU) {
                compute_rtab(F, ws, S, (const float*)(ws + WS_BGU) + l * 9 * NGU, NGU);
                pg8::Gemm g{(const pg8::bf16_t*)(ws + WS_A), (const pg8::bf16_t*)(ws + WS_WGU) + (size_t)l * NGU * DM, M_ALL, NGU, DM};
                pg8::EpiGU E{ws, rtab};
                pg8::gemm_phase<pg8::EpiGU, pg8::Sched2, true, true>(F.lds, g, S, E, F.wave);
            } else if (type == T_RESN) {
                const bool down = K == FFD;
                const pg8::bf16_t* Ap = down ? (ctxdown ? (const pg8::bf16_t*)(ws + WS_HC) - (size_t)M_LAT * FFD : (const pg8::bf16_t*)(ws + WS_H)) : (const pg8::bf16_t*)(ws + WS_MIX);
                const pg8::bf16_t* Bp = down ? (const pg8::bf16_t*)(ws + WS_WDN) + (size_t)el * DM * FFD : (const pg8::bf16_t*)(ws + WS_WOUT) + (size_t)el * DM * DM;
                pg8::Gemm g{Ap, Bp, M_ALL, DM, K};
                void* xl_out = (!down && el == NLAYER - 1) ? (void*)(ws + WS_XB2) : (void*)A.out;
                pg8::EpiRes<true> E{(const void*)A.out, xl_out, ws, el * 9 * 6144 + (down ? 5120 : 2048), down ? A.in[6] + (el + 1) * DM : A.in[7] + el * DM, down ? (el + 1) * 9 * 6144 + 1024 : el * 9 * 6144 + 4096};
                pg8::gemm_phase<pg8::EpiRes<true>, pg8::Sched2, true, true>(F.lds, g, S, E, F.wave);
                if (sigw >= 0) {
                    pg8::Unit u0; if (S.next(0, u0)) {
                    asm volatile("s_waitcnt vmcnt(0)" ::: "memory"); __syncthreads();
                    if (F.wave == 0 && lane_id() == 0) { __builtin_amdgcn_fence(__ATOMIC_RELEASE, "agent"); asm volatile("s_waitcnt vmcnt(0)" ::: "memory");
                        __hip_atomic_fetch_add((unsigned*)(ws + WS_CTL) + sigw + 64 * (cid & 7), 1u, __ATOMIC_RELAXED, __HIP_MEMORY_SCOPE_AGENT); } }
                }
            } else {
                pg8::Gemm g{(const pg8::bf16_t*)(ws + WS_H), (const pg8::bf16_t*)(ws + WS_WDN) + (size_t)l * DM * FFD, M_ALL, DM, FFD};
                pg8::EpiRes<false> E{(const void*)(ws + WS_XB2), (void*)A.out, ws, l * 9 * 6144 + 5120, nullptr, 0};
                pg8::gemm_phase<pg8::EpiRes<false>, pg8::Sched2, true, true>(F.lds, g, S, E, F.wave);
            }
        }
        if (ph + 1 < hi) { XcdBarrier bar; bar.bar = (unsigned*)(args.ws + WS_CTL) + CW_BAR; bar.x = xb_xcc_id(); bar.st = MISC + 8; xcd_barrier(bar); }
    }
#if PROBE_S
    if (blockIdx.x == 0 && F0.wave == 0) { const unsigned long long t0 = __builtin_amdgcn_s_memrealtime(); const unsigned long long dl = 5ull * (MISC[40 + ((PROBE_S) & 255)] - MISC[40 + ((PROBE_S) >> 8)]);
        while (__builtin_amdgcn_s_memrealtime() - t0 < dl) __builtin_amdgcn_s_sleep(32); }
#endif
#if PROBE_A
    if (blockIdx.x == 0 && F0.wave == 0) { const unsigned long long t0 = __builtin_amdgcn_s_memrealtime(); MISC[16 + N_PHASES] = (unsigned)t0; unsigned long long dl = 0;
        for (int p = 0; p < N_PHASES; ++p) if ((PROBE_A >> p) & 1) dl += 5ull * (MISC[17 + p] - MISC[16 + p]);
        while (__builtin_amdgcn_s_memrealtime() - t0 < dl) __builtin_amdgcn_s_sleep(32); }
#endif
}
static_assert(EWS_MOD == WS_MOD && EWS_BIN == WS_BIN && EWS_BGU == WS_BGU && EWS_ROPE == WS_ROPE && EWS_SSQ == WS_SSQ && EWS_A == WS_A && EWS_XC == WS_XC && EWS_QB == WS_QB && EWS_KB == WS_KB && EWS_VB == WS_VB && EWS_TC == WS_TC && EWS_T == WS_T && EWS_H == WS_H && EWS_HC == WS_HC, "epilogue offsets vs d_ws map");
#ifndef MK_PER_PHASE
#define MK_PER_PHASE 0
#endif
extern "C" void kernel_launch(void* const* d_in, const int* in_sizes, int n_in, void* d_out, int out_size, void* d_ws, size_t ws_size, hipStream_t stream) {
    static int grid = 0;
    if (grid == 0) {
        if (n_in != 21 || in_sizes[0] != M_LAT * DM || out_size != M_LAT * DM || ws_size < WS_END) { fprintf(stderr, "kernel_launch: unexpected shapes (n_in %d, in0 %d, out %d, ws %zu)\n", n_in, n_in > 0 ? in_sizes[0] : -1, out_size, ws_size); grid = -1; return; }
        int dev = 0, cus = 0, per_cu = 0;
        if (hipGetDevice(&dev) != hipSuccess || hipDeviceGetAttribute(&cus, hipDeviceAttributeMultiprocessorCount, dev) != hipSuccess) { grid = -1; return; }
        if (hipFuncSetAttribute((const void*)fwd_kernel, hipFuncAttributeMaxDynamicSharedMemorySize, LDS_BYTES) != hipSuccess) { fprintf(stderr, "kernel_launch: hipFuncSetAttribute failed\n"); grid = -1; return; }
        if (hipOccupancyMaxActiveBlocksPerMultiprocessor(&per_cu, (const void*)fwd_kernel, NWAVES * 64, LDS_BYTES) != hipSuccess || per_cu < 1) { fprintf(stderr, "kernel_launch: occupancy query reports %d\n", per_cu); }
        (void)hipGetLastError();
        grid = cus;
    }
    if (grid < 0) return;
    (void)hipMemsetAsync((char*)d_ws + WS_CTL, 0, CTL_ZERO_BYTES, stream);
    Args a{};
    for (int i = 0; i < 21; ++i) a.in[i] = (const float*)d_in[i];
    a.out = (float*)d_out; a.ws = (unsigned char*)d_ws;
#if MK_PER_PHASE
#ifndef REP_MASK
#define REP_MASK 0
#endif
    for (int ph = 0; ph < N_PHASES; ++ph) { a.ph_lo = ph; a.ph_hi = ph + 1; for (int rep = 0; rep < (((REP_MASK) >> ph) & 1) + 1; ++rep) hipLaunchKernelGGL(fwd_kernel, dim3(grid), dim3(NWAVES * 64), LDS_BYTES, stream, a); }
#else
    a.ph_lo = 0; a.ph_hi = N_PHASES; hipLaunchKernelGGL(fwd_kernel, dim3(grid), dim3(NWAVES * 64), LDS_BYTES, stream, a);
#endif
    const hipError_t le = hipPeekAtLastError();
    if (le != hipSuccess) fprintf(stderr, "kernel_launch: launch failed: %s\n", hipGetErrorName(le));
}
```

```cpp
#define MK_PER_PHASE 0
#include <hip/hip_runtime.h>
#include <cstdio>
#include <cstdint>
#include <math.h>
constexpr size_t EWS_MOD = 64 * 1024, EWS_BIN = 512 * 1024, EWS_BGU = (1u << 20) + 768 * 1024, EWS_ROPE = EWS_BGU + 512 * 1024, EWS_SSQ = 5u << 20, EWS_A = 56u << 20, EWS_XC = 92u << 20,
                 EWS_QB = 100u << 20, EWS_KB = 118u << 20, EWS_VB = 136u << 20, EWS_TC = 186u << 20, EWS_T = 154u << 20, EWS_H = 100u << 20, EWS_HC = 226u << 20;
namespace pg8 {
#define PG8_LAS __attribute__((address_space(3)))
typedef unsigned short bf16_t;
typedef short bf16x8 __attribute__((ext_vector_type(8)));
typedef float f32x4 __attribute__((ext_vector_type(4)));
typedef unsigned u32x4 __attribute__((ext_vector_type(4)));
constexpr int BM = 256, BK = 64, HALF = 128, HTB = HALF * BK * 2  , STAGE_BYTES = 8 * HTB, NXCD = 8, WGM = 2;

__host__ __device__ __forceinline__ int lds_byte(int r, int c) { const int st = (r >> 4) * 2 + (c >> 5), rr = r & 15, cc = c & 31, ob = rr * 64 + cc * 2; return st * 1024 + (ob ^ (((ob >> 9) & 1) << 5)); }
__host__ __device__ __forceinline__ void stage_rc(int b, int& R, int& C) { const int st = b / 1024, sb = b % 1024, swz = sb ^ (((sb >> 9) & 1) << 5); R = (st >> 1) * 16 + swz / 64; C = (st & 1) * 32 + (swz % 64) / 2; }
__host__ __device__ __forceinline__ int perm32(int rho) { const int n = rho >> 4, i = rho & 15; return 8 * (i >> 2) + 4 * n + (i & 3); }

struct Unit { int pm, pn; };
struct Gemm { const bf16_t* A; const bf16_t* Bt; int M, N, K; };

struct StaticOrder {
    int nM, nN, nwg, G, c;
    __host__ __device__ void init(int M, int N, int G_, int c_) { nM = M / BM; nN = N / BM; nwg = nM * nN; G = G_; c = c_; }
    __host__ __device__ bool next(int i, Unit& u) const {
        const long L = (long)i * G + c; if (L >= nwg) return false;
        int wgid = (int)L; { const int q = nwg / NXCD, r = nwg % NXCD, xcd = wgid % NXCD, off = wgid / NXCD; wgid = (xcd < r ? xcd * (q + 1) : r * (q + 1) + (xcd - r) * q) + off; }
        const int nig = WGM * nN, gid = wgid / nig, fm = gid * WGM, gsz = (nM - fm) < WGM ? (nM - fm) : WGM;
        u.pm = fm + ((wgid % nig) % gsz); u.pn = (wgid % nig) / gsz; return true;
    }
    __device__ __forceinline__ void a_ready(const Unit&) const {}
    __device__ __forceinline__ void done(const Unit&) const {}
};

struct Sched2 {
    int nMa, nNa, nA, pmB, nMb, pnB, nNb, nB, G, c, ns = 0, is = 0, wgm = WGM;
    __device__ void init(int nMa_, int nNa_, int pmB_, int nMb_, int pnB_, int nNb_, int G_, int c_, int rot) { nMa = nMa_; nNa = nNa_; nA = nMa * nNa; pmB = pmB_; nMb = nMb_; pnB = pnB_; nNb = nNb_; nB = nMb * nNb; G = G_; c = (c_ + rot) % G_; }
    __device__ bool next(int i, Unit& u) const {
        long L;
        if (ns == 0 || i < is) { if (ns != 0 && i >= is && c < ns) return false; L = (long)i * G + c; }
        else { if (c < ns) return false; L = (long)is * G + (long)(i - is) * (G - ns) + (c - ns); }
        if (L >= nA + nB) return false;
        if (L < nA) {
            int wgid = (int)L; { const int q = nA / NXCD, r = nA % NXCD, xcd = wgid % NXCD, off = wgid / NXCD; wgid = (xcd < r ? xcd * (q + 1) : r * (q + 1) + (xcd - r) * q) + off; }
            const int nig = wgm * nNa, gid = wgid / nig, fm = gid * wgm, gsz = (nMa - fm) < wgm ? (nMa - fm) : wgm;
            u.pm = fm + ((wgid % nig) % gsz); u.pn = (wgid % nig) / gsz;
        } else { const int r = (int)L - nA; u.pm = pmB + r % nMb; u.pn = pnB + r / nMb; }
        return true;
    }
    __device__ __forceinline__ void a_ready(const Unit&) const {}
    __device__ __forceinline__ void done(const Unit&) const {}
};
__device__ __forceinline__ unsigned cvt_pk_bf16(float lo, float hi) { unsigned r; asm volatile("v_cvt_pk_bf16_f32 %0, %1, %2" : "=v"(r) : "v"(lo), "v"(hi)); return r; }
typedef unsigned u32x2 __attribute__((ext_vector_type(2)));
__device__ __forceinline__ u32x2 pk4(f32x4 v) { u32x2 w; w.x = cvt_pk_bf16(v[0], v[1]); w.y = cvt_pk_bf16(v[2], v[3]); return w; }
#ifndef WT_STORES
#define WT_STORES 0
#endif
__device__ __forceinline__ void st8(void* p, u32x2 v) {
#if WT_STORES
    __hip_atomic_store((unsigned long long*)p, ((unsigned long long)v.y << 32) | v.x, __ATOMIC_RELAXED, __HIP_MEMORY_SCOPE_AGENT);
#else
    *(u32x2*)p = v;
#endif
}
__device__ __forceinline__ float rowsum4(float s) {
    { const unsigned u = __builtin_bit_cast(unsigned, s); auto a = __builtin_amdgcn_permlane16_swap(u, u, false, false); const unsigned a0 = a[0], a1 = a[1]; s = __builtin_bit_cast(float, a0) + __builtin_bit_cast(float, a1); }
    { const unsigned u = __builtin_bit_cast(unsigned, s); auto b = __builtin_amdgcn_permlane32_swap(u, u, false, false); const unsigned b0 = b[0], b1 = b[1]; s = __builtin_bit_cast(float, b0) + __builtin_bit_cast(float, b1); }
    return s;
}
__device__ __forceinline__ float dot4(f32x4 v) { return (v[0] * v[0] + v[1] * v[1]) + (v[2] * v[2] + v[3] * v[3]); }
constexpr int BT_F = (140288 - 131072) / 4, ET_F = (147456 - 131072) / 4;
constexpr int M_LAT_TILES = 64;
constexpr float QSCALE = 0.125f * 1.4426950408889634f;
constexpr float ZS_LAT = 1.0f / 512.0f;
constexpr float ZS_CTX = 0.005524271728019903f;

struct EpiIn {
    static constexpr bool PERM = false, AFTER_DRAIN = false;
    unsigned char* ws; const PG8_LAS float* rtab;
    __device__ __forceinline__ void operator()(const f32x4 (&acc)[2][2][4][2], const Unit& u, int ui, int wr, int wc, int fr, int fq) const {
        const int pm = u.pm, pn = u.pn; const bool lat = pm < M_LAT_TILES; const int bm = lat ? (pm >> 3) : 8;
        const PG8_LAS float* rope = rtab + ET_F;
        bf16_t* QB = (bf16_t*)(ws + EWS_QB); bf16_t* KB = (bf16_t*)(ws + EWS_KB); bf16_t* VB = (bf16_t*)(ws + EWS_VB); bf16_t* T = (bf16_t*)(ws + EWS_T); bf16_t* Tc = (bf16_t*)(ws + EWS_TC);
        const PG8_LAS float* bp = rtab + BT_F + ui * 256 + wc * 32 + fq * 4;
        f32x4 bv[2][2];
#pragma unroll
        for (int bj = 0; bj < 2; ++bj)
#pragma unroll
            for (int n = 0; n < 2; ++n) bv[bj][n] = *(const PG8_LAS f32x4*)(bp + bj * 128 + n * 16);
        const PG8_LAS float* rt = rtab + ui * 256 + wr * 64 + fr;
        if (pn < 4) {
            const PG8_LAS float* gp = rope + 3072 + (pn < 2 ? 0 : 64) + fq * 4; const float qs = pn < 2 ? QSCALE : 1.f;
            f32x4 gv[2][2];
#pragma unroll
            for (int bj = 0; bj < 2; ++bj)
#pragma unroll
                for (int n = 0; n < 2; ++n) gv[bj][n] = *(const PG8_LAS f32x4*)(gp + bj * 32 + n * 16) * qs;
            bf16_t* dst = (pn < 2 ? QB : KB) + (pn & 1) * 256 + wc * 64 + fq * 4;
#pragma unroll
            for (int ai = 0; ai < 2; ++ai)
#pragma unroll
                for (int m = 0; m < 4; ++m) {
                    const int rl = ai * 128 + wr * 64 + m * 16 + fr, row = pm * 256 + rl; const float r = rt[ai * 128 + m * 16];
                    f32x4 v[2][2]; float ssq = 0.f;
#pragma unroll
                    for (int bj = 0; bj < 2; ++bj)
#pragma unroll
                        for (int n = 0; n < 2; ++n) { v[bj][n] = acc[ai][bj][m][n] * r + bv[bj][n]; ssq += dot4(v[bj][n]); }
                    ssq = rowsum4(ssq);
                    const float rn = __builtin_amdgcn_rsqf(ssq * (1.0f / 64.0f) + 1e-6f);
#pragma unroll
                    for (int bj = 0; bj < 2; ++bj)
#pragma unroll
                        for (int n = 0; n < 2; ++n) v[bj][n] = v[bj][n] * rn * gv[bj][n];
                    if (lat) { const int pos = row & 2047;
#pragma unroll
                        for (int bj = 0; bj < 2; ++bj) { const PG8_LAS float* cp = rope + (bj == 0 ? (pos >> 6) : 32 + (pos & 63)) * 16 + fq * 4; const f32x4 c4 = *(const PG8_LAS f32x4*)cp, s4 = *(const PG8_LAS f32x4*)(cp + 1536); const f32x4 t1 = v[bj][0], t2 = v[bj][1];
                            v[bj][0] = t1 * c4 - t2 * s4; v[bj][1] = t2 * c4 + t1 * s4; } }
#pragma unroll
                    for (int bj = 0; bj < 2; ++bj)
#pragma unroll
                        for (int n = 0; n < 2; ++n) *(u32x2*)(dst + (size_t)row * 512 + bj * 32 + n * 16) = pk4(v[bj][n]);
                }
        } else if (pn < 6) {
            bf16_t* dst = VB + (pn - 4) * 256 + wc * 32 + fq * 4;
#pragma unroll
            for (int ai = 0; ai < 2; ++ai)
#pragma unroll
                for (int m = 0; m < 4; ++m) {
                    const int rl = ai * 128 + wr * 64 + m * 16 + fr, row = pm * 256 + rl; const float r = rt[ai * 128 + m * 16];
#pragma unroll
                    for (int bj = 0; bj < 2; ++bj)
#pragma unroll
                        for (int n = 0; n < 2; ++n) *(u32x2*)(dst + (size_t)row * 512 + bj * 128 + n * 16) = pk4(acc[ai][bj][m][n] * r + bv[bj][n]);
                }
        } else {
            const int g = pn - 6; const float zs = lat ? ZS_LAT : ZS_CTX;
            const int b = lat ? (pm >> 3) : (pm - M_LAT_TILES);
            bf16_t* tb = (lat ? T + (size_t)((b * 8 + (pm & 7)) * 512) * 512 : Tc + (size_t)(b * 512) * 512) + (size_t)(g * 128 + wc * 32 + fq * 4) * 512;
#pragma unroll
            for (int ai = 0; ai < 2; ++ai)
#pragma unroll
                for (int m = 0; m < 4; ++m) {
                    const int rl = ai * 128 + wr * 64 + m * 16 + fr; const float r = rt[ai * 128 + m * 16];
#pragma unroll
                    for (int n = 0; n < 2; ++n) { const f32x4 re = (acc[ai][0][m][n] * r + bv[0][n]) * zs, im = (acc[ai][1][m][n] * r + bv[1][n]) * zs;
#pragma unroll
                        for (int i = 0; i < 4; ++i) *(unsigned*)(tb + (size_t)(n * 16 + i) * 512 + rl * 2) = cvt_pk_bf16(re[i], im[i]); }
                }
        }
    }
};
typedef _Float16 h16x2 __attribute__((ext_vector_type(2)));
__device__ __forceinline__ unsigned pkh2(float a, float b) { const h16x2 h = {(_Float16)a, (_Float16)b}; return __builtin_bit_cast(unsigned, h); }
__device__ __forceinline__ u32x2 pkh4(f32x4 v) { u32x2 w; w.x = pkh2(v[0], v[1]); w.y = pkh2(v[2], v[3]); return w; }
__device__ __forceinline__ f32x4 unh4(u32x2 w) { const unsigned lo = w.x, hi = w.y; const h16x2 a = __builtin_bit_cast(h16x2, lo), b = __builtin_bit_cast(h16x2, hi);     return (f32x4){(float)a[0], (float)a[1], (float)b[0], (float)b[1]}; }
template <bool NEXT> struct EpiRes {
    static constexpr bool PERM = false, AFTER_DRAIN = false;
    const void* xl_in; void* xl_out;
    unsigned char* ws; int gate_off;
    const float* ng; int nsc_off;
    __device__ __forceinline__ void operator()(const f32x4 (&acc)[2][2][4][2], const Unit& u, int ui, int wr, int wc, int fr, int fq) const {
        const int pm = u.pm, pn = u.pn; const bool lat = pm < M_LAT_TILES; const int bm = lat ? (pm >> 3) : 8; const int col0 = pn * 256 + wc * 32 + fq * 4;
        const float* gate = (const float*)(ws + EWS_MOD) + gate_off; const float* nsc = (const float*)(ws + EWS_MOD) + nsc_off; bf16_t* A = (bf16_t*)(ws + EWS_A); float* ssq = (float*)(ws + EWS_SSQ);
        const _Float16* xin = lat ? (const _Float16*)xl_in + (size_t)pm * 256 * 1024 : (const _Float16*)(ws + EWS_XC) + (size_t)(pm - M_LAT_TILES) * 256 * 1024;
        _Float16* xout = lat ? (_Float16*)xl_out + (size_t)pm * 256 * 1024 : (_Float16*)(ws + EWS_XC) + (size_t)(pm - M_LAT_TILES) * 256 * 1024;
        float* xoutf = (float*)xl_out + (size_t)pm * 256 * 1024;
        float ssq_[2][4];
#pragma unroll
        for (int ai = 0; ai < 2; ++ai)
#pragma unroll
            for (int m = 0; m < 4; ++m) ssq_[ai][m] = 0.f;
        f32x4 ga[2][2], gv[2][2]; u32x2 preA[4][2], preB[4][2];
        auto loadx = [&](int g, u32x2 (&p)[4][2]) __attribute__((always_inline)) { const int bj = g >> 1, ai = g & 1;
#pragma unroll
            for (int m = 0; m < 4; ++m)
#pragma unroll
                for (int n = 0; n < 2; ++n) p[m][n] = *(const u32x2*)(xin + (size_t)(ai * 128 + wr * 64 + m * 16 + fr) * 1024 + col0 + bj * 128 + n * 16); };
        auto loadg = [&](int bj) __attribute__((always_inline)) {
#pragma unroll
            for (int n = 0; n < 2; ++n) { const int c = col0 + bj * 128 + n * 16; ga[bj][n] = *(const f32x4*)(gate + bm * 6144 + c);
                if (NEXT) gv[bj][n] = *(const f32x4*)(ng + c) * (*(const f32x4*)(nsc + bm * 6144 + c) + 1.0f); } };
        auto proc = [&](int g, const u32x2 (&p)[4][2]) __attribute__((always_inline)) { const int bj = g >> 1, ai = g & 1;
#pragma unroll
            for (int m = 0; m < 4; ++m) {
                const int rl = ai * 128 + wr * 64 + m * 16 + fr; const size_t row = (size_t)pm * 256 + rl;
#pragma unroll
                for (int n = 0; n < 2; ++n) { const size_t off = (size_t)rl * 1024 + col0 + bj * 128 + n * 16; const f32x4 xn = unh4(p[m][n]) + ga[bj][n] * acc[ai][bj][m][n];
                    if (NEXT) *(u32x2*)(xout + off) = pkh4(xn); else *(f32x4*)(xoutf + off) = xn;
                    if (NEXT) { ssq_[ai][m] += dot4(xn); *(u32x2*)(A + row * 1024 + col0 + bj * 128 + n * 16) = pk4(xn * gv[bj][n]); } }
            }
            asm volatile("" ::: "memory"); };
        loadx(0, preA); loadg(0); loadx(1, preB); asm volatile("" ::: "memory");
        proc(0, preA); loadg(1); loadx(2, preA); asm volatile("" ::: "memory");
        proc(1, preB); loadx(3, preB); asm volatile("" ::: "memory");
        proc(2, preA); proc(3, preB);
        if (NEXT) {
#pragma unroll
            for (int ai = 0; ai < 2; ++ai)
#pragma unroll
                for (int m = 0; m < 4; ++m) { const float s = rowsum4(ssq_[ai][m]); if (fq == 0) ssq[((size_t)pm * 256 + ai * 128 + wr * 64 + m * 16 + fr) * 16 + pn * 4 + wc] = s; }
        }
    }
};
struct EpiGU {
    static constexpr bool PERM = false, AFTER_DRAIN = false;
    unsigned char* ws; const PG8_LAS float* rtab;
    __device__ __forceinline__ void operator()(const f32x4 (&acc)[2][2][4][2], const Unit& u, int ui, int wr, int wc, int fr, int fq) const {
        const int pm = u.pm, pn = u.pn; const int bm = pm < M_LAT_TILES ? (pm >> 3) : 8;
        bf16_t* H = (bf16_t*)(ws + EWS_H);
        const PG8_LAS float* bp = rtab + BT_F + ui * 256 + wc * 32 + fq * 4;
        f32x4 bg[2], bu[2];
#pragma unroll
        for (int n = 0; n < 2; ++n) { bg[n] = *(const PG8_LAS f32x4*)(bp + n * 16); bu[n] = *(const PG8_LAS f32x4*)(bp + 128 + n * 16); }
        const PG8_LAS float* rt = rtab + ui * 256 + wr * 64 + fr;
        if (pm >= M_LAT_TILES) H = (bf16_t*)(ws + EWS_HC) - (size_t)16384 * 2816;
        bf16_t* dst = H + pn * 128 + wc * 32 + fq * 4;
#pragma unroll
        for (int ai = 0; ai < 2; ++ai)
#pragma unroll
            for (int m = 0; m < 4; ++m) {
                const int rl = ai * 128 + wr * 64 + m * 16 + fr; const size_t row = (size_t)pm * 256 + rl; const float r = rt[ai * 128 + m * 16];
#pragma unroll
                for (int n = 0; n < 2; ++n) { const f32x4 gg = acc[ai][0][m][n] * r + bg[n], uu = acc[ai][1][m][n] * r + bu[n]; f32x4 h;
#pragma unroll
                    for (int i = 0; i < 4; ++i) h[i] = gg[i] * __builtin_amdgcn_rcpf(1.0f + __builtin_amdgcn_exp2f(-1.4426950408889634f * gg[i])) * uu[i];
                    st8(dst + row * 2816 + n * 16, pk4(h)); }
            }
    }
};
struct EpiDft {
    static constexpr bool PERM = true, AFTER_DRAIN = false;
    bf16_t* MIX;
    __device__ __forceinline__ void operator()(const f32x4 (&acc)[2][2][4][2], const Unit& u, int ui, int wr, int wc, int fr, int fq) const {
        const int pn = u.pn;
#pragma unroll
        for (int bj = 0; bj < 2; ++bj) {
            const int c = pn * 256 + bj * 128 + wc * 32 + fq * 8; int rowbase, rstride, ch;
            if (pn < 128) { const int b = c >> 12, r = (c >> 9) & 7; ch = c & 511; rowbase = b * 2048 + r; rstride = 8; }
            else { const int c2 = c - 32768; const int b = c2 >> 9; ch = c2 & 511; rowbase = 16384 + b * 256; rstride = 1; }
#pragma unroll
            for (int ai = 0; ai < 2; ++ai)
#pragma unroll
                for (int m = 0; m < 4; ++m) { const int mm = ai * 128 + wr * 64 + m * 16 + fr; const size_t row = (size_t)rowbase + (size_t)mm * rstride;
                    const f32x4 v0 = acc[ai][bj][m][0], v1 = acc[ai][bj][m][1]; u32x4 w; w.x = cvt_pk_bf16(v0[0], v0[1]); w.y = cvt_pk_bf16(v0[2], v0[3]); w.z = cvt_pk_bf16(v1[0], v1[1]); w.w = cvt_pk_bf16(v1[2], v1[3]);
                    *(u32x4*)(MIX + row * 1024 + 512 + ch) = w; }
        }
    }
};
template <class Epi, class Sched, bool ALIGN_EPI = false, bool SP2 = false>
__device__ __forceinline__ void gemm_phase(PG8_LAS unsigned char* lds, const Gemm g, const Sched& S, const Epi& E, int wave_) {
    unsigned z_ = 0u; asm volatile("" : "+v"(z_)); int tid_ = wave_ * 64 + (int)__builtin_amdgcn_mbcnt_hi(~0u, __builtin_amdgcn_mbcnt_lo(~0u, z_)); asm volatile("" : "+v"(tid_));
    const int tid = tid_, wid = __builtin_amdgcn_readfirstlane(tid >> 6), lane = tid & 63, wr = wid >> 2, wc = wid & 3, fr = lane & 15, fq = lane >> 4;
    const int K = g.K, nt = K / BK;
    unsigned voffA[2], voffB[2];
#pragma unroll
    for (int i = 0; i < 2; ++i) { int R, C; stage_rc(tid * 16 + i * 8192, R, C); const int Rb = Epi::PERM ? ((R & ~31) + perm32(R & 31)) : R;
        voffA[i] = (unsigned)(R * K + C) * 2u; voffB[i] = (unsigned)(Rb * K + C) * 2u; }
    const size_t kstep = (size_t)(BK * 2);
    const size_t hstep = (size_t)HALF * K * 2;
    const size_t tstep = 2 * hstep;
    const unsigned ldsw = (unsigned)wid * 1024u;
    const int aoff = lds_byte(wr * 64 + fr, fq * 8), boff = lds_byte(wc * 32 + fr, fq * 8);
#define PG8_SA(b, h) (((b) * 2 + (h)) * HTB)
#define PG8_SB(b, h) ((4 + (b) * 2 + (h)) * HTB)
#define PG8_STAGE(bufoff, gbase, voff) do { _Pragma("unroll") for (int _i = 0; _i < 2; ++_i) \
        __builtin_amdgcn_global_load_lds((const unsigned*)((const char*)(gbase) + (voff)[_i]), (PG8_LAS unsigned*)(lds + (bufoff) + ldsw + _i * 8192), 16, 0, 0); } while (0)
#define PG8_LDA(dst, b, h) do { _Pragma("unroll") for (int m = 0; m < 4; ++m) _Pragma("unroll") for (int k = 0; k < 2; ++k) dst[m][k] = *(const PG8_LAS bf16x8*)(lds + PG8_SA(b, h) + aoff + m * 2048 + k * 1024); } while (0)
#define PG8_LDB(dst, b, h) do { _Pragma("unroll") for (int n = 0; n < 2; ++n) _Pragma("unroll") for (int k = 0; k < 2; ++k) dst[n][k] = *(const PG8_LAS bf16x8*)(lds + PG8_SB(b, h) + boff + n * 2048 + k * 1024); } while (0)
#define PG8_MMA(ai, bj, At, Bt) do { __builtin_amdgcn_s_setprio(1); _Pragma("unroll") for (int m = 0; m < 4; ++m) _Pragma("unroll") for (int n = 0; n < 2; ++n) _Pragma("unroll") for (int k = 0; k < 2; ++k) \
        acc[ai][bj][m][n] = __builtin_amdgcn_mfma_f32_16x16x32_bf16(Bt[n][k], At[m][k], acc[ai][bj][m][n], 0, 0, 0); __builtin_amdgcn_s_setprio(0); } while (0)
#define PG8_WAIT_V(n) asm volatile("s_waitcnt vmcnt(" #n ")" ::: "memory")
#define PG8_WAIT_L(n) asm volatile("s_waitcnt lgkmcnt(" #n ")" ::: "memory")
#define PG8_BAR __builtin_amdgcn_s_barrier()
#define PG8_SCHED __builtin_amdgcn_sched_barrier(0)
    Unit cur, nxt; int ui = 0;
    if (!S.next(0, cur)) return;
    f32x4 acc[2][2][4][2];
#pragma unroll
    for (int a = 0; a < 2; ++a)
#pragma unroll
        for (int b = 0; b < 2; ++b)
#pragma unroll
            for (int m = 0; m < 4; ++m)
#pragma unroll
                for (int n = 0; n < 2; ++n) acc[a][b][m][n] = (f32x4){0.f, 0.f, 0.f, 0.f};
    bf16x8 At[4][2], B0[2][2], B1[2][2];
    const char* cA = (const char*)g.A + (size_t)cur.pm * tstep; const char* cB = (const char*)g.Bt + (size_t)cur.pn * tstep;
    S.a_ready(cur);
    if constexpr (SP2) {
        PG8_STAGE(PG8_SB(0, 0), cB, voffB); PG8_STAGE(PG8_SB(0, 1), cB + hstep, voffB); PG8_STAGE(PG8_SA(0, 0), cA, voffA); PG8_STAGE(PG8_SA(0, 1), cA + hstep, voffA);
        if (wr == 1) PG8_BAR;
        PG8_WAIT_V(2); PG8_BAR;
        PG8_STAGE(PG8_SB(1, 0), cB + kstep, voffB); PG8_STAGE(PG8_SA(1, 0), cA + kstep, voffA); PG8_STAGE(PG8_SB(1, 1), cB + hstep + kstep, voffB);
        PG8_WAIT_V(6); PG8_BAR;
    } else {
        PG8_STAGE(PG8_SB(0, 0), cB, voffB); PG8_STAGE(PG8_SA(0, 0), cA, voffA); PG8_STAGE(PG8_SB(0, 1), cB + hstep, voffB); PG8_STAGE(PG8_SA(0, 1), cA + hstep, voffA);
        if (wr == 1) PG8_BAR;
        PG8_WAIT_V(4); PG8_BAR;
        PG8_STAGE(PG8_SB(1, 0), cB + kstep, voffB); PG8_STAGE(PG8_SA(1, 0), cA + kstep, voffA); PG8_STAGE(PG8_SB(1, 1), cB + hstep + kstep, voffB);
        PG8_WAIT_V(6); PG8_BAR;
    }
    for (;;) {
        const bool has_next = S.next(ui + 1, nxt);
        const char* nA = has_next ? (const char*)g.A + (size_t)nxt.pm * tstep : cA; const char* nB = has_next ? (const char*)g.Bt + (size_t)nxt.pn * tstep : cB;
        for (int t = 0; t < nt; t += 2) {
            const bool last = (t == nt - 2);
            const char* a1 = cA + (size_t)(t + 1) * kstep;
            const char* a2 = last ? nA : cA + (size_t)(t + 2) * kstep; const char* b2 = last ? nB : cB + (size_t)(t + 2) * kstep;
            const char* a3 = a2 + kstep; const char* b3 = b2 + kstep;
            if (last && has_next) S.a_ready(nxt);
            if constexpr (SP2) {
            PG8_LDB(B0, 0, 0); PG8_LDB(B1, 0, 1); PG8_SCHED; PG8_LDA(At, 0, 0); PG8_STAGE(PG8_SA(1, 1), a1 + hstep, voffA);
            PG8_WAIT_V(8); PG8_WAIT_L(0); PG8_BAR; PG8_MMA(0, 0, At, B0); PG8_MMA(0, 1, At, B1); PG8_BAR; PG8_SCHED;
            PG8_LDA(At, 0, 1); PG8_STAGE(PG8_SB(0, 0), b2, voffB); PG8_STAGE(PG8_SB(0, 1), b2 + hstep, voffB); PG8_STAGE(PG8_SA(0, 0), a2, voffA);
            PG8_WAIT_V(8); PG8_WAIT_L(0); PG8_BAR; PG8_MMA(1, 0, At, B0); PG8_MMA(1, 1, At, B1); PG8_BAR; PG8_SCHED;
            PG8_LDB(B0, 1, 0); PG8_LDB(B1, 1, 1); PG8_SCHED; PG8_LDA(At, 1, 0); PG8_STAGE(PG8_SA(0, 1), a2 + hstep, voffA);
            PG8_WAIT_V(8); PG8_WAIT_L(0); PG8_BAR; PG8_MMA(0, 0, At, B0); PG8_MMA(0, 1, At, B1); PG8_BAR; PG8_SCHED;
            PG8_LDA(At, 1, 1); PG8_STAGE(PG8_SB(1, 0), b3, voffB); PG8_STAGE(PG8_SB(1, 1), b3 + hstep, voffB); PG8_STAGE(PG8_SA(1, 0), a3, voffA);
            PG8_WAIT_V(8); PG8_WAIT_L(0); PG8_BAR; PG8_MMA(1, 0, At, B0); PG8_MMA(1, 1, At, B1); PG8_BAR; PG8_SCHED;
            } else {
            PG8_LDB(B0, 0, 0); PG8_SCHED; PG8_LDA(At, 0, 0); PG8_STAGE(PG8_SA(1, 1), a1 + hstep, voffA);
            PG8_WAIT_L(8); PG8_BAR; PG8_WAIT_L(0); PG8_MMA(0, 0, At, B0); PG8_BAR; PG8_SCHED;
            PG8_LDB(B1, 0, 1); PG8_STAGE(PG8_SB(0, 0), b2, voffB);
            PG8_BAR; PG8_WAIT_L(0); PG8_MMA(0, 1, At, B1); PG8_BAR;
            PG8_LDA(At, 0, 1); PG8_STAGE(PG8_SA(0, 0), a2, voffA);
            PG8_BAR; PG8_WAIT_L(0); PG8_MMA(1, 0, At, B0); PG8_BAR; PG8_SCHED;
            PG8_STAGE(PG8_SB(0, 1), b2 + hstep, voffB);
            PG8_WAIT_V(6); PG8_BAR; PG8_MMA(1, 1, At, B1); PG8_BAR;
            PG8_LDB(B0, 1, 0); PG8_SCHED; PG8_LDA(At, 1, 0); PG8_STAGE(PG8_SA(0, 1), a2 + hstep, voffA);
            PG8_WAIT_L(8); PG8_BAR; PG8_WAIT_L(0); PG8_MMA(0, 0, At, B0); PG8_BAR; PG8_SCHED;
            PG8_LDB(B1, 1, 1); PG8_STAGE(PG8_SB(1, 0), b3, voffB);
            PG8_BAR; PG8_WAIT_L(0); PG8_MMA(0, 1, At, B1); PG8_BAR;
            PG8_LDA(At, 1, 1); PG8_STAGE(PG8_SA(1, 0), a3, voffA);
            PG8_BAR; PG8_WAIT_L(0); PG8_MMA(1, 0, At, B0); PG8_BAR; PG8_SCHED;
            PG8_STAGE(PG8_SB(1, 1), b3 + hstep, voffB);
            PG8_WAIT_V(6); PG8_BAR; PG8_MMA(1, 1, At, B1); PG8_BAR;
            }
        }
        if constexpr (ALIGN_EPI) { if (wr == 0) PG8_BAR; }
        if constexpr (!Epi::AFTER_DRAIN) { int fr_ = fr, fq_ = fq; asm volatile("" : "+v"(fr_), "+v"(fq_)); E(acc, cur, ui, wr, wc, fr_, fq_); S.done(cur); }
        if (!has_next) break;
#pragma unroll
        for (int a = 0; a < 2; ++a)
#pragma unroll
            for (int b = 0; b < 2; ++b)
#pragma unroll
                for (int m = 0; m < 4; ++m)
#pragma unroll
                    for (int n = 0; n < 2; ++n) acc[a][b][m][n] = (f32x4){0.f, 0.f, 0.f, 0.f};
        cur = nxt; cA = nA; cB = nB; ++ui;
        if constexpr (ALIGN_EPI) { if (wr == 1) PG8_BAR; }
    }
    PG8_WAIT_V(0);
    if constexpr (!ALIGN_EPI) { if (wr == 0) PG8_BAR; }
    PG8_BAR;
    if constexpr (Epi::AFTER_DRAIN) { E.fused(acc, cur, wr, wc, fr, fq, lds, wid, lane); S.done(cur); }
#undef PG8_SA
#undef PG8_SB
#undef PG8_STAGE
#undef PG8_LDA
#undef PG8_LDB
#undef PG8_MMA
#undef PG8_WAIT_V
#undef PG8_WAIT_L
#undef PG8_BAR
#undef PG8_SCHED
}
}
#ifndef EN_ATTEPI
#define EN_ATTEPI 1
#endif
namespace att {
typedef unsigned short bf16;
using bf16x8 = __attribute__((ext_vector_type(8))) short;
using s16x4  = __attribute__((ext_vector_type(4))) short;
using f32x16 = __attribute__((ext_vector_type(16))) float;
using u32x4  = __attribute__((ext_vector_type(4))) unsigned;
constexpr int KVBLK = 64;
constexpr int NBUF = 3;
constexpr size_t SHM_V = KVBLK * 128 * 2, SHM_K = KVBLK * 128 * 2, SHM_ATTN = NBUF * SHM_V + NBUF * SHM_K + 8 * 64 * 4;
#define KSWZ(row, colB) ((row) * 256 + ((colB) ^ (((row) & 7) << 4)))
#define SBAR() __builtin_amdgcn_sched_barrier(0)
__device__ __forceinline__ int crow(int r, int hi) { return (r & 3) + 8 * (r >> 2) + 4 * hi; }
__device__ __forceinline__ unsigned cvtpk(float lo, float hi) { unsigned r; asm volatile("v_cvt_pk_bf16_f32 %0, %1, %2" : "=v"(r) : "v"(lo), "v"(hi)); return r; }
__device__ __forceinline__ bf16x8 ld8(const bf16* p) { return *reinterpret_cast<const bf16x8*>(p); }
__device__ __forceinline__ void sm_first(f32x16& p0, f32x16& p1, float negoff) {
  (void)p1; (void)negoff;
#pragma unroll
  for (int r = 0; r < 16; ++r) p0[r] = __builtin_amdgcn_exp2f(p0[r]);
}
__device__ __forceinline__ void sm_finish(f32x16& p0, f32x16& p1, float& l_reg, bf16x8& pa0, bf16x8& pa1, bf16x8& pa2, bf16x8& pa3) {
#pragma unroll
  for (int r = 0; r < 16; ++r) p1[r] = __builtin_amdgcn_exp2f(p1[r]);
  float ps = 0;
#pragma unroll
  for (int r = 0; r < 16; ++r) ps += p0[r];
#pragma unroll
  for (int r = 0; r < 16; ++r) ps += p1[r];
  l_reg += ps;
#define PK4(P, BASE, OUT) do { unsigned a0 = cvtpk(P[BASE + 0], P[BASE + 1]), a1 = cvtpk(P[BASE + 2], P[BASE + 3]);   \
    unsigned b0 = cvtpk(P[BASE + 4], P[BASE + 5]), b1 = cvtpk(P[BASE + 6], P[BASE + 7]);                              \
    auto r0 = __builtin_amdgcn_permlane32_swap(a0, b0, false, false); auto r1 = __builtin_amdgcn_permlane32_swap(a1, b1, false, false); \
    u32x4 w = {r0[0], r1[0], r0[1], r1[1]}; OUT = *reinterpret_cast<bf16x8*>(&w); } while (0)
  PK4(p0, 0, pa0); PK4(p0, 8, pa1); PK4(p1, 0, pa2); PK4(p1, 8, pa3);
#undef PK4
}
__device__ __forceinline__ void qkt(f32x16& p0, f32x16& p1, const bf16* Ks, const bf16x8* qr, int r32, int hi, int mapoff, float negoff) {
  p0 = f32x16{}; p1 = f32x16{}; (void)negoff;
#pragma unroll
  for (int d0 = 0; d0 < 4; ++d0) { const int cb = (mapoff + d0 * 16 + hi * 8) * 2;
    bf16x8 b0 = *reinterpret_cast<const bf16x8*>((const char*)Ks + KSWZ(r32, cb));
    bf16x8 b1 = *reinterpret_cast<const bf16x8*>((const char*)Ks + KSWZ(32 + r32, cb));
    p0 = __builtin_amdgcn_mfma_f32_32x32x16_bf16(b0, qr[d0], p0, 0, 0, 0);
    p1 = __builtin_amdgcn_mfma_f32_32x32x16_bf16(b1, qr[d0], p1, 0, 0, 0); }
}
__device__ __forceinline__ int v_st(int k, int c) { const int kk = (k & ~0xC) | ((k & 4) << 1) | ((k & 8) >> 1); return ((kk >> 3) * 4 + (c >> 5)) * 512 + ((kk & 7) * 32 + (c & 31)) * 2; }
__device__ __forceinline__ int v_rd_base(int lane) { return ((lane & 3) << 3) | (((lane >> 2) & 3) << 6) | (((lane >> 4) & 1) << 5) | (((lane >> 5) & 1) << 8); }
constexpr int v_rd_off(int d0, int ks, int half) { return d0 * 512 + ks * 4096 + half * 2048; }
typedef short v4i16_t __attribute__((ext_vector_type(4)));
template <int OFF> __device__ __forceinline__ s16x4 tr_read(int vb) {
  return __builtin_bit_cast(s16x4, __builtin_amdgcn_ds_read_tr16_b64_v4i16((__attribute__((address_space(3))) v4i16_t*)(uintptr_t)(unsigned)(vb + OFF)));
}
template <int D0> __device__ __forceinline__ void pv_one(f32x16& od, int vb, bf16x8 pa0, bf16x8 pa1, bf16x8 pa2, bf16x8 pa3) {
  const s16x4 l0 = tr_read<v_rd_off(D0, 0, 0)>(vb), h0 = tr_read<v_rd_off(D0, 0, 1)>(vb), l1 = tr_read<v_rd_off(D0, 1, 0)>(vb), h1 = tr_read<v_rd_off(D0, 1, 1)>(vb);
  const s16x4 l2 = tr_read<v_rd_off(D0, 2, 0)>(vb), h2 = tr_read<v_rd_off(D0, 2, 1)>(vb), l3 = tr_read<v_rd_off(D0, 3, 0)>(vb), h3 = tr_read<v_rd_off(D0, 3, 1)>(vb);
#define PK(L, H) (bf16x8){L[0], L[1], L[2], L[3], H[0], H[1], H[2], H[3]}
  od = __builtin_amdgcn_mfma_f32_32x32x16_bf16(pa0, PK(l0, h0), od, 0, 0, 0);
  od = __builtin_amdgcn_mfma_f32_32x32x16_bf16(pa1, PK(l1, h1), od, 0, 0, 0);
  od = __builtin_amdgcn_mfma_f32_32x32x16_bf16(pa2, PK(l2, h2), od, 0, 0, 0);
  od = __builtin_amdgcn_mfma_f32_32x32x16_bf16(pa3, PK(l3, h3), od, 0, 0, 0);
#undef PK
}
__device__ __forceinline__ void pv_d0(f32x16* o, int vb, bf16x8 pa0, bf16x8 pa1, bf16x8 pa2, bf16x8 pa3) {
  pv_one<0>(o[0], vb, pa0, pa1, pa2, pa3); pv_one<1>(o[1], vb, pa0, pa1, pa2, pa3); pv_one<2>(o[2], vb, pa0, pa1, pa2, pa3); pv_one<3>(o[3], vb, pa0, pa1, pa2, pa3);
}
__device__ __forceinline__ void attn_unit(const bf16* __restrict__ Qh, const bf16* __restrict__ Kh, const bf16* __restrict__ Vh, bf16* __restrict__ Oh, long qrow0, long k0a, int nt0, long k0b, int NT,
                                          float lam, float oscale, const float* __restrict__ subg, float negoff, char* lds, int wave_, unsigned lds3) {
  unsigned z_ = 0u; asm volatile("" : "+v"(z_)); int tid_ = wave_ * 64 + (int)__builtin_amdgcn_mbcnt_hi(~0u, __builtin_amdgcn_mbcnt_lo(~0u, z_)); asm volatile("" : "+v"(tid_));
  const int tid = tid_, wid = __builtin_amdgcn_readfirstlane(tid >> 6), lane = tid & 63, r32 = lane & 31, hi = lane >> 5, qsub = wid >> 1, map = wid & 1, mapoff = map * 64;
  bf16* V_lds = (bf16*)lds; bf16* K_lds = (bf16*)(lds + NBUF * SHM_V);
  float* ws = (float*)(lds + NBUF * SHM_V + NBUF * SHM_K) + wid * 64; float* li_l = ws;
  float l_reg = 0; f32x16 o[4] = {}; bf16x8 qr[4];
  const bf16* Qw = Qh + (qrow0 + qsub * 32 + r32) * 512 + mapoff + hi * 8;
#pragma unroll
  for (int d0 = 0; d0 < 4; ++d0) qr[d0] = ld8(Qw + d0 * 16);
  const int vb0 = (int)(uintptr_t)V_lds + v_rd_base(lane);
  int koff[2], voff[2];
#pragma unroll
  for (int i = 0; i < 2; ++i) { const int o = (wid + 8 * i) * 1024 + lane * 16;
    { const int row = o >> 8, cB = (o & 255) ^ ((row & 7) << 4); koff[i] = row * 512 + (cB >> 1); }
    { const int sub = o >> 9, kkhi = sub >> 2, cg = sub & 3, q = (o & 511) >> 1, kklo = q >> 5, cin = q & 31, kk = kkhi * 8 + kklo; voff[i] = kk * 512 + cg * 32 + cin; } }
  typedef __attribute__((address_space(3))) unsigned lds_u32;
  const unsigned ldsK = lds3 + NBUF * (unsigned)SHM_V + (unsigned)wid * 1024u, ldsV = lds3 + (unsigned)wid * 1024u;
#define KROW(j) (((j) < nt0) ? (k0a + (long)(j) * KVBLK) : (k0b + (long)((j) - nt0) * KVBLK))
#define DMAK(b, j) do { const long kr_ = KROW(j) * 512; _Pragma("unroll") for (int i_ = 0; i_ < 2; ++i_) \
    __builtin_amdgcn_global_load_lds((const unsigned*)(Kh + kr_ + koff[i_]), (lds_u32*)(uintptr_t)(ldsK + (b) * (unsigned)SHM_K + i_ * 8192u), 16, 0, 0); } while (0)
#define DMAV(b, j) do { const long kr_ = KROW(j) * 512; _Pragma("unroll") for (int i_ = 0; i_ < 2; ++i_) \
    __builtin_amdgcn_global_load_lds((const unsigned*)(Vh + kr_ + voff[i_]), (lds_u32*)(uintptr_t)(ldsV + (b) * (unsigned)SHM_V + i_ * 8192u), 16, 0, 0); } while (0)
  f32x16 p0, p1; bf16x8 pa0, pa1, pa2 = {}, pa3 = {};
#define KFR(kb, d0, half) (*reinterpret_cast<const bf16x8*>((const char*)K_lds + (kb) * (int)SHM_K + KSWZ((half) * 32 + r32, (mapoff + (d0) * 16 + hi * 8) * 2)))
#define VRD4(S, vbuf, D0, KS) do { const int vb_ = vb0 + (vbuf) * (int)SHM_V; S##a = tr_read<v_rd_off(D0, KS, 0)>(vb_); S##b = tr_read<v_rd_off(D0, KS, 1)>(vb_); S##c = tr_read<v_rd_off(D0, (KS) + 1, 0)>(vb_); S##d = tr_read<v_rd_off(D0, (KS) + 1, 1)>(vb_); } while (0)
#define PKV(L, H) (bf16x8){L[0], L[1], L[2], L[3], H[0], H[1], H[2], H[3]}
#define MM(ACC, A_, B_) ACC = __builtin_amdgcn_mfma_f32_32x32x16_bf16(A_, B_, ACC, 0, 0, 0)
#define FADD(D, S) asm volatile("v_add_f32 %0, %0, %1" : "+v"(D) : "v"(S))
#define SMA(P, c) do { P[2 * (c)] = __builtin_amdgcn_exp2f(P[2 * (c)]); P[2 * (c) + 1] = __builtin_amdgcn_exp2f(P[2 * (c) + 1]); FADD(ls0, P[2 * (c)]); FADD(ls1, P[2 * (c) + 1]); } while (0)
#define SMB_CVT(P, BASE) do { ca0 = cvtpk(P[BASE + 0], P[BASE + 1]); ca1 = cvtpk(P[BASE + 2], P[BASE + 3]); cb0 = cvtpk(P[BASE + 4], P[BASE + 5]); cb1 = cvtpk(P[BASE + 6], P[BASE + 7]); } while (0)
#define SMB_PERM(OUT) do { u32x4 w_ = {ca0, ca1, cb0, cb1}; OUT = *reinterpret_cast<bf16x8*>(&w_); } while (0)
#define STAGE_PV(PA, PB, P, KLD_STMT) do { KLD_STMT; \
    MM(o[0], PA, PKV(vAa, vAb)); SMA(P, 0); SBAR(); MM(o[0], PB, PKV(vAc, vAd)); SMA(P, 1); SBAR(); \
    MM(o[1], PA, PKV(vBa, vBb)); SMA(P, 2); SBAR(); MM(o[1], PB, PKV(vBc, vBd)); SMA(P, 3); SBAR(); \
    MM(o[2], PA, PKV(vCa, vCb)); SMA(P, 4); SBAR(); MM(o[2], PB, PKV(vCc, vCd)); SMA(P, 5); SBAR(); \
    MM(o[3], PA, PKV(vDa, vDb)); SMA(P, 6); SBAR(); MM(o[3], PB, PKV(vDc, vDd)); SMA(P, 7); SBAR(); } while (0)
#define VRD16(vbuf, KS) do { VRD4(vA, vbuf, 0, KS); VRD4(vB, vbuf, 1, KS); VRD4(vC, vbuf, 2, KS); VRD4(vD, vbuf, 3, KS); } while (0)
#define STAGE_QK(PD, P, OUT0, OUT1, vbuf, KS) do { VRD16(vbuf, KS); \
    PD = __builtin_amdgcn_mfma_f32_32x32x16_bf16(kf0, qr[0], f32x16{}, 0, 0, 0); SMB_CVT(P, 0); SBAR(); \
    MM(PD, kf1, qr[1]); SMB_PERM(OUT0); SBAR(); MM(PD, kf2, qr[2]); SMB_CVT(P, 8); SBAR(); MM(PD, kf3, qr[3]); SMB_PERM(OUT1); SBAR(); } while (0)
#define KLD4(kb, half) do { kf0 = KFR(kb, 0, half); kf1 = KFR(kb, 1, half); kf2 = KFR(kb, 2, half); kf3 = KFR(kb, 3, half); } while (0)
  s16x4 vAa, vAb, vAc, vAd, vBa, vBb, vBc, vBd, vCa, vCb, vCc, vCd, vDa, vDb, vDc, vDd; bf16x8 kf0, kf1, kf2, kf3; unsigned ca0, ca1, cb0, cb1; float ls0 = 0.f, ls1 = 0.f;
  DMAK(0, 0); DMAK(1, 1); DMAV(0, 0); asm volatile("s_waitcnt vmcnt(0)" ::: "memory"); __syncthreads();
  KLD4(0, 0); p0 = __builtin_amdgcn_mfma_f32_32x32x16_bf16(kf0, qr[0], f32x16{}, 0, 0, 0); MM(p0, kf1, qr[1]); MM(p0, kf2, qr[2]); MM(p0, kf3, qr[3]);
  VRD16(0, 2);
  int bp = 0, bc = 0, bn = 1, bnn = 2;
#pragma unroll 1
  for (int j = 0; j < NT; ++j) {
    asm volatile("s_waitcnt vmcnt(0)" ::: "memory"); SBAR(); __builtin_amdgcn_s_barrier(); SBAR();
    if (j + 2 < NT) DMAK(bnn, j + 2);
    if (j + 1 < NT) DMAV(bn, j + 1);
    STAGE_PV(pa2, pa3, p0, KLD4(bc, 1));
    STAGE_QK(p1, p0, pa0, pa1, bc, 0);
    const int kbn = (j + 1 < NT) ? bn : bc;
    STAGE_PV(pa0, pa1, p1, KLD4(kbn, 0));
    STAGE_QK(p0, p1, pa2, pa3, bc, 2);
    bp = bc; bc = bn; bn = bnn; bnn = bp;
  }
  MM(o[0], pa2, PKV(vAa, vAb)); MM(o[0], pa3, PKV(vAc, vAd)); MM(o[1], pa2, PKV(vBa, vBb)); MM(o[1], pa3, PKV(vBc, vBd));
  MM(o[2], pa2, PKV(vCa, vCb)); MM(o[2], pa3, PKV(vCc, vCd)); MM(o[3], pa2, PKV(vDa, vDb)); MM(o[3], pa3, PKV(vDc, vDd));
  l_reg = ls0 + ls1;
#undef KLD4
#undef STAGE_QK
#undef VRD16
#undef FADD
#undef STAGE_PV
#undef SMB_PERM
#undef SMB_CVT
#undef SMA
#undef MM
#undef VRD4
#undef PKV
#undef KFR
#undef DMAK
#undef DMAV
#if EN_ATTEPI
  { auto rr = __builtin_amdgcn_permlane32_swap(__float_as_uint(l_reg), __float_as_uint(l_reg), false, false); l_reg = __uint_as_float(rr[0]) + __uint_as_float(rr[1]); }
  if (hi == 0) li_l[r32] = l_reg;
  asm volatile("s_waitcnt lgkmcnt(0)" ::: "memory");
  const float fm = map ? lam : 1.f;
#pragma unroll
  for (int r = 0; r < 16; ++r) { const float rl = __builtin_amdgcn_rcpf(li_l[crow(r, hi)]) * fm;
#pragma unroll
    for (int d0 = 0; d0 < 4; ++d0) o[d0][r] *= rl; }
  __syncthreads();
  float* X = (float*)lds + qsub * 4096 + lane;
  if (map == 1) {
#pragma unroll
    for (int d0 = 0; d0 < 4; ++d0)
#pragma unroll
      for (int r = 0; r < 16; ++r) X[(d0 * 16 + r) * 64] = o[d0][r];
  }
  __syncthreads();
  if (map == 0) {
    float sg[4];
#pragma unroll
    for (int d0 = 0; d0 < 4; ++d0) sg[d0] = subg[d0 * 32 + r32] * oscale;
    bf16* Ow = Oh + (qrow0 + qsub * 32) * 1024 + r32;
#pragma unroll
    for (int r = 0; r < 16; ++r) {
      float ss = 0.f;
#pragma unroll
      for (int d0 = 0; d0 < 4; ++d0) { o[d0][r] -= X[(d0 * 16 + r) * 64]; ss += o[d0][r] * o[d0][r]; }
      ss += __shfl_xor(ss, 1); ss += __shfl_xor(ss, 2); ss += __shfl_xor(ss, 4); ss += __shfl_xor(ss, 8); ss += __shfl_xor(ss, 16);
      const float rn = 1.0f / sqrtf(ss * (1.0f / 128.0f) + 1e-6f);
      const int orow = crow(r, hi);
#pragma unroll
      for (int d0 = 0; d0 < 4; ++d0) { const unsigned w = cvtpk(o[d0][r] * rn * sg[d0], 0.f); Ow[(long)orow * 1024 + d0 * 32] = (bf16)(w & 0xffffu); }
    }
  }
  __syncthreads();
#else
  { float s = l_reg; for (int d0 = 0; d0 < 4; ++d0) for (int r = 0; r < 16; ++r) s += o[d0][r]; Oh[qrow0 * 1024 + tid] = (bf16)(int)s; }
#endif
#undef KROW
}
#undef KSWZ
#undef SBAR
}
#ifndef EN_ALL
#define EN_ALL 1
#endif
#ifndef EN_PH0
#define EN_PH0 EN_ALL
#endif
#ifndef EN_PH1
#define EN_PH1 EN_ALL
#endif
#ifndef EN_P1
#define EN_P1 EN_ALL
#endif
#ifndef EN_P2A
#define EN_P2A EN_ALL
#endif
#ifndef EN_P2B
#define EN_P2B EN_ALL
#endif
#ifndef EN_P3
#define EN_P3 EN_ALL
#endif
#ifndef EN_P4
#define EN_P4 EN_ALL
#endif
#ifndef EN_P5
#define EN_P5 EN_ALL
#endif
#ifndef EN_ATT
#define EN_ATT 1
#endif
#ifndef EN_DFT
#define EN_DFT 1
#endif
#ifndef EN_ATTC
#define EN_ATTC 1
#endif
#ifndef SCHED_OLD
#define SCHED_OLD 0
#endif
#ifndef PROBE_A
#define PROBE_A 0
#endif
#ifndef PROBE_S
#define PROBE_S 0
#endif
#if PROBE_S
#define SUBSTAMP(i) do { if (blockIdx.x == 0 && F.wave == 0) ((volatile LAS unsigned*)(F.lds + MISC_OFF))[40 + (i)] = (unsigned)__builtin_amdgcn_s_memrealtime(); } while (0)
#else
#define SUBSTAMP(i) do {} while (0)
#endif
#ifndef PROBE_B
#define PROBE_B 0
#endif
#ifndef WGM_WIDE
#define WGM_WIDE 2
#endif
#ifndef WGM_MID
#define WGM_MID 2
#endif
constexpr int NWAVES = 8;
constexpr int DM = 1024, NBATCH = 8, SEQ = 2048, CTXL = 256, M_LAT = NBATCH * SEQ, M_CTX = NBATCH * CTXL, M_ALL = M_LAT + M_CTX, NIN = 2560, NINSRC = 2048, FFD = 2816, NGU = 5632, NLAYER = 2;
constexpr size_t MiB = 1u << 20;
constexpr size_t WS_CTL = 0, CTL_ZERO_BYTES = 1 * MiB;
constexpr size_t WS_MOD = 64 * 1024;
constexpr size_t WS_BIN = 512 * 1024;
constexpr size_t WS_BGU = 1 * MiB + 768 * 1024;
constexpr size_t WS_ROPE = WS_BGU + 512 * 1024;
constexpr size_t WS_DFT = WS_ROPE + 512 * 1024;
constexpr size_t WS_TF = 4 * MiB;
constexpr size_t WS_SSQ = 5 * MiB;
constexpr size_t WS_WIN = 8 * MiB;
constexpr size_t WS_WOUT = 18 * MiB;
constexpr size_t WS_WGU = 22 * MiB;
constexpr size_t WS_WDN = 44 * MiB;
constexpr size_t WS_A = 56 * MiB;
constexpr size_t WS_XC = 92 * MiB;
constexpr size_t WS_QB = 100 * MiB, WS_KB = 118 * MiB, WS_VB = 136 * MiB;
constexpr size_t WS_T = 154 * MiB;
constexpr size_t WS_TC = 186 * MiB;
constexpr size_t WS_MIX = 190 * MiB;
constexpr size_t WS_H = 100 * MiB;
constexpr size_t WS_HC = 226 * MiB;
constexpr size_t WS_END = 238 * MiB;
constexpr size_t WS_XB2 = 222 * MiB;
static_assert(WS_DFT + 256 * 512 * 2 <= WS_TF && WS_SSQ + (size_t)M_ALL * 64 <= WS_WIN && WS_H + (size_t)M_ALL * FFD * 2 <= WS_END && WS_MIX + (size_t)M_ALL * DM * 2 <= WS_END, "d_ws map");
constexpr int CW_TMO = 0, CW_BAR = 4096, CW_CTXCNT = 8192, CW_BFCNT = 8192 + 512, CW_C3CNT = 8192 + 1024;
constexpr int RING_BYTES = 131072, RTAB_OFF = RING_BYTES, RTAB_BYTES = 8192, LDSCTL_OFF = RTAB_OFF + RTAB_BYTES, MISC_OFF = LDSCTL_OFF + 320, BTAB_OFF = 140288, ETAB_OFF = 147456, LDS_BYTES = ETAB_OFF + 12288 + 512;
static_assert(MISC_OFF + 512 <= BTAB_OFF && BTAB_OFF + 7 * 1024 == ETAB_OFF && BTAB_OFF == RTAB_OFF + 4 * pg8::BT_F && ETAB_OFF == RTAB_OFF + 4 * pg8::ET_F && LDS_BYTES <= 160 * 1024, "LDS map");
constexpr int N_PHASES = 2 + 6 * NLAYER;

#define GAS __attribute__((address_space(1)))
#define LAS __attribute__((address_space(3)))
typedef unsigned short bf16;
typedef unsigned v4u __attribute__((ext_vector_type(4)));
typedef unsigned v2u __attribute__((ext_vector_type(2)));
typedef float f32x4 __attribute__((ext_vector_type(4)));
#define LDS_WAIT() asm volatile("s_waitcnt lgkmcnt(0)" ::: "memory")
#define VM_WAIT() asm volatile("s_waitcnt vmcnt(0)" ::: "memory")
__device__ __forceinline__ unsigned f2bf(float f) { unsigned u = __builtin_bit_cast(unsigned, f); return (u + 0x7fffu + ((u >> 16) & 1u)) >> 16; }
__device__ __forceinline__ unsigned pk2(float lo, float hi) { return f2bf(lo) | (f2bf(hi) << 16); }
__device__ __forceinline__ float bf2f(unsigned short h) { return __builtin_bit_cast(float, (unsigned)h << 16); }
__device__ __forceinline__ int lane_id() { unsigned z = 0u; asm volatile("" : "+v"(z)); return (int)__builtin_amdgcn_mbcnt_hi(~0u, __builtin_amdgcn_mbcnt_lo(~0u, z)); }
__device__ __forceinline__ float wave_sum(float v) {
#pragma unroll
    for (int o = 1; o < 64; o <<= 1) v += __shfl_xor(v, o);
    return v;
}

#define XB_TMO      128
#define XB_XCNT(j)  (256  + 64 * (j))
#define XB_XSUB(j)  (1280 + 64 * (j))
#define XB_XGEN(j)  (2304 + 64 * (j))
#define XB_TOP      3328
#define XB_TOPGEN   3392
#define XCD_BAR_WORDS 3456
#define XB_SPIN_CAP (1u << 18)

__device__ __forceinline__ unsigned xb_ld(unsigned* p)              { return __hip_atomic_load(p, __ATOMIC_RELAXED, __HIP_MEMORY_SCOPE_AGENT); }
__device__ __forceinline__ unsigned xb_add(unsigned* p, unsigned v) { return __hip_atomic_fetch_add(p, v, __ATOMIC_RELAXED, __HIP_MEMORY_SCOPE_AGENT); }
__device__ __forceinline__ unsigned xb_xcc_id() { return (unsigned)__builtin_amdgcn_s_getreg((3 << 11) | 20) & 0xFu; }
#define XB_SPIN(cond, bar) do { unsigned _sp = 0; while (cond) { __builtin_amdgcn_s_sleep(1); \
    if ((++_sp & 255u) == 0u) { if (xb_ld(&(bar)[XB_TMO])) break; if (_sp > XB_SPIN_CAP) { atomicAdd(&(bar)[XB_TMO], 1u); break; } } } } while (0)

struct XcdBarrier {
    unsigned* bar; unsigned x;
    volatile LAS unsigned* st;
};

__device__ __forceinline__ XcdBarrier xcd_barrier_post(unsigned* bar, volatile LAS unsigned* st) {
    XcdBarrier b; b.bar = bar; b.x = xb_xcc_id(); b.st = st;
    if (threadIdx.x == 0) (void)xb_add(&bar[XB_XCNT(b.x)], 1u);
    return b;
}
__device__ __forceinline__ void xcd_barrier_complete(unsigned* bar, unsigned x, unsigned& nloc, unsigned& nx) {
    const unsigned G = gridDim.x * gridDim.y * gridDim.z;
    unsigned sum, cnt, mine, sp = 0u;
    for (;;) {
        sum = 0u; cnt = 0u; mine = 0u;
#pragma unroll
        for (unsigned j = 0; j < 16; ++j) { const unsigned c = xb_ld(&bar[XB_XCNT(j)]); sum += c; cnt += (c > 0u) ? 1u : 0u; mine = (j == x) ? c : mine; }
        if (sum == G) break;
        __builtin_amdgcn_s_sleep(1);
        if ((++sp & 255u) == 0u) { if (xb_ld(&bar[XB_TMO])) break; if (sp > XB_SPIN_CAP) { atomicAdd(&bar[XB_TMO], 1u); break; } }
    }
    nloc = mine > 0u ? mine : 1u; nx = cnt > 0u ? cnt : 1u;
}

__device__ __forceinline__ void xcd_barrier(const XcdBarrier& b) {
    asm volatile("s_waitcnt vmcnt(0)" ::: "memory");
    __syncthreads();
    if (threadIdx.x == 0) {
        unsigned* bar = b.bar;
        __builtin_amdgcn_s_waitcnt(0);
        unsigned nloc = b.st[0], nx = b.st[1];
        if (nloc == 0u) { xcd_barrier_complete(bar, b.x, nloc, nx); b.st[0] = nloc; b.st[1] = nx; }
        const unsigned old = xb_add(&bar[XB_XSUB(b.x)], 1u);
        const unsigned gen = old / nloc;
        if (old + 1u == (gen + 1u) * nloc) {
            __builtin_amdgcn_fence(__ATOMIC_RELEASE, "agent");
            asm volatile("s_waitcnt vmcnt(0)" ::: "memory");
            const unsigned og = xb_add(&bar[XB_TOP], 1u);
            const unsigned tg = og / nx;
            if (og + 1u == (tg + 1u) * nx) xb_add(&bar[XB_TOPGEN], 1u);
            else XB_SPIN(xb_ld(&bar[XB_TOPGEN]) == tg, bar);
            __builtin_amdgcn_fence(__ATOMIC_ACQUIRE, "agent");
            xb_add(&bar[XB_XGEN(b.x)], 1u);
            asm volatile("s_waitcnt vmcnt(0)" ::: "memory");
        } else {
            XB_SPIN(xb_ld(&bar[XB_XGEN(b.x)]) == gen, bar);
            __builtin_amdgcn_fence(__ATOMIC_ACQUIRE, "agent");
            asm volatile("s_waitcnt vmcnt(0)" ::: "memory");
        }
    }
    __syncthreads();
}


struct Args { const float* in[21]; float* out; unsigned char* ws; int ph_lo, ph_hi; };
struct Frame {
    LAS unsigned char* lds; int wave, vcu, G;
};

__device__ __forceinline__ void transpose_item(const float* W, int ldn, bf16* WT, int ldk, int k0, int n0, int drow0, LAS float* scr, int lane) {
    const int r = lane >> 3, c4 = (lane & 7) * 4; f32x4 v[8];
#pragma unroll
    for (int j = 0; j < 8; ++j) v[j] = *(const f32x4*)(W + (size_t)(k0 + 8 * j + r) * ldn + n0 + c4);
#pragma unroll
    for (int j = 0; j < 8; ++j) { LAS float* d = scr + (8 * j + r) * 33 + c4; d[0] = v[j][0]; d[1] = v[j][1]; d[2] = v[j][2]; d[3] = v[j][3]; }
    LDS_WAIT(); asm volatile("" ::: "memory");
    const int c = lane & 7;
#pragma unroll
    for (int j = 0; j < 4; ++j) { const int n = (lane >> 3) + 8 * j; const LAS float* s = scr + (8 * c) * 33 + n;
        v4u o; o.x = pk2(s[0 * 33], s[1 * 33]); o.y = pk2(s[2 * 33], s[3 * 33]); o.z = pk2(s[4 * 33], s[5 * 33]); o.w = pk2(s[6 * 33], s[7 * 33]);
        *(GAS v4u*)(WT + (size_t)(drow0 + n) * ldk + k0 + 8 * c) = o; }
    LDS_WAIT(); asm volatile("" ::: "memory");
}
__device__ __forceinline__ void ph0(Frame& F, const Args& A, unsigned char* ws) {
    int tid_ = F.wave * 64 + lane_id(); asm volatile("" : "+v"(tid_));
    LAS float* scr = (LAS float*)(F.lds + F.wave * 16384);
    const int gw = F.vcu * NWAVES + F.wave, NGW = F.G * NWAVES;
    SUBSTAMP(0);
    constexpr int I_IN = 16 * 48, I_OUT = 16 * 32, I_G = 16 * 88, I_D = 44 * 32, I_LAYER = I_IN + I_OUT + 2 * I_G + I_D;
    for (int it = gw; it < NLAYER * I_LAYER; it += NGW) {
        const int l = it / I_LAYER; int r = it % I_LAYER;
        if (r < I_IN) { const int kb = r / 48, nb = r % 48, n0 = nb * 32, pn = n0 >> 8, cc = n0 & 255; const int drow = pn < 4 ? pn * 256 + ((cc >> 5) & 1) * 128 + (cc >> 6) * 32 : n0;
            transpose_item(A.in[8] + (size_t)l * DM * NINSRC, NINSRC, (bf16*)(ws + WS_WIN) + (size_t)l * NIN * DM, DM, kb * 64, n0, drow, scr, (tid_ & 63)); continue; } r -= I_IN;
        if (r < I_OUT) { const int kb = r / 32, nb = r % 32; transpose_item(A.in[17] + (size_t)l * DM * DM, DM, (bf16*)(ws + WS_WOUT) + (size_t)l * DM * DM, DM, kb * 64, nb * 32, nb * 32, scr, (tid_ & 63)); continue; } r -= I_OUT;
        if (r < 2 * I_G) { const int up = r >= I_G; if (up) r -= I_G; const int kb = r / 88, nb = r % 88, n0 = nb * 32; const int drow = (n0 >> 7) * 256 + up * 128 + (n0 & 127);
            transpose_item((up ? A.in[19] : A.in[18]) + (size_t)l * DM * FFD, FFD, (bf16*)(ws + WS_WGU) + (size_t)l * NGU * DM, DM, kb * 64, n0, drow, scr, (tid_ & 63)); continue; } r -= 2 * I_G;
        { const int kb = r / 32, nb = r % 32; transpose_item(A.in[20] + (size_t)l * FFD * DM, DM, (bf16*)(ws + WS_WDN) + (size_t)l * DM * FFD, FFD, kb * 64, nb * 32, nb * 32, scr, (tid_ & 63)); }
    }
    __syncthreads();
    SUBSTAMP(1);
    LAS float* sl = (LAS float*)F.lds;
    LAS float* red = (LAS float*)(F.lds + 40960);
    { f32x4 v[5];
#pragma unroll
      for (int q = 0; q < 5; ++q) { const int i4 = tid_ + q * (NWAVES * 64); const int j = i4 >> 8, k4 = (i4 & 255) * 4; v[q] = (i4 < 9 * 256) ? *(const f32x4*)((j < 8) ? A.in[1] + j * DM + k4 : A.in[3] + k4) : (f32x4){0.f, 0.f, 0.f, 0.f}; }
#pragma unroll
      for (int q = 0; q < 5; ++q) { const int i4 = tid_ + q * (NWAVES * 64); if (i4 < 9 * 256) { f32x4 s; for (int e = 0; e < 4; ++e) s[e] = v[q][e] / (1.f + __expf(-v[q][e])); *(LAS f32x4*)(sl + i4 * 4) = s; } } }
    __syncthreads();
    { const int lane = tid_ & 63; const int NIT = NLAYER * 24 * 16;
      f32x4 wa[8], wb[8], wc[8];
#define MOD_LOAD(W, it_) do { const int kb_ = (it_) & 15, cb_ = ((it_) >> 4) % 24, l_ = (it_) / (24 * 16); const float* W_ = A.in[4] + (size_t)l_ * DM * 6144 + (size_t)(kb_ * 64 + F.wave * 8) * 6144 + cb_ * 256 + lane * 4; \
        _Pragma("unroll") for (int r = 0; r < 8; ++r) W[r] = *(const f32x4*)(W_ + (size_t)r * 6144); } while (0)
#define MOD_ITEM(W, it_) do { const int kb = (it_) & 15, cb = ((it_) >> 4) % 24, l = (it_) / (24 * 16); \
        f32x4 acc[9]; \
        _Pragma("unroll") for (int j = 0; j < 9; ++j) acc[j] = (f32x4){0.f, 0.f, 0.f, 0.f}; \
        _Pragma("unroll") for (int r4 = 0; r4 < 8; r4 += 4) \
            _Pragma("unroll") for (int j = 0; j < 9; ++j) { const f32x4 s = *(const LAS f32x4*)(sl + j * DM + kb * 64 + F.wave * 8 + r4); acc[j] += W[r4] * s[0] + W[r4 + 1] * s[1] + W[r4 + 2] * s[2] + W[r4 + 3] * s[3]; } \
        _Pragma("unroll") for (int j = 0; j < 9; ++j) *(LAS f32x4*)(red + (F.wave * 9 + j) * 256 + lane * 4) = acc[j]; \
        __syncthreads(); \
        for (int i = tid_; i < 9 * 256; i += NWAVES * 64) { const int j = i >> 8, cn = i & 255; float s = 0.f; \
            _Pragma("unroll") for (int w8 = 0; w8 < 8; ++w8) s += red[(w8 * 9 + j) * 256 + cn]; \
            const int nn = cb * 256 + cn; if (kb == 0) s += A.in[5][l * 6144 + nn]; \
            atomicAdd((float*)(ws + WS_MOD) + (l * 9 + j) * 6144 + nn, s); } \
        __syncthreads(); } while (0)
      for (int it0 = F.vcu; it0 < NIT; it0 += 3 * F.G) {
        const int it1 = it0 + F.G, it2 = it0 + 2 * F.G;
        MOD_LOAD(wa, it0); if (it1 < NIT) MOD_LOAD(wb, it1); if (it2 < NIT) MOD_LOAD(wc, it2);
        MOD_ITEM(wa, it0); if (it1 < NIT) MOD_ITEM(wb, it1); if (it2 < NIT) MOD_ITEM(wc, it2);
      }
#undef MOD_ITEM
#undef MOD_LOAD
    }
    SUBSTAMP(2);
    const int gt = F.vcu * (NWAVES * 64) + tid_, NGT = F.G * NWAVES * 64;
    for (int i = gt; i < 96 * 16; i += NGT) { const int p = i >> 4, j = i & 15; const float inv = powf(10000.0f, -(float)j * (1.0f / 16.0f)); const float ang = (float)(p < 32 ? p : p - 32) * inv;
        float sn, cs; sincosf(ang, &sn, &cs); ((float*)(ws + WS_ROPE))[i] = cs; ((float*)(ws + WS_ROPE))[1536 + i] = sn; }
    for (int i = gt; i < 256 * 512; i += NGT) { const int m = i >> 9, kk = i & 511, n = kk >> 1; const int p = (m * n) & 255; float sn, cs; sincospif((float)p * (1.0f / 128.0f), &sn, &cs);
        ((bf16*)(ws + WS_DFT))[i] = (bf16)f2bf((kk & 1) ? sn : cs); }
    SUBSTAMP(3);
    __syncthreads();
    if (F.vcu < NLAYER * 4 * 32) {
        const int lg = F.vcu >> 5, c0 = (F.vcu & 31) * 4;
        LAS float* wl = (LAS float*)F.lds; LAS float* ct = (LAS float*)(F.lds + 65536); LAS float* st = ct + 128;
        { f32x4 wv[8];
#pragma unroll
          for (int q = 0; q < 8; ++q) wv[q] = *(const f32x4*)(A.in[16] + (size_t)lg * 128 * 128 + (tid_ + q * (NWAVES * 64)) * 4);
#pragma unroll
          for (int q = 0; q < 8; ++q) *(LAS f32x4*)(wl + (tid_ + q * (NWAVES * 64)) * 4) = wv[q]; }
        if (tid_ < 128) { float sn, cs; sincospif((float)tid_ * (1.0f / 64.0f), &sn, &cs); ct[tid_] = cs; st[tid_] = sn; }
        __syncthreads();
        for (int o = tid_; o < 4 * 256; o += NWAVES * 64) { const int d = o & 127, ri = (o >> 7) & 1, cch = c0 + (o >> 8); float s = 0.f;
#pragma unroll 8
            for (int c2 = 0; c2 < 128; ++c2) { const int p = (cch * c2) & 127; s += (ri ? -st[p] : ct[p]) * wl[c2 * 128 + d]; }
            ((float*)(ws + WS_TF))[(size_t)lg * 32768 + cch * 256 + ri * 128 + d] = s; }
    }
    SUBSTAMP(4);
}
__device__ __forceinline__ void ph1(Frame& F, const Args& A, unsigned char* ws) {
    int tid_ = F.wave * 64 + lane_id(); asm volatile("" : "+v"(tid_));
    const float* mod = (const float*)(ws + WS_MOD);
    SUBSTAMP(5);
    { const int gw = F.vcu * NWAVES + F.wave, NGW = F.G * NWAVES; const int lane = tid_ & 63;
      for (int row0 = gw; row0 < M_ALL; row0 += 2 * NGW) {
          const int row1 = row0 + NGW; const bool two = row1 < M_ALL;
          f32x4 v[2][4]; float s[2] = {0.f, 0.f};
#pragma unroll
          for (int q = 0; q < 2; ++q) { const int row = q ? (two ? row1 : row0) : row0; const float* xr = row < M_LAT ? A.in[0] + (size_t)row * DM : A.in[2] + (size_t)(row - M_LAT) * DM;
#pragma unroll
              for (int j = 0; j < 4; ++j) v[q][j] = *(const f32x4*)(xr + 256 * j + 4 * lane); }
#pragma unroll
          for (int q = 0; q < 2; ++q) {
#pragma unroll
              for (int j = 0; j < 4; ++j) s[q] += (v[q][j][0] * v[q][j][0] + v[q][j][1] * v[q][j][1]) + (v[q][j][2] * v[q][j][2] + v[q][j][3] * v[q][j][3]);
              s[q] = wave_sum(s[q]); }
#pragma unroll
          for (int q = 0; q < 2; ++q) { if (q == 1 && !two) break; const int row = q ? row1 : row0; const int bm = row < M_LAT ? (row >> 11) : 8; const float* sc = mod + bm * 6144 + 1024;
              bf16* ar = (bf16*)(ws + WS_A) + (size_t)row * DM;
              _Float16* hr = row < M_LAT ? (_Float16*)A.out + (size_t)row * DM : (_Float16*)(ws + WS_XC) + (size_t)(row - M_LAT) * DM;
#pragma unroll
              for (int j = 0; j < 4; ++j) { v2u h; h.x = pg8::pkh2(v[q][j][0], v[q][j][1]); h.y = pg8::pkh2(v[q][j][2], v[q][j][3]); *(v2u*)(hr + 256 * j + 4 * lane) = h; }
#pragma unroll
              for (int j = 0; j < 4; ++j) { const int k = 256 * j + 4 * lane; const f32x4 g = *(const f32x4*)(A.in[6] + k) * (*(const f32x4*)(sc + k) + 1.0f); const f32x4 a = v[q][j] * g; v2u w; w.x = pk2(a[0], a[1]); w.y = pk2(a[2], a[3]); *(v2u*)(ar + k) = w; }
              if (lane < 16) ((float*)(ws + WS_SSQ))[(size_t)row * 16 + lane] = lane == 0 ? s[q] : 0.f; }
      } }
    __syncthreads();
    SUBSTAMP(6);
    { LAS float* wl = (LAS float*)F.lds;
      LAS float* tl = (LAS float*)(F.lds + 128 * 132 * 4);
      LAS float* shl = (LAS float*)(F.lds + 128 * 132 * 4 + 128 * 64 * 4);
      LAS float* redl = shl + 9 * 128;
      for (int it = F.vcu; it < NLAYER * 4 * 4 * 8; it += F.G) {
          const int kb = it & 7, q = (it >> 3) & 3, g = (it >> 5) & 3, l = it >> 7;
          const float* wsrc = A.in[8] + (size_t)l * DM * NINSRC + (size_t)(kb * 128) * NINSRC + 1536 + g * 128;
          f32x4 wv[8], tv[4];
#pragma unroll
          for (int q = 0; q < 8; ++q) { const int i = tid_ + q * (NWAVES * 64); wv[q] = *(const f32x4*)(wsrc + (size_t)(i >> 5) * NINSRC + (i & 31) * 4); }
          const float* tsrc = (const float*)(ws + WS_TF) + (size_t)(l * 4 + g) * 128 * 256 + q * 64;
#pragma unroll
          for (int q = 0; q < 4; ++q) { const int i = tid_ + q * (NWAVES * 64); tv[q] = *(const f32x4*)(tsrc + (size_t)(i >> 4) * 256 + (i & 15) * 4); }
#pragma unroll
          for (int q = 0; q < 8; ++q) { const int i = tid_ + q * (NWAVES * 64); *(LAS f32x4*)(wl + (i >> 5) * 132 + (i & 31) * 4) = wv[q]; }
#pragma unroll
          for (int q = 0; q < 4; ++q) { const int i = tid_ + q * (NWAVES * 64); *(LAS f32x4*)(tl + (i >> 4) * 64 + (i & 15) * 4) = tv[q]; }
          if (tid_ < 9 * 32) *(LAS f32x4*)(shl + tid_ * 4) = *(const f32x4*)(mod + (l * 9 + (tid_ >> 5)) * 6144 + kb * 128 + (tid_ & 31) * 4);
          __syncthreads();
          const int dcol = tid_ & 63, kg = tid_ >> 6; float acc[16];
#pragma unroll
          for (int i = 0; i < 16; ++i) acc[i] = 0.f;
          for (int c4 = 0; c4 < 128; c4 += 4) { const float t0 = tl[c4 * 64 + dcol], t1 = tl[(c4 + 1) * 64 + dcol], t2 = tl[(c4 + 2) * 64 + dcol], t3 = tl[(c4 + 3) * 64 + dcol];
#pragma unroll
              for (int i = 0; i < 16; ++i) { const f32x4 w = *(const LAS f32x4*)(wl + (kg * 16 + i) * 132 + c4); acc[i] += w[0] * t0 + w[1] * t1 + w[2] * t2 + w[3] * t3; } }
          bf16* dst = (bf16*)(ws + WS_WIN) + (size_t)l * NIN * DM + (size_t)(1536 + g * 256 + q * 64 + dcol) * DM + kb * 128 + kg * 16;
          v4u o0, o1; o0.x = pk2(acc[0], acc[1]); o0.y = pk2(acc[2], acc[3]); o0.z = pk2(acc[4], acc[5]); o0.w = pk2(acc[6], acc[7]); o1.x = pk2(acc[8], acc[9]); o1.y = pk2(acc[10], acc[11]); o1.z = pk2(acc[12], acc[13]); o1.w = pk2(acc[14], acc[15]);
          *(v4u*)dst = o0; *(v4u*)(dst + 8) = o1;
          { float bs[9];
#pragma unroll
            for (int j = 0; j < 9; ++j) { float s = 0.f;
#pragma unroll
                for (int i4 = 0; i4 < 4; ++i4) { const f32x4 sv = *(const LAS f32x4*)(shl + j * 128 + kg * 16 + i4 * 4); s += sv[0] * acc[4 * i4] + sv[1] * acc[4 * i4 + 1] + sv[2] * acc[4 * i4 + 2] + sv[3] * acc[4 * i4 + 3]; }
                bs[j] = s; }
#pragma unroll
            for (int j = 0; j < 9; ++j) redl[(kg * 9 + j) * 64 + dcol] = bs[j]; }
          __syncthreads();
          for (int i = tid_; i < 9 * 64; i += NWAVES * 64) { const int j = i >> 6, dc = i & 63; float s = 0.f;
#pragma unroll
              for (int w = 0; w < 8; ++w) s += redl[(w * 9 + j) * 64 + dc];
              atomicAdd((float*)(ws + WS_BIN) + (l * 9 + j) * NIN + 1536 + g * 256 + q * 64 + dc, s); }
          __syncthreads();
      } }
    SUBSTAMP(7);
    { LAS unsigned short* sh16 = (LAS unsigned short*)F.lds;
      for (int i = tid_; i < 4 * 16 * 256; i += NWAVES * 64) { const int set = i >> 12, row = (i >> 8) & 15, k4 = (i & 255) * 4; v2u o = {0u, 0u};
          if (row < 9) { const f32x4 v = *(const f32x4*)(mod + ((set >> 1) * 9 + row) * 6144 + ((set & 1) ? 3072 : 0) + k4); o.x = pk2(v[0], v[1]); o.y = pk2(v[2], v[3]); }
          *(LAS v2u*)(sh16 + (size_t)i * 4) = o; }
      __syncthreads();
      typedef short bf8 __attribute__((ext_vector_type(8)));
      const int lane = tid_ & 63, fr = lane & 15, fq = lane >> 4;
      const int gw = F.vcu * NWAVES + F.wave, NGW = F.G * NWAVES;
      for (int t = gw; t < 896; t += NGW) {
          int set, n0; if (t < 96) { set = 0; n0 = t * 16; } else if (t < 448) { set = 1; n0 = (t - 96) * 16; } else if (t < 544) { set = 2; n0 = (t - 448) * 16; } else { set = 3; n0 = (t - 544) * 16; }
          const int l = set >> 1, gu = set & 1;
          const bf16* WT = gu ? (const bf16*)(ws + WS_WGU) + (size_t)l * NGU * DM : (const bf16*)(ws + WS_WIN) + (size_t)l * NIN * DM;
          const bf16* wrow = WT + (size_t)(n0 + fr) * DM + fq * 8; const LAS unsigned short* arow = sh16 + (size_t)set * 16 * 1024 + fr * 1024 + fq * 8;
          pg8::f32x4 acc = {0.f, 0.f, 0.f, 0.f};
#pragma unroll
          for (int s8 = 0; s8 < 32; s8 += 8) { bf8 b[8];
#pragma unroll
              for (int q = 0; q < 8; ++q) b[q] = *(const bf8*)(wrow + (s8 + q) * 32);
#pragma unroll
              for (int q = 0; q < 8; ++q) { const bf8 a = *(const LAS bf8*)(arow + (s8 + q) * 32); acc = __builtin_amdgcn_mfma_f32_16x16x32_bf16(a, b[q], acc, 0, 0, 0); } }
          float* bo = gu ? (float*)(ws + WS_BGU) + l * 9 * NGU : (float*)(ws + WS_BIN) + l * 9 * NIN; const int ldb = gu ? NGU : NIN;
#pragma unroll
          for (int r = 0; r < 4; ++r) { const int j = fq * 4 + r; if (j < 9) bo[j * ldb + n0 + fr] = acc[r]; }
      }
    }
    SUBSTAMP(8);
}
__device__ __forceinline__ void fft8(float (&xr)[8], float (&xi)[8]) {
    const float S = 0.70710678118654752f;
    const float u0r = xr[0] + xr[4], u0i = xi[0] + xi[4], d0r = xr[0] - xr[4], d0i = xi[0] - xi[4];
    const float u1r = xr[1] + xr[5], u1i = xi[1] + xi[5], d1r = xr[1] - xr[5], d1i = xi[1] - xi[5];
    const float u2r = xr[2] + xr[6], u2i = xi[2] + xi[6], d2r = xr[2] - xr[6], d2i = xi[2] - xi[6];
    const float u3r = xr[3] + xr[7], u3i = xi[3] + xi[7], d3r = xr[3] - xr[7], d3i = xi[3] - xi[7];
    const float v0r = d0r, v0i = d0i;
    const float v1r = (d1r + d1i) * S, v1i = (d1i - d1r) * S;
    const float v2r = d2i, v2i = -d2r;
    const float v3r = (d3i - d3r) * S, v3i = -(d3r + d3i) * S;
    { const float p0r = u0r + u2r, p0i = u0i + u2i, p1r = u1r + u3r, p1i = u1i + u3i, p2r = u0r - u2r, p2i = u0i - u2i, qr = u1r - u3r, qi = u1i - u3i; const float p3r = qi, p3i = -qr;
      xr[0] = p0r + p1r; xi[0] = p0i + p1i; xr[4] = p0r - p1r; xi[4] = p0i - p1i; xr[2] = p2r + p3r; xi[2] = p2i + p3i; xr[6] = p2r - p3r; xi[6] = p2i - p3i; }
    { const float p0r = v0r + v2r, p0i = v0i + v2i, p1r = v1r + v3r, p1i = v1i + v3i, p2r = v0r - v2r, p2i = v0i - v2i, qr = v1r - v3r, qi = v1i - v3i; const float p3r = qi, p3i = -qr;
      xr[1] = p0r + p1r; xi[1] = p0i + p1i; xr[5] = p0r - p1r; xi[5] = p0i - p1i; xr[3] = p2r + p3r; xi[3] = p2i + p3i; xr[7] = p2r - p3r; xi[7] = p2i - p3i; }
}
__device__ __forceinline__ void butterfly_phase(Frame& F, unsigned char* ws) {
    bf16* T = (bf16*)(ws + WS_T);
    int tid_ = F.wave * 64 + lane_id(); asm volatile("" : "+v"(tid_));
    const int gt = F.vcu * (NWAVES * 64) + tid_, NGT = F.G * NWAVES * 64;
    for (int it = gt; it < NBATCH * 512 * 128; it += NGT) {
        const int n0 = (it & 127) * 2, bc = it >> 7, b = bc >> 9, ch = bc & 511; bf16* tp = T + ((size_t)(b * 8) * 512 + ch) * 512 + n0 * 2;
        v2u q[8];
#pragma unroll
        for (int j = 0; j < 8; ++j) q[j] = *(const v2u*)(tp + (size_t)j * 512 * 512);
        float ar[8], ai[8], br[8], bi[8];
#define BF_UNP(k) ar[k] = __builtin_bit_cast(float, q[k].x << 16); ai[k] = __builtin_bit_cast(float, q[k].x & 0xffff0000u); br[k] = __builtin_bit_cast(float, q[k].y << 16); bi[k] = __builtin_bit_cast(float, q[k].y & 0xffff0000u);
        BF_UNP(0) BF_UNP(1) BF_UNP(2) BF_UNP(3) BF_UNP(4) BF_UNP(5) BF_UNP(6) BF_UNP(7)
#undef BF_UNP
        fft8(ar, ai); fft8(br, bi);
        const float th0 = (float)n0 * (1.0f / 1024.0f), th1 = (float)(n0 + 1) * (1.0f / 1024.0f);
#define BF_OUT(r) { float s0, c0, s1, c1; sincospif(th0 * (float)(r), &s0, &c0); sincospif(th1 * (float)(r), &s1, &c1); v2u o_; \
          o_.x = pk2(ar[r] * c0 + ai[r] * s0, ai[r] * c0 - ar[r] * s0); o_.y = pk2(br[r] * c1 + bi[r] * s1, bi[r] * c1 - br[r] * s1); *(v2u*)(tp + (size_t)(r) * 512 * 512) = o_; }
        BF_OUT(0) BF_OUT(1) BF_OUT(2) BF_OUT(3) BF_OUT(4) BF_OUT(5) BF_OUT(6) BF_OUT(7)
#undef BF_OUT
    }
}
template <class S> __device__ __forceinline__ void compute_rtab(Frame& F, unsigned char* ws, const S& sched, const float* bias, int NC) {
    LAS float* rt = (LAS float*)(F.lds + RTAB_OFF); LAS float* bt = (LAS float*)(F.lds + BTAB_OFF); pg8::Unit u;
    int tid_ = F.wave * 64 + lane_id(); asm volatile("" : "+v"(tid_));
    const int t = tid_ & 255, par = tid_ >> 8;
    for (int i = 0; i < 7 && sched.next(i, u); ++i) if ((i & 1) == par) { const float* p = (const float*)(ws + WS_SSQ) + ((size_t)u.pm * 256 + t) * 16; float s = 0.f;
        const float bvv = bias[(u.pm < 64 ? (u.pm >> 3) : 8) * NC + u.pn * 256 + t];
#pragma unroll
        for (int q = 0; q < 4; ++q) { const f32x4 a = *(const f32x4*)(p + 4 * q); s += (a[0] + a[1]) + (a[2] + a[3]); }
        rt[i * 256 + t] = __builtin_amdgcn_rsqf(s * (1.0f / 1024.0f) + 1e-6f); bt[i * 256 + t] = bvv; }
    __syncthreads();
}
__device__ __forceinline__ void attn_phase(Frame& F, const Args& A, unsigned char* ws, int l, char* lds) {
    int tid_ = F.wave * 64 + lane_id(); asm volatile("" : "+v"(tid_));
    const float lambda_init = l == 0 ? 0.2f : 0.355509068f;
    const float lam = expf(wave_sum(A.in[11][l * 64 + (tid_ & 63)] * A.in[12][l * 64 + (tid_ & 63)])) - expf(wave_sum(A.in[13][l * 64 + (tid_ & 63)] * A.in[14][l * 64 + (tid_ & 63)])) + lambda_init;
    float gq = fabsf(A.in[9][l * 64 + (tid_ & 63)]), gk = fabsf(A.in[10][l * 64 + (tid_ & 63)]);
#pragma unroll
    for (int o = 1; o < 64; o <<= 1) { gq = fmaxf(gq, __shfl_xor(gq, o)); gk = fmaxf(gk, __shfl_xor(gk, o)); }
    const float negoff = -fmaxf(0.f, 8.0f * 1.4426950408889634f * gq * gk * 1.0001f - 40.0f);
    const att::bf16* QB = (const att::bf16*)(ws + WS_QB); const att::bf16* KB = (const att::bf16*)(ws + WS_KB); const att::bf16* VB = (const att::bf16*)(ws + WS_VB); att::bf16* MIX = (att::bf16*)(ws + WS_MIX);
    const float* subg = A.in[15] + l * 128;
    const int per = (512 + F.G - 1) / F.G;
    for (int u = F.vcu * per; u < (F.vcu + 1) * per && u < 512; ++u) {
        const int qblk = u & 15, bh = u >> 4, b = bh >> 2, h = bh & 3;
        att::attn_unit(QB + h * 128, KB + h * 128, VB + h * 128, MIX + h * 128, (long)b * SEQ + qblk * 128, (long)M_LAT + b * CTXL, 4, (long)b * SEQ, 36, lam, 1.0f - lambda_init, subg, negoff, lds, F.wave, (unsigned)(uintptr_t)F.lds);
    }
#if EN_ATTC
    if (l == 0) for (int u = F.vcu; u < 64; u += F.G) {
        const int qblk = u & 1, bh = u >> 1, b = bh >> 2, h = bh & 3;
        att::attn_unit(QB + h * 128, KB + h * 128, VB + h * 128, MIX + h * 128, (long)M_LAT + b * CTXL + qblk * 128, (long)M_LAT + b * CTXL, 4, 0, 4, lam, 1.0f - lambda_init, subg, negoff, lds, F.wave, (unsigned)(uintptr_t)F.lds);
    }
#endif
}

__global__ void __launch_bounds__(NWAVES * 64, 2) fwd_kernel(const Args args) {
    extern __shared__ __attribute__((aligned(16))) unsigned char lds[];
    Frame F0;
    F0.lds = (LAS unsigned char*)lds;
    F0.wave = __builtin_amdgcn_readfirstlane((int)threadIdx.x >> 6);
    F0.G = gridDim.x; { const int bx = blockIdx.x; F0.vcu = (F0.G % 8 == 0) ? (bx % 8) * (F0.G / 8) + bx / 8 : bx; }
    for (int u = ((int)threadIdx.x); u < (LDS_BYTES - LDSCTL_OFF) / 4; u += NWAVES * 64) ((LAS unsigned*)(F0.lds + LDSCTL_OFF))[u] = 0u;
    __syncthreads();
    volatile LAS unsigned* MISC = (volatile LAS unsigned*)(F0.lds + MISC_OFF);
    (void)xcd_barrier_post((unsigned*)(args.ws + WS_CTL) + CW_BAR, MISC + 8);
    const int lo = args.ph_lo, hi = args.ph_hi;
    const int cid = (int)blockIdx.x;
    const LAS float* rtab = (const LAS float*)(F0.lds + RTAB_OFF);
#pragma unroll 1
    for (int ph = lo; ph < hi; ++ph) {
#if PROBE_A
        if (blockIdx.x == 0 && F0.wave == 0) MISC[16 + ph] = (unsigned)__builtin_amdgcn_s_memrealtime();
#endif
        unsigned char* ws = args.ws; asm volatile("" : "+s"(ws)); const Args& A = args;
        Frame F = F0; asm volatile("" : "+s"(F.G), "+s"(F.vcu), "+s"(F.wave));
        int l = 0, k = -1; if (ph >= 2) { l = (ph - 2) / 6; k = (ph - 2) % 6; }
        if (ph == 0) ph0(F, A, ws);
        else if (ph == 1) ph1(F, A, ws);
        else if (k == 1) continue;
        else if (k == 2) {
            butterfly_phase(F, ws);
            asm volatile("s_waitcnt vmcnt(0)" ::: "memory"); __syncthreads();
            if (F.wave == 0 && lane_id() == 0) { __builtin_amdgcn_fence(__ATOMIC_RELEASE, "agent"); asm volatile("s_waitcnt vmcnt(0)" ::: "memory");
                __hip_atomic_fetch_add((unsigned*)(ws + WS_CTL) + CW_BFCNT + 64 * l, 1u, __ATOMIC_RELAXED, __HIP_MEMORY_SCOPE_AGENT); }
            attn_phase(F, A, ws, l, (char*)lds);
        }
#pragma unroll 1
        for (int ci = 0; ci < 2; ++ci) {
            enum { T_NONE = 0, T_IN = 1, T_DFT = 2, T_RESN = 3, T_RESL = 4, T_GU = 5 };
            int type = T_NONE, nMa = 0, nNa = 0, pmB = 0, nMb = 0, pnB = 0, nNb = 0, Gs = F.G, cs = cid, rot = 0, K = DM, el = l, nshort = 0, ishort = 0; bool ctxdown = false; int sigw = -1, waitw = -1;
#if SCHED_OLD
            const int nM = l == 0 ? 72 : 64;
            if (ci == 0) {
                if (k == 0) { type = T_IN; if (l == 0) { nMa = 72; nNa = 10; } else { nMa = 64; nNa = 10; pmB = 64; nMb = 8; pnB = 2; nNb = 4; } }
                else if (k == 2) { type = T_DFT; nMa = 1; nNa = l == 0 ? 144 : 128; rot = F.G - 64; K = 512; }
                else if (k == 3) { type = T_RESN; nMa = nM; nNa = 4; }
                else if (k == 4) { type = T_GU; nMa = nM; nNa = 22; }
                else if (k == 5) { type = l == NLAYER - 1 ? T_RESL : T_RESN; nMa = nM; nNa = 4; K = FFD; }
            }
#else
            if (k == 0) {
                if (l == 0) { if (ci == 0) { type = T_IN; nMa = 72; nNa = 10; } }
                else if (ci == 0) { type = T_RESN; pmB = 64; nMb = 8; pnB = 0; nNb = 4; K = FFD; el = 0; ctxdown = true; sigw = CW_CTXCNT; }
                else if (cid >= 32) { type = T_IN; nMa = 64; nNa = 10; Gs = F.G - 32; cs = cid - 32; }
                else if (l == NLAYER - 1) { type = T_IN; pmB = 64; nMb = 8; pnB = 2; nNb = 4; waitw = CW_CTXCNT; }
            }
            else if (k == 2) { if (ci == 0) { type = T_DFT; nMa = 1; nNa = l == 0 ? 144 : 128; rot = F.G - 64; K = 512; } }
            else if (k == 3) { if (ci == 0) { type = T_RESN; nMa = 64; nNa = 4; } }
            else if (k == 4) { if (l == 0 && ci == 0) { type = T_RESN; pmB = 64; nMb = 8; pnB = 0; nNb = 4; }
                               else if (ci == (l == 0 ? 1 : 0)) { type = T_GU; nMa = 64; nNa = 22; if (l == 0) { nshort = 32; ishort = 4; } } }
            else if (k == 5) { const int cdn = (l == 0) ? 1 : 0;
                               if (ci == cdn) { type = l == NLAYER - 1 ? T_RESL : T_RESN; nMa = 64; nNa = 4; K = FFD; } else if (l == 0 && ci == 0) { type = T_GU; pmB = 64; nMb = 8; pnB = 0; nNb = 22; } }
#endif
            if (type == T_NONE) continue;
            pg8::Sched2 S; S.init(nMa, nNa, pmB, nMb, pnB, nNb, Gs, cs, rot); S.ns = nshort; S.is = ishort;
            if (waitw >= 0) {
                pg8::Unit u0; if (!S.next(0, u0)) continue;
                if (F.wave == 0) { unsigned* cw = (unsigned*)(ws + WS_CTL) + waitw + 64 * (cid & 7); unsigned sp = 0;
                    while (__hip_atomic_load(cw, __ATOMIC_RELAXED, __HIP_MEMORY_SCOPE_AGENT) < 4u) { __builtin_amdgcn_s_sleep(8); if (++sp > (1u << 22)) break; }
                    __builtin_amdgcn_fence(__ATOMIC_ACQUIRE, "agent"); asm volatile("s_waitcnt vmcnt(0)" ::: "memory"); }
                __syncthreads();
            } S.wgm = (nNa >= 16) ? WGM_WIDE : ((nNa >= 8) ? WGM_MID : 2);
            if (type == T_IN) {
                {
                    int t_ = F.wave * 64 + lane_id(); asm volatile("" : "+v"(t_)); LAS float* et = (LAS float*)(F.lds + ETAB_OFF);
                    for (int i = t_; i < 3072 + 128; i += NWAVES * 64) et[i] = i < 3072 ? ((const float*)(ws + WS_ROPE))[i] : (i < 3136 ? A.in[9][l * 64 + i - 3072] : A.in[10][l * 64 + i - 3136]);
                }
                compute_rtab(F, ws, S, (const float*)(ws + WS_BIN) + l * 9 * NIN, NIN);
                pg8::Gemm g{(const pg8::bf16_t*)(ws + WS_A), (const pg8::bf16_t*)(ws + WS_WIN) + (size_t)l * NIN * DM, M_ALL, NIN, DM};
                pg8::EpiIn E{ws, rtab};
                pg8::gemm_phase<pg8::EpiIn, pg8::Sched2, true, true>(F.lds, g, S, E, F.wave);
            } else if (type == T_DFT) {
                {
                    if (F.wave == 0) { unsigned* cw = (unsigned*)(ws + WS_CTL) + CW_BFCNT + 64 * l; unsigned sp = 0;
                        while (__hip_atomic_load(cw, __ATOMIC_RELAXED, __HIP_MEMORY_SCOPE_AGENT) < (unsigned)F.G) { __builtin_amdgcn_s_sleep(8); if (++sp > (1u << 22)) break; }
                        __builtin_amdgcn_fence(__ATOMIC_ACQUIRE, "agent"); asm volatile("s_waitcnt vmcnt(0)" ::: "memory"); }
                    __syncthreads();
                }
                pg8::Gemm g{(const pg8::bf16_t*)(ws + WS_DFT), (const pg8::bf16_t*)(ws + WS_T), 256, 36864, 512};
                pg8::EpiDft E{(pg8::bf16_t*)(ws + WS_MIX)};
                pg8::gemm_phase<pg8::EpiDft, pg8::Sched2, true, true>(F.lds, g, S, E, F.wave);
            } else if (type == T_GU) {
                compute_rtab(F, ws, S, (const float*)(ws + WS_BGU) + l * 9 * NGU, NGU);
                pg8::Gemm g{(const pg8::bf16_t*)(ws + WS_A), (const pg8::bf16_t*)(ws + WS_WGU) + (size_t)l * NGU * DM, M_ALL, NGU, DM};
                pg8::EpiGU E{ws, rtab};
                pg8::gemm_phase<pg8::EpiGU, pg8::Sched2, true, true>(F.lds, g, S, E, F.wave);
            } else if (type == T_RESN) {
                const bool down = K == FFD;
                const pg8::bf16_t* Ap = down ? (ctxdown ? (const pg8::bf16_t*)(ws + WS_HC) - (size_t)M_LAT * FFD : (const pg8::bf16_t*)(ws + WS_H)) : (const pg8::bf16_t*)(ws + WS_MIX);
                const pg8::bf16_t* Bp = down ? (const pg8::bf16_t*)(ws + WS_WDN) + (size_t)el * DM * FFD : (const pg8::bf16_t*)(ws + WS_WOUT) + (size_t)el * DM * DM;
                pg8::Gemm g{Ap, Bp, M_ALL, DM, K};
                void* xl_out = (!down && el == NLAYER - 1) ? (void*)(ws + WS_XB2) : (void*)A.out;
                pg8::EpiRes<true> E{(const void*)A.out, xl_out, ws, el * 9 * 6144 + (down ? 5120 : 2048), down ? A.in[6] + (el + 1) * DM : A.in[7] + el * DM, down ? (el + 1) * 9 * 6144 + 1024 : el * 9 * 6144 + 4096};
                pg8::gemm_phase<pg8::EpiRes<true>, pg8::Sched2, true, true>(F.lds, g, S, E, F.wave);
                if (sigw >= 0) {
                    pg8::Unit u0; if (S.next(0, u0)) {
                    asm volatile("s_waitcnt vmcnt(0)" ::: "memory"); __syncthreads();
                    if (F.wave == 0 && lane_id() == 0) { __builtin_amdgcn_fence(__ATOMIC_RELEASE, "agent"); asm volatile("s_waitcnt vmcnt(0)" ::: "memory");
                        __hip_atomic_fetch_add((unsigned*)(ws + WS_CTL) + sigw + 64 * (cid & 7), 1u, __ATOMIC_RELAXED, __HIP_MEMORY_SCOPE_AGENT); } }
                }
            } else {
                pg8::Gemm g{(const pg8::bf16_t*)(ws + WS_H), (const pg8::bf16_t*)(ws + WS_WDN) + (size_t)l * DM * FFD, M_ALL, DM, FFD};
                pg8::EpiRes<false> E{(const void*)(ws + WS_XB2), (void*)A.out, ws, l * 9 * 6144 + 5120, nullptr, 0};
                pg8::gemm_phase<pg8::EpiRes<false>, pg8::Sched2, true, true>(F.lds, g, S, E, F.wave);
            }
        }
        if (ph + 1 < hi) { XcdBarrier bar; bar.bar = (unsigned*)(args.ws + WS_CTL) + CW_BAR; bar.x = xb_xcc_id(); bar.st = MISC + 8; xcd_barrier(bar); }
    }
#if PROBE_S
    if (blockIdx.x == 0 && F0.wave == 0) { const unsigned long long t0 = __builtin_amdgcn_s_memrealtime(); const unsigned long long dl = 5ull * (MISC[40 + ((PROBE_S) & 255)] - MISC[40 + ((PROBE_S) >> 8)]);
        while (__builtin_amdgcn_s_memrealtime() - t0 < dl) __builtin_amdgcn_s_sleep(32); }
#endif
#if PROBE_A
    if (blockIdx.x == 0 && F0.wave == 0) { const unsigned long long t0 = __builtin_amdgcn_s_memrealtime(); MISC[16 + N_PHASES] = (unsigned)t0; unsigned long long dl = 0;
        for (int p = 0; p < N_PHASES; ++p) if ((PROBE_A >> p) & 1) dl += 5ull * (MISC[17 + p] - MISC[16 + p]);
        while (__builtin_amdgcn_s_memrealtime() - t0 < dl) __builtin_amdgcn_s_sleep(32); }
#endif
}
static_assert(EWS_MOD == WS_MOD && EWS_BIN == WS_BIN && EWS_BGU == WS_BGU && EWS_ROPE == WS_ROPE && EWS_SSQ == WS_SSQ && EWS_A == WS_A && EWS_XC == WS_XC && EWS_QB == WS_QB && EWS_KB == WS_KB && EWS_VB == WS_VB && EWS_TC == WS_TC && EWS_T == WS_T && EWS_H == WS_H && EWS_HC == WS_HC, "epilogue offsets vs d_ws map");
#ifndef MK_PER_PHASE
#define MK_PER_PHASE 0
#endif
extern "C" void kernel_launch(void* const* d_in, const int* in_sizes, int n_in, void* d_out, int out_size, void* d_ws, size_t ws_size, hipStream_t stream) {
    static int grid = 0;
    if (grid == 0) {
        if (n_in != 21 || in_sizes[0] != M_LAT * DM || out_size != M_LAT * DM || ws_size < WS_END) { fprintf(stderr, "kernel_launch: unexpected shapes (n_in %d, in0 %d, out %d, ws %zu)\n", n_in, n_in > 0 ? in_sizes[0] : -1, out_size, ws_size); grid = -1; return; }
        int dev = 0, cus = 0, per_cu = 0;
        if (hipGetDevice(&dev) != hipSuccess || hipDeviceGetAttribute(&cus, hipDeviceAttributeMultiprocessorCount, dev) != hipSuccess) { grid = -1; return; }
        if (hipFuncSetAttribute((const void*)fwd_kernel, hipFuncAttributeMaxDynamicSharedMemorySize, LDS_BYTES) != hipSuccess) { fprintf(stderr, "kernel_launch: hipFuncSetAttribute failed\n"); grid = -1; return; }
        if (hipOccupancyMaxActiveBlocksPerMultiprocessor(&per_cu, (const void*)fwd_kernel, NWAVES * 64, LDS_BYTES) != hipSuccess || per_cu < 1) { fprintf(stderr, "kernel_launch: occupancy query reports %d\n", per_cu); }
        (void)hipGetLastError();
        grid = cus;
    }
    if (grid < 0) return;
    (void)hipMemsetAsync((char*)d_ws + WS_CTL, 0, CTL_ZERO_BYTES, stream);
    Args a{};
    for (int i = 0; i < 21; ++i) a.in[i] = (const float*)d_in[i];
    a.out = (float*)d_out; a.ws = (unsigned char*)d_ws;
#if MK_PER_PHASE
#ifndef REP_MASK
#define REP_MASK 0
#endif
    for (int ph = 0; ph < N_PHASES; ++ph) { a.ph_lo = ph; a.ph_hi = ph + 1; for (int rep = 0; rep < (((REP_MASK) >> ph) & 1) + 1; ++rep) hipLaunchKernelGGL(fwd_kernel, dim3(grid), dim3(NWAVES * 64), LDS_BYTES, stream, a); }
#else
    a.ph_lo = 0; a.ph_hi = N_PHASES; hipLaunchKernelGGL(fwd_kernel, dim3(grid), dim3(NWAVES * 64), LDS_BYTES, stream, a);
#endif
    const hipError_t le = hipPeekAtLastError();
    if (le != hipSuccess) fprintf(stderr, "kernel_launch: launch failed: %s\n", hipGetErrorName(le));
}
```

```cpp
#define MK_PER_PHASE 0
#include <hip/hip_runtime.h>
#include <cstdio>
#include <cstdint>
#include <math.h>
constexpr size_t EWS_MOD = 64 * 1024, EWS_BIN = 512 * 1024, EWS_BGU = (1u << 20) + 768 * 1024, EWS_ROPE = EWS_BGU + 512 * 1024, EWS_SSQ = 5u << 20, EWS_A = 56u << 20, EWS_XC = 92u << 20,
                 EWS_QB = 100u << 20, EWS_KB = 118u << 20, EWS_VB = 136u << 20, EWS_TC = 186u << 20, EWS_T = 154u << 20, EWS_H = 100u << 20, EWS_HC = 226u << 20;
namespace pg8 {
#define PG8_LAS __attribute__((address_space(3)))
typedef unsigned short bf16_t;
typedef short bf16x8 __attribute__((ext_vector_type(8)));
typedef float f32x4 __attribute__((ext_vector_type(4)));
typedef unsigned u32x4 __attribute__((ext_vector_type(4)));
constexpr int BM = 256, BK = 64, HALF = 128, HTB = HALF * BK * 2  , STAGE_BYTES = 8 * HTB, NXCD = 8, WGM = 2;

__host__ __device__ __forceinline__ int lds_byte(int r, int c) { const int st = (r >> 4) * 2 + (c >> 5), rr = r & 15, cc = c & 31, ob = rr * 64 + cc * 2; return st * 1024 + (ob ^ (((ob >> 9) & 1) << 5)); }
__host__ __device__ __forceinline__ void stage_rc(int b, int& R, int& C) { const int st = b / 1024, sb = b % 1024, swz = sb ^ (((sb >> 9) & 1) << 5); R = (st >> 1) * 16 + swz / 64; C = (st & 1) * 32 + (swz % 64) / 2; }
__host__ __device__ __forceinline__ int perm32(int rho) { const int n = rho >> 4, i = rho & 15; return 8 * (i >> 2) + 4 * n + (i & 3); }

struct Unit { int pm, pn; };
struct Gemm { const bf16_t* A; const bf16_t* Bt; int M, N, K; };

struct StaticOrder {
    int nM, nN, nwg, G, c;
    __host__ __device__ void init(int M, int N, int G_, int c_) { nM = M / BM; nN = N / BM; nwg = nM * nN; G = G_; c = c_; }
    __host__ __device__ bool next(int i, Unit& u) const {
        const long L = (long)i * G + c; if (L >= nwg) return false;
        int wgid = (int)L; { const int q = nwg / NXCD, r = nwg % NXCD, xcd = wgid % NXCD, off = wgid / NXCD; wgid = (xcd < r ? xcd * (q + 1) : r * (q + 1) + (xcd - r) * q) + off; }
        const int nig = WGM * nN, gid = wgid / nig, fm = gid * WGM, gsz = (nM - fm) < WGM ? (nM - fm) : WGM;
        u.pm = fm + ((wgid % nig) % gsz); u.pn = (wgid % nig) / gsz; return true;
    }
    __device__ __forceinline__ void a_ready(const Unit&) const {}
    __device__ __forceinline__ void done(const Unit&) const {}
};

struct Sched2 {
    int nMa, nNa, nA, pmB, nMb, pnB, nNb, nB, G, c, ns = 0, is = 0, wgm = WGM;
    __device__ void init(int nMa_, int nNa_, int pmB_, int nMb_, int pnB_, int nNb_, int G_, int c_, int rot) { nMa = nMa_; nNa = nNa_; nA = nMa * nNa; pmB = pmB_; nMb = nMb_; pnB = pnB_; nNb = nNb_; nB = nMb * nNb; G = G_; c = (c_ + rot) % G_; }
    __device__ bool next(int i, Unit& u) const {
        long L;
        if (ns == 0 || i < is) { if (ns != 0 && i >= is && c < ns) return false; L = (long)i * G + c; }
        else { if (c < ns) return false; L = (long)is * G + (long)(i - is) * (G - ns) + (c - ns); }
        if (L >= nA + nB) return false;
        if (L < nA) {
            int wgid = (int)L; { const int q = nA / NXCD, r = nA % NXCD, xcd = wgid % NXCD, off = wgid / NXCD; wgid = (xcd < r ? xcd * (q + 1) : r * (q + 1) + (xcd - r) * q) + off; }
            const int nig = wgm * nNa, gid = wgid / nig, fm = gid * wgm, gsz = (nMa - fm) < wgm ? (nMa - fm) : wgm;
            u.pm = fm + ((wgid % nig) % gsz); u.pn = (wgid % nig) / gsz;
        } else { const int r = (int)L - nA; u.pm = pmB + r % nMb; u.pn = pnB + r / nMb; }
        return true;
    }
    __device__ __forceinline__ void a_ready(const Unit&) const {}
    __device__ __forceinline__ void done(const Unit&) const {}
};
__device__ __forceinline__ unsigned cvt_pk_bf16(float lo, float hi) { unsigned r; asm volatile("v_cvt_pk_bf16_f32 %0, %1, %2" : "=v"(r) : "v"(lo), "v"(hi)); return r; }
typedef unsigned u32x2 __attribute__((ext_vector_type(2)));
__device__ __forceinline__ u32x2 pk4(f32x4 v) { u32x2 w; w.x = cvt_pk_bf16(v[0], v[1]); w.y = cvt_pk_bf16(v[2], v[3]); return w; }
#ifndef WT_STORES
#define WT_STORES 0
#endif
#ifndef NT_STORES
#define NT_STORES 0
#endif
__device__ __forceinline__ void st8(void* p, u32x2 v) {
#if WT_STORES
    __hip_atomic_store((unsigned long long*)p, ((unsigned long long)v.y << 32) | v.x, __ATOMIC_RELAXED, __HIP_MEMORY_SCOPE_AGENT);
#elif NT_STORES
    __builtin_nontemporal_store(v, (u32x2*)p);
#else
    *(u32x2*)p = v;
#endif
}
__device__ __forceinline__ float rowsum4(float s) {
    { const unsigned u = __builtin_bit_cast(unsigned, s); auto a = __builtin_amdgcn_permlane16_swap(u, u, false, false); const unsigned a0 = a[0], a1 = a[1]; s = __builtin_bit_cast(float, a0) + __builtin_bit_cast(float, a1); }
    { const unsigned u = __builtin_bit_cast(unsigned, s); auto b = __builtin_amdgcn_permlane32_swap(u, u, false, false); const unsigned b0 = b[0], b1 = b[1]; s = __builtin_bit_cast(float, b0) + __builtin_bit_cast(float, b1); }
    return s;
}
__device__ __forceinline__ float dot4(f32x4 v) { return (v[0] * v[0] + v[1] * v[1]) + (v[2] * v[2] + v[3] * v[3]); }
constexpr int BT_F = (140288 - 131072) / 4, ET_F = (147456 - 131072) / 4;
constexpr int M_LAT_TILES = 64;
constexpr float QSCALE = 0.125f * 1.4426950408889634f;
constexpr float ZS_LAT = 1.0f / 512.0f;
constexpr float ZS_CTX = 0.005524271728019903f;

struct EpiIn {
    static constexpr bool PERM = false, AFTER_DRAIN = false;
    unsigned char* ws; const PG8_LAS float* rtab;
    __device__ __forceinline__ void operator()(const f32x4 (&acc)[2][2][4][2], const Unit& u, int ui, int wr, int wc, int fr, int fq) const {
        const int pm = u.pm, pn = u.pn; const bool lat = pm < M_LAT_TILES; const int bm = lat ? (pm >> 3) : 8;
        const PG8_LAS float* rope = rtab + ET_F;
        bf16_t* QB = (bf16_t*)(ws + EWS_QB); bf16_t* KB = (bf16_t*)(ws + EWS_KB); bf16_t* VB = (bf16_t*)(ws + EWS_VB); bf16_t* T = (bf16_t*)(ws + EWS_T); bf16_t* Tc = (bf16_t*)(ws + EWS_TC);
        const PG8_LAS float* bp = rtab + BT_F + ui * 256 + wc * 32 + fq * 4;
        f32x4 bv[2][2];
#pragma unroll
        for (int bj = 0; bj < 2; ++bj)
#pragma unroll
            for (int n = 0; n < 2; ++n) bv[bj][n] = *(const PG8_LAS f32x4*)(bp + bj * 128 + n * 16);
        const PG8_LAS float* rt = rtab + ui * 256 + wr * 64 + fr;
        if (pn < 4) {
            const PG8_LAS float* gp = rope + 3072 + (pn < 2 ? 0 : 64) + fq * 4; const float qs = pn < 2 ? QSCALE : 1.f;
            f32x4 gv[2][2];
#pragma unroll
            for (int bj = 0; bj < 2; ++bj)
#pragma unroll
                for (int n = 0; n < 2; ++n) gv[bj][n] = *(const PG8_LAS f32x4*)(gp + bj * 32 + n * 16) * qs;
            bf16_t* dst = (pn < 2 ? QB : KB) + (pn & 1) * 256 + wc * 64 + fq * 4;
#pragma unroll
            for (int ai = 0; ai < 2; ++ai)
#pragma unroll
                for (int m = 0; m < 4; ++m) {
                    const int rl = ai * 128 + wr * 64 + m * 16 + fr, row = pm * 256 + rl; const float r = rt[ai * 128 + m * 16];
                    f32x4 v[2][2]; float ssq = 0.f;
#pragma unroll
                    for (int bj = 0; bj < 2; ++bj)
#pragma unroll
                        for (int n = 0; n < 2; ++n) { v[bj][n] = acc[ai][bj][m][n] * r + bv[bj][n]; ssq += dot4(v[bj][n]); }
                    ssq = rowsum4(ssq);
                    const float rn = __builtin_amdgcn_rsqf(ssq * (1.0f / 64.0f) + 1e-6f);
#pragma unroll
                    for (int bj = 0; bj < 2; ++bj)
#pragma unroll
                        for (int n = 0; n < 2; ++n) v[bj][n] = v[bj][n] * rn * gv[bj][n];
                    if (lat) { const int pos = row & 2047;
#pragma unroll
                        for (int bj = 0; bj < 2; ++bj) { const PG8_LAS float* cp = rope + (bj == 0 ? (pos >> 6) : 32 + (pos & 63)) * 16 + fq * 4; const f32x4 c4 = *(const PG8_LAS f32x4*)cp, s4 = *(const PG8_LAS f32x4*)(cp + 1536); const f32x4 t1 = v[bj][0], t2 = v[bj][1];
                            v[bj][0] = t1 * c4 - t2 * s4; v[bj][1] = t2 * c4 + t1 * s4; } }
#pragma unroll
                    for (int bj = 0; bj < 2; ++bj)
#pragma unroll
                        for (int n = 0; n < 2; ++n) *(u32x2*)(dst + (size_t)row * 512 + bj * 32 + n * 16) = pk4(v[bj][n]);
                }
        } else if (pn < 6) {
            bf16_t* dst = VB + (pn - 4) * 256 + wc * 32 + fq * 4;
#pragma unroll
            for (int ai = 0; ai < 2; ++ai)
#pragma unroll
                for (int m = 0; m < 4; ++m) {
                    const int rl = ai * 128 + wr * 64 + m * 16 + fr, row = pm * 256 + rl; const float r = rt[ai * 128 + m * 16];
#pragma unroll
                    for (int bj = 0; bj < 2; ++bj)
#pragma unroll
                        for (int n = 0; n < 2; ++n) *(u32x2*)(dst + (size_t)row * 512 + bj * 128 + n * 16) = pk4(acc[ai][bj][m][n] * r + bv[bj][n]);
                }
        } else {
            const int g = pn - 6; const float zs = lat ? ZS_LAT : ZS_CTX;
            const int b = lat ? (pm >> 3) : (pm - M_LAT_TILES);
            bf16_t* tb = (lat ? T + (size_t)((b * 8 + (pm & 7)) * 512) * 512 : Tc + (size_t)(b * 512) * 512) + (size_t)(g * 128 + wc * 32 + fq * 4) * 512;
#pragma unroll
            for (int ai = 0; ai < 2; ++ai)
#pragma unroll
                for (int m = 0; m < 4; ++m) {
                    const int rl = ai * 128 + wr * 64 + m * 16 + fr; const float r = rt[ai * 128 + m * 16];
#pragma unroll
                    for (int n = 0; n < 2; ++n) { const f32x4 re = (acc[ai][0][m][n] * r + bv[0][n]) * zs, im = (acc[ai][1][m][n] * r + bv[1][n]) * zs;
#pragma unroll
                        for (int i = 0; i < 4; ++i) *(unsigned*)(tb + (size_t)(n * 16 + i) * 512 + rl * 2) = cvt_pk_bf16(re[i], im[i]); }
                }
        }
    }
};
typedef _Float16 h16x2 __attribute__((ext_vector_type(2)));
__device__ __forceinline__ unsigned pkh2(float a, float b) { const h16x2 h = {(_Float16)a, (_Float16)b}; return __builtin_bit_cast(unsigned, h); }
__device__ __forceinline__ u32x2 pkh4(f32x4 v) { u32x2 w; w.x = pkh2(v[0], v[1]); w.y = pkh2(v[2], v[3]); return w; }
__device__ __forceinline__ f32x4 unh4(u32x2 w) { const unsigned lo = w.x, hi = w.y; const h16x2 a = __builtin_bit_cast(h16x2, lo), b = __builtin_bit_cast(h16x2, hi);     return (f32x4){(float)a[0], (float)a[1], (float)b[0], (float)b[1]}; }
template <bool NEXT> struct EpiRes {
    static constexpr bool PERM = false, AFTER_DRAIN = false;
    const void* xl_in; void* xl_out;
    unsigned char* ws; int gate_off;
    const float* ng; int nsc_off;
    __device__ __forceinline__ void operator()(const f32x4 (&acc)[2][2][4][2], const Unit& u, int ui, int wr, int wc, int fr, int fq) const {
        const int pm = u.pm, pn = u.pn; const bool lat = pm < M_LAT_TILES; const int bm = lat ? (pm >> 3) : 8; const int col0 = pn * 256 + wc * 32 + fq * 4;
        const float* gate = (const float*)(ws + EWS_MOD) + gate_off; const float* nsc = (const float*)(ws + EWS_MOD) + nsc_off; bf16_t* A = (bf16_t*)(ws + EWS_A); float* ssq = (float*)(ws + EWS_SSQ);
        const _Float16* xin = lat ? (const _Float16*)xl_in + (size_t)pm * 256 * 1024 : (const _Float16*)(ws + EWS_XC) + (size_t)(pm - M_LAT_TILES) * 256 * 1024;
        _Float16* xout = lat ? (_Float16*)xl_out + (size_t)pm * 256 * 1024 : (_Float16*)(ws + EWS_XC) + (size_t)(pm - M_LAT_TILES) * 256 * 1024;
        float* xoutf = (float*)xl_out + (size_t)pm * 256 * 1024;
        float ssq_[2][4];
#pragma unroll
        for (int ai = 0; ai < 2; ++ai)
#pragma unroll
            for (int m = 0; m < 4; ++m) ssq_[ai][m] = 0.f;
        f32x4 ga[2][2], gv[2][2]; u32x2 preA[4][2], preB[4][2];
        auto loadx = [&](int g, u32x2 (&p)[4][2]) __attribute__((always_inline)) { const int bj = g >> 1, ai = g & 1;
#pragma unroll
            for (int m = 0; m < 4; ++m)
#pragma unroll
                for (int n = 0; n < 2; ++n) p[m][n] = *(const u32x2*)(xin + (size_t)(ai * 128 + wr * 64 + m * 16 + fr) * 1024 + col0 + bj * 128 + n * 16); };
        auto loadg = [&](int bj) __attribute__((always_inline)) {
#pragma unroll
            for (int n = 0; n < 2; ++n) { const int c = col0 + bj * 128 + n * 16; ga[bj][n] = *(const f32x4*)(gate + bm * 6144 + c);
                if (NEXT) gv[bj][n] = *(const f32x4*)(ng + c) * (*(const f32x4*)(nsc + bm * 6144 + c) + 1.0f); } };
        auto proc = [&](int g, const u32x2 (&p)[4][2]) __attribute__((always_inline)) { const int bj = g >> 1, ai = g & 1;
#pragma unroll
            for (int m = 0; m < 4; ++m) {
                const int rl = ai * 128 + wr * 64 + m * 16 + fr; const size_t row = (size_t)pm * 256 + rl;
#pragma unroll
                for (int n = 0; n < 2; ++n) { const size_t off = (size_t)rl * 1024 + col0 + bj * 128 + n * 16; const f32x4 xn = unh4(p[m][n]) + ga[bj][n] * acc[ai][bj][m][n];
                    if (NEXT) *(u32x2*)(xout + off) = pkh4(xn); else *(f32x4*)(xoutf + off) = xn;
                    if (NEXT) { ssq_[ai][m] += dot4(xn); *(u32x2*)(A + row * 1024 + col0 + bj * 128 + n * 16) = pk4(xn * gv[bj][n]); } }
            }
            asm volatile("" ::: "memory"); };
        loadx(0, preA); loadg(0); loadx(1, preB); asm volatile("" ::: "memory");
        proc(0, preA); loadg(1); loadx(2, preA); asm volatile("" ::: "memory");
        proc(1, preB); loadx(3, preB); asm volatile("" ::: "memory");
        proc(2, preA); proc(3, preB);
        if (NEXT) {
#pragma unroll
            for (int ai = 0; ai < 2; ++ai)
#pragma unroll
                for (int m = 0; m < 4; ++m) { const float s = rowsum4(ssq_[ai][m]); if (fq == 0) ssq[((size_t)pm * 256 + ai * 128 + wr * 64 + m * 16 + fr) * 16 + pn * 4 + wc] = s; }
        }
    }
};
struct EpiGU {
    static constexpr bool PERM = false, AFTER_DRAIN = false;
    unsigned char* ws; const PG8_LAS float* rtab;
    __device__ __forceinline__ void operator()(const f32x4 (&acc)[2][2][4][2], const Unit& u, int ui, int wr, int wc, int fr, int fq) const {
        const int pm = u.pm, pn = u.pn; const int bm = pm < M_LAT_TILES ? (pm >> 3) : 8;
        bf16_t* H = (bf16_t*)(ws + EWS_H);
        const PG8_LAS float* bp = rtab + BT_F + ui * 256 + wc * 32 + fq * 4;
        f32x4 bg[2], bu[2];
#pragma unroll
        for (int n = 0; n < 2; ++n) { bg[n] = *(const PG8_LAS f32x4*)(bp + n * 16); bu[n] = *(const PG8_LAS f32x4*)(bp + 128 + n * 16); }
        const PG8_LAS float* rt = rtab + ui * 256 + wr * 64 + fr;
        if (pm >= M_LAT_TILES) H = (bf16_t*)(ws + EWS_HC) - (size_t)16384 * 2816;
        bf16_t* dst = H + pn * 128 + wc * 32 + fq * 4;
#pragma unroll
        for (int ai = 0; ai < 2; ++ai)
#pragma unroll
            for (int m = 0; m < 4; ++m) {
                const int rl = ai * 128 + wr * 64 + m * 16 + fr; const size_t row = (size_t)pm * 256 + rl; const float r = rt[ai * 128 + m * 16];
#pragma unroll
                for (int n = 0; n < 2; ++n) { const f32x4 gg = acc[ai][0][m][n] * r + bg[n], uu = acc[ai][1][m][n] * r + bu[n]; f32x4 h;
#pragma unroll
                    for (int i = 0; i < 4; ++i) h[i] = gg[i] * __builtin_amdgcn_rcpf(1.0f + __builtin_amdgcn_exp2f(-1.4426950408889634f * gg[i])) * uu[i];
                    st8(dst + row * 2816 + n * 16, pk4(h)); }
            }
    }
};
struct EpiDft {
    static constexpr bool PERM = true, AFTER_DRAIN = false;
    bf16_t* MIX;
    __device__ __forceinline__ void operator()(const f32x4 (&acc)[2][2][4][2], const Unit& u, int ui, int wr, int wc, int fr, int fq) const {
        const int pn = u.pn;
#pragma unroll
        for (int bj = 0; bj < 2; ++bj) {
            const int c = pn * 256 + bj * 128 + wc * 32 + fq * 8; int rowbase, rstride, ch;
            if (pn < 128) { const int b = c >> 12, r = (c >> 9) & 7; ch = c & 511; rowbase = b * 2048 + r; rstride = 8; }
            else { const int c2 = c - 32768; const int b = c2 >> 9; ch = c2 & 511; rowbase = 16384 + b * 256; rstride = 1; }
#pragma unroll
            for (int ai = 0; ai < 2; ++ai)
#pragma unroll
                for (int m = 0; m < 4; ++m) { const int mm = ai * 128 + wr * 64 + m * 16 + fr; const size_t row = (size_t)rowbase + (size_t)mm * rstride;
                    const f32x4 v0 = acc[ai][bj][m][0], v1 = acc[ai][bj][m][1]; u32x4 w; w.x = cvt_pk_bf16(v0[0], v0[1]); w.y = cvt_pk_bf16(v0[2], v0[3]); w.z = cvt_pk_bf16(v1[0], v1[1]); w.w = cvt_pk_bf16(v1[2], v1[3]);
                    *(u32x4*)(MIX + row * 1024 + 512 + ch) = w; }
        }
    }
};
template <class Epi, class Sched, bool ALIGN_EPI = false, bool SP2 = false>
__device__ __forceinline__ void gemm_phase(PG8_LAS unsigned char* lds, const Gemm g, const Sched& S, const Epi& E, int wave_) {
    unsigned z_ = 0u; asm volatile("" : "+v"(z_)); int tid_ = wave_ * 64 + (int)__builtin_amdgcn_mbcnt_hi(~0u, __builtin_amdgcn_mbcnt_lo(~0u, z_)); asm volatile("" : "+v"(tid_));
    const int tid = tid_, wid = __builtin_amdgcn_readfirstlane(tid >> 6), lane = tid & 63, wr = wid >> 2, wc = wid & 3, fr = lane & 15, fq = lane >> 4;
    const int K = g.K, nt = K / BK;
    unsigned voffA[2], voffB[2];
#pragma unroll
    for (int i = 0; i < 2; ++i) { int R, C; stage_rc(tid * 16 + i * 8192, R, C); const int Rb = Epi::PERM ? ((R & ~31) + perm32(R & 31)) : R;
        voffA[i] = (unsigned)(R * K + C) * 2u; voffB[i] = (unsigned)(Rb * K + C) * 2u; }
    const size_t kstep = (size_t)(BK * 2);
    const size_t hstep = (size_t)HALF * K * 2;
    const size_t tstep = 2 * hstep;
    const unsigned ldsw = (unsigned)wid * 1024u;
    const int aoff = lds_byte(wr * 64 + fr, fq * 8), boff = lds_byte(wc * 32 + fr, fq * 8);
#define PG8_SA(b, h) (((b) * 2 + (h)) * HTB)
#define PG8_SB(b, h) ((4 + (b) * 2 + (h)) * HTB)
#define PG8_STAGE(bufoff, gbase, voff) do { _Pragma("unroll") for (int _i = 0; _i < 2; ++_i) \
        __builtin_amdgcn_global_load_lds((const unsigned*)((const char*)(gbase) + (voff)[_i]), (PG8_LAS unsigned*)(lds + (bufoff) + ldsw + _i * 8192), 16, 0, 0); } while (0)
#define PG8_LDA(dst, b, h) do { _Pragma("unroll") for (int m = 0; m < 4; ++m) _Pragma("unroll") for (int k = 0; k < 2; ++k) dst[m][k] = *(const PG8_LAS bf16x8*)(lds + PG8_SA(b, h) + aoff + m * 2048 + k * 1024); } while (0)
#define PG8_LDB(dst, b, h) do { _Pragma("unroll") for (int n = 0; n < 2; ++n) _Pragma("unroll") for (int k = 0; k < 2; ++k) dst[n][k] = *(const PG8_LAS bf16x8*)(lds + PG8_SB(b, h) + boff + n * 2048 + k * 1024); } while (0)
#define PG8_MMA(ai, bj, At, Bt) do { __builtin_amdgcn_s_setprio(1); _Pragma("unroll") for (int m = 0; m < 4; ++m) _Pragma("unroll") for (int n = 0; n < 2; ++n) _Pragma("unroll") for (int k = 0; k < 2; ++k) \
        acc[ai][bj][m][n] = __builtin_amdgcn_mfma_f32_16x16x32_bf16(Bt[n][k], At[m][k], acc[ai][bj][m][n], 0, 0, 0); __builtin_amdgcn_s_setprio(0); } while (0)
#define PG8_WAIT_V(n) asm volatile("s_waitcnt vmcnt(" #n ")" ::: "memory")
#define PG8_WAIT_L(n) asm volatile("s_waitcnt lgkmcnt(" #n ")" ::: "memory")
#define PG8_BAR __builtin_amdgcn_s_barrier()
#define PG8_SCHED __builtin_amdgcn_sched_barrier(0)
    Unit cur, nxt; int ui = 0;
    if (!S.next(0, cur)) return;
    f32x4 acc[2][2][4][2];
#pragma unroll
    for (int a = 0; a < 2; ++a)
#pragma unroll
        for (int b = 0; b < 2; ++b)
#pragma unroll
            for (int m = 0; m < 4; ++m)
#pragma unroll
                for (int n = 0; n < 2; ++n) acc[a][b][m][n] = (f32x4){0.f, 0.f, 0.f, 0.f};
    bf16x8 At[4][2], B0[2][2], B1[2][2];
    const char* cA = (const char*)g.A + (size_t)cur.pm * tstep; const char* cB = (const char*)g.Bt + (size_t)cur.pn * tstep;
    S.a_ready(cur);
    if constexpr (SP2) {
        PG8_STAGE(PG8_SB(0, 0), cB, voffB); PG8_STAGE(PG8_SB(0, 1), cB + hstep, voffB); PG8_STAGE(PG8_SA(0, 0), cA, voffA); PG8_STAGE(PG8_SA(0, 1), cA + hstep, voffA);
        if (wr == 1) PG8_BAR;
        PG8_WAIT_V(2); PG8_BAR;
        PG8_STAGE(PG8_SB(1, 0), cB + kstep, voffB); PG8_STAGE(PG8_SA(1, 0), cA + kstep, voffA); PG8_STAGE(PG8_SB(1, 1), cB + hstep + kstep, voffB);
        PG8_WAIT_V(6); PG8_BAR;
    } else {
        PG8_STAGE(PG8_SB(0, 0), cB, voffB); PG8_STAGE(PG8_SA(0, 0), cA, voffA); PG8_STAGE(PG8_SB(0, 1), cB + hstep, voffB); PG8_STAGE(PG8_SA(0, 1), cA + hstep, voffA);
        if (wr == 1) PG8_BAR;
        PG8_WAIT_V(4); PG8_BAR;
        PG8_STAGE(PG8_SB(1, 0), cB + kstep, voffB); PG8_STAGE(PG8_SA(1, 0), cA + kstep, voffA); PG8_STAGE(PG8_SB(1, 1), cB + hstep + kstep, voffB);
        PG8_WAIT_V(6); PG8_BAR;
    }
    for (;;) {
        const bool has_next = S.next(ui + 1, nxt);
        const char* nA = has_next ? (const char*)g.A + (size_t)nxt.pm * tstep : cA; const char* nB = has_next ? (const char*)g.Bt + (size_t)nxt.pn * tstep : cB;
        for (int t = 0; t < nt; t += 2) {
            const bool last = (t == nt - 2);
            const char* a1 = cA + (size_t)(t + 1) * kstep;
            const char* a2 = last ? nA : cA + (size_t)(t + 2) * kstep; const char* b2 = last ? nB : cB + (size_t)(t + 2) * kstep;
            const char* a3 = a2 + kstep; const char* b3 = b2 + kstep;
            if (last && has_next) S.a_ready(nxt);
            if constexpr (SP2) {
            PG8_LDB(B0, 0, 0); PG8_LDB(B1, 0, 1); PG8_SCHED; PG8_LDA(At, 0, 0); PG8_STAGE(PG8_SA(1, 1), a1 + hstep, voffA);
            PG8_WAIT_V(8); PG8_WAIT_L(0); PG8_BAR; PG8_MMA(0, 0, At, B0); PG8_MMA(0, 1, At, B1); PG8_BAR; PG8_SCHED;
            PG8_LDA(At, 0, 1); PG8_STAGE(PG8_SB(0, 0), b2, voffB); PG8_STAGE(PG8_SB(0, 1), b2 + hstep, voffB); PG8_STAGE(PG8_SA(0, 0), a2, voffA);
            PG8_WAIT_V(8); PG8_WAIT_L(0); PG8_BAR; PG8_MMA(1, 0, At, B0); PG8_MMA(1, 1, At, B1); PG8_BAR; PG8_SCHED;
            PG8_LDB(B0, 1, 0); PG8_LDB(B1, 1, 1); PG8_SCHED; PG8_LDA(At, 1, 0); PG8_STAGE(PG8_SA(0, 1), a2 + hstep, voffA);
            PG8_WAIT_V(8); PG8_WAIT_L(0); PG8_BAR; PG8_MMA(0, 0, At, B0); PG8_MMA(0, 1, At, B1); PG8_BAR; PG8_SCHED;
            PG8_LDA(At, 1, 1); PG8_STAGE(PG8_SB(1, 0), b3, voffB); PG8_STAGE(PG8_SB(1, 1), b3 + hstep, voffB); PG8_STAGE(PG8_SA(1, 0), a3, voffA);
            PG8_WAIT_V(8); PG8_WAIT_L(0); PG8_BAR; PG8_MMA(1, 0, At, B0); PG8_MMA(1, 1, At, B1); PG8_BAR; PG8_SCHED;
            } else {
            PG8_LDB(B0, 0, 0); PG8_SCHED; PG8_LDA(At, 0, 0); PG8_STAGE(PG8_SA(1, 1), a1 + hstep, voffA);
            PG8_WAIT_L(8); PG8_BAR; PG8_WAIT_L(0); PG8_MMA(0, 0, At, B0); PG8_BAR; PG8_SCHED;
            PG8_LDB(B1, 0, 1); PG8_STAGE(PG8_SB(0, 0), b2, voffB);
            PG8_BAR; PG8_WAIT_L(0); PG8_MMA(0, 1, At, B1); PG8_BAR;
            PG8_LDA(At, 0, 1); PG8_STAGE(PG8_SA(0, 0), a2, voffA);
            PG8_BAR; PG8_WAIT_L(0); PG8_MMA(1, 0, At, B0); PG8_BAR; PG8_SCHED;
            PG8_STAGE(PG8_SB(0, 1), b2 + hstep, voffB);
            PG8_WAIT_V(6); PG8_BAR; PG8_MMA(1, 1, At, B1); PG8_BAR;
            PG8_LDB(B0, 1, 0); PG8_SCHED; PG8_LDA(At, 1, 0); PG8_STAGE(PG8_SA(0, 1), a2 + hstep, voffA);
            PG8_WAIT_L(8); PG8_BAR; PG8_WAIT_L(0); PG8_MMA(0, 0, At, B0); PG8_BAR; PG8_SCHED;
            PG8_LDB(B1, 1, 1); PG8_STAGE(PG8_SB(1, 0), b3, voffB);
            PG8_BAR; PG8_WAIT_L(0); PG8_MMA(0, 1, At, B1); PG8_BAR;
            PG8_LDA(At, 1, 1); PG8_STAGE(PG8_SA(1, 0), a3, voffA);
            PG8_BAR; PG8_WAIT_L(0); PG8_MMA(1, 0, At, B0); PG8_BAR; PG8_SCHED;
            PG8_STAGE(PG8_SB(1, 1), b3 + hstep, voffB);
            PG8_WAIT_V(6); PG8_BAR; PG8_MMA(1, 1, At, B1); PG8_BAR;
            }
        }
        if constexpr (ALIGN_EPI) { if (wr == 0) PG8_BAR; }
        if constexpr (!Epi::AFTER_DRAIN) { int fr_ = fr, fq_ = fq; asm volatile("" : "+v"(fr_), "+v"(fq_)); E(acc, cur, ui, wr, wc, fr_, fq_); S.done(cur); }
        if (!has_next) break;
#pragma unroll
        for (int a = 0; a < 2; ++a)
#pragma unroll
            for (int b = 0; b < 2; ++b)
#pragma unroll
                for (int m = 0; m < 4; ++m)
#pragma unroll
                    for (int n = 0; n < 2; ++n) acc[a][b][m][n] = (f32x4){0.f, 0.f, 0.f, 0.f};
        cur = nxt; cA = nA; cB = nB; ++ui;
        if constexpr (ALIGN_EPI) { if (wr == 1) PG8_BAR; }
    }
    PG8_WAIT_V(0);
    if constexpr (!ALIGN_EPI) { if (wr == 0) PG8_BAR; }
    PG8_BAR;
    if constexpr (Epi::AFTER_DRAIN) { E.fused(acc, cur, wr, wc, fr, fq, lds, wid, lane); S.done(cur); }
#undef PG8_SA
#undef PG8_SB
#undef PG8_STAGE
#undef PG8_LDA
#undef PG8_LDB
#undef PG8_MMA
#undef PG8_WAIT_V
#undef PG8_WAIT_L
#undef PG8_BAR
#undef PG8_SCHED
}
}
#ifndef EN_ATTEPI
#define EN_ATTEPI 1
#endif
namespace att {
typedef unsigned short bf16;
using bf16x8 = __attribute__((ext_vector_type(8))) short;
using s16x4  = __attribute__((ext_vector_type(4))) short;
using f32x16 = __attribute__((ext_vector_type(16))) float;
using u32x4  = __attribute__((ext_vector_type(4))) unsigned;
constexpr int KVBLK = 64;
constexpr int NBUF = 3;
constexpr size_t SHM_V = KVBLK * 128 * 2, SHM_K = KVBLK * 128 * 2, SHM_ATTN = NBUF * SHM_V + NBUF * SHM_K + 8 * 64 * 4;
#define KSWZ(row, colB) ((row) * 256 + ((colB) ^ (((row) & 7) << 4)))
#define SBAR() __builtin_amdgcn_sched_barrier(0)
__device__ __forceinline__ int crow(int r, int hi) { return (r & 3) + 8 * (r >> 2) + 4 * hi; }
__device__ __forceinline__ unsigned cvtpk(float lo, float hi) { unsigned r; asm volatile("v_cvt_pk_bf16_f32 %0, %1, %2" : "=v"(r) : "v"(lo), "v"(hi)); return r; }
__device__ __forceinline__ bf16x8 ld8(const bf16* p) { return *reinterpret_cast<const bf16x8*>(p); }
__device__ __forceinline__ void sm_first(f32x16& p0, f32x16& p1, float negoff) {
  (void)p1; (void)negoff;
#pragma unroll
  for (int r = 0; r < 16; ++r) p0[r] = __builtin_amdgcn_exp2f(p0[r]);
}
__device__ __forceinline__ void sm_finish(f32x16& p0, f32x16& p1, float& l_reg, bf16x8& pa0, bf16x8& pa1, bf16x8& pa2, bf16x8& pa3) {
#pragma unroll
  for (int r = 0; r < 16; ++r) p1[r] = __builtin_amdgcn_exp2f(p1[r]);
  float ps = 0;
#pragma unroll
  for (int r = 0; r < 16; ++r) ps += p0[r];
#pragma unroll
  for (int r = 0; r < 16; ++r) ps += p1[r];
  l_reg += ps;
#define PK4(P, BASE, OUT) do { unsigned a0 = cvtpk(P[BASE + 0], P[BASE + 1]), a1 = cvtpk(P[BASE + 2], P[BASE + 3]);   \
    unsigned b0 = cvtpk(P[BASE + 4], P[BASE + 5]), b1 = cvtpk(P[BASE + 6], P[BASE + 7]);                              \
    auto r0 = __builtin_amdgcn_permlane32_swap(a0, b0, false, false); auto r1 = __builtin_amdgcn_permlane32_swap(a1, b1, false, false); \
    u32x4 w = {r0[0], r1[0], r0[1], r1[1]}; OUT = *reinterpret_cast<bf16x8*>(&w); } while (0)
  PK4(p0, 0, pa0); PK4(p0, 8, pa1); PK4(p1, 0, pa2); PK4(p1, 8, pa3);
#undef PK4
}
__device__ __forceinline__ void qkt(f32x16& p0, f32x16& p1, const bf16* Ks, const bf16x8* qr, int r32, int hi, int mapoff, float negoff) {
  p0 = f32x16{}; p1 = f32x16{}; (void)negoff;
#pragma unroll
  for (int d0 = 0; d0 < 4; ++d0) { const int cb = (mapoff + d0 * 16 + hi * 8) * 2;
    bf16x8 b0 = *reinterpret_cast<const bf16x8*>((const char*)Ks + KSWZ(r32, cb));
    bf16x8 b1 = *reinterpret_cast<const bf16x8*>((const char*)Ks + KSWZ(32 + r32, cb));
    p0 = __builtin_amdgcn_mfma_f32_32x32x16_bf16(b0, qr[d0], p0, 0, 0, 0);
    p1 = __builtin_amdgcn_mfma_f32_32x32x16_bf16(b1, qr[d0], p1, 0, 0, 0); }
}
__device__ __forceinline__ int v_st(int k, int c) { const int kk = (k & ~0xC) | ((k & 4) << 1) | ((k & 8) >> 1); return ((kk >> 3) * 4 + (c >> 5)) * 512 + ((kk & 7) * 32 + (c & 31)) * 2; }
__device__ __forceinline__ int v_rd_base(int lane) { return ((lane & 3) << 3) | (((lane >> 2) & 3) << 6) | (((lane >> 4) & 1) << 5) | (((lane >> 5) & 1) << 8); }
constexpr int v_rd_off(int d0, int ks, int half) { return d0 * 512 + ks * 4096 + half * 2048; }
typedef short v4i16_t __attribute__((ext_vector_type(4)));
template <int OFF> __device__ __forceinline__ s16x4 tr_read(int vb) {
  return __builtin_bit_cast(s16x4, __builtin_amdgcn_ds_read_tr16_b64_v4i16((__attribute__((address_space(3))) v4i16_t*)(uintptr_t)(unsigned)(vb + OFF)));
}
template <int D0> __device__ __forceinline__ void pv_one(f32x16& od, int vb, bf16x8 pa0, bf16x8 pa1, bf16x8 pa2, bf16x8 pa3) {
  const s16x4 l0 = tr_read<v_rd_off(D0, 0, 0)>(vb), h0 = tr_read<v_rd_off(D0, 0, 1)>(vb), l1 = tr_read<v_rd_off(D0, 1, 0)>(vb), h1 = tr_read<v_rd_off(D0, 1, 1)>(vb);
  const s16x4 l2 = tr_read<v_rd_off(D0, 2, 0)>(vb), h2 = tr_read<v_rd_off(D0, 2, 1)>(vb), l3 = tr_read<v_rd_off(D0, 3, 0)>(vb), h3 = tr_read<v_rd_off(D0, 3, 1)>(vb);
#define PK(L, H) (bf16x8){L[0], L[1], L[2], L[3], H[0], H[1], H[2], H[3]}
  od = __builtin_amdgcn_mfma_f32_32x32x16_bf16(pa0, PK(l0, h0), od, 0, 0, 0);
  od = __builtin_amdgcn_mfma_f32_32x32x16_bf16(pa1, PK(l1, h1), od, 0, 0, 0);
  od = __builtin_amdgcn_mfma_f32_32x32x16_bf16(pa2, PK(l2, h2), od, 0, 0, 0);
  od = __builtin_amdgcn_mfma_f32_32x32x16_bf16(pa3, PK(l3, h3), od, 0, 0, 0);
#undef PK
}
__device__ __forceinline__ void pv_d0(f32x16* o, int vb, bf16x8 pa0, bf16x8 pa1, bf16x8 pa2, bf16x8 pa3) {
  pv_one<0>(o[0], vb, pa0, pa1, pa2, pa3); pv_one<1>(o[1], vb, pa0, pa1, pa2, pa3); pv_one<2>(o[2], vb, pa0, pa1, pa2, pa3); pv_one<3>(o[3], vb, pa0, pa1, pa2, pa3);
}
__device__ __forceinline__ void attn_unit(const bf16* __restrict__ Qh, const bf16* __restrict__ Kh, const bf16* __restrict__ Vh, bf16* __restrict__ Oh, long qrow0, long k0a, int nt0, long k0b, int NT,
                                          float lam, float oscale, const float* __restrict__ subg, float negoff, char* lds, int wave_, unsigned lds3) {
  unsigned z_ = 0u; asm volatile("" : "+v"(z_)); int tid_ = wave_ * 64 + (int)__builtin_amdgcn_mbcnt_hi(~0u, __builtin_amdgcn_mbcnt_lo(~0u, z_)); asm volatile("" : "+v"(tid_));
  const int tid = tid_, wid = __builtin_amdgcn_readfirstlane(tid >> 6), lane = tid & 63, r32 = lane & 31, hi = lane >> 5, qsub = wid >> 1, map = wid & 1, mapoff = map * 64;
  bf16* V_lds = (bf16*)lds; bf16* K_lds = (bf16*)(lds + NBUF * SHM_V);
  float* ws = (float*)(lds + NBUF * SHM_V + NBUF * SHM_K) + wid * 64; float* li_l = ws;
  float l_reg = 0; f32x16 o[4] = {}; bf16x8 qr[4];
  const bf16* Qw = Qh + (qrow0 + qsub * 32 + r32) * 512 + mapoff + hi * 8;
#pragma unroll
  for (int d0 = 0; d0 < 4; ++d0) qr[d0] = ld8(Qw + d0 * 16);
  const int vb0 = (int)(uintptr_t)V_lds + v_rd_base(lane);
  int koff[2], voff[2];
#pragma unroll
  for (int i = 0; i < 2; ++i) { const int o = (wid + 8 * i) * 1024 + lane * 16;
    { const int row = o >> 8, cB = (o & 255) ^ ((row & 7) << 4); koff[i] = row * 512 + (cB >> 1); }
    { const int sub = o >> 9, kkhi = sub >> 2, cg = sub & 3, q = (o & 511) >> 1, kklo = q >> 5, cin = q & 31, kk = kkhi * 8 + kklo; voff[i] = kk * 512 + cg * 32 + cin; } }
  typedef __attribute__((address_space(3))) unsigned lds_u32;
  const unsigned ldsK = lds3 + NBUF * (unsigned)SHM_V + (unsigned)wid * 1024u, ldsV = lds3 + (unsigned)wid * 1024u;
#define KROW(j) (((j) < nt0) ? (k0a + (long)(j) * KVBLK) : (k0b + (long)((j) - nt0) * KVBLK))
#define DMAK(b, j) do { const long kr_ = KROW(j) * 512; _Pragma("unroll") for (int i_ = 0; i_ < 2; ++i_) \
    __builtin_amdgcn_global_load_lds((const unsigned*)(Kh + kr_ + koff[i_]), (lds_u32*)(uintptr_t)(ldsK + (b) * (unsigned)SHM_K + i_ * 8192u), 16, 0, 0); } while (0)
#define DMAV(b, j) do { const long kr_ = KROW(j) * 512; _Pragma("unroll") for (int i_ = 0; i_ < 2; ++i_) \
    __builtin_amdgcn_global_load_lds((const unsigned*)(Vh + kr_ + voff[i_]), (lds_u32*)(uintptr_t)(ldsV + (b) * (unsigned)SHM_V + i_ * 8192u), 16, 0, 0); } while (0)
  f32x16 p0, p1; bf16x8 pa0, pa1, pa2 = {}, pa3 = {};
#define KFR(kb, d0, half) (*reinterpret_cast<const bf16x8*>((const char*)K_lds + (kb) * (int)SHM_K + KSWZ((half) * 32 + r32, (mapoff + (d0) * 16 + hi * 8) * 2)))
#define VRD4(S, vbuf, D0, KS) do { const int vb_ = vb0 + (vbuf) * (int)SHM_V; S##a = tr_read<v_rd_off(D0, KS, 0)>(vb_); S##b = tr_read<v_rd_off(D0, KS, 1)>(vb_); S##c = tr_read<v_rd_off(D0, (KS) + 1, 0)>(vb_); S##d = tr_read<v_rd_off(D0, (KS) + 1, 1)>(vb_); } while (0)
#define PKV(L, H) (bf16x8){L[0], L[1], L[2], L[3], H[0], H[1], H[2], H[3]}
#define MM(ACC, A_, B_) ACC = __builtin_amdgcn_mfma_f32_32x32x16_bf16(A_, B_, ACC, 0, 0, 0)
#define FADD(D, S) asm volatile("v_add_f32 %0, %0, %1" : "+v"(D) : "v"(S))
#define SMA(P, c) do { P[2 * (c)] = __builtin_amdgcn_exp2f(P[2 * (c)]); P[2 * (c) + 1] = __builtin_amdgcn_exp2f(P[2 * (c) + 1]); FADD(ls0, P[2 * (c)]); FADD(ls1, P[2 * (c) + 1]); } while (0)
#define SMB_CVT(P, BASE) do { ca0 = cvtpk(P[BASE + 0], P[BASE + 1]); ca1 = cvtpk(P[BASE + 2], P[BASE + 3]); cb0 = cvtpk(P[BASE + 4], P[BASE + 5]); cb1 = cvtpk(P[BASE + 6], P[BASE + 7]); } while (0)
#define SMB_PERM(OUT) do { u32x4 w_ = {ca0, ca1, cb0, cb1}; OUT = *reinterpret_cast<bf16x8*>(&w_); } while (0)
#define STAGE_PV(PA, PB, P, KLD_STMT) do { KLD_STMT; \
    MM(o[0], PA, PKV(vAa, vAb)); SMA(P, 0); SBAR(); MM(o[0], PB, PKV(vAc, vAd)); SMA(P, 1); SBAR(); \
    MM(o[1], PA, PKV(vBa, vBb)); SMA(P, 2); SBAR(); MM(o[1], PB, PKV(vBc, vBd)); SMA(P, 3); SBAR(); \
    MM(o[2], PA, PKV(vCa, vCb)); SMA(P, 4); SBAR(); MM(o[2], PB, PKV(vCc, vCd)); SMA(P, 5); SBAR(); \
    MM(o[3], PA, PKV(vDa, vDb)); SMA(P, 6); SBAR(); MM(o[3], PB, PKV(vDc, vDd)); SMA(P, 7); SBAR(); } while (0)
#define VRD16(vbuf, KS) do { VRD4(vA, vbuf, 0, KS); VRD4(vB, vbuf, 1, KS); VRD4(vC, vbuf, 2, KS); VRD4(vD, vbuf, 3, KS); } while (0)
#define STAGE_QK(PD, P, OUT0, OUT1, vbuf, KS) do { VRD16(vbuf, KS); \
    PD = __builtin_amdgcn_mfma_f32_32x32x16_bf16(kf0, qr[0], f32x16{}, 0, 0, 0); SMB_CVT(P, 0); SBAR(); \
    MM(PD, kf1, qr[1]); SMB_PERM(OUT0); SBAR(); MM(PD, kf2, qr[2]); SMB_CVT(P, 8); SBAR(); MM(PD, kf3, qr[3]); SMB_PERM(OUT1); SBAR(); } while (0)
#define KLD4(kb, half) do { kf0 = KFR(kb, 0, half); kf1 = KFR(kb, 1, half); kf2 = KFR(kb, 2, half); kf3 = KFR(kb, 3, half); } while (0)
  s16x4 vAa, vAb, vAc, vAd, vBa, vBb, vBc, vBd, vCa, vCb, vCc, vCd, vDa, vDb, vDc, vDd; bf16x8 kf0, kf1, kf2, kf3; unsigned ca0, ca1, cb0, cb1; float ls0 = 0.f, ls1 = 0.f;
  DMAK(0, 0); DMAK(1, 1); DMAV(0, 0); asm volatile("s_waitcnt vmcnt(0)" ::: "memory"); __syncthreads();
  KLD4(0, 0); p0 = __builtin_amdgcn_mfma_f32_32x32x16_bf16(kf0, qr[0], f32x16{}, 0, 0, 0); MM(p0, kf1, qr[1]); MM(p0, kf2, qr[2]); MM(p0, kf3, qr[3]);
  VRD16(0, 2);
  int bp = 0, bc = 0, bn = 1, bnn = 2;
#pragma unroll 1
  for (int j = 0; j < NT; ++j) {
    asm volatile("s_waitcnt vmcnt(0)" ::: "memory"); SBAR(); __builtin_amdgcn_s_barrier(); SBAR();
    if (j + 2 < NT) DMAK(bnn, j + 2);
    if (j + 1 < NT) DMAV(bn, j + 1);
    STAGE_PV(pa2, pa3, p0, KLD4(bc, 1));
    STAGE_QK(p1, p0, pa0, pa1, bc, 0);
    const int kbn = (j + 1 < NT) ? bn : bc;
    STAGE_PV(pa0, pa1, p1, KLD4(kbn, 0));
    STAGE_QK(p0, p1, pa2, pa3, bc, 2);
    bp = bc; bc = bn; bn = bnn; bnn = bp;
  }
  MM(o[0], pa2, PKV(vAa, vAb)); MM(o[0], pa3, PKV(vAc, vAd)); MM(o[1], pa2, PKV(vBa, vBb)); MM(o[1], pa3, PKV(vBc, vBd));
  MM(o[2], pa2, PKV(vCa, vCb)); MM(o[2], pa3, PKV(vCc, vCd)); MM(o[3], pa2, PKV(vDa, vDb)); MM(o[3], pa3, PKV(vDc, vDd));
  l_reg = ls0 + ls1;
#undef KLD4
#undef STAGE_QK
#undef VRD16
#undef FADD
#undef STAGE_PV
#undef SMB_PERM
#undef SMB_CVT
#undef SMA
#undef MM
#undef VRD4
#undef PKV
#undef KFR
#undef DMAK
#undef DMAV
#if EN_ATTEPI
  { auto rr = __builtin_amdgcn_permlane32_swap(__float_as_uint(l_reg), __float_as_uint(l_reg), false, false); l_reg = __uint_as_float(rr[0]) + __uint_as_float(rr[1]); }
  if (hi == 0) li_l[r32] = l_reg;
  asm volatile("s_waitcnt lgkmcnt(0)" ::: "memory");
  const float fm = map ? lam : 1.f;
#pragma unroll
  for (int r = 0; r < 16; ++r) { const float rl = __builtin_amdgcn_rcpf(li_l[crow(r, hi)]) * fm;
#pragma unroll
    for (int d0 = 0; d0 < 4; ++d0) o[d0][r] *= rl; }
  __syncthreads();
  float* X = (float*)lds + qsub * 4096 + lane;
  if (map == 1) {
#pragma unroll
    for (int d0 = 0; d0 < 4; ++d0)
#pragma unroll
      for (int r = 0; r < 16; ++r) X[(d0 * 16 + r) * 64] = o[d0][r];
  }
  __syncthreads();
  if (map == 0) {
    float sg[4];
#pragma unroll
    for (int d0 = 0; d0 < 4; ++d0) sg[d0] = subg[d0 * 32 + r32] * oscale;
    bf16* Ow = Oh + (qrow0 + qsub * 32) * 1024 + r32;
#pragma unroll
    for (int r = 0; r < 16; ++r) {
      float ss = 0.f;
#pragma unroll
      for (int d0 = 0; d0 < 4; ++d0) { o[d0][r] -= X[(d0 * 16 + r) * 64]; ss += o[d0][r] * o[d0][r]; }
      ss += __shfl_xor(ss, 1); ss += __shfl_xor(ss, 2); ss += __shfl_xor(ss, 4); ss += __shfl_xor(ss, 8); ss += __shfl_xor(ss, 16);
      const float rn = 1.0f / sqrtf(ss * (1.0f / 128.0f) + 1e-6f);
      const int orow = crow(r, hi);
#pragma unroll
      for (int d0 = 0; d0 < 4; ++d0) { const unsigned w = cvtpk(o[d0][r] * rn * sg[d0], 0.f); Ow[(long)orow * 1024 + d0 * 32] = (bf16)(w & 0xffffu); }
    }
  }
  __syncthreads();
#else
  { float s = l_reg; for (int d0 = 0; d0 < 4; ++d0) for (int r = 0; r < 16; ++r) s += o[d0][r]; Oh[qrow0 * 1024 + tid] = (bf16)(int)s; }
#endif
#undef KROW
}
#undef KSWZ
#undef SBAR
}
#ifndef EN_ALL
#define EN_ALL 1
#endif
#ifndef EN_PH0
#define EN_PH0 EN_ALL
#endif
#ifndef EN_PH1
#define EN_PH1 EN_ALL
#endif
#ifndef EN_P1
#define EN_P1 EN_ALL
#endif
#ifndef EN_P2A
#define EN_P2A EN_ALL
#endif
#ifndef EN_P2B
#define EN_P2B EN_ALL
#endif
#ifndef EN_P3
#define EN_P3 EN_ALL
#endif
#ifndef EN_P4
#define EN_P4 EN_ALL
#endif
#ifndef EN_P5
#define EN_P5 EN_ALL
#endif
#ifndef EN_ATT
#define EN_ATT 1
#endif
#ifndef EN_DFT
#define EN_DFT 1
#endif
#ifndef EN_ATTC
#define EN_ATTC 1
#endif
#ifndef SCHED_OLD
#define SCHED_OLD 0
#endif
#ifndef PROBE_A
#define PROBE_A 0
#endif
#ifndef PROBE_S
#define PROBE_S 0
#endif
#if PROBE_S
#define SUBSTAMP(i) do { if (blockIdx.x == 0 && F.wave == 0) ((volatile LAS unsigned*)(F.lds + MISC_OFF))[40 + (i)] = (unsigned)__builtin_amdgcn_s_memrealtime(); } while (0)
#else
#define SUBSTAMP(i) do {} while (0)
#endif
#ifndef PROBE_B
#define PROBE_B 0
#endif
#ifndef WGM_WIDE
#define WGM_WIDE 2
#endif
#ifndef WGM_MID
#define WGM_MID 2
#endif
constexpr int NWAVES = 8;
constexpr int DM = 1024, NBATCH = 8, SEQ = 2048, CTXL = 256, M_LAT = NBATCH * SEQ, M_CTX = NBATCH * CTXL, M_ALL = M_LAT + M_CTX, NIN = 2560, NINSRC = 2048, FFD = 2816, NGU = 5632, NLAYER = 2;
constexpr size_t MiB = 1u << 20;
constexpr size_t WS_CTL = 0, CTL_ZERO_BYTES = 1 * MiB;
constexpr size_t WS_MOD = 64 * 1024;
constexpr size_t WS_BIN = 512 * 1024;
constexpr size_t WS_BGU = 1 * MiB + 768 * 1024;
constexpr size_t WS_ROPE = WS_BGU + 512 * 1024;
constexpr size_t WS_DFT = WS_ROPE + 512 * 1024;
constexpr size_t WS_TF = 4 * MiB;
constexpr size_t WS_SSQ = 5 * MiB;
constexpr size_t WS_WIN = 8 * MiB;
constexpr size_t WS_WOUT = 18 * MiB;
constexpr size_t WS_WGU = 22 * MiB;
constexpr size_t WS_WDN = 44 * MiB;
constexpr size_t WS_A = 56 * MiB;
constexpr size_t WS_XC = 92 * MiB;
constexpr size_t WS_QB = 100 * MiB, WS_KB = 118 * MiB, WS_VB = 136 * MiB;
constexpr size_t WS_T = 154 * MiB;
constexpr size_t WS_TC = 186 * MiB;
constexpr size_t WS_MIX = 190 * MiB;
constexpr size_t WS_H = 100 * MiB;
constexpr size_t WS_HC = 226 * MiB;
constexpr size_t WS_END = 238 * MiB;
constexpr size_t WS_XB2 = 222 * MiB;
static_assert(WS_DFT + 256 * 512 * 2 <= WS_TF && WS_SSQ + (size_t)M_ALL * 64 <= WS_WIN && WS_H + (size_t)M_ALL * FFD * 2 <= WS_END && WS_MIX + (size_t)M_ALL * DM * 2 <= WS_END, "d_ws map");
constexpr int CW_TMO = 0, CW_BAR = 4096, CW_CTXCNT = 8192, CW_BFCNT = 8192 + 512, CW_C3CNT = 8192 + 1024;
constexpr int RING_BYTES = 131072, RTAB_OFF = RING_BYTES, RTAB_BYTES = 8192, LDSCTL_OFF = RTAB_OFF + RTAB_BYTES, MISC_OFF = LDSCTL_OFF + 320, BTAB_OFF = 140288, ETAB_OFF = 147456, LDS_BYTES = ETAB_OFF + 12288 + 512;
static_assert(MISC_OFF + 512 <= BTAB_OFF && BTAB_OFF + 7 * 1024 == ETAB_OFF && BTAB_OFF == RTAB_OFF + 4 * pg8::BT_F && ETAB_OFF == RTAB_OFF + 4 * pg8::ET_F && LDS_BYTES <= 160 * 1024, "LDS map");
constexpr int N_PHASES = 2 + 6 * NLAYER;

#define GAS __attribute__((address_space(1)))
#define LAS __attribute__((address_space(3)))
typedef unsigned short bf16;
typedef unsigned v4u __attribute__((ext_vector_type(4)));
typedef unsigned v2u __attribute__((ext_vector_type(2)));
typedef float f32x4 __attribute__((ext_vector_type(4)));
#define LDS_WAIT() asm volatile("s_waitcnt lgkmcnt(0)" ::: "memory")
#define VM_WAIT() asm volatile("s_waitcnt vmcnt(0)" ::: "memory")
__device__ __forceinline__ unsigned f2bf(float f) { unsigned u = __builtin_bit_cast(unsigned, f); return (u + 0x7fffu + ((u >> 16) & 1u)) >> 16; }
__device__ __forceinline__ unsigned pk2(float lo, float hi) { return f2bf(lo) | (f2bf(hi) << 16); }
__device__ __forceinline__ float bf2f(unsigned short h) { return __builtin_bit_cast(float, (unsigned)h << 16); }
__device__ __forceinline__ int lane_id() { unsigned z = 0u; asm volatile("" : "+v"(z)); return (int)__builtin_amdgcn_mbcnt_hi(~0u, __builtin_amdgcn_mbcnt_lo(~0u, z)); }
__device__ __forceinline__ float wave_sum(float v) {
#pragma unroll
    for (int o = 1; o < 64; o <<= 1) v += __shfl_xor(v, o);
    return v;
}

#define XB_TMO      128
#define XB_XCNT(j)  (256  + 64 * (j))
#define XB_XSUB(j)  (1280 + 64 * (j))
#define XB_XGEN(j)  (2304 + 64 * (j))
#define XB_TOP      3328
#define XB_TOPGEN   3392
#define XCD_BAR_WORDS 3456
#define XB_SPIN_CAP (1u << 18)

__device__ __forceinline__ unsigned xb_ld(unsigned* p)              { return __hip_atomic_load(p, __ATOMIC_RELAXED, __HIP_MEMORY_SCOPE_AGENT); }
__device__ __forceinline__ unsigned xb_add(unsigned* p, unsigned v) { return __hip_atomic_fetch_add(p, v, __ATOMIC_RELAXED, __HIP_MEMORY_SCOPE_AGENT); }
__device__ __forceinline__ unsigned xb_xcc_id() { return (unsigned)__builtin_amdgcn_s_getreg((3 << 11) | 20) & 0xFu; }
#define XB_SPIN(cond, bar) do { unsigned _sp = 0; while (cond) { __builtin_amdgcn_s_sleep(1); \
    if ((++_sp & 255u) == 0u) { if (xb_ld(&(bar)[XB_TMO])) break; if (_sp > XB_SPIN_CAP) { atomicAdd(&(bar)[XB_TMO], 1u); break; } } } } while (0)

struct XcdBarrier {
    unsigned* bar; unsigned x;
    volatile LAS unsigned* st;
};

__device__ __forceinline__ XcdBarrier xcd_barrier_post(unsigned* bar, volatile LAS unsigned* st) {
    XcdBarrier b; b.bar = bar; b.x = xb_xcc_id(); b.st = st;
    if (threadIdx.x == 0) (void)xb_add(&bar[XB_XCNT(b.x)], 1u);
    return b;
}
__device__ __forceinline__ void xcd_barrier_complete(unsigned* bar, unsigned x, unsigned& nloc, unsigned& nx) {
    const unsigned G = gridDim.x * gridDim.y * gridDim.z;
    unsigned sum, cnt, mine, sp = 0u;
    for (;;) {
        sum = 0u; cnt = 0u; mine = 0u;
#pragma unroll
        for (unsigned j = 0; j < 16; ++j) { const unsigned c = xb_ld(&bar[XB_XCNT(j)]); sum += c; cnt += (c > 0u) ? 1u : 0u; mine = (j == x) ? c : mine; }
        if (sum == G) break;
        __builtin_amdgcn_s_sleep(1);
        if ((++sp & 255u) == 0u) { if (xb_ld(&bar[XB_TMO])) break; if (sp > XB_SPIN_CAP) { atomicAdd(&bar[XB_TMO], 1u); break; } }
    }
    nloc = mine > 0u ? mine : 1u; nx = cnt > 0u ? cnt : 1u;
}

__device__ __forceinline__ void xcd_barrier(const XcdBarrier& b) {
    asm volatile("s_waitcnt vmcnt(0)" ::: "memory");
    __syncthreads();
    if (threadIdx.x == 0) {
        unsigned* bar = b.bar;
        __builtin_amdgcn_s_waitcnt(0);
        unsigned nloc = b.st[0], nx = b.st[1];
        if (nloc == 0u) { xcd_barrier_complete(bar, b.x, nloc, nx); b.st[0] = nloc; b.st[1] = nx; }
        const unsigned old = xb_add(&bar[XB_XSUB(b.x)], 1u);
        const unsigned gen = old / nloc;
        if (old + 1u == (gen + 1u) * nloc) {
            __builtin_amdgcn_fence(__ATOMIC_RELEASE, "agent");
            asm volatile("s_waitcnt vmcnt(0)" ::: "memory");
            const unsigned og = xb_add(&bar[XB_TOP], 1u);
            const unsigned tg = og / nx;
            if (og + 1u == (tg + 1u) * nx) xb_add(&bar[XB_TOPGEN], 1u);
            else XB_SPIN(xb_ld(&bar[XB_TOPGEN]) == tg, bar);
            __builtin_amdgcn_fence(__ATOMIC_ACQUIRE, "agent");
            xb_add(&bar[XB_XGEN(b.x)], 1u);
            asm volatile("s_waitcnt vmcnt(0)" ::: "memory");
        } else {
            XB_SPIN(xb_ld(&bar[XB_XGEN(b.x)]) == gen, bar);
            __builtin_amdgcn_fence(__ATOMIC_ACQUIRE, "agent");
            asm volatile("s_waitcnt vmcnt(0)" ::: "memory");
        }
    }
    __syncthreads();
}


struct Args { const float* in[21]; float* out; unsigned char* ws; int ph_lo, ph_hi; };
struct Frame {
    LAS unsigned char* lds; int wave, vcu, G;
};

__device__ __forceinline__ void transpose_item(const float* W, int ldn, bf16* WT, int ldk, int k0, int n0, int drow0, LAS float* scr, int lane) {
    const int r = lane >> 3, c4 = (lane & 7) * 4; f32x4 v[8];
#pragma unroll
    for (int j = 0; j < 8; ++j) v[j] = *(const f32x4*)(W + (size_t)(k0 + 8 * j + r) * ldn + n0 + c4);
#pragma unroll
    for (int j = 0; j < 8; ++j) { LAS float* d = scr + (8 * j + r) * 33 + c4; d[0] = v[j][0]; d[1] = v[j][1]; d[2] = v[j][2]; d[3] = v[j][3]; }
    LDS_WAIT(); asm volatile("" ::: "memory");
    const int c = lane & 7;
#pragma unroll
    for (int j = 0; j < 4; ++j) { const int n = (lane >> 3) + 8 * j; const LAS float* s = scr + (8 * c) * 33 + n;
        v4u o; o.x = pk2(s[0 * 33], s[1 * 33]); o.y = pk2(s[2 * 33], s[3 * 33]); o.z = pk2(s[4 * 33], s[5 * 33]); o.w = pk2(s[6 * 33], s[7 * 33]);
        *(GAS v4u*)(WT + (size_t)(drow0 + n) * ldk + k0 + 8 * c) = o; }
    LDS_WAIT(); asm volatile("" ::: "memory");
}
__device__ __forceinline__ void ph0(Frame& F, const Args& A, unsigned char* ws) {
    int tid_ = F.wave * 64 + lane_id(); asm volatile("" : "+v"(tid_));
    LAS float* scr = (LAS float*)(F.lds + F.wave * 16384);
    const int gw = F.vcu * NWAVES + F.wave, NGW = F.G * NWAVES;
    SUBSTAMP(0);
    constexpr int I_IN = 16 * 48, I_OUT = 16 * 32, I_G = 16 * 88, I_D = 44 * 32, I_LAYER = I_IN + I_OUT + 2 * I_G + I_D;
    for (int it = gw; it < NLAYER * I_LAYER; it += NGW) {
        const int l = it / I_LAYER; int r = it % I_LAYER;
        if (r < I_IN) { const int kb = r / 48, nb = r % 48, n0 = nb * 32, pn = n0 >> 8, cc = n0 & 255; const int drow = pn < 4 ? pn * 256 + ((cc >> 5) & 1) * 128 + (cc >> 6) * 32 : n0;
            transpose_item(A.in[8] + (size_t)l * DM * NINSRC, NINSRC, (bf16*)(ws + WS_WIN) + (size_t)l * NIN * DM, DM, kb * 64, n0, drow, scr, (tid_ & 63)); continue; } r -= I_IN;
        if (r < I_OUT) { const int kb = r / 32, nb = r % 32; transpose_item(A.in[17] + (size_t)l * DM * DM, DM, (bf16*)(ws + WS_WOUT) + (size_t)l * DM * DM, DM, kb * 64, nb * 32, nb * 32, scr, (tid_ & 63)); continue; } r -= I_OUT;
        if (r < 2 * I_G) { const int up = r >= I_G; if (up) r -= I_G; const int kb = r / 88, nb = r % 88, n0 = nb * 32; const int drow = (n0 >> 7) * 256 + up * 128 + (n0 & 127);
            transpose_item((up ? A.in[19] : A.in[18]) + (size_t)l * DM * FFD, FFD, (bf16*)(ws + WS_WGU) + (size_t)l * NGU * DM, DM, kb * 64, n0, drow, scr, (tid_ & 63)); continue; } r -= 2 * I_G;
        { const int kb = r / 32, nb = r % 32; transpose_item(A.in[20] + (size_t)l * FFD * DM, DM, (bf16*)(ws + WS_WDN) + (size_t)l * DM * FFD, FFD, kb * 64, nb * 32, nb * 32, scr, (tid_ & 63)); }
    }
    __syncthreads();
    SUBSTAMP(1);
    LAS float* sl = (LAS float*)F.lds;
    LAS float* red = (LAS float*)(F.lds + 40960);
    { f32x4 v[5];
#pragma unroll
      for (int q = 0; q < 5; ++q) { const int i4 = tid_ + q * (NWAVES * 64); const int j = i4 >> 8, k4 = (i4 & 255) * 4; v[q] = (i4 < 9 * 256) ? *(const f32x4*)((j < 8) ? A.in[1] + j * DM + k4 : A.in[3] + k4) : (f32x4){0.f, 0.f, 0.f, 0.f}; }
#pragma unroll
      for (int q = 0; q < 5; ++q) { const int i4 = tid_ + q * (NWAVES * 64); if (i4 < 9 * 256) { f32x4 s; for (int e = 0; e < 4; ++e) s[e] = v[q][e] / (1.f + __expf(-v[q][e])); *(LAS f32x4*)(sl + i4 * 4) = s; } } }
    __syncthreads();
    { const int lane = tid_ & 63; const int NIT = NLAYER * 24 * 16;
      f32x4 wa[8], wb[8], wc[8];
#define MOD_LOAD(W, it_) do { const int kb_ = (it_) & 15, cb_ = ((it_) >> 4) % 24, l_ = (it_) / (24 * 16); const float* W_ = A.in[4] + (size_t)l_ * DM * 6144 + (size_t)(kb_ * 64 + F.wave * 8) * 6144 + cb_ * 256 + lane * 4; \
        _Pragma("unroll") for (int r = 0; r < 8; ++r) W[r] = *(const f32x4*)(W_ + (size_t)r * 6144); } while (0)
#define MOD_ITEM(W, it_) do { const int kb = (it_) & 15, cb = ((it_) >> 4) % 24, l = (it_) / (24 * 16); \
        f32x4 acc[9]; \
        _Pragma("unroll") for (int j = 0; j < 9; ++j) acc[j] = (f32x4){0.f, 0.f, 0.f, 0.f}; \
        _Pragma("unroll") for (int r4 = 0; r4 < 8; r4 += 4) \
            _Pragma("unroll") for (int j = 0; j < 9; ++j) { const f32x4 s = *(const LAS f32x4*)(sl + j * DM + kb * 64 + F.wave * 8 + r4); acc[j] += W[r4] * s[0] + W[r4 + 1] * s[1] + W[r4 + 2] * s[2] + W[r4 + 3] * s[3]; } \
        _Pragma("unroll") for (int j = 0; j < 9; ++j) *(LAS f32x4*)(red + (F.wave * 9 + j) * 256 + lane * 4) = acc[j]; \
        __syncthreads(); \
        for (int i = tid_; i < 9 * 256; i += NWAVES * 64) { const int j = i >> 8, cn = i & 255; float s = 0.f; \
            _Pragma("unroll") for (int w8 = 0; w8 < 8; ++w8) s += red[(w8 * 9 + j) * 256 + cn]; \
            const int nn = cb * 256 + cn; if (kb == 0) s += A.in[5][l * 6144 + nn]; \
            atomicAdd((float*)(ws + WS_MOD) + (l * 9 + j) * 6144 + nn, s); } \
        __syncthreads(); } while (0)
      for (int it0 = F.vcu; it0 < NIT; it0 += 3 * F.G) {
        const int it1 = it0 + F.G, it2 = it0 + 2 * F.G;
        MOD_LOAD(wa, it0); if (it1 < NIT) MOD_LOAD(wb, it1); if (it2 < NIT) MOD_LOAD(wc, it2);
        MOD_ITEM(wa, it0); if (it1 < NIT) MOD_ITEM(wb, it1); if (it2 < NIT) MOD_ITEM(wc, it2);
      }
#undef MOD_ITEM
#undef MOD_LOAD
    }
    SUBSTAMP(2);
    const int gt = F.vcu * (NWAVES * 64) + tid_, NGT = F.G * NWAVES * 64;
    for (int i = gt; i < 96 * 16; i += NGT) { const int p = i >> 4, j = i & 15; const float inv = powf(10000.0f, -(float)j * (1.0f / 16.0f)); const float ang = (float)(p < 32 ? p : p - 32) * inv;
        float sn, cs; sincosf(ang, &sn, &cs); ((float*)(ws + WS_ROPE))[i] = cs; ((float*)(ws + WS_ROPE))[1536 + i] = sn; }
    for (int i = gt; i < 256 * 512; i += NGT) { const int m = i >> 9, kk = i & 511, n = kk >> 1; const int p = (m * n) & 255; float sn, cs; sincospif((float)p * (1.0f / 128.0f), &sn, &cs);
        ((bf16*)(ws + WS_DFT))[i] = (bf16)f2bf((kk & 1) ? sn : cs); }
    SUBSTAMP(3);
    __syncthreads();
    if (F.vcu < NLAYER * 4 * 32) {
        const int lg = F.vcu >> 5, c0 = (F.vcu & 31) * 4;
        LAS float* wl = (LAS float*)F.lds; LAS float* ct = (LAS float*)(F.lds + 65536); LAS float* st = ct + 128;
        { f32x4 wv[8];
#pragma unroll
          for (int q = 0; q < 8; ++q) wv[q] = *(const f32x4*)(A.in[16] + (size_t)lg * 128 * 128 + (tid_ + q * (NWAVES * 64)) * 4);
#pragma unroll
          for (int q = 0; q < 8; ++q) *(LAS f32x4*)(wl + (tid_ + q * (NWAVES * 64)) * 4) = wv[q]; }
        if (tid_ < 128) { float sn, cs; sincospif((float)tid_ * (1.0f / 64.0f), &sn, &cs); ct[tid_] = cs; st[tid_] = sn; }
        __syncthreads();
        for (int o = tid_; o < 4 * 256; o += NWAVES * 64) { const int d = o & 127, ri = (o >> 7) & 1, cch = c0 + (o >> 8); float s = 0.f;
#pragma unroll 8
            for (int c2 = 0; c2 < 128; ++c2) { const int p = (cch * c2) & 127; s += (ri ? -st[p] : ct[p]) * wl[c2 * 128 + d]; }
            ((float*)(ws + WS_TF))[(size_t)lg * 32768 + cch * 256 + ri * 128 + d] = s; }
    }
    SUBSTAMP(4);
}
__device__ __forceinline__ void ph1(Frame& F, const Args& A, unsigned char* ws) {
    int tid_ = F.wave * 64 + lane_id(); asm volatile("" : "+v"(tid_));
    const float* mod = (const float*)(ws + WS_MOD);
    SUBSTAMP(5);
    { const int gw = F.vcu * NWAVES + F.wave, NGW = F.G * NWAVES; const int lane = tid_ & 63;
      for (int row0 = gw; row0 < M_ALL; row0 += 2 * NGW) {
          const int row1 = row0 + NGW; const bool two = row1 < M_ALL;
          f32x4 v[2][4]; float s[2] = {0.f, 0.f};
#pragma unroll
          for (int q = 0; q < 2; ++q) { const int row = q ? (two ? row1 : row0) : row0; const float* xr = row < M_LAT ? A.in[0] + (size_t)row * DM : A.in[2] + (size_t)(row - M_LAT) * DM;
#pragma unroll
              for (int j = 0; j < 4; ++j) v[q][j] = *(const f32x4*)(xr + 256 * j + 4 * lane); }
#pragma unroll
          for (int q = 0; q < 2; ++q) {
#pragma unroll
              for (int j = 0; j < 4; ++j) s[q] += (v[q][j][0] * v[q][j][0] + v[q][j][1] * v[q][j][1]) + (v[q][j][2] * v[q][j][2] + v[q][j][3] * v[q][j][3]);
              s[q] = wave_sum(s[q]); }
#pragma unroll
          for (int q = 0; q < 2; ++q) { if (q == 1 && !two) break; const int row = q ? row1 : row0; const int bm = row < M_LAT ? (row >> 11) : 8; const float* sc = mod + bm * 6144 + 1024;
              bf16* ar = (bf16*)(ws + WS_A) + (size_t)row * DM;
              _Float16* hr = row < M_LAT ? (_Float16*)A.out + (size_t)row * DM : (_Float16*)(ws + WS_XC) + (size_t)(row - M_LAT) * DM;
#pragma unroll
              for (int j = 0; j < 4; ++j) { v2u h; h.x = pg8::pkh2(v[q][j][0], v[q][j][1]); h.y = pg8::pkh2(v[q][j][2], v[q][j][3]); *(v2u*)(hr + 256 * j + 4 * lane) = h; }
#pragma unroll
              for (int j = 0; j < 4; ++j) { const int k = 256 * j + 4 * lane; const f32x4 g = *(const f32x4*)(A.in[6] + k) * (*(const f32x4*)(sc + k) + 1.0f); const f32x4 a = v[q][j] * g; v2u w; w.x = pk2(a[0], a[1]); w.y = pk2(a[2], a[3]); *(v2u*)(ar + k) = w; }
              if (lane < 16) ((float*)(ws + WS_SSQ))[(size_t)row * 16 + lane] = lane == 0 ? s[q] : 0.f; }
      } }
    __syncthreads();
    SUBSTAMP(6);
    { LAS float* wl = (LAS float*)F.lds;
      LAS float* tl = (LAS float*)(F.lds + 128 * 132 * 4);
      LAS float* shl = (LAS float*)(F.lds + 128 * 132 * 4 + 128 * 64 * 4);
      LAS float* redl = shl + 9 * 128;
      for (int it = F.vcu; it < NLAYER * 4 * 4 * 8; it += F.G) {
          const int kb = it & 7, q = (it >> 3) & 3, g = (it >> 5) & 3, l = it >> 7;
          const float* wsrc = A.in[8] + (size_t)l * DM * NINSRC + (size_t)(kb * 128) * NINSRC + 1536 + g * 128;
          f32x4 wv[8], tv[4];
#pragma unroll
          for (int q = 0; q < 8; ++q) { const int i = tid_ + q * (NWAVES * 64); wv[q] = *(const f32x4*)(wsrc + (size_t)(i >> 5) * NINSRC + (i & 31) * 4); }
          const float* tsrc = (const float*)(ws + WS_TF) + (size_t)(l * 4 + g) * 128 * 256 + q * 64;
#pragma unroll
          for (int q = 0; q < 4; ++q) { const int i = tid_ + q * (NWAVES * 64); tv[q] = *(const f32x4*)(tsrc + (size_t)(i >> 4) * 256 + (i & 15) * 4); }
#pragma unroll
          for (int q = 0; q < 8; ++q) { const int i = tid_ + q * (NWAVES * 64); *(LAS f32x4*)(wl + (i >> 5) * 132 + (i & 31) * 4) = wv[q]; }
#pragma unroll
          for (int q = 0; q < 4; ++q) { const int i = tid_ + q * (NWAVES * 64); *(LAS f32x4*)(tl + (i >> 4) * 64 + (i & 15) * 4) = tv[q]; }
          if (tid_ < 9 * 32) *(LAS f32x4*)(shl + tid_ * 4) = *(const f32x4*)(mod + (l * 9 + (tid_ >> 5)) * 6144 + kb * 128 + (tid_ & 31) * 4);
          __syncthreads();
          const int lane_ = tid_ & 63, l32 = lane_ & 31, hi = lane_ >> 5, wk = F.wave >> 1, wc = F.wave & 1, dcol = wc * 32 + l32;
          typedef float f32x16_t __attribute__((ext_vector_type(16)));
          f32x16_t acc = {};
          { const LAS float* ap = wl + (wk * 32 + l32) * 132 + hi; const LAS float* bp = tl + hi * 64 + dcol;
#pragma unroll 8
            for (int s2 = 0; s2 < 64; ++s2) acc = __builtin_amdgcn_mfma_f32_32x32x2f32(ap[2 * s2], bp[2 * s2 * 64], acc, 0, 0, 0); }
          bf16* dst = (bf16*)(ws + WS_WIN) + (size_t)l * NIN * DM + (size_t)(1536 + g * 256 + q * 64 + dcol) * DM + kb * 128 + wk * 32 + hi * 4;
#pragma unroll
          for (int gq = 0; gq < 4; ++gq) { v2u o; o.x = pk2(acc[4 * gq], acc[4 * gq + 1]); o.y = pk2(acc[4 * gq + 2], acc[4 * gq + 3]); *(v2u*)(dst + 8 * gq) = o; }
#pragma unroll
          for (int j = 0; j < 9; ++j) { float s = 0.f;
#pragma unroll
              for (int gq = 0; gq < 4; ++gq) { const f32x4 sv = *(const LAS f32x4*)(shl + j * 128 + wk * 32 + gq * 8 + hi * 4); s += sv[0] * acc[4 * gq] + sv[1] * acc[4 * gq + 1] + sv[2] * acc[4 * gq + 2] + sv[3] * acc[4 * gq + 3]; }
              redl[((wk * 2 + hi) * 9 + j) * 64 + dcol] = s; }
          __syncthreads();
          for (int i = tid_; i < 9 * 64; i += NWAVES * 64) { const int j = i >> 6, dc = i & 63; float s = 0.f;
#pragma unroll
              for (int w = 0; w < 8; ++w) s += redl[(w * 9 + j) * 64 + dc];
              atomicAdd((float*)(ws + WS_BIN) + (l * 9 + j) * NIN + 1536 + g * 256 + q * 64 + dc, s); }
          __syncthreads();
      } }
    SUBSTAMP(7);
    { LAS unsigned short* sh16 = (LAS unsigned short*)F.lds;
      for (int i = tid_; i < 4 * 16 * 256; i += NWAVES * 64) { const int set = i >> 12, row = (i >> 8) & 15, k4 = (i & 255) * 4; v2u o = {0u, 0u};
          if (row < 9) { const f32x4 v = *(const f32x4*)(mod + ((set >> 1) * 9 + row) * 6144 + ((set & 1) ? 3072 : 0) + k4); o.x = pk2(v[0], v[1]); o.y = pk2(v[2], v[3]); }
          *(LAS v2u*)(sh16 + (size_t)i * 4) = o; }
      __syncthreads();
      typedef short bf8 __attribute__((ext_vector_type(8)));
      const int lane = tid_ & 63, fr = lane & 15, fq = lane >> 4;
      const int gw = F.vcu * NWAVES + F.wave, NGW = F.G * NWAVES;
      for (int t = gw; t < 896; t += NGW) {
          int set, n0; if (t < 96) { set = 0; n0 = t * 16; } else if (t < 448) { set = 1; n0 = (t - 96) * 16; } else if (t < 544) { set = 2; n0 = (t - 448) * 16; } else { set = 3; n0 = (t - 544) * 16; }
          const int l = set >> 1, gu = set & 1;
          const bf16* WT = gu ? (const bf16*)(ws + WS_WGU) + (size_t)l * NGU * DM : (const bf16*)(ws + WS_WIN) + (size_t)l * NIN * DM;
          const bf16* wrow = WT + (size_t)(n0 + fr) * DM + fq * 8; const LAS unsigned short* arow = sh16 + (size_t)set * 16 * 1024 + fr * 1024 + fq * 8;
          pg8::f32x4 acc = {0.f, 0.f, 0.f, 0.f};
#pragma unroll
          for (int s8 = 0; s8 < 32; s8 += 8) { bf8 b[8];
#pragma unroll
              for (int q = 0; q < 8; ++q) b[q] = *(const bf8*)(wrow + (s8 + q) * 32);
#pragma unroll
              for (int q = 0; q < 8; ++q) { const bf8 a = *(const LAS bf8*)(arow + (s8 + q) * 32); acc = __builtin_amdgcn_mfma_f32_16x16x32_bf16(a, b[q], acc, 0, 0, 0); } }
          float* bo = gu ? (float*)(ws + WS_BGU) + l * 9 * NGU : (float*)(ws + WS_BIN) + l * 9 * NIN; const int ldb = gu ? NGU : NIN;
#pragma unroll
          for (int r = 0; r < 4; ++r) { const int j = fq * 4 + r; if (j < 9) bo[j * ldb + n0 + fr] = acc[r]; }
      }
    }
    SUBSTAMP(8);
}
__device__ __forceinline__ void fft8(float (&xr)[8], float (&xi)[8]) {
    const float S = 0.70710678118654752f;
    const float u0r = xr[0] + xr[4], u0i = xi[0] + xi[4], d0r = xr[0] - xr[4], d0i = xi[0] - xi[4];
    const float u1r = xr[1] + xr[5], u1i = xi[1] + xi[5], d1r = xr[1] - xr[5], d1i = xi[1] - xi[5];
    const float u2r = xr[2] + xr[6], u2i = xi[2] + xi[6], d2r = xr[2] - xr[6], d2i = xi[2] - xi[6];
    const float u3r = xr[3] + xr[7], u3i = xi[3] + xi[7], d3r = xr[3] - xr[7], d3i = xi[3] - xi[7];
    const float v0r = d0r, v0i = d0i;
    const float v1r = (d1r + d1i) * S, v1i = (d1i - d1r) * S;
    const float v2r = d2i, v2i = -d2r;
    const float v3r = (d3i - d3r) * S, v3i = -(d3r + d3i) * S;
    { const float p0r = u0r + u2r, p0i = u0i + u2i, p1r = u1r + u3r, p1i = u1i + u3i, p2r = u0r - u2r, p2i = u0i - u2i, qr = u1r - u3r, qi = u1i - u3i; const float p3r = qi, p3i = -qr;
      xr[0] = p0r + p1r; xi[0] = p0i + p1i; xr[4] = p0r - p1r; xi[4] = p0i - p1i; xr[2] = p2r + p3r; xi[2] = p2i + p3i; xr[6] = p2r - p3r; xi[6] = p2i - p3i; }
    { const float p0r = v0r + v2r, p0i = v0i + v2i, p1r = v1r + v3r, p1i = v1i + v3i, p2r = v0r - v2r, p2i = v0i - v2i, qr = v1r - v3r, qi = v1i - v3i; const float p3r = qi, p3i = -qr;
      xr[1] = p0r + p1r; xi[1] = p0i + p1i; xr[5] = p0r - p1r; xi[5] = p0i - p1i; xr[3] = p2r + p3r; xi[3] = p2i + p3i; xr[7] = p2r - p3r; xi[7] = p2i - p3i; }
}
__device__ __forceinline__ void butterfly_phase(Frame& F, unsigned char* ws) {
    bf16* T = (bf16*)(ws + WS_T);
    int tid_ = F.wave * 64 + lane_id(); asm volatile("" : "+v"(tid_));
    const int gt = F.vcu * (NWAVES * 64) + tid_, NGT = F.G * NWAVES * 64;
    for (int it = gt; it < NBATCH * 512 * 128; it += NGT) {
        const int n0 = (it & 127) * 2, bc = it >> 7, b = bc >> 9, ch = bc & 511; bf16* tp = T + ((size_t)(b * 8) * 512 + ch) * 512 + n0 * 2;
        v2u q[8];
#pragma unroll
        for (int j = 0; j < 8; ++j) q[j] = *(const v2u*)(tp + (size_t)j * 512 * 512);
        float ar[8], ai[8], br[8], bi[8];
#define BF_UNP(k) ar[k] = __builtin_bit_cast(float, q[k].x << 16); ai[k] = __builtin_bit_cast(float, q[k].x & 0xffff0000u); br[k] = __builtin_bit_cast(float, q[k].y << 16); bi[k] = __builtin_bit_cast(float, q[k].y & 0xffff0000u);
        BF_UNP(0) BF_UNP(1) BF_UNP(2) BF_UNP(3) BF_UNP(4) BF_UNP(5) BF_UNP(6) BF_UNP(7)
#undef BF_UNP
        fft8(ar, ai); fft8(br, bi);
        const float th0 = (float)n0 * (1.0f / 1024.0f), th1 = (float)(n0 + 1) * (1.0f / 1024.0f);
#define BF_OUT(r) { float s0, c0, s1, c1; sincospif(th0 * (float)(r), &s0, &c0); sincospif(th1 * (float)(r), &s1, &c1); v2u o_; \
          o_.x = pk2(ar[r] * c0 + ai[r] * s0, ai[r] * c0 - ar[r] * s0); o_.y = pk2(br[r] * c1 + bi[r] * s1, bi[r] * c1 - br[r] * s1); *(v2u*)(tp + (size_t)(r) * 512 * 512) = o_; }
        BF_OUT(0) BF_OUT(1) BF_OUT(2) BF_OUT(3) BF_OUT(4) BF_OUT(5) BF_OUT(6) BF_OUT(7)
#undef BF_OUT
    }
}
template <class S> __device__ __forceinline__ void compute_rtab(Frame& F, unsigned char* ws, const S& sched, const float* bias, int NC) {
    LAS float* rt = (LAS float*)(F.lds + RTAB_OFF); LAS float* bt = (LAS float*)(F.lds + BTAB_OFF); pg8::Unit u;
    int tid_ = F.wave * 64 + lane_id(); asm volatile("" : "+v"(tid_));
    const int t = tid_ & 255, par = tid_ >> 8;
    for (int i = 0; i < 7 && sched.next(i, u); ++i) if ((i & 1) == par) { const float* p = (const float*)(ws + WS_SSQ) + ((size_t)u.pm * 256 + t) * 16; float s = 0.f;
        const float bvv = bias[(u.pm < 64 ? (u.pm >> 3) : 8) * NC + u.pn * 256 + t];
#pragma unroll
        for (int q = 0; q < 4; ++q) { const f32x4 a = *(const f32x4*)(p + 4 * q); s += (a[0] + a[1]) + (a[2] + a[3]); }
        rt[i * 256 + t] = __builtin_amdgcn_rsqf(s * (1.0f / 1024.0f) + 1e-6f); bt[i * 256 + t] = bvv; }
    __syncthreads();
}
__device__ __forceinline__ void attn_phase(Frame& F, const Args& A, unsigned char* ws, int l, char* lds) {
    int tid_ = F.wave * 64 + lane_id(); asm volatile("" : "+v"(tid_));
    const float lambda_init = l == 0 ? 0.2f : 0.355509068f;
    const float lam = expf(wave_sum(A.in[11][l * 64 + (tid_ & 63)] * A.in[12][l * 64 + (tid_ & 63)])) - expf(wave_sum(A.in[13][l * 64 + (tid_ & 63)] * A.in[14][l * 64 + (tid_ & 63)])) + lambda_init;
    float gq = fabsf(A.in[9][l * 64 + (tid_ & 63)]), gk = fabsf(A.in[10][l * 64 + (tid_ & 63)]);
#pragma unroll
    for (int o = 1; o < 64; o <<= 1) { gq = fmaxf(gq, __shfl_xor(gq, o)); gk = fmaxf(gk, __shfl_xor(gk, o)); }
    const float negoff = -fmaxf(0.f, 8.0f * 1.4426950408889634f * gq * gk * 1.0001f - 40.0f);
    const att::bf16* QB = (const att::bf16*)(ws + WS_QB); const att::bf16* KB = (const att::bf16*)(ws + WS_KB); const att::bf16* VB = (const att::bf16*)(ws + WS_VB); att::bf16* MIX = (att::bf16*)(ws + WS_MIX);
    const float* subg = A.in[15] + l * 128;
    const int per = (512 + F.G - 1) / F.G;
    for (int u = F.vcu * per; u < (F.vcu + 1) * per && u < 512; ++u) {
        const int qblk = u & 15, bh = u >> 4, b = bh >> 2, h = bh & 3;
        att::attn_unit(QB + h * 128, KB + h * 128, VB + h * 128, MIX + h * 128, (long)b * SEQ + qblk * 128, (long)M_LAT + b * CTXL, 4, (long)b * SEQ, 36, lam, 1.0f - lambda_init, subg, negoff, lds, F.wave, (unsigned)(uintptr_t)F.lds);
    }
#if EN_ATTC
    if (l == 0) for (int u = F.vcu; u < 64; u += F.G) {
        const int qblk = u & 1, bh = u >> 1, b = bh >> 2, h = bh & 3;
        att::attn_unit(QB + h * 128, KB + h * 128, VB + h * 128, MIX + h * 128, (long)M_LAT + b * CTXL + qblk * 128, (long)M_LAT + b * CTXL, 4, 0, 4, lam, 1.0f - lambda_init, subg, negoff, lds, F.wave, (unsigned)(uintptr_t)F.lds);
    }
#endif
}

__global__ void __launch_bounds__(NWAVES * 64, 2) fwd_kernel(const Args args) {
    extern __shared__ __attribute__((aligned(16))) unsigned char lds[];
    Frame F0;
    F0.lds = (LAS unsigned char*)lds;
    F0.wave = __builtin_amdgcn_readfirstlane((int)threadIdx.x >> 6);
    F0.G = gridDim.x; { const int bx = blockIdx.x; F0.vcu = (F0.G % 8 == 0) ? (bx % 8) * (F0.G / 8) + bx / 8 : bx; }
    for (int u = ((int)threadIdx.x); u < (LDS_BYTES - LDSCTL_OFF) / 4; u += NWAVES * 64) ((LAS unsigned*)(F0.lds + LDSCTL_OFF))[u] = 0u;
    __syncthreads();
    volatile LAS unsigned* MISC = (volatile LAS unsigned*)(F0.lds + MISC_OFF);
    (void)xcd_barrier_post((unsigned*)(args.ws + WS_CTL) + CW_BAR, MISC + 8);
    const int lo = args.ph_lo, hi = args.ph_hi;
    const int cid = (int)blockIdx.x;
    const LAS float* rtab = (const LAS float*)(F0.lds + RTAB_OFF);
#pragma unroll 1
    for (int ph = lo; ph < hi; ++ph) {
#if PROBE_A
        if (blockIdx.x == 0 && F0.wave == 0) MISC[16 + ph] = (unsigned)__builtin_amdgcn_s_memrealtime();
#endif
        unsigned char* ws = args.ws; asm volatile("" : "+s"(ws)); const Args& A = args;
        Frame F = F0; asm volatile("" : "+s"(F.G), "+s"(F.vcu), "+s"(F.wave));
        int l = 0, k = -1; if (ph >= 2) { l = (ph - 2) / 6; k = (ph - 2) % 6; }
        if (ph == 0) ph0(F, A, ws);
        else if (ph == 1) ph1(F, A, ws);
        else if (k == 1) continue;
        else if (k == 2) {
            butterfly_phase(F, ws);
            asm volatile("s_waitcnt vmcnt(0)" ::: "memory"); __syncthreads();
            if (F.wave == 0 && lane_id() == 0) { __builtin_amdgcn_fence(__ATOMIC_RELEASE, "agent"); asm volatile("s_waitcnt vmcnt(0)" ::: "memory");
                __hip_atomic_fetch_add((unsigned*)(ws + WS_CTL) + CW_BFCNT + 64 * l, 1u, __ATOMIC_RELAXED, __HIP_MEMORY_SCOPE_AGENT); }
            attn_phase(F, A, ws, l, (char*)lds);
        }
#pragma unroll 1
        for (int ci = 0; ci < 2; ++ci) {
            enum { T_NONE = 0, T_IN = 1, T_DFT = 2, T_RESN = 3, T_RESL = 4, T_GU = 5 };
            int type = T_NONE, nMa = 0, nNa = 0, pmB = 0, nMb = 0, pnB = 0, nNb = 0, Gs = F.G, cs = cid, rot = 0, K = DM, el = l, nshort = 0, ishort = 0; bool ctxdown = false; int sigw = -1, waitw = -1;
#if SCHED_OLD
            const int nM = l == 0 ? 72 : 64;
            if (ci == 0) {
                if (k == 0) { type = T_IN; if (l == 0) { nMa = 72; nNa = 10; } else { nMa = 64; nNa = 10; pmB = 64; nMb = 8; pnB = 2; nNb = 4; } }
                else if (k == 2) { type = T_DFT; nMa = 1; nNa = l == 0 ? 144 : 128; rot = F.G - 64; K = 512; }
                else if (k == 3) { type = T_RESN; nMa = nM; nNa = 4; }
                else if (k == 4) { type = T_GU; nMa = nM; nNa = 22; }
                else if (k == 5) { type = l == NLAYER - 1 ? T_RESL : T_RESN; nMa = nM; nNa = 4; K = FFD; }
            }
#else
            if (k == 0) {
                if (l == 0) { if (ci == 0) { type = T_IN; nMa = 72; nNa = 10; } }
                else if (ci == 0) { type = T_RESN; pmB = 64; nMb = 8; pnB = 0; nNb = 4; K = FFD; el = 0; ctxdown = true; sigw = CW_CTXCNT; }
                else if (cid >= 32) { type = T_IN; nMa = 64; nNa = 10; Gs = F.G - 32; cs = cid - 32; }
                else if (l == NLAYER - 1) { type = T_IN; pmB = 64; nMb = 8; pnB = 2; nNb = 4; waitw = CW_CTXCNT; }
            }
            else if (k == 2) { if (ci == 0) { type = T_DFT; nMa = 1; nNa = l == 0 ? 144 : 128; rot = F.G - 64; K = 512; } }
            else if (k == 3) { if (ci == 0) { type = T_RESN; nMa = 64; nNa = 4; } }
            else if (k == 4) { if (l == 0 && ci == 0) { type = T_RESN; pmB = 64; nMb = 8; pnB = 0; nNb = 4; }
                               else if (ci == (l == 0 ? 1 : 0)) { type = T_GU; nMa = 64; nNa = 22; if (l == 0) { nshort = 32; ishort = 4; } } }
            else if (k == 5) { const int cdn = (l == 0) ? 1 : 0;
                               if (ci == cdn) { type = l == NLAYER - 1 ? T_RESL : T_RESN; nMa = 64; nNa = 4; K = FFD; } else if (l == 0 && ci == 0) { type = T_GU; pmB = 64; nMb = 8; pnB = 0; nNb = 22; } }
#endif
            if (type == T_NONE) continue;
            pg8::Sched2 S; S.init(nMa, nNa, pmB, nMb, pnB, nNb, Gs, cs, rot); S.ns = nshort; S.is = ishort;
            if (waitw >= 0) {
                pg8::Unit u0; if (!S.next(0, u0)) continue;
                if (F.wave == 0) { unsigned* cw = (unsigned*)(ws + WS_CTL) + waitw + 64 * (cid & 7); unsigned sp = 0;
                    while (__hip_atomic_load(cw, __ATOMIC_RELAXED, __HIP_MEMORY_SCOPE_AGENT) < 4u) { __builtin_amdgcn_s_sleep(8); if (++sp > (1u << 22)) break; }
                    __builtin_amdgcn_fence(__ATOMIC_ACQUIRE, "agent"); asm volatile("s_waitcnt vmcnt(0)" ::: "memory"); }
                __syncthreads();
            } S.wgm = (nNa >= 16) ? WGM_WIDE : ((nNa >= 8) ? WGM_MID : 2);
            if (type == T_IN) {
                {
                    int t_ = F.wave * 64 + lane_id(); asm volatile("" : "+v"(t_)); LAS float* et = (LAS float*)(F.lds + ETAB_OFF);
                    for (int i = t_; i < 3072 + 128; i += NWAVES * 64) et[i] = i < 3072 ? ((const float*)(ws + WS_ROPE))[i] : (i < 3136 ? A.in[9][l * 64 + i - 3072] : A.in[10][l * 64 + i - 3136]);
                }
                compute_rtab(F, ws, S, (const float*)(ws + WS_BIN) + l * 9 * NIN, NIN);
                pg8::Gemm g{(const pg8::bf16_t*)(ws + WS_A), (const pg8::bf16_t*)(ws + WS_WIN) + (size_t)l * NIN * DM, M_ALL, NIN, DM};
                pg8::EpiIn E{ws, rtab};
                pg8::gemm_phase<pg8::EpiIn, pg8::Sched2, true, true>(F.lds, g, S, E, F.wave);
            } else if (type == T_DFT) {
                {
                    if (F.wave == 0) { unsigned* cw = (unsigned*)(ws + WS_CTL) + CW_BFCNT + 64 * l; unsigned sp = 0;
                        while (__hip_atomic_load(cw, __ATOMIC_RELAXED, __HIP_MEMORY_SCOPE_AGENT) < (unsigned)F.G) { __builtin_amdgcn_s_sleep(8); if (++sp > (1u << 22)) break; }
                        __builtin_amdgcn_fence(__ATOMIC_ACQUIRE, "agent"); asm volatile("s_waitcnt vmcnt(0)" ::: "memory"); }
                    __syncthreads();
                }
                pg8::Gemm g{(const pg8::bf16_t*)(ws + WS_DFT), (const pg8::bf16_t*)(ws + WS_T), 256, 36864, 512};
                pg8::EpiDft E{(pg8::bf16_t*)(ws + WS_MIX)};
                pg8::gemm_phase<pg8::EpiDft, pg8::Sched2, true, true>(F.lds, g, S, E, F.wave);
            } else if (type == T_GU) {
                compute_rtab(F, ws, S, (const float*)(ws + WS_BGU) + l * 9 * NGU, NGU);
                pg8::Gemm g{(const pg8::bf16_t*)(ws + WS_A), (const pg8::bf16_t*)(ws + WS_WGU) + (size_t)l * NGU * DM, M_ALL, NGU, DM};
                pg8::EpiGU E{ws, rtab};
                pg8::gemm_phase<pg8::EpiGU, pg8::Sched2, true, true>(F.lds, g, S, E, F.wave);
            } else if (type == T_RESN) {
                const bool down = K == FFD;
                const pg8::bf16_t* Ap = down ? (ctxdown ? (const pg8::bf16_t*)(ws + WS_HC) - (size_t)M_LAT * FFD : (const pg8::bf16_t*)(ws + WS_H)) : (const pg8::bf16_t*)(ws + WS_MIX);
                const pg8::bf16_t* Bp = down ? (const pg8::bf16_t*)(ws + WS_WDN) + (size_t)el * DM * FFD : (const pg8::bf16_t*)(ws + WS_WOUT) + (size_t)el * DM * DM;
                pg8::Gemm g{Ap, Bp, M_ALL, DM, K};
                void* xl_out = (!down && el == NLAYER - 1) ? (void*)(ws + WS_XB2) : (void*)A.out;
                pg8::EpiRes<true> E{(const void*)A.out, xl_out, ws, el * 9 * 6144 + (down ? 5120 : 2048), down ? A.in[6] + (el + 1) * DM : A.in[7] + el * DM, down ? (el + 1) * 9 * 6144 + 1024 : el * 9 * 6144 + 4096};
                pg8::gemm_phase<pg8::EpiRes<true>, pg8::Sched2, true, true>(F.lds, g, S, E, F.wave);
                if (sigw >= 0) {
                    pg8::Unit u0; if (S.next(0, u0)) {
                    asm volatile("s_waitcnt vmcnt(0)" ::: "memory"); __syncthreads();
                    if (F.wave == 0 && lane_id() == 0) { __builtin_amdgcn_fence(__ATOMIC_RELEASE, "agent"); asm volatile("s_waitcnt vmcnt(0)" ::: "memory");
                        __hip_atomic_fetch_add((unsigned*)(ws + WS_CTL) + sigw + 64 * (cid & 7), 1u, __ATOMIC_RELAXED, __HIP_MEMORY_SCOPE_AGENT); } }
                }
            } else {
                pg8::Gemm g{(const pg8::bf16_t*)(ws + WS_H), (const pg8::bf16_t*)(ws + WS_WDN) + (size_t)l * DM * FFD, M_ALL, DM, FFD};
                pg8::EpiRes<false> E{(const void*)(ws + WS_XB2), (void*)A.out, ws, l * 9 * 6144 + 5120, nullptr, 0};
                pg8::gemm_phase<pg8::EpiRes<false>, pg8::Sched2, true, true>(F.lds, g, S, E, F.wave);
            }
        }
        if (ph + 1 < hi) { XcdBarrier bar; bar.bar = (unsigned*)(args.ws + WS_CTL) + CW_BAR; bar.x = xb_xcc_id(); bar.st = MISC + 8; xcd_barrier(bar); }
    }
#if PROBE_S
    if (blockIdx.x == 0 && F0.wave == 0) { const unsigned long long t0 = __builtin_amdgcn_s_memrealtime(); const unsigned long long dl = 5ull * (MISC[40 + ((PROBE_S) & 255)] - MISC[40 + ((PROBE_S) >> 8)]);
        while (__builtin_amdgcn_s_memrealtime() - t0 < dl) __builtin_amdgcn_s_sleep(32); }
#endif
#if PROBE_A
    if (blockIdx.x == 0 && F0.wave == 0) { const unsigned long long t0 = __builtin_amdgcn_s_memrealtime(); MISC[16 + N_PHASES] = (unsigned)t0; unsigned long long dl = 0;
        for (int p = 0; p < N_PHASES; ++p) if ((PROBE_A >> p) & 1) dl += 5ull * (MISC[17 + p] - MISC[16 + p]);
        while (__builtin_amdgcn_s_memrealtime() - t0 < dl) __builtin_amdgcn_s_sleep(32); }
#endif
}
static_assert(EWS_MOD == WS_MOD && EWS_BIN == WS_BIN && EWS_BGU == WS_BGU && EWS_ROPE == WS_ROPE && EWS_SSQ == WS_SSQ && EWS_A == WS_A && EWS_XC == WS_XC && EWS_QB == WS_QB && EWS_KB == WS_KB && EWS_VB == WS_VB && EWS_TC == WS_TC && EWS_T == WS_T && EWS_H == WS_H && EWS_HC == WS_HC, "epilogue offsets vs d_ws map");
#ifndef MK_PER_PHASE
#define MK_PER_PHASE 0
#endif
extern "C" void kernel_launch(void* const* d_in, const int* in_sizes, int n_in, void* d_out, int out_size, void* d_ws, size_t ws_size, hipStream_t stream) {
    static int grid = 0;
    if (grid == 0) {
        if (n_in != 21 || in_sizes[0] != M_LAT * DM || out_size != M_LAT * DM || ws_size < WS_END) { fprintf(stderr, "kernel_launch: unexpected shapes (n_in %d, in0 %d, out %d, ws %zu)\n", n_in, n_in > 0 ? in_sizes[0] : -1, out_size, ws_size); grid = -1; return; }
        int dev = 0, cus = 0, per_cu = 0;
        if (hipGetDevice(&dev) != hipSuccess || hipDeviceGetAttribute(&cus, hipDeviceAttributeMultiprocessorCount, dev) != hipSuccess) { grid = -1; return; }
        if (hipFuncSetAttribute((const void*)fwd_kernel, hipFuncAttributeMaxDynamicSharedMemorySize, LDS_BYTES) != hipSuccess) { fprintf(stderr, "kernel_launch: hipFuncSetAttribute failed\n"); grid = -1; return; }
        if (hipOccupancyMaxActiveBlocksPerMultiprocessor(&per_cu, (const void*)fwd_kernel, NWAVES * 64, LDS_BYTES) != hipSuccess || per_cu < 1) { fprintf(stderr, "kernel_launch: occupancy query reports %d\n", per_cu); }
        (void)hipGetLastError();
        grid = cus;
    }
    if (grid < 0) return;
    (void)hipMemsetAsync((char*)d_ws + WS_CTL, 0, CTL_ZERO_BYTES, stream);
    Args a{};
    for (int i = 0; i < 21; ++i) a.in[i] = (const float*)d_in[i];
    a.out = (float*)d_out; a.ws = (unsigned char*)d_ws;
#if MK_PER_PHASE
#ifndef REP_MASK
#define REP_MASK 0
#endif
    for (int ph = 0; ph < N_PHASES; ++ph) { a.ph_lo = ph; a.ph_hi = ph + 1; for (int rep = 0; rep < (((REP_MASK) >> ph) & 1) + 1; ++rep) hipLaunchKernelGGL(fwd_kernel, dim3(grid), dim3(NWAVES * 64), LDS_BYTES, stream, a); }
#else
    a.ph_lo = 0; a.ph_hi = N_PHASES; hipLaunchKernelGGL(fwd_kernel, dim3(grid), dim3(NWAVES * 64), LDS_BYTES, stream, a);
#endif
    const hipError_t le = hipPeekAtLastError();
    if (le != hipSuccess) fprintf(stderr, "kernel_launch: launch failed: %s\n", hipGetErrorName(le));
}
```

```cpp
#define MK_PER_PHASE 0
#include <hip/hip_runtime.h>
#include <cstdio>
#include <cstdint>
#include <math.h>
constexpr size_t EWS_MOD = 64 * 1024, EWS_BIN = 512 * 1024, EWS_BGU = (1u << 20) + 768 * 1024, EWS_ROPE = EWS_BGU + 512 * 1024, EWS_SSQ = 5u << 20, EWS_A = 56u << 20, EWS_XC = 92u << 20,
                 EWS_QB = 100u << 20, EWS_KB = 118u << 20, EWS_VB = 136u << 20, EWS_TC = 186u << 20, EWS_T = 154u << 20, EWS_H = 100u << 20, EWS_HC = 226u << 20;
namespace pg8 {
#define PG8_LAS __attribute__((address_space(3)))
typedef unsigned short bf16_t;
typedef short bf16x8 __attribute__((ext_vector_type(8)));
typedef float f32x4 __attribute__((ext_vector_type(4)));
typedef unsigned u32x4 __attribute__((ext_vector_type(4)));
constexpr int BM = 256, BK = 64, HALF = 128, HTB = HALF * BK * 2  , STAGE_BYTES = 8 * HTB, NXCD = 8, WGM = 2;

__host__ __device__ __forceinline__ int lds_byte(int r, int c) { const int st = (r >> 4) * 2 + (c >> 5), rr = r & 15, cc = c & 31, ob = rr * 64 + cc * 2; return st * 1024 + (ob ^ (((ob >> 9) & 1) << 5)); }
__host__ __device__ __forceinline__ void stage_rc(int b, int& R, int& C) { const int st = b / 1024, sb = b % 1024, swz = sb ^ (((sb >> 9) & 1) << 5); R = (st >> 1) * 16 + swz / 64; C = (st & 1) * 32 + (swz % 64) / 2; }
__host__ __device__ __forceinline__ int perm32(int rho) { const int n = rho >> 4, i = rho & 15; return 8 * (i >> 2) + 4 * n + (i & 3); }

struct Unit { int pm, pn; };
struct Gemm { const bf16_t* A; const bf16_t* Bt; int M, N, K; };

struct StaticOrder {
    int nM, nN, nwg, G, c;
    __host__ __device__ void init(int M, int N, int G_, int c_) { nM = M / BM; nN = N / BM; nwg = nM * nN; G = G_; c = c_; }
    __host__ __device__ bool next(int i, Unit& u) const {
        const long L = (long)i * G + c; if (L >= nwg) return false;
        int wgid = (int)L; { const int q = nwg / NXCD, r = nwg % NXCD, xcd = wgid % NXCD, off = wgid / NXCD; wgid = (xcd < r ? xcd * (q + 1) : r * (q + 1) + (xcd - r) * q) + off; }
        const int nig = WGM * nN, gid = wgid / nig, fm = gid * WGM, gsz = (nM - fm) < WGM ? (nM - fm) : WGM;
        u.pm = fm + ((wgid % nig) % gsz); u.pn = (wgid % nig) / gsz; return true;
    }
    __device__ __forceinline__ void a_ready(const Unit&) const {}
    __device__ __forceinline__ void done(const Unit&) const {}
};

struct Sched2 {
    int nMa, nNa, nA, pmB, nMb, pnB, nNb, nB, G, c, ns = 0, is = 0, wgm = WGM;
    __device__ void init(int nMa_, int nNa_, int pmB_, int nMb_, int pnB_, int nNb_, int G_, int c_, int rot) { nMa = nMa_; nNa = nNa_; nA = nMa * nNa; pmB = pmB_; nMb = nMb_; pnB = pnB_; nNb = nNb_; nB = nMb * nNb; G = G_; c = (c_ + rot) % G_; }
    __device__ bool next(int i, Unit& u) const {
        long L;
        if (ns == 0 || i < is) { if (ns != 0 && i >= is && c < ns) return false; L = (long)i * G + c; }
        else { if (c < ns) return false; L = (long)is * G + (long)(i - is) * (G - ns) + (c - ns); }
        if (L >= nA + nB) return false;
        if (L < nA) {
            int wgid = (int)L; { const int q = nA / NXCD, r = nA % NXCD, xcd = wgid % NXCD, off = wgid / NXCD; wgid = (xcd < r ? xcd * (q + 1) : r * (q + 1) + (xcd - r) * q) + off; }
            const int nig = wgm * nNa, gid = wgid / nig, fm = gid * wgm, gsz = (nMa - fm) < wgm ? (nMa - fm) : wgm;
            u.pm = fm + ((wgid % nig) % gsz); u.pn = (wgid % nig) / gsz;
        } else { const int r = (int)L - nA; u.pm = pmB + r % nMb; u.pn = pnB + r / nMb; }
        return true;
    }
    __device__ __forceinline__ void a_ready(const Unit&) const {}
    __device__ __forceinline__ void done(const Unit&) const {}
};
__device__ __forceinline__ unsigned cvt_pk_bf16(float lo, float hi) { unsigned r; asm volatile("v_cvt_pk_bf16_f32 %0, %1, %2" : "=v"(r) : "v"(lo), "v"(hi)); return r; }
typedef unsigned u32x2 __attribute__((ext_vector_type(2)));
__device__ __forceinline__ u32x2 pk4(f32x4 v) { u32x2 w; w.x = cvt_pk_bf16(v[0], v[1]); w.y = cvt_pk_bf16(v[2], v[3]); return w; }
#ifndef WT_STORES
#define WT_STORES 0
#endif
#ifndef NT_STORES
#define NT_STORES 0
#endif
__device__ __forceinline__ void st8(void* p, u32x2 v) {
#if WT_STORES
    __hip_atomic_store((unsigned long long*)p, ((unsigned long long)v.y << 32) | v.x, __ATOMIC_RELAXED, __HIP_MEMORY_SCOPE_AGENT);
#elif NT_STORES
    __builtin_nontemporal_store(v, (u32x2*)p);
#else
    *(u32x2*)p = v;
#endif
}
__device__ __forceinline__ float rowsum4(float s) {
    { const unsigned u = __builtin_bit_cast(unsigned, s); auto a = __builtin_amdgcn_permlane16_swap(u, u, false, false); const unsigned a0 = a[0], a1 = a[1]; s = __builtin_bit_cast(float, a0) + __builtin_bit_cast(float, a1); }
    { const unsigned u = __builtin_bit_cast(unsigned, s); auto b = __builtin_amdgcn_permlane32_swap(u, u, false, false); const unsigned b0 = b[0], b1 = b[1]; s = __builtin_bit_cast(float, b0) + __builtin_bit_cast(float, b1); }
    return s;
}
__device__ __forceinline__ float dot4(f32x4 v) { return (v[0] * v[0] + v[1] * v[1]) + (v[2] * v[2] + v[3] * v[3]); }
constexpr int BT_F = (140288 - 131072) / 4, ET_F = (147456 - 131072) / 4;
constexpr int M_LAT_TILES = 64;
constexpr float QSCALE = 0.125f * 1.4426950408889634f;
constexpr float ZS_LAT = 1.0f / 512.0f;
constexpr float ZS_CTX = 0.005524271728019903f;

struct EpiIn {
    static constexpr bool PERM = false, AFTER_DRAIN = false;
    unsigned char* ws; const PG8_LAS float* rtab;
    __device__ __forceinline__ void operator()(const f32x4 (&acc)[2][2][4][2], const Unit& u, int ui, int wr, int wc, int fr, int fq) const {
        const int pm = u.pm, pn = u.pn; const bool lat = pm < M_LAT_TILES; const int bm = lat ? (pm >> 3) : 8;
        const PG8_LAS float* rope = rtab + ET_F;
        bf16_t* QB = (bf16_t*)(ws + EWS_QB); bf16_t* KB = (bf16_t*)(ws + EWS_KB); bf16_t* VB = (bf16_t*)(ws + EWS_VB); bf16_t* T = (bf16_t*)(ws + EWS_T); bf16_t* Tc = (bf16_t*)(ws + EWS_TC);
        const PG8_LAS float* bp = rtab + BT_F + ui * 256 + wc * 32 + fq * 4;
        f32x4 bv[2][2];
#pragma unroll
        for (int bj = 0; bj < 2; ++bj)
#pragma unroll
            for (int n = 0; n < 2; ++n) bv[bj][n] = *(const PG8_LAS f32x4*)(bp + bj * 128 + n * 16);
        const PG8_LAS float* rt = rtab + ui * 256 + wr * 64 + fr;
        if (pn < 4) {
            const PG8_LAS float* gp = rope + 3072 + (pn < 2 ? 0 : 64) + fq * 4; const float qs = pn < 2 ? QSCALE : 1.f;
            f32x4 gv[2][2];
#pragma unroll
            for (int bj = 0; bj < 2; ++bj)
#pragma unroll
                for (int n = 0; n < 2; ++n) gv[bj][n] = *(const PG8_LAS f32x4*)(gp + bj * 32 + n * 16) * qs;
            bf16_t* dst = (pn < 2 ? QB : KB) + (pn & 1) * 256 + wc * 64 + fq * 4;
#pragma unroll
            for (int ai = 0; ai < 2; ++ai)
#pragma unroll
                for (int m = 0; m < 4; ++m) {
                    const int rl = ai * 128 + wr * 64 + m * 16 + fr, row = pm * 256 + rl; const float r = rt[ai * 128 + m * 16];
                    f32x4 v[2][2]; float ssq = 0.f;
#pragma unroll
                    for (int bj = 0; bj < 2; ++bj)
#pragma unroll
                        for (int n = 0; n < 2; ++n) { v[bj][n] = acc[ai][bj][m][n] * r + bv[bj][n]; ssq += dot4(v[bj][n]); }
                    ssq = rowsum4(ssq);
                    const float rn = __builtin_amdgcn_rsqf(ssq * (1.0f / 64.0f) + 1e-6f);
#pragma unroll
                    for (int bj = 0; bj < 2; ++bj)
#pragma unroll
                        for (int n = 0; n < 2; ++n) v[bj][n] = v[bj][n] * rn * gv[bj][n];
                    if (lat) { const int pos = row & 2047;
#pragma unroll
                        for (int bj = 0; bj < 2; ++bj) { const PG8_LAS float* cp = rope + (bj == 0 ? (pos >> 6) : 32 + (pos & 63)) * 16 + fq * 4; const f32x4 c4 = *(const PG8_LAS f32x4*)cp, s4 = *(const PG8_LAS f32x4*)(cp + 1536); const f32x4 t1 = v[bj][0], t2 = v[bj][1];
                            v[bj][0] = t1 * c4 - t2 * s4; v[bj][1] = t2 * c4 + t1 * s4; } }
#pragma unroll
                    for (int bj = 0; bj < 2; ++bj)
#pragma unroll
                        for (int n = 0; n < 2; ++n) *(u32x2*)(dst + (size_t)row * 512 + bj * 32 + n * 16) = pk4(v[bj][n]);
                }
        } else if (pn < 6) {
            bf16_t* dst = VB + (pn - 4) * 256 + wc * 32 + fq * 4;
#pragma unroll
            for (int ai = 0; ai < 2; ++ai)
#pragma unroll
                for (int m = 0; m < 4; ++m) {
                    const int rl = ai * 128 + wr * 64 + m * 16 + fr, row = pm * 256 + rl; const float r = rt[ai * 128 + m * 16];
#pragma unroll
                    for (int bj = 0; bj < 2; ++bj)
#pragma unroll
                        for (int n = 0; n < 2; ++n) *(u32x2*)(dst + (size_t)row * 512 + bj * 128 + n * 16) = pk4(acc[ai][bj][m][n] * r + bv[bj][n]);
                }
        } else {
            const int g = pn - 6; const float zs = lat ? ZS_LAT : ZS_CTX;
            const int b = lat ? (pm >> 3) : (pm - M_LAT_TILES);
            bf16_t* tb = (lat ? T + (size_t)((b * 8 + (pm & 7)) * 512) * 512 : Tc + (size_t)(b * 512) * 512) + (size_t)(g * 128 + wc * 32 + fq * 4) * 512;
#pragma unroll
            for (int ai = 0; ai < 2; ++ai)
#pragma unroll
                for (int m = 0; m < 4; ++m) {
                    const int rl = ai * 128 + wr * 64 + m * 16 + fr; const float r = rt[ai * 128 + m * 16];
#pragma unroll
                    for (int n = 0; n < 2; ++n) { const f32x4 re = (acc[ai][0][m][n] * r + bv[0][n]) * zs, im = (acc[ai][1][m][n] * r + bv[1][n]) * zs;
#pragma unroll
                        for (int i = 0; i < 4; ++i) *(unsigned*)(tb + (size_t)(n * 16 + i) * 512 + rl * 2) = cvt_pk_bf16(re[i], im[i]); }
                }
        }
    }
};
typedef _Float16 h16x2 __attribute__((ext_vector_type(2)));
__device__ __forceinline__ unsigned pkh2(float a, float b) { const h16x2 h = {(_Float16)a, (_Float16)b}; return __builtin_bit_cast(unsigned, h); }
__device__ __forceinline__ u32x2 pkh4(f32x4 v) { u32x2 w; w.x = pkh2(v[0], v[1]); w.y = pkh2(v[2], v[3]); return w; }
__device__ __forceinline__ f32x4 unh4(u32x2 w) { const unsigned lo = w.x, hi = w.y; const h16x2 a = __builtin_bit_cast(h16x2, lo), b = __builtin_bit_cast(h16x2, hi);     return (f32x4){(float)a[0], (float)a[1], (float)b[0], (float)b[1]}; }
template <bool NEXT> struct EpiRes {
    static constexpr bool PERM = false, AFTER_DRAIN = false;
    const void* xl_in; void* xl_out;
    unsigned char* ws; int gate_off;
    const float* ng; int nsc_off;
    __device__ __forceinline__ void operator()(const f32x4 (&acc)[2][2][4][2], const Unit& u, int ui, int wr, int wc, int fr, int fq) const {
        const int pm = u.pm, pn = u.pn; const bool lat = pm < M_LAT_TILES; const int bm = lat ? (pm >> 3) : 8; const int col0 = pn * 256 + wc * 32 + fq * 4;
        const float* gate = (const float*)(ws + EWS_MOD) + gate_off; const float* nsc = (const float*)(ws + EWS_MOD) + nsc_off; bf16_t* A = (bf16_t*)(ws + EWS_A); float* ssq = (float*)(ws + EWS_SSQ);
        const _Float16* xin = lat ? (const _Float16*)xl_in + (size_t)pm * 256 * 1024 : (const _Float16*)(ws + EWS_XC) + (size_t)(pm - M_LAT_TILES) * 256 * 1024;
        _Float16* xout = lat ? (_Float16*)xl_out + (size_t)pm * 256 * 1024 : (_Float16*)(ws + EWS_XC) + (size_t)(pm - M_LAT_TILES) * 256 * 1024;
        float* xoutf = (float*)xl_out + (size_t)pm * 256 * 1024;
        float ssq_[2][4];
#pragma unroll
        for (int ai = 0; ai < 2; ++ai)
#pragma unroll
            for (int m = 0; m < 4; ++m) ssq_[ai][m] = 0.f;
        f32x4 ga[2][2], gv[2][2]; u32x2 preA[4][2], preB[4][2];
        auto loadx = [&](int g, u32x2 (&p)[4][2]) __attribute__((always_inline)) { const int bj = g >> 1, ai = g & 1;
#pragma unroll
            for (int m = 0; m < 4; ++m)
#pragma unroll
                for (int n = 0; n < 2; ++n) p[m][n] = *(const u32x2*)(xin + (size_t)(ai * 128 + wr * 64 + m * 16 + fr) * 1024 + col0 + bj * 128 + n * 16); };
        auto loadg = [&](int bj) __attribute__((always_inline)) {
#pragma unroll
            for (int n = 0; n < 2; ++n) { const int c = col0 + bj * 128 + n * 16; ga[bj][n] = *(const f32x4*)(gate + bm * 6144 + c);
                if (NEXT) gv[bj][n] = *(const f32x4*)(ng + c) * (*(const f32x4*)(nsc + bm * 6144 + c) + 1.0f); } };
        auto proc = [&](int g, const u32x2 (&p)[4][2]) __attribute__((always_inline)) { const int bj = g >> 1, ai = g & 1;
#pragma unroll
            for (int m = 0; m < 4; ++m) {
                const int rl = ai * 128 + wr * 64 + m * 16 + fr; const size_t row = (size_t)pm * 256 + rl;
#pragma unroll
                for (int n = 0; n < 2; ++n) { const size_t off = (size_t)rl * 1024 + col0 + bj * 128 + n * 16; const f32x4 xn = unh4(p[m][n]) + ga[bj][n] * acc[ai][bj][m][n];
                    if (NEXT) *(u32x2*)(xout + off) = pkh4(xn); else *(f32x4*)(xoutf + off) = xn;
                    if (NEXT) { ssq_[ai][m] += dot4(xn); *(u32x2*)(A + row * 1024 + col0 + bj * 128 + n * 16) = pk4(xn * gv[bj][n]); } }
            }
            asm volatile("" ::: "memory"); };
        loadx(0, preA); loadg(0); loadx(1, preB); asm volatile("" ::: "memory");
        proc(0, preA); loadg(1); loadx(2, preA); asm volatile("" ::: "memory");
        proc(1, preB); loadx(3, preB); asm volatile("" ::: "memory");
        proc(2, preA); proc(3, preB);
        if (NEXT) {
#pragma unroll
            for (int ai = 0; ai < 2; ++ai)
#pragma unroll
                for (int m = 0; m < 4; ++m) { const float s = rowsum4(ssq_[ai][m]); if (fq == 0) ssq[((size_t)pm * 256 + ai * 128 + wr * 64 + m * 16 + fr) * 16 + pn * 4 + wc] = s; }
        }
    }
};
struct EpiGU {
    static constexpr bool PERM = false, AFTER_DRAIN = false;
    unsigned char* ws; const PG8_LAS float* rtab;
    __device__ __forceinline__ void operator()(const f32x4 (&acc)[2][2][4][2], const Unit& u, int ui, int wr, int wc, int fr, int fq) const {
        const int pm = u.pm, pn = u.pn; const int bm = pm < M_LAT_TILES ? (pm >> 3) : 8;
        bf16_t* H = (bf16_t*)(ws + EWS_H);
        const PG8_LAS float* bp = rtab + BT_F + ui * 256 + wc * 32 + fq * 4;
        f32x4 bg[2], bu[2];
#pragma unroll
        for (int n = 0; n < 2; ++n) { bg[n] = *(const PG8_LAS f32x4*)(bp + n * 16); bu[n] = *(const PG8_LAS f32x4*)(bp + 128 + n * 16); }
        const PG8_LAS float* rt = rtab + ui * 256 + wr * 64 + fr;
        if (pm >= M_LAT_TILES) H = (bf16_t*)(ws + EWS_HC) - (size_t)16384 * 2816;
        bf16_t* dst = H + pn * 128 + wc * 32 + fq * 4;
#pragma unroll
        for (int ai = 0; ai < 2; ++ai)
#pragma unroll
            for (int m = 0; m < 4; ++m) {
                const int rl = ai * 128 + wr * 64 + m * 16 + fr; const size_t row = (size_t)pm * 256 + rl; const float r = rt[ai * 128 + m * 16];
#pragma unroll
                for (int n = 0; n < 2; ++n) { const f32x4 gg = acc[ai][0][m][n] * r + bg[n], uu = acc[ai][1][m][n] * r + bu[n]; f32x4 h;
#pragma unroll
                    for (int i = 0; i < 4; ++i) h[i] = gg[i] * __builtin_amdgcn_rcpf(1.0f + __builtin_amdgcn_exp2f(-1.4426950408889634f * gg[i])) * uu[i];
                    st8(dst + row * 2816 + n * 16, pk4(h)); }
            }
    }
};
struct EpiDft {
    static constexpr bool PERM = true, AFTER_DRAIN = false;
    bf16_t* MIX;
    __device__ __forceinline__ void operator()(const f32x4 (&acc)[2][2][4][2], const Unit& u, int ui, int wr, int wc, int fr, int fq) const {
        const int pn = u.pn;
#pragma unroll
        for (int bj = 0; bj < 2; ++bj) {
            const int c = pn * 256 + bj * 128 + wc * 32 + fq * 8; int rowbase, rstride, ch;
            if (pn < 128) { const int b = c >> 12, r = (c >> 9) & 7; ch = c & 511; rowbase = b * 2048 + r; rstride = 8; }
            else { const int c2 = c - 32768; const int b = c2 >> 9; ch = c2 & 511; rowbase = 16384 + b * 256; rstride = 1; }
#pragma unroll
            for (int ai = 0; ai < 2; ++ai)
#pragma unroll
                for (int m = 0; m < 4; ++m) { const int mm = ai * 128 + wr * 64 + m * 16 + fr; const size_t row = (size_t)rowbase + (size_t)mm * rstride;
                    const f32x4 v0 = acc[ai][bj][m][0], v1 = acc[ai][bj][m][1]; u32x4 w; w.x = cvt_pk_bf16(v0[0], v0[1]); w.y = cvt_pk_bf16(v0[2], v0[3]); w.z = cvt_pk_bf16(v1[0], v1[1]); w.w = cvt_pk_bf16(v1[2], v1[3]);
                    *(u32x4*)(MIX + row * 1024 + 512 + ch) = w; }
        }
    }
};
template <class Epi, class Sched, bool ALIGN_EPI = false, bool SP2 = false>
__device__ __forceinline__ void gemm_phase(PG8_LAS unsigned char* lds, const Gemm g, const Sched& S, const Epi& E, int wave_) {
    unsigned z_ = 0u; asm volatile("" : "+v"(z_)); int tid_ = wave_ * 64 + (int)__builtin_amdgcn_mbcnt_hi(~0u, __builtin_amdgcn_mbcnt_lo(~0u, z_)); asm volatile("" : "+v"(tid_));
    const int tid = tid_, wid = __builtin_amdgcn_readfirstlane(tid >> 6), lane = tid & 63, wr = wid >> 2, wc = wid & 3, fr = lane & 15, fq = lane >> 4;
    const int K = g.K, nt = K / BK;
    unsigned voffA[2], voffB[2];
#pragma unroll
    for (int i = 0; i < 2; ++i) { int R, C; stage_rc(tid * 16 + i * 8192, R, C); const int Rb = Epi::PERM ? ((R & ~31) + perm32(R & 31)) : R;
        voffA[i] = (unsigned)(R * K + C) * 2u; voffB[i] = (unsigned)(Rb * K + C) * 2u; }
    const size_t kstep = (size_t)(BK * 2);
    const size_t hstep = (size_t)HALF * K * 2;
    const size_t tstep = 2 * hstep;
    const unsigned ldsw = (unsigned)wid * 1024u;
    const int aoff = lds_byte(wr * 64 + fr, fq * 8), boff = lds_byte(wc * 32 + fr, fq * 8);
#define PG8_SA(b, h) (((b) * 2 + (h)) * HTB)
#define PG8_SB(b, h) ((4 + (b) * 2 + (h)) * HTB)
#define PG8_STAGE(bufoff, gbase, voff) do { _Pragma("unroll") for (int _i = 0; _i < 2; ++_i) \
        __builtin_amdgcn_global_load_lds((const unsigned*)((const char*)(gbase) + (voff)[_i]), (PG8_LAS unsigned*)(lds + (bufoff) + ldsw + _i * 8192), 16, 0, 0); } while (0)
#define PG8_LDA(dst, b, h) do { _Pragma("unroll") for (int m = 0; m < 4; ++m) _Pragma("unroll") for (int k = 0; k < 2; ++k) dst[m][k] = *(const PG8_LAS bf16x8*)(lds + PG8_SA(b, h) + aoff + m * 2048 + k * 1024); } while (0)
#define PG8_LDB(dst, b, h) do { _Pragma("unroll") for (int n = 0; n < 2; ++n) _Pragma("unroll") for (int k = 0; k < 2; ++k) dst[n][k] = *(const PG8_LAS bf16x8*)(lds + PG8_SB(b, h) + boff + n * 2048 + k * 1024); } while (0)
#define PG8_MMA(ai, bj, At, Bt) do { __builtin_amdgcn_s_setprio(1); _Pragma("unroll") for (int m = 0; m < 4; ++m) _Pragma("unroll") for (int n = 0; n < 2; ++n) _Pragma("unroll") for (int k = 0; k < 2; ++k) \
        acc[ai][bj][m][n] = __builtin_amdgcn_mfma_f32_16x16x32_bf16(Bt[n][k], At[m][k], acc[ai][bj][m][n], 0, 0, 0); __builtin_amdgcn_s_setprio(0); } while (0)
#define PG8_WAIT_V(n) asm volatile("s_waitcnt vmcnt(" #n ")" ::: "memory")
#define PG8_WAIT_L(n) asm volatile("s_waitcnt lgkmcnt(" #n ")" ::: "memory")
#define PG8_BAR __builtin_amdgcn_s_barrier()
#define PG8_SCHED __builtin_amdgcn_sched_barrier(0)
    Unit cur, nxt; int ui = 0;
    if (!S.next(0, cur)) return;
    f32x4 acc[2][2][4][2];
#pragma unroll
    for (int a = 0; a < 2; ++a)
#pragma unroll
        for (int b = 0; b < 2; ++b)
#pragma unroll
            for (int m = 0; m < 4; ++m)
#pragma unroll
                for (int n = 0; n < 2; ++n) acc[a][b][m][n] = (f32x4){0.f, 0.f, 0.f, 0.f};
    bf16x8 At[4][2], B0[2][2], B1[2][2];
    const char* cA = (const char*)g.A + (size_t)cur.pm * tstep; const char* cB = (const char*)g.Bt + (size_t)cur.pn * tstep;
    S.a_ready(cur);
    if constexpr (SP2) {
        PG8_STAGE(PG8_SB(0, 0), cB, voffB); PG8_STAGE(PG8_SB(0, 1), cB + hstep, voffB); PG8_STAGE(PG8_SA(0, 0), cA, voffA); PG8_STAGE(PG8_SA(0, 1), cA + hstep, voffA);
        if (wr == 1) PG8_BAR;
        PG8_WAIT_V(2); PG8_BAR;
        PG8_STAGE(PG8_SB(1, 0), cB + kstep, voffB); PG8_STAGE(PG8_SA(1, 0), cA + kstep, voffA); PG8_STAGE(PG8_SB(1, 1), cB + hstep + kstep, voffB);
        PG8_WAIT_V(6); PG8_BAR;
    } else {
        PG8_STAGE(PG8_SB(0, 0), cB, voffB); PG8_STAGE(PG8_SA(0, 0), cA, voffA); PG8_STAGE(PG8_SB(0, 1), cB + hstep, voffB); PG8_STAGE(PG8_SA(0, 1), cA + hstep, voffA);
        if (wr == 1) PG8_BAR;
        PG8_WAIT_V(4); PG8_BAR;
        PG8_STAGE(PG8_SB(1, 0), cB + kstep, voffB); PG8_STAGE(PG8_SA(1, 0), cA + kstep, voffA); PG8_STAGE(PG8_SB(1, 1), cB + hstep + kstep, voffB);
        PG8_WAIT_V(6); PG8_BAR;
    }
    for (;;) {
        const bool has_next = S.next(ui + 1, nxt);
        const char* nA = has_next ? (const char*)g.A + (size_t)nxt.pm * tstep : cA; const char* nB = has_next ? (const char*)g.Bt + (size_t)nxt.pn * tstep : cB;
        for (int t = 0; t < nt; t += 2) {
            const bool last = (t == nt - 2);
            const char* a1 = cA + (size_t)(t + 1) * kstep;
            const char* a2 = last ? nA : cA + (size_t)(t + 2) * kstep; const char* b2 = last ? nB : cB + (size_t)(t + 2) * kstep;
            const char* a3 = a2 + kstep; const char* b3 = b2 + kstep;
            if (last && has_next) S.a_ready(nxt);
            if constexpr (SP2) {
            PG8_LDB(B0, 0, 0); PG8_LDB(B1, 0, 1); PG8_SCHED; PG8_LDA(At, 0, 0); PG8_STAGE(PG8_SA(1, 1), a1 + hstep, voffA);
            PG8_WAIT_V(8); PG8_WAIT_L(0); PG8_BAR; PG8_MMA(0, 0, At, B0); PG8_MMA(0, 1, At, B1); PG8_BAR; PG8_SCHED;
            PG8_LDA(At, 0, 1); PG8_STAGE(PG8_SB(0, 0), b2, voffB); PG8_STAGE(PG8_SB(0, 1), b2 + hstep, voffB); PG8_STAGE(PG8_SA(0, 0), a2, voffA);
            PG8_WAIT_V(8); PG8_WAIT_L(0); PG8_BAR; PG8_MMA(1, 0, At, B0); PG8_MMA(1, 1, At, B1); PG8_BAR; PG8_SCHED;
            PG8_LDB(B0, 1, 0); PG8_LDB(B1, 1, 1); PG8_SCHED; PG8_LDA(At, 1, 0); PG8_STAGE(PG8_SA(0, 1), a2 + hstep, voffA);
            PG8_WAIT_V(8); PG8_WAIT_L(0); PG8_BAR; PG8_MMA(0, 0, At, B0); PG8_MMA(0, 1, At, B1); PG8_BAR; PG8_SCHED;
            PG8_LDA(At, 1, 1); PG8_STAGE(PG8_SB(1, 0), b3, voffB); PG8_STAGE(PG8_SB(1, 1), b3 + hstep, voffB); PG8_STAGE(PG8_SA(1, 0), a3, voffA);
            PG8_WAIT_V(8); PG8_WAIT_L(0); PG8_BAR; PG8_MMA(1, 0, At, B0); PG8_MMA(1, 1, At, B1); PG8_BAR; PG8_SCHED;
            } else {
            PG8_LDB(B0, 0, 0); PG8_SCHED; PG8_LDA(At, 0, 0); PG8_STAGE(PG8_SA(1, 1), a1 + hstep, voffA);
            PG8_WAIT_L(8); PG8_BAR; PG8_WAIT_L(0); PG8_MMA(0, 0, At, B0); PG8_BAR; PG8_SCHED;
            PG8_LDB(B1, 0, 1); PG8_STAGE(PG8_SB(0, 0), b2, voffB);
            PG8_BAR; PG8_WAIT_L(0); PG8_MMA(0, 1, At, B1); PG8_BAR;
            PG8_LDA(At, 0, 1); PG8_STAGE(PG8_SA(0, 0), a2, voffA);
            PG8_BAR; PG8_WAIT_L(0); PG8_MMA(1, 0, At, B0); PG8_BAR; PG8_SCHED;
            PG8_STAGE(PG8_SB(0, 1), b2 + hstep, voffB);
            PG8_WAIT_V(6); PG8_BAR; PG8_MMA(1, 1, At, B1); PG8_BAR;
            PG8_LDB(B0, 1, 0); PG8_SCHED; PG8_LDA(At, 1, 0); PG8_STAGE(PG8_SA(0, 1), a2 + hstep, voffA);
            PG8_WAIT_L(8); PG8_BAR; PG8_WAIT_L(0); PG8_MMA(0, 0, At, B0); PG8_BAR; PG8_SCHED;
            PG8_LDB(B1, 1, 1); PG8_STAGE(PG8_SB(1, 0), b3, voffB);
            PG8_BAR; PG8_WAIT_L(0); PG8_MMA(0, 1, At, B1); PG8_BAR;
            PG8_LDA(At, 1, 1); PG8_STAGE(PG8_SA(1, 0), a3, voffA);
            PG8_BAR; PG8_WAIT_L(0); PG8_MMA(1, 0, At, B0); PG8_BAR; PG8_SCHED;
            PG8_STAGE(PG8_SB(1, 1), b3 + hstep, voffB);
            PG8_WAIT_V(6); PG8_BAR; PG8_MMA(1, 1, At, B1); PG8_BAR;
            }
        }
        if constexpr (ALIGN_EPI) { if (wr == 0) PG8_BAR; }
        if constexpr (!Epi::AFTER_DRAIN) { int fr_ = fr, fq_ = fq; asm volatile("" : "+v"(fr_), "+v"(fq_)); E(acc, cur, ui, wr, wc, fr_, fq_); S.done(cur); }
        if (!has_next) break;
#pragma unroll
        for (int a = 0; a < 2; ++a)
#pragma unroll
            for (int b = 0; b < 2; ++b)
#pragma unroll
                for (int m = 0; m < 4; ++m)
#pragma unroll
                    for (int n = 0; n < 2; ++n) acc[a][b][m][n] = (f32x4){0.f, 0.f, 0.f, 0.f};
        cur = nxt; cA = nA; cB = nB; ++ui;
        if constexpr (ALIGN_EPI) { if (wr == 1) PG8_BAR; }
    }
    PG8_WAIT_V(0);
    if constexpr (!ALIGN_EPI) { if (wr == 0) PG8_BAR; }
    PG8_BAR;
    if constexpr (Epi::AFTER_DRAIN) { E.fused(acc, cur, wr, wc, fr, fq, lds, wid, lane); S.done(cur); }
#undef PG8_SA
#undef PG8_SB
#undef PG8_STAGE
#undef PG8_LDA
#undef PG8_LDB
#undef PG8_MMA
#undef PG8_WAIT_V
#undef PG8_WAIT_L
#undef PG8_BAR
#undef PG8_SCHED
}
}
#ifndef EN_ATTEPI
#define EN_ATTEPI 1
#endif
namespace att {
typedef unsigned short bf16;
using bf16x8 = __attribute__((ext_vector_type(8))) short;
using s16x4  = __attribute__((ext_vector_type(4))) short;
using f32x16 = __attribute__((ext_vector_type(16))) float;
using u32x4  = __attribute__((ext_vector_type(4))) unsigned;
constexpr int KVBLK = 64;
constexpr int NBUF = 3;
constexpr size_t SHM_V = KVBLK * 128 * 2, SHM_K = KVBLK * 128 * 2, SHM_ATTN = NBUF * SHM_V + NBUF * SHM_K + 8 * 64 * 4;
#define KSWZ(row, colB) ((row) * 256 + ((colB) ^ (((row) & 7) << 4)))
#define SBAR() __builtin_amdgcn_sched_barrier(0)
__device__ __forceinline__ int crow(int r, int hi) { return (r & 3) + 8 * (r >> 2) + 4 * hi; }
__device__ __forceinline__ unsigned cvtpk(float lo, float hi) { unsigned r; asm volatile("v_cvt_pk_bf16_f32 %0, %1, %2" : "=v"(r) : "v"(lo), "v"(hi)); return r; }
__device__ __forceinline__ bf16x8 ld8(const bf16* p) { return *reinterpret_cast<const bf16x8*>(p); }
__device__ __forceinline__ void sm_first(f32x16& p0, f32x16& p1, float negoff) {
  (void)p1; (void)negoff;
#pragma unroll
  for (int r = 0; r < 16; ++r) p0[r] = __builtin_amdgcn_exp2f(p0[r]);
}
__device__ __forceinline__ void sm_finish(f32x16& p0, f32x16& p1, float& l_reg, bf16x8& pa0, bf16x8& pa1, bf16x8& pa2, bf16x8& pa3) {
#pragma unroll
  for (int r = 0; r < 16; ++r) p1[r] = __builtin_amdgcn_exp2f(p1[r]);
  float ps = 0;
#pragma unroll
  for (int r = 0; r < 16; ++r) ps += p0[r];
#pragma unroll
  for (int r = 0; r < 16; ++r) ps += p1[r];
  l_reg += ps;
#define PK4(P, BASE, OUT) do { unsigned a0 = cvtpk(P[BASE + 0], P[BASE + 1]), a1 = cvtpk(P[BASE + 2], P[BASE + 3]);   \
    unsigned b0 = cvtpk(P[BASE + 4], P[BASE + 5]), b1 = cvtpk(P[BASE + 6], P[BASE + 7]);                              \
    auto r0 = __builtin_amdgcn_permlane32_swap(a0, b0, false, false); auto r1 = __builtin_amdgcn_permlane32_swap(a1, b1, false, false); \
    u32x4 w = {r0[0], r1[0], r0[1], r1[1]}; OUT = *reinterpret_cast<bf16x8*>(&w); } while (0)
  PK4(p0, 0, pa0); PK4(p0, 8, pa1); PK4(p1, 0, pa2); PK4(p1, 8, pa3);
#undef PK4
}
__device__ __forceinline__ void qkt(f32x16& p0, f32x16& p1, const bf16* Ks, const bf16x8* qr, int r32, int hi, int mapoff, float negoff) {
  p0 = f32x16{}; p1 = f32x16{}; (void)negoff;
#pragma unroll
  for (int d0 = 0; d0 < 4; ++d0) { const int cb = (mapoff + d0 * 16 + hi * 8) * 2;
    bf16x8 b0 = *reinterpret_cast<const bf16x8*>((const char*)Ks + KSWZ(r32, cb));
    bf16x8 b1 = *reinterpret_cast<const bf16x8*>((const char*)Ks + KSWZ(32 + r32, cb));
    p0 = __builtin_amdgcn_mfma_f32_32x32x16_bf16(b0, qr[d0], p0, 0, 0, 0);
    p1 = __builtin_amdgcn_mfma_f32_32x32x16_bf16(b1, qr[d0], p1, 0, 0, 0); }
}
__device__ __forceinline__ int v_st(int k, int c) { const int kk = (k & ~0xC) | ((k & 4) << 1) | ((k & 8) >> 1); return ((kk >> 3) * 4 + (c >> 5)) * 512 + ((kk & 7) * 32 + (c & 31)) * 2; }
__device__ __forceinline__ int v_rd_base(int lane) { return ((lane & 3) << 3) | (((lane >> 2) & 3) << 6) | (((lane >> 4) & 1) << 5) | (((lane >> 5) & 1) << 8); }
constexpr int v_rd_off(int d0, int ks, int half) { return d0 * 512 + ks * 4096 + half * 2048; }
typedef short v4i16_t __attribute__((ext_vector_type(4)));
template <int OFF> __device__ __forceinline__ s16x4 tr_read(int vb) {
  return __builtin_bit_cast(s16x4, __builtin_amdgcn_ds_read_tr16_b64_v4i16((__attribute__((address_space(3))) v4i16_t*)(uintptr_t)(unsigned)(vb + OFF)));
}
template <int D0> __device__ __forceinline__ void pv_one(f32x16& od, int vb, bf16x8 pa0, bf16x8 pa1, bf16x8 pa2, bf16x8 pa3) {
  const s16x4 l0 = tr_read<v_rd_off(D0, 0, 0)>(vb), h0 = tr_read<v_rd_off(D0, 0, 1)>(vb), l1 = tr_read<v_rd_off(D0, 1, 0)>(vb), h1 = tr_read<v_rd_off(D0, 1, 1)>(vb);
  const s16x4 l2 = tr_read<v_rd_off(D0, 2, 0)>(vb), h2 = tr_read<v_rd_off(D0, 2, 1)>(vb), l3 = tr_read<v_rd_off(D0, 3, 0)>(vb), h3 = tr_read<v_rd_off(D0, 3, 1)>(vb);
#define PK(L, H) (bf16x8){L[0], L[1], L[2], L[3], H[0], H[1], H[2], H[3]}
  od = __builtin_amdgcn_mfma_f32_32x32x16_bf16(pa0, PK(l0, h0), od, 0, 0, 0);
  od = __builtin_amdgcn_mfma_f32_32x32x16_bf16(pa1, PK(l1, h1), od, 0, 0, 0);
  od = __builtin_amdgcn_mfma_f32_32x32x16_bf16(pa2, PK(l2, h2), od, 0, 0, 0);
  od = __builtin_amdgcn_mfma_f32_32x32x16_bf16(pa3, PK(l3, h3), od, 0, 0, 0);
#undef PK
}
__device__ __forceinline__ void pv_d0(f32x16* o, int vb, bf16x8 pa0, bf16x8 pa1, bf16x8 pa2, bf16x8 pa3) {
  pv_one<0>(o[0], vb, pa0, pa1, pa2, pa3); pv_one<1>(o[1], vb, pa0, pa1, pa2, pa3); pv_one<2>(o[2], vb, pa0, pa1, pa2, pa3); pv_one<3>(o[3], vb, pa0, pa1, pa2, pa3);
}
__device__ __forceinline__ void attn_unit(const bf16* __restrict__ Qh, const bf16* __restrict__ Kh, const bf16* __restrict__ Vh, bf16* __restrict__ Oh, long qrow0, long k0a, int nt0, long k0b, int NT,
                                          float lam, float oscale, const float* __restrict__ subg, float negoff, char* lds, int wave_, unsigned lds3) {
  unsigned z_ = 0u; asm volatile("" : "+v"(z_)); int tid_ = wave_ * 64 + (int)__builtin_amdgcn_mbcnt_hi(~0u, __builtin_amdgcn_mbcnt_lo(~0u, z_)); asm volatile("" : "+v"(tid_));
  const int tid = tid_, wid = __builtin_amdgcn_readfirstlane(tid >> 6), lane = tid & 63, r32 = lane & 31, hi = lane >> 5, qsub = wid >> 1, map = wid & 1, mapoff = map * 64;
  bf16* V_lds = (bf16*)lds; bf16* K_lds = (bf16*)(lds + NBUF * SHM_V);
  float* ws = (float*)(lds + NBUF * SHM_V + NBUF * SHM_K) + wid * 64; float* li_l = ws;
  float l_reg = 0; f32x16 o[4] = {}; bf16x8 qr[4];
  const bf16* Qw = Qh + (qrow0 + qsub * 32 + r32) * 512 + mapoff + hi * 8;
#pragma unroll
  for (int d0 = 0; d0 < 4; ++d0) qr[d0] = ld8(Qw + d0 * 16);
  const int vb0 = (int)(uintptr_t)V_lds + v_rd_base(lane);
  int koff[2], voff[2];
#pragma unroll
  for (int i = 0; i < 2; ++i) { const int o = (wid + 8 * i) * 1024 + lane * 16;
    { const int row = o >> 8, cB = (o & 255) ^ ((row & 7) << 4); koff[i] = row * 512 + (cB >> 1); }
    { const int sub = o >> 9, kkhi = sub >> 2, cg = sub & 3, q = (o & 511) >> 1, kklo = q >> 5, cin = q & 31, kk = kkhi * 8 + kklo; voff[i] = kk * 512 + cg * 32 + cin; } }
  typedef __attribute__((address_space(3))) unsigned lds_u32;
  const unsigned ldsK = lds3 + NBUF * (unsigned)SHM_V + (unsigned)wid * 1024u, ldsV = lds3 + (unsigned)wid * 1024u;
#define KROW(j) (((j) < nt0) ? (k0a + (long)(j) * KVBLK) : (k0b + (long)((j) - nt0) * KVBLK))
#define DMAK(b, j) do { const long kr_ = KROW(j) * 512; _Pragma("unroll") for (int i_ = 0; i_ < 2; ++i_) \
    __builtin_amdgcn_global_load_lds((const unsigned*)(Kh + kr_ + koff[i_]), (lds_u32*)(uintptr_t)(ldsK + (b) * (unsigned)SHM_K + i_ * 8192u), 16, 0, 0); } while (0)
#define DMAV(b, j) do { const long kr_ = KROW(j) * 512; _Pragma("unroll") for (int i_ = 0; i_ < 2; ++i_) \
    __builtin_amdgcn_global_load_lds((const unsigned*)(Vh + kr_ + voff[i_]), (lds_u32*)(uintptr_t)(ldsV + (b) * (unsigned)SHM_V + i_ * 8192u), 16, 0, 0); } while (0)
  f32x16 p0, p1; bf16x8 pa0, pa1, pa2 = {}, pa3 = {};
#define KFR(kb, d0, half) (*reinterpret_cast<const bf16x8*>((const char*)K_lds + (kb) * (int)SHM_K + KSWZ((half) * 32 + r32, (mapoff + (d0) * 16 + hi * 8) * 2)))
#define VRD4(S, vbuf, D0, KS) do { const int vb_ = vb0 + (vbuf) * (int)SHM_V; S##a = tr_read<v_rd_off(D0, KS, 0)>(vb_); S##b = tr_read<v_rd_off(D0, KS, 1)>(vb_); S##c = tr_read<v_rd_off(D0, (KS) + 1, 0)>(vb_); S##d = tr_read<v_rd_off(D0, (KS) + 1, 1)>(vb_); } while (0)
#define PKV(L, H) (bf16x8){L[0], L[1], L[2], L[3], H[0], H[1], H[2], H[3]}
#define MM(ACC, A_, B_) ACC = __builtin_amdgcn_mfma_f32_32x32x16_bf16(A_, B_, ACC, 0, 0, 0)
#define FADD(D, S) asm volatile("v_add_f32 %0, %0, %1" : "+v"(D) : "v"(S))
#define SMA(P, c) do { P[2 * (c)] = __builtin_amdgcn_exp2f(P[2 * (c)]); P[2 * (c) + 1] = __builtin_amdgcn_exp2f(P[2 * (c) + 1]); FADD(ls0, P[2 * (c)]); FADD(ls1, P[2 * (c) + 1]); } while (0)
#define SMB_CVT(P, BASE) do { ca0 = cvtpk(P[BASE + 0], P[BASE + 1]); ca1 = cvtpk(P[BASE + 2], P[BASE + 3]); cb0 = cvtpk(P[BASE + 4], P[BASE + 5]); cb1 = cvtpk(P[BASE + 6], P[BASE + 7]); } while (0)
#define SMB_PERM(OUT) do { u32x4 w_ = {ca0, ca1, cb0, cb1}; OUT = *reinterpret_cast<bf16x8*>(&w_); } while (0)
#define STAGE_PV(PA, PB, P, KLD_STMT) do { KLD_STMT; \
    MM(o[0], PA, PKV(vAa, vAb)); SMA(P, 0); SBAR(); MM(o[0], PB, PKV(vAc, vAd)); SMA(P, 1); SBAR(); \
    MM(o[1], PA, PKV(vBa, vBb)); SMA(P, 2); SBAR(); MM(o[1], PB, PKV(vBc, vBd)); SMA(P, 3); SBAR(); \
    MM(o[2], PA, PKV(vCa, vCb)); SMA(P, 4); SBAR(); MM(o[2], PB, PKV(vCc, vCd)); SMA(P, 5); SBAR(); \
    MM(o[3], PA, PKV(vDa, vDb)); SMA(P, 6); SBAR(); MM(o[3], PB, PKV(vDc, vDd)); SMA(P, 7); SBAR(); } while (0)
#define VRD16(vbuf, KS) do { VRD4(vA, vbuf, 0, KS); VRD4(vB, vbuf, 1, KS); VRD4(vC, vbuf, 2, KS); VRD4(vD, vbuf, 3, KS); } while (0)
#define STAGE_QK(PD, P, OUT0, OUT1, vbuf, KS) do { VRD16(vbuf, KS); \
    PD = __builtin_amdgcn_mfma_f32_32x32x16_bf16(kf0, qr[0], f32x16{}, 0, 0, 0); SMB_CVT(P, 0); SBAR(); \
    MM(PD, kf1, qr[1]); SMB_PERM(OUT0); SBAR(); MM(PD, kf2, qr[2]); SMB_CVT(P, 8); SBAR(); MM(PD, kf3, qr[3]); SMB_PERM(OUT1); SBAR(); } while (0)
#define KLD4(kb, half) do { kf0 = KFR(kb, 0, half); kf1 = KFR(kb, 1, half); kf2 = KFR(kb, 2, half); kf3 = KFR(kb, 3, half); } while (0)
  s16x4 vAa, vAb, vAc, vAd, vBa, vBb, vBc, vBd, vCa, vCb, vCc, vCd, vDa, vDb, vDc, vDd; bf16x8 kf0, kf1, kf2, kf3; unsigned ca0, ca1, cb0, cb1; float ls0 = 0.f, ls1 = 0.f;
  DMAK(0, 0); DMAK(1, 1); DMAV(0, 0); asm volatile("s_waitcnt vmcnt(0)" ::: "memory"); __syncthreads();
  KLD4(0, 0); p0 = __builtin_amdgcn_mfma_f32_32x32x16_bf16(kf0, qr[0], f32x16{}, 0, 0, 0); MM(p0, kf1, qr[1]); MM(p0, kf2, qr[2]); MM(p0, kf3, qr[3]);
  VRD16(0, 2);
  int bp = 0, bc = 0, bn = 1, bnn = 2;
#pragma unroll 1
  for (int j = 0; j < NT; ++j) {
    asm volatile("s_waitcnt vmcnt(0)" ::: "memory"); SBAR(); __builtin_amdgcn_s_barrier(); SBAR();
    if (j + 2 < NT) DMAK(bnn, j + 2);
    if (j + 1 < NT) DMAV(bn, j + 1);
    STAGE_PV(pa2, pa3, p0, KLD4(bc, 1));
    STAGE_QK(p1, p0, pa0, pa1, bc, 0);
    const int kbn = (j + 1 < NT) ? bn : bc;
    STAGE_PV(pa0, pa1, p1, KLD4(kbn, 0));
    STAGE_QK(p0, p1, pa2, pa3, bc, 2);
    bp = bc; bc = bn; bn = bnn; bnn = bp;
  }
  MM(o[0], pa2, PKV(vAa, vAb)); MM(o[0], pa3, PKV(vAc, vAd)); MM(o[1], pa2, PKV(vBa, vBb)); MM(o[1], pa3, PKV(vBc, vBd));
  MM(o[2], pa2, PKV(vCa, vCb)); MM(o[2], pa3, PKV(vCc, vCd)); MM(o[3], pa2, PKV(vDa, vDb)); MM(o[3], pa3, PKV(vDc, vDd));
  l_reg = ls0 + ls1;
#undef KLD4
#undef STAGE_QK
#undef VRD16
#undef FADD
#undef STAGE_PV
#undef SMB_PERM
#undef SMB_CVT
#undef SMA
#undef MM
#undef VRD4
#undef PKV
#undef KFR
#undef DMAK
#undef DMAV
#if EN_ATTEPI
  { auto rr = __builtin_amdgcn_permlane32_swap(__float_as_uint(l_reg), __float_as_uint(l_reg), false, false); l_reg = __uint_as_float(rr[0]) + __uint_as_float(rr[1]); }
  if (hi == 0) li_l[r32] = l_reg;
  asm volatile("s_waitcnt lgkmcnt(0)" ::: "memory");
  const float fm = map ? lam : 1.f;
#pragma unroll
  for (int r = 0; r < 16; ++r) { const float rl = __builtin_amdgcn_rcpf(li_l[crow(r, hi)]) * fm;
#pragma unroll
    for (int d0 = 0; d0 < 4; ++d0) o[d0][r] *= rl; }
  __syncthreads();
  float* X = (float*)lds + qsub * 4096 + lane;
  if (map == 1) {
#pragma unroll
    for (int d0 = 0; d0 < 4; ++d0)
#pragma unroll
      for (int r = 0; r < 16; ++r) X[(d0 * 16 + r) * 64] = o[d0][r];
  }
  __syncthreads();
  if (map == 0) {
    float sg[4];
#pragma unroll
    for (int d0 = 0; d0 < 4; ++d0) sg[d0] = subg[d0 * 32 + r32] * oscale;
    bf16* Ow = Oh + (qrow0 + qsub * 32) * 1024 + r32;
#pragma unroll
    for (int r = 0; r < 16; ++r) {
      float ss = 0.f;
#pragma unroll
      for (int d0 = 0; d0 < 4; ++d0) { o[d0][r] -= X[(d0 * 16 + r) * 64]; ss += o[d0][r] * o[d0][r]; }
      ss += __shfl_xor(ss, 1); ss += __shfl_xor(ss, 2); ss += __shfl_xor(ss, 4); ss += __shfl_xor(ss, 8); ss += __shfl_xor(ss, 16);
      const float rn = 1.0f / sqrtf(ss * (1.0f / 128.0f) + 1e-6f);
      const int orow = crow(r, hi);
#pragma unroll
      for (int d0 = 0; d0 < 4; ++d0) { const unsigned w = cvtpk(o[d0][r] * rn * sg[d0], 0.f); Ow[(long)orow * 1024 + d0 * 32] = (bf16)(w & 0xffffu); }
    }
  }
  __syncthreads();
#else
  { float s = l_reg; for (int d0 = 0; d0 < 4; ++d0) for (int r = 0; r < 16; ++r) s += o[d0][r]; Oh[qrow0 * 1024 + tid] = (bf16)(int)s; }
#endif
#undef KROW
}
#undef KSWZ
#undef SBAR
}
#ifndef EN_ALL
#define EN_ALL 1
#endif
#ifndef EN_PH0
#define EN_PH0 EN_ALL
#endif
#ifndef EN_PH1
#define EN_PH1 EN_ALL
#endif
#ifndef EN_P1
#define EN_P1 EN_ALL
#endif
#ifndef EN_P2A
#define EN_P2A EN_ALL
#endif
#ifndef EN_P2B
#define EN_P2B EN_ALL
#endif
#ifndef EN_P3
#define EN_P3 EN_ALL
#endif
#ifndef EN_P4
#define EN_P4 EN_ALL
#endif
#ifndef EN_P5
#define EN_P5 EN_ALL
#endif
#ifndef EN_ATT
#define EN_ATT 1
#endif
#ifndef EN_DFT
#define EN_DFT 1
#endif
#ifndef EN_ATTC
#define EN_ATTC 1
#endif
#ifndef SCHED_OLD
#define SCHED_OLD 0
#endif
#ifndef PROBE_A
#define PROBE_A 0
#endif
#ifndef PROBE_S
#define PROBE_S 0
#endif
#if PROBE_S
#define SUBSTAMP(i) do { if (blockIdx.x == 0 && F.wave == 0) ((volatile LAS unsigned*)(F.lds + MISC_OFF))[40 + (i)] = (unsigned)__builtin_amdgcn_s_memrealtime(); } while (0)
#else
#define SUBSTAMP(i) do {} while (0)
#endif
#ifndef PROBE_B
#define PROBE_B 0
#endif
#ifndef WGM_WIDE
#define WGM_WIDE 2
#endif
#ifndef WGM_MID
#define WGM_MID 2
#endif
constexpr int NWAVES = 8;
constexpr int DM = 1024, NBATCH = 8, SEQ = 2048, CTXL = 256, M_LAT = NBATCH * SEQ, M_CTX = NBATCH * CTXL, M_ALL = M_LAT + M_CTX, NIN = 2560, NINSRC = 2048, FFD = 2816, NGU = 5632, NLAYER = 2;
constexpr size_t MiB = 1u << 20;
constexpr size_t WS_CTL = 0, CTL_ZERO_BYTES = 1 * MiB;
constexpr size_t WS_MOD = 64 * 1024;
constexpr size_t WS_BIN = 512 * 1024;
constexpr size_t WS_BGU = 1 * MiB + 768 * 1024;
constexpr size_t WS_ROPE = WS_BGU + 512 * 1024;
constexpr size_t WS_DFT = WS_ROPE + 512 * 1024;
constexpr size_t WS_TF = 4 * MiB;
constexpr size_t WS_SSQ = 5 * MiB;
constexpr size_t WS_WIN = 8 * MiB;
constexpr size_t WS_WOUT = 18 * MiB;
constexpr size_t WS_WGU = 22 * MiB;
constexpr size_t WS_WDN = 44 * MiB;
constexpr size_t WS_A = 56 * MiB;
constexpr size_t WS_XC = 92 * MiB;
constexpr size_t WS_QB = 100 * MiB, WS_KB = 118 * MiB, WS_VB = 136 * MiB;
constexpr size_t WS_T = 154 * MiB;
constexpr size_t WS_TC = 186 * MiB;
constexpr size_t WS_MIX = 190 * MiB;
constexpr size_t WS_H = 100 * MiB;
constexpr size_t WS_HC = 226 * MiB;
constexpr size_t WS_END = 238 * MiB;
constexpr size_t WS_XB2 = 222 * MiB;
static_assert(WS_DFT + 256 * 512 * 2 <= WS_TF && WS_SSQ + (size_t)M_ALL * 64 <= WS_WIN && WS_H + (size_t)M_ALL * FFD * 2 <= WS_END && WS_MIX + (size_t)M_ALL * DM * 2 <= WS_END, "d_ws map");
constexpr int CW_TMO = 0, CW_BAR = 4096, CW_CTXCNT = 8192, CW_BFCNT = 8192 + 512, CW_C3CNT = 8192 + 1024;
constexpr int RING_BYTES = 131072, RTAB_OFF = RING_BYTES, RTAB_BYTES = 8192, LDSCTL_OFF = RTAB_OFF + RTAB_BYTES, MISC_OFF = LDSCTL_OFF + 320, BTAB_OFF = 140288, ETAB_OFF = 147456, LDS_BYTES = ETAB_OFF + 12288 + 512;
static_assert(MISC_OFF + 512 <= BTAB_OFF && BTAB_OFF + 7 * 1024 == ETAB_OFF && BTAB_OFF == RTAB_OFF + 4 * pg8::BT_F && ETAB_OFF == RTAB_OFF + 4 * pg8::ET_F && LDS_BYTES <= 160 * 1024, "LDS map");
constexpr int N_PHASES = 2 + 6 * NLAYER;

#define GAS __attribute__((address_space(1)))
#define LAS __attribute__((address_space(3)))
typedef unsigned short bf16;
typedef unsigned v4u __attribute__((ext_vector_type(4)));
typedef unsigned v2u __attribute__((ext_vector_type(2)));
typedef float f32x4 __attribute__((ext_vector_type(4)));
#define LDS_WAIT() asm volatile("s_waitcnt lgkmcnt(0)" ::: "memory")
#define VM_WAIT() asm volatile("s_waitcnt vmcnt(0)" ::: "memory")
__device__ __forceinline__ unsigned f2bf(float f) { unsigned u = __builtin_bit_cast(unsigned, f); return (u + 0x7fffu + ((u >> 16) & 1u)) >> 16; }
__device__ __forceinline__ unsigned pk2(float lo, float hi) { return f2bf(lo) | (f2bf(hi) << 16); }
__device__ __forceinline__ float bf2f(unsigned short h) { return __builtin_bit_cast(float, (unsigned)h << 16); }
__device__ __forceinline__ int lane_id() { unsigned z = 0u; asm volatile("" : "+v"(z)); return (int)__builtin_amdgcn_mbcnt_hi(~0u, __builtin_amdgcn_mbcnt_lo(~0u, z)); }
__device__ __forceinline__ float wave_sum(float v) {
#pragma unroll
    for (int o = 1; o < 64; o <<= 1) v += __shfl_xor(v, o);
    return v;
}

#define XB_TMO      128
#define XB_XCNT(j)  (256  + 64 * (j))
#define XB_XSUB(j)  (1280 + 64 * (j))
#define XB_XGEN(j)  (2304 + 64 * (j))
#define XB_TOP      3328
#define XB_TOPGEN   3392
#define XCD_BAR_WORDS 3456
#define XB_SPIN_CAP (1u << 18)

__device__ __forceinline__ unsigned xb_ld(unsigned* p)              { return __hip_atomic_load(p, __ATOMIC_RELAXED, __HIP_MEMORY_SCOPE_AGENT); }
__device__ __forceinline__ unsigned xb_add(unsigned* p, unsigned v) { return __hip_atomic_fetch_add(p, v, __ATOMIC_RELAXED, __HIP_MEMORY_SCOPE_AGENT); }
__device__ __forceinline__ unsigned xb_xcc_id() { return (unsigned)__builtin_amdgcn_s_getreg((3 << 11) | 20) & 0xFu; }
#define XB_SPIN(cond, bar) do { unsigned _sp = 0; while (cond) { __builtin_amdgcn_s_sleep(1); \
    if ((++_sp & 255u) == 0u) { if (xb_ld(&(bar)[XB_TMO])) break; if (_sp > XB_SPIN_CAP) { atomicAdd(&(bar)[XB_TMO], 1u); break; } } } } while (0)

struct XcdBarrier {
    unsigned* bar; unsigned x;
    volatile LAS unsigned* st;
};

__device__ __forceinline__ XcdBarrier xcd_barrier_post(unsigned* bar, volatile LAS unsigned* st) {
    XcdBarrier b; b.bar = bar; b.x = xb_xcc_id(); b.st = st;
    if (threadIdx.x == 0) (void)xb_add(&bar[XB_XCNT(b.x)], 1u);
    return b;
}
__device__ __forceinline__ void xcd_barrier_complete(unsigned* bar, unsigned x, unsigned& nloc, unsigned& nx) {
    const unsigned G = gridDim.x * gridDim.y * gridDim.z;
    unsigned sum, cnt, mine, sp = 0u;
    for (;;) {
        sum = 0u; cnt = 0u; mine = 0u;
#pragma unroll
        for (unsigned j = 0; j < 16; ++j) { const unsigned c = xb_ld(&bar[XB_XCNT(j)]); sum += c; cnt += (c > 0u) ? 1u : 0u; mine = (j == x) ? c : mine; }
        if (sum == G) break;
        __builtin_amdgcn_s_sleep(1);
        if ((++sp & 255u) == 0u) { if (xb_ld(&bar[XB_TMO])) break; if (sp > XB_SPIN_CAP) { atomicAdd(&bar[XB_TMO], 1u); break; } }
    }
    nloc = mine > 0u ? mine : 1u; nx = cnt > 0u ? cnt : 1u;
}

__device__ __forceinline__ void xcd_barrier(const XcdBarrier& b) {
    asm volatile("s_waitcnt vmcnt(0)" ::: "memory");
    __syncthreads();
    if (threadIdx.x == 0) {
        unsigned* bar = b.bar;
        __builtin_amdgcn_s_waitcnt(0);
        unsigned nloc = b.st[0], nx = b.st[1];
        if (nloc == 0u) { xcd_barrier_complete(bar, b.x, nloc, nx); b.st[0] = nloc; b.st[1] = nx; }
        const unsigned old = xb_add(&bar[XB_XSUB(b.x)], 1u);
        const unsigned gen = old / nloc;
        if (old + 1u == (gen + 1u) * nloc) {
            __builtin_amdgcn_fence(__ATOMIC_RELEASE, "agent");
            asm volatile("s_waitcnt vmcnt(0)" ::: "memory");
            const unsigned og = xb_add(&bar[XB_TOP], 1u);
            const unsigned tg = og / nx;
            if (og + 1u == (tg + 1u) * nx) xb_add(&bar[XB_TOPGEN], 1u);
            else XB_SPIN(xb_ld(&bar[XB_TOPGEN]) == tg, bar);
            __builtin_amdgcn_fence(__ATOMIC_ACQUIRE, "agent");
            xb_add(&bar[XB_XGEN(b.x)], 1u);
            asm volatile("s_waitcnt vmcnt(0)" ::: "memory");
        } else {
            XB_SPIN(xb_ld(&bar[XB_XGEN(b.x)]) == gen, bar);
            __builtin_amdgcn_fence(__ATOMIC_ACQUIRE, "agent");
            asm volatile("s_waitcnt vmcnt(0)" ::: "memory");
        }
    }
    __syncthreads();
}


struct Args { const float* in[21]; float* out; unsigned char* ws; int ph_lo, ph_hi; };
struct Frame {
    LAS unsigned char* lds; int wave, vcu, G;
};

struct TrItem { const float* W; bf16* WT; int ldn, ldk, k0, n0, drow0; };
__device__ __forceinline__ void transpose_load(const TrItem& t, f32x4 (&v)[8], int lane) {
    const int r = lane >> 3, c4 = (lane & 7) * 4;
#pragma unroll
    for (int j = 0; j < 8; ++j) v[j] = *(const f32x4*)(t.W + (size_t)(t.k0 + 8 * j + r) * t.ldn + t.n0 + c4);
}
__device__ __forceinline__ void transpose_finish(const TrItem& t, const f32x4 (&v)[8], LAS float* scr, int lane) {
    const int r = lane >> 3, c4 = (lane & 7) * 4;
#pragma unroll
    for (int j = 0; j < 8; ++j) { LAS float* d = scr + (8 * j + r) * 33 + c4; d[0] = v[j][0]; d[1] = v[j][1]; d[2] = v[j][2]; d[3] = v[j][3]; }
    LDS_WAIT(); asm volatile("" ::: "memory");
    const int c = lane & 7;
#pragma unroll
    for (int j = 0; j < 4; ++j) { const int n = (lane >> 3) + 8 * j; const LAS float* s = scr + (8 * c) * 33 + n;
        v4u o; o.x = pk2(s[0 * 33], s[1 * 33]); o.y = pk2(s[2 * 33], s[3 * 33]); o.z = pk2(s[4 * 33], s[5 * 33]); o.w = pk2(s[6 * 33], s[7 * 33]);
        *(GAS v4u*)(t.WT + (size_t)(t.drow0 + n) * t.ldk + t.k0 + 8 * c) = o; }
    LDS_WAIT(); asm volatile("" ::: "memory");
}
__device__ __forceinline__ void ph0(Frame& F, const Args& A, unsigned char* ws) {
    int tid_ = F.wave * 64 + lane_id(); asm volatile("" : "+v"(tid_));
    LAS float* scr = (LAS float*)(F.lds + F.wave * 16384);
    const int gw = F.vcu * NWAVES + F.wave, NGW = F.G * NWAVES;
    SUBSTAMP(0);
    constexpr int I_IN = 16 * 48, I_OUT = 16 * 32, I_G = 16 * 88, I_D = 44 * 32, I_LAYER = I_IN + I_OUT + 2 * I_G + I_D;
    auto decode = [&](int it, TrItem& t) __attribute__((always_inline)) {
        const int l = it / I_LAYER; int r = it % I_LAYER;
        if (r < I_IN) { const int kb = r / 48, nb = r % 48, n0 = nb * 32, pn = n0 >> 8, cc = n0 & 255; const int drow = pn < 4 ? pn * 256 + ((cc >> 5) & 1) * 128 + (cc >> 6) * 32 : n0;
            t = TrItem{A.in[8] + (size_t)l * DM * NINSRC, (bf16*)(ws + WS_WIN) + (size_t)l * NIN * DM, NINSRC, DM, kb * 64, n0, drow}; return; } r -= I_IN;
        if (r < I_OUT) { const int kb = r / 32, nb = r % 32; t = TrItem{A.in[17] + (size_t)l * DM * DM, (bf16*)(ws + WS_WOUT) + (size_t)l * DM * DM, DM, DM, kb * 64, nb * 32, nb * 32}; return; } r -= I_OUT;
        if (r < 2 * I_G) { const int up = r >= I_G; if (up) r -= I_G; const int kb = r / 88, nb = r % 88, n0 = nb * 32; const int drow = (n0 >> 7) * 256 + up * 128 + (n0 & 127);
            t = TrItem{(up ? A.in[19] : A.in[18]) + (size_t)l * DM * FFD, (bf16*)(ws + WS_WGU) + (size_t)l * NGU * DM, FFD, DM, kb * 64, n0, drow}; return; } r -= 2 * I_G;
        { const int kb = r / 32, nb = r % 32; t = TrItem{A.in[20] + (size_t)l * FFD * DM, (bf16*)(ws + WS_WDN) + (size_t)l * DM * FFD, DM, FFD, kb * 64, nb * 32, nb * 32}; } };
    { const int lane = tid_ & 63; const int NITEM = NLAYER * I_LAYER; TrItem ta, tb; f32x4 va[8], vb[8];
      int it = gw;
      if (it < NITEM) { decode(it, ta); transpose_load(ta, va, lane); }
      while (it < NITEM) {
          const int it2 = it + NGW, it3 = it2 + NGW;
          if (it2 < NITEM) { decode(it2, tb); transpose_load(tb, vb, lane); }
          transpose_finish(ta, va, scr, lane);
          if (it2 >= NITEM) break;
          if (it3 < NITEM) { decode(it3, ta); transpose_load(ta, va, lane); }
          transpose_finish(tb, vb, scr, lane);
          it = it3;
      } }
    __syncthreads();
    SUBSTAMP(1);
    LAS float* sl = (LAS float*)F.lds;
    LAS float* red = (LAS float*)(F.lds + 40960);
    { f32x4 v[5];
#pragma unroll
      for (int q = 0; q < 5; ++q) { const int i4 = tid_ + q * (NWAVES * 64); const int j = i4 >> 8, k4 = (i4 & 255) * 4; v[q] = (i4 < 9 * 256) ? *(const f32x4*)((j < 8) ? A.in[1] + j * DM + k4 : A.in[3] + k4) : (f32x4){0.f, 0.f, 0.f, 0.f}; }
#pragma unroll
      for (int q = 0; q < 5; ++q) { const int i4 = tid_ + q * (NWAVES * 64); if (i4 < 9 * 256) { f32x4 s; for (int e = 0; e < 4; ++e) s[e] = v[q][e] / (1.f + __expf(-v[q][e])); *(LAS f32x4*)(sl + i4 * 4) = s; } } }
    __syncthreads();
    { const int lane = tid_ & 63; const int NIT = NLAYER * 24 * 16;
      f32x4 wa[8], wb[8], wc[8];
#define MOD_LOAD(W, it_) do { const int kb_ = (it_) & 15, cb_ = ((it_) >> 4) % 24, l_ = (it_) / (24 * 16); const float* W_ = A.in[4] + (size_t)l_ * DM * 6144 + (size_t)(kb_ * 64 + F.wave * 8) * 6144 + cb_ * 256 + lane * 4; \
        _Pragma("unroll") for (int r = 0; r < 8; ++r) W[r] = *(const f32x4*)(W_ + (size_t)r * 6144); } while (0)
#define MOD_ITEM(W, it_) do { const int kb = (it_) & 15, cb = ((it_) >> 4) % 24, l = (it_) / (24 * 16); \
        f32x4 acc[9]; \
        _Pragma("unroll") for (int j = 0; j < 9; ++j) acc[j] = (f32x4){0.f, 0.f, 0.f, 0.f}; \
        _Pragma("unroll") for (int r4 = 0; r4 < 8; r4 += 4) \
            _Pragma("unroll") for (int j = 0; j < 9; ++j) { const f32x4 s = *(const LAS f32x4*)(sl + j * DM + kb * 64 + F.wave * 8 + r4); acc[j] += W[r4] * s[0] + W[r4 + 1] * s[1] + W[r4 + 2] * s[2] + W[r4 + 3] * s[3]; } \
        _Pragma("unroll") for (int j = 0; j < 9; ++j) *(LAS f32x4*)(red + (F.wave * 9 + j) * 256 + lane * 4) = acc[j]; \
        __syncthreads(); \
        for (int i = tid_; i < 9 * 256; i += NWAVES * 64) { const int j = i >> 8, cn = i & 255; float s = 0.f; \
            _Pragma("unroll") for (int w8 = 0; w8 < 8; ++w8) s += red[(w8 * 9 + j) * 256 + cn]; \
            const int nn = cb * 256 + cn; if (kb == 0) s += A.in[5][l * 6144 + nn]; \
            atomicAdd((float*)(ws + WS_MOD) + (l * 9 + j) * 6144 + nn, s); } \
        __syncthreads(); } while (0)
      for (int it0 = F.vcu; it0 < NIT; it0 += 3 * F.G) {
        const int it1 = it0 + F.G, it2 = it0 + 2 * F.G;
        MOD_LOAD(wa, it0); if (it1 < NIT) MOD_LOAD(wb, it1); if (it2 < NIT) MOD_LOAD(wc, it2);
        MOD_ITEM(wa, it0); if (it1 < NIT) MOD_ITEM(wb, it1); if (it2 < NIT) MOD_ITEM(wc, it2);
      }
#undef MOD_ITEM
#undef MOD_LOAD
    }
    SUBSTAMP(2);
    const int gt = F.vcu * (NWAVES * 64) + tid_, NGT = F.G * NWAVES * 64;
    for (int i = gt; i < 96 * 16; i += NGT) { const int p = i >> 4, j = i & 15; const float inv = powf(10000.0f, -(float)j * (1.0f / 16.0f)); const float ang = (float)(p < 32 ? p : p - 32) * inv;
        float sn, cs; sincosf(ang, &sn, &cs); ((float*)(ws + WS_ROPE))[i] = cs; ((float*)(ws + WS_ROPE))[1536 + i] = sn; }
    for (int i = gt; i < 256 * 512; i += NGT) { const int m = i >> 9, kk = i & 511, n = kk >> 1; const int p = (m * n) & 255; float sn, cs; sincospif((float)p * (1.0f / 128.0f), &sn, &cs);
        ((bf16*)(ws + WS_DFT))[i] = (bf16)f2bf((kk & 1) ? sn : cs); }
    SUBSTAMP(3);
    __syncthreads();
    if (F.vcu < NLAYER * 4 * 32) {
        const int lg = F.vcu >> 5, c0 = (F.vcu & 31) * 4;
        LAS float* wl = (LAS float*)F.lds; LAS float* ct = (LAS float*)(F.lds + 65536); LAS float* st = ct + 128;
        { f32x4 wv[8];
#pragma unroll
          for (int q = 0; q < 8; ++q) wv[q] = *(const f32x4*)(A.in[16] + (size_t)lg * 128 * 128 + (tid_ + q * (NWAVES * 64)) * 4);
#pragma unroll
          for (int q = 0; q < 8; ++q) *(LAS f32x4*)(wl + (tid_ + q * (NWAVES * 64)) * 4) = wv[q]; }
        if (tid_ < 128) { float sn, cs; sincospif((float)tid_ * (1.0f / 64.0f), &sn, &cs); ct[tid_] = cs; st[tid_] = sn; }
        __syncthreads();
        for (int o = tid_; o < 4 * 256; o += NWAVES * 64) { const int d = o & 127, ri = (o >> 7) & 1, cch = c0 + (o >> 8); float s = 0.f;
#pragma unroll 8
            for (int c2 = 0; c2 < 128; ++c2) { const int p = (cch * c2) & 127; s += (ri ? -st[p] : ct[p]) * wl[c2 * 128 + d]; }
            ((float*)(ws + WS_TF))[(size_t)lg * 32768 + cch * 256 + ri * 128 + d] = s; }
    }
    SUBSTAMP(4);
}
__device__ __forceinline__ void ph1(Frame& F, const Args& A, unsigned char* ws) {
    int tid_ = F.wave * 64 + lane_id(); asm volatile("" : "+v"(tid_));
    const float* mod = (const float*)(ws + WS_MOD);
    SUBSTAMP(5);
    { const int gw = F.vcu * NWAVES + F.wave, NGW = F.G * NWAVES; const int lane = tid_ & 63;
      for (int row0 = gw; row0 < M_ALL; row0 += 2 * NGW) {
          const int row1 = row0 + NGW; const bool two = row1 < M_ALL;
          f32x4 v[2][4]; float s[2] = {0.f, 0.f};
#pragma unroll
          for (int q = 0; q < 2; ++q) { const int row = q ? (two ? row1 : row0) : row0; const float* xr = row < M_LAT ? A.in[0] + (size_t)row * DM : A.in[2] + (size_t)(row - M_LAT) * DM;
#pragma unroll
              for (int j = 0; j < 4; ++j) v[q][j] = *(const f32x4*)(xr + 256 * j + 4 * lane); }
#pragma unroll
          for (int q = 0; q < 2; ++q) {
#pragma unroll
              for (int j = 0; j < 4; ++j) s[q] += (v[q][j][0] * v[q][j][0] + v[q][j][1] * v[q][j][1]) + (v[q][j][2] * v[q][j][2] + v[q][j][3] * v[q][j][3]);
              s[q] = wave_sum(s[q]); }
#pragma unroll
          for (int q = 0; q < 2; ++q) { if (q == 1 && !two) break; const int row = q ? row1 : row0; const int bm = row < M_LAT ? (row >> 11) : 8; const float* sc = mod + bm * 6144 + 1024;
              bf16* ar = (bf16*)(ws + WS_A) + (size_t)row * DM;
              _Float16* hr = row < M_LAT ? (_Float16*)A.out + (size_t)row * DM : (_Float16*)(ws + WS_XC) + (size_t)(row - M_LAT) * DM;
#pragma unroll
              for (int j = 0; j < 4; ++j) { v2u h; h.x = pg8::pkh2(v[q][j][0], v[q][j][1]); h.y = pg8::pkh2(v[q][j][2], v[q][j][3]); *(v2u*)(hr + 256 * j + 4 * lane) = h; }
#pragma unroll
              for (int j = 0; j < 4; ++j) { const int k = 256 * j + 4 * lane; const f32x4 g = *(const f32x4*)(A.in[6] + k) * (*(const f32x4*)(sc + k) + 1.0f); const f32x4 a = v[q][j] * g; v2u w; w.x = pk2(a[0], a[1]); w.y = pk2(a[2], a[3]); *(v2u*)(ar + k) = w; }
              if (lane < 16) ((float*)(ws + WS_SSQ))[(size_t)row * 16 + lane] = lane == 0 ? s[q] : 0.f; }
      } }
    __syncthreads();
    SUBSTAMP(6);
    { LAS float* wl = (LAS float*)F.lds;
      LAS float* tl = (LAS float*)(F.lds + 128 * 132 * 4);
      LAS float* shl = (LAS float*)(F.lds + 128 * 132 * 4 + 128 * 64 * 4);
      LAS float* redl = shl + 9 * 128;
      for (int it = F.vcu; it < NLAYER * 4 * 4 * 8; it += F.G) {
          const int kb = it & 7, q = (it >> 3) & 3, g = (it >> 5) & 3, l = it >> 7;
          const float* wsrc = A.in[8] + (size_t)l * DM * NINSRC + (size_t)(kb * 128) * NINSRC + 1536 + g * 128;
          f32x4 wv[8], tv[4];
#pragma unroll
          for (int q = 0; q < 8; ++q) { const int i = tid_ + q * (NWAVES * 64); wv[q] = *(const f32x4*)(wsrc + (size_t)(i >> 5) * NINSRC + (i & 31) * 4); }
          const float* tsrc = (const float*)(ws + WS_TF) + (size_t)(l * 4 + g) * 128 * 256 + q * 64;
#pragma unroll
          for (int q = 0; q < 4; ++q) { const int i = tid_ + q * (NWAVES * 64); tv[q] = *(const f32x4*)(tsrc + (size_t)(i >> 4) * 256 + (i & 15) * 4); }
#pragma unroll
          for (int q = 0; q < 8; ++q) { const int i = tid_ + q * (NWAVES * 64); *(LAS f32x4*)(wl + (i >> 5) * 132 + (i & 31) * 4) = wv[q]; }
#pragma unroll
          for (int q = 0; q < 4; ++q) { const int i = tid_ + q * (NWAVES * 64); *(LAS f32x4*)(tl + (i >> 4) * 64 + (i & 15) * 4) = tv[q]; }
          if (tid_ < 9 * 32) *(LAS f32x4*)(shl + tid_ * 4) = *(const f32x4*)(mod + (l * 9 + (tid_ >> 5)) * 6144 + kb * 128 + (tid_ & 31) * 4);
          __syncthreads();
          const int lane_ = tid_ & 63, l32 = lane_ & 31, hi = lane_ >> 5, wk = F.wave >> 1, wc = F.wave & 1, dcol = wc * 32 + l32;
          typedef float f32x16_t __attribute__((ext_vector_type(16)));
          f32x16_t acc = {};
          { const LAS float* ap = wl + (wk * 32 + l32) * 132 + hi; const LAS float* bp = tl + hi * 64 + dcol;
#pragma unroll 8
            for (int s2 = 0; s2 < 64; ++s2) acc = __builtin_amdgcn_mfma_f32_32x32x2f32(ap[2 * s2], bp[2 * s2 * 64], acc, 0, 0, 0); }
          bf16* dst = (bf16*)(ws + WS_WIN) + (size_t)l * NIN * DM + (size_t)(1536 + g * 256 + q * 64 + dcol) * DM + kb * 128 + wk * 32 + hi * 4;
#pragma unroll
          for (int gq = 0; gq < 4; ++gq) { v2u o; o.x = pk2(acc[4 * gq], acc[4 * gq + 1]); o.y = pk2(acc[4 * gq + 2], acc[4 * gq + 3]); *(v2u*)(dst + 8 * gq) = o; }
#pragma unroll
          for (int j = 0; j < 9; ++j) { float s = 0.f;
#pragma unroll
              for (int gq = 0; gq < 4; ++gq) { const f32x4 sv = *(const LAS f32x4*)(shl + j * 128 + wk * 32 + gq * 8 + hi * 4); s += sv[0] * acc[4 * gq] + sv[1] * acc[4 * gq + 1] + sv[2] * acc[4 * gq + 2] + sv[3] * acc[4 * gq + 3]; }
              redl[((wk * 2 + hi) * 9 + j) * 64 + dcol] = s; }
          __syncthreads();
          for (int i = tid_; i < 9 * 64; i += NWAVES * 64) { const int j = i >> 6, dc = i & 63; float s = 0.f;
#pragma unroll
              for (int w = 0; w < 8; ++w) s += redl[(w * 9 + j) * 64 + dc];
              atomicAdd((float*)(ws + WS_BIN) + (l * 9 + j) * NIN + 1536 + g * 256 + q * 64 + dc, s); }
          __syncthreads();
      } }
    SUBSTAMP(7);
    { LAS unsigned short* sh16 = (LAS unsigned short*)F.lds;
      for (int i = tid_; i < 4 * 16 * 256; i += NWAVES * 64) { const int set = i >> 12, row = (i >> 8) & 15, k4 = (i & 255) * 4; v2u o = {0u, 0u};
          if (row < 9) { const f32x4 v = *(const f32x4*)(mod + ((set >> 1) * 9 + row) * 6144 + ((set & 1) ? 3072 : 0) + k4); o.x = pk2(v[0], v[1]); o.y = pk2(v[2], v[3]); }
          *(LAS v2u*)(sh16 + (size_t)i * 4) = o; }
      __syncthreads();
      typedef short bf8 __attribute__((ext_vector_type(8)));
      const int lane = tid_ & 63, fr = lane & 15, fq = lane >> 4;
      const int gw = F.vcu * NWAVES + F.wave, NGW = F.G * NWAVES;
      for (int t = gw; t < 896; t += NGW) {
          int set, n0; if (t < 96) { set = 0; n0 = t * 16; } else if (t < 448) { set = 1; n0 = (t - 96) * 16; } else if (t < 544) { set = 2; n0 = (t - 448) * 16; } else { set = 3; n0 = (t - 544) * 16; }
          const int l = set >> 1, gu = set & 1;
          const bf16* WT = gu ? (const bf16*)(ws + WS_WGU) + (size_t)l * NGU * DM : (const bf16*)(ws + WS_WIN) + (size_t)l * NIN * DM;
          const bf16* wrow = WT + (size_t)(n0 + fr) * DM + fq * 8; const LAS unsigned short* arow = sh16 + (size_t)set * 16 * 1024 + fr * 1024 + fq * 8;
          pg8::f32x4 acc = {0.f, 0.f, 0.f, 0.f};
#pragma unroll
          for (int s8 = 0; s8 < 32; s8 += 8) { bf8 b[8];
#pragma unroll
              for (int q = 0; q < 8; ++q) b[q] = *(const bf8*)(wrow + (s8 + q) * 32);
#pragma unroll
              for (int q = 0; q < 8; ++q) { const bf8 a = *(const LAS bf8*)(arow + (s8 + q) * 32); acc = __builtin_amdgcn_mfma_f32_16x16x32_bf16(a, b[q], acc, 0, 0, 0); } }
          float* bo = gu ? (float*)(ws + WS_BGU) + l * 9 * NGU : (float*)(ws + WS_BIN) + l * 9 * NIN; const int ldb = gu ? NGU : NIN;
#pragma unroll
          for (int r = 0; r < 4; ++r) { const int j = fq * 4 + r; if (j < 9) bo[j * ldb + n0 + fr] = acc[r]; }
      }
    }
    SUBSTAMP(8);
}
__device__ __forceinline__ void fft8(float (&xr)[8], float (&xi)[8]) {
    const float S = 0.70710678118654752f;
    const float u0r = xr[0] + xr[4], u0i = xi[0] + xi[4], d0r = xr[0] - xr[4], d0i = xi[0] - xi[4];
    const float u1r = xr[1] + xr[5], u1i = xi[1] + xi[5], d1r = xr[1] - xr[5], d1i = xi[1] - xi[5];
    const float u2r = xr[2] + xr[6], u2i = xi[2] + xi[6], d2r = xr[2] - xr[6], d2i = xi[2] - xi[6];
    const float u3r = xr[3] + xr[7], u3i = xi[3] + xi[7], d3r = xr[3] - xr[7], d3i = xi[3] - xi[7];
    const float v0r = d0r, v0i = d0i;
    const float v1r = (d1r + d1i) * S, v1i = (d1i - d1r) * S;
    const float v2r = d2i, v2i = -d2r;
    const float v3r = (d3i - d3r) * S, v3i = -(d3r + d3i) * S;
    { const float p0r = u0r + u2r, p0i = u0i + u2i, p1r = u1r + u3r, p1i = u1i + u3i, p2r = u0r - u2r, p2i = u0i - u2i, qr = u1r - u3r, qi = u1i - u3i; const float p3r = qi, p3i = -qr;
      xr[0] = p0r + p1r; xi[0] = p0i + p1i; xr[4] = p0r - p1r; xi[4] = p0i - p1i; xr[2] = p2r + p3r; xi[2] = p2i + p3i; xr[6] = p2r - p3r; xi[6] = p2i - p3i; }
    { const float p0r = v0r + v2r, p0i = v0i + v2i, p1r = v1r + v3r, p1i = v1i + v3i, p2r = v0r - v2r, p2i = v0i - v2i, qr = v1r - v3r, qi = v1i - v3i; const float p3r = qi, p3i = -qr;
      xr[1] = p0r + p1r; xi[1] = p0i + p1i; xr[5] = p0r - p1r; xi[5] = p0i - p1i; xr[3] = p2r + p3r; xi[3] = p2i + p3i; xr[7] = p2r - p3r; xi[7] = p2i - p3i; }
}
__device__ __forceinline__ void butterfly_phase(Frame& F, unsigned char* ws) {
    bf16* T = (bf16*)(ws + WS_T);
    int tid_ = F.wave * 64 + lane_id(); asm volatile("" : "+v"(tid_));
    const int gt = F.vcu * (NWAVES * 64) + tid_, NGT = F.G * NWAVES * 64;
    for (int it = gt; it < NBATCH * 512 * 128; it += NGT) {
        const int n0 = (it & 127) * 2, bc = it >> 7, b = bc >> 9, ch = bc & 511; bf16* tp = T + ((size_t)(b * 8) * 512 + ch) * 512 + n0 * 2;
        v2u q[8];
#pragma unroll
        for (int j = 0; j < 8; ++j) q[j] = *(const v2u*)(tp + (size_t)j * 512 * 512);
        float ar[8], ai[8], br[8], bi[8];
#define BF_UNP(k) ar[k] = __builtin_bit_cast(float, q[k].x << 16); ai[k] = __builtin_bit_cast(float, q[k].x & 0xffff0000u); br[k] = __builtin_bit_cast(float, q[k].y << 16); bi[k] = __builtin_bit_cast(float, q[k].y & 0xffff0000u);
        BF_UNP(0) BF_UNP(1) BF_UNP(2) BF_UNP(3) BF_UNP(4) BF_UNP(5) BF_UNP(6) BF_UNP(7)
#undef BF_UNP
        fft8(ar, ai); fft8(br, bi);
        const float th0 = (float)n0 * (1.0f / 1024.0f), th1 = (float)(n0 + 1) * (1.0f / 1024.0f);
#define BF_OUT(r) { float s0, c0, s1, c1; sincospif(th0 * (float)(r), &s0, &c0); sincospif(th1 * (float)(r), &s1, &c1); v2u o_; \
          o_.x = pk2(ar[r] * c0 + ai[r] * s0, ai[r] * c0 - ar[r] * s0); o_.y = pk2(br[r] * c1 + bi[r] * s1, bi[r] * c1 - br[r] * s1); *(v2u*)(tp + (size_t)(r) * 512 * 512) = o_; }
        BF_OUT(0) BF_OUT(1) BF_OUT(2) BF_OUT(3) BF_OUT(4) BF_OUT(5) BF_OUT(6) BF_OUT(7)
#undef BF_OUT
    }
}
template <class S> __device__ __forceinline__ void compute_rtab(Frame& F, unsigned char* ws, const S& sched, const float* bias, int NC) {
    LAS float* rt = (LAS float*)(F.lds + RTAB_OFF); LAS float* bt = (LAS float*)(F.lds + BTAB_OFF); pg8::Unit u;
    int tid_ = F.wave * 64 + lane_id(); asm volatile("" : "+v"(tid_));
    const int t = tid_ & 255, par = tid_ >> 8;
    for (int i = 0; i < 7 && sched.next(i, u); ++i) if ((i & 1) == par) { const float* p = (const float*)(ws + WS_SSQ) + ((size_t)u.pm * 256 + t) * 16; float s = 0.f;
        const float bvv = bias[(u.pm < 64 ? (u.pm >> 3) : 8) * NC + u.pn * 256 + t];
#pragma unroll
        for (int q = 0; q < 4; ++q) { const f32x4 a = *(const f32x4*)(p + 4 * q); s += (a[0] + a[1]) + (a[2] + a[3]); }
        rt[i * 256 + t] = __builtin_amdgcn_rsqf(s * (1.0f / 1024.0f) + 1e-6f); bt[i * 256 + t] = bvv; }
    __syncthreads();
}
__device__ __forceinline__ void attn_phase(Frame& F, const Args& A, unsigned char* ws, int l, char* lds) {
    int tid_ = F.wave * 64 + lane_id(); asm volatile("" : "+v"(tid_));
    const float lambda_init = l == 0 ? 0.2f : 0.355509068f;
    const float lam = expf(wave_sum(A.in[11][l * 64 + (tid_ & 63)] * A.in[12][l * 64 + (tid_ & 63)])) - expf(wave_sum(A.in[13][l * 64 + (tid_ & 63)] * A.in[14][l * 64 + (tid_ & 63)])) + lambda_init;
    float gq = fabsf(A.in[9][l * 64 + (tid_ & 63)]), gk = fabsf(A.in[10][l * 64 + (tid_ & 63)]);
#pragma unroll
    for (int o = 1; o < 64; o <<= 1) { gq = fmaxf(gq, __shfl_xor(gq, o)); gk = fmaxf(gk, __shfl_xor(gk, o)); }
    const float negoff = -fmaxf(0.f, 8.0f * 1.4426950408889634f * gq * gk * 1.0001f - 40.0f);
    const att::bf16* QB = (const att::bf16*)(ws + WS_QB); const att::bf16* KB = (const att::bf16*)(ws + WS_KB); const att::bf16* VB = (const att::bf16*)(ws + WS_VB); att::bf16* MIX = (att::bf16*)(ws + WS_MIX);
    const float* subg = A.in[15] + l * 128;
    const int per = (512 + F.G - 1) / F.G;
    for (int u = F.vcu * per; u < (F.vcu + 1) * per && u < 512; ++u) {
        const int qblk = u & 15, bh = u >> 4, b = bh >> 2, h = bh & 3;
        att::attn_unit(QB + h * 128, KB + h * 128, VB + h * 128, MIX + h * 128, (long)b * SEQ + qblk * 128, (long)M_LAT + b * CTXL, 4, (long)b * SEQ, 36, lam, 1.0f - lambda_init, subg, negoff, lds, F.wave, (unsigned)(uintptr_t)F.lds);
    }
#if EN_ATTC
    if (l == 0) for (int u = F.vcu; u < 64; u += F.G) {
        const int qblk = u & 1, bh = u >> 1, b = bh >> 2, h = bh & 3;
        att::attn_unit(QB + h * 128, KB + h * 128, VB + h * 128, MIX + h * 128, (long)M_LAT + b * CTXL + qblk * 128, (long)M_LAT + b * CTXL, 4, 0, 4, lam, 1.0f - lambda_init, subg, negoff, lds, F.wave, (unsigned)(uintptr_t)F.lds);
    }
#endif
}

__global__ void __launch_bounds__(NWAVES * 64, 2) fwd_kernel(const Args args) {
    extern __shared__ __attribute__((aligned(16))) unsigned char lds[];
    Frame F0;
    F0.lds = (LAS unsigned char*)lds;
    F0.wave = __builtin_amdgcn_readfirstlane((int)threadIdx.x >> 6);
    F0.G = gridDim.x; { const int bx = blockIdx.x; F0.vcu = (F0.G % 8 == 0) ? (bx % 8) * (F0.G / 8) + bx / 8 : bx; }
    for (int u = ((int)threadIdx.x); u < (LDS_BYTES - LDSCTL_OFF) / 4; u += NWAVES * 64) ((LAS unsigned*)(F0.lds + LDSCTL_OFF))[u] = 0u;
    __syncthreads();
    volatile LAS unsigned* MISC = (volatile LAS unsigned*)(F0.lds + MISC_OFF);
    (void)xcd_barrier_post((unsigned*)(args.ws + WS_CTL) + CW_BAR, MISC + 8);
    const int lo = args.ph_lo, hi = args.ph_hi;
    const int cid = (int)blockIdx.x;
    const LAS float* rtab = (const LAS float*)(F0.lds + RTAB_OFF);
#pragma unroll 1
    for (int ph = lo; ph < hi; ++ph) {
#if PROBE_A
        if (blockIdx.x == 0 && F0.wave == 0) MISC[16 + ph] = (unsigned)__builtin_amdgcn_s_memrealtime();
#endif
        unsigned char* ws = args.ws; asm volatile("" : "+s"(ws)); const Args& A = args;
        Frame F = F0; asm volatile("" : "+s"(F.G), "+s"(F.vcu), "+s"(F.wave));
        int l = 0, k = -1; if (ph >= 2) { l = (ph - 2) / 6; k = (ph - 2) % 6; }
        if (ph == 0) ph0(F, A, ws);
        else if (ph == 1) ph1(F, A, ws);
        else if (k == 1) continue;
        else if (k == 2) {
            butterfly_phase(F, ws);
            asm volatile("s_waitcnt vmcnt(0)" ::: "memory"); __syncthreads();
            if (F.wave == 0 && lane_id() == 0) { __builtin_amdgcn_fence(__ATOMIC_RELEASE, "agent"); asm volatile("s_waitcnt vmcnt(0)" ::: "memory");
                __hip_atomic_fetch_add((unsigned*)(ws + WS_CTL) + CW_BFCNT + 64 * l, 1u, __ATOMIC_RELAXED, __HIP_MEMORY_SCOPE_AGENT); }
            attn_phase(F, A, ws, l, (char*)lds);
        }
#pragma unroll 1
        for (int ci = 0; ci < 2; ++ci) {
            enum { T_NONE = 0, T_IN = 1, T_DFT = 2, T_RESN = 3, T_RESL = 4, T_GU = 5 };
            int type = T_NONE, nMa = 0, nNa = 0, pmB = 0, nMb = 0, pnB = 0, nNb = 0, Gs = F.G, cs = cid, rot = 0, K = DM, el = l, nshort = 0, ishort = 0; bool ctxdown = false; int sigw = -1, waitw = -1;
#if SCHED_OLD
            const int nM = l == 0 ? 72 : 64;
            if (ci == 0) {
                if (k == 0) { type = T_IN; if (l == 0) { nMa = 72; nNa = 10; } else { nMa = 64; nNa = 10; pmB = 64; nMb = 8; pnB = 2; nNb = 4; } }
                else if (k == 2) { type = T_DFT; nMa = 1; nNa = l == 0 ? 144 : 128; rot = F.G - 64; K = 512; }
                else if (k == 3) { type = T_RESN; nMa = nM; nNa = 4; }
                else if (k == 4) { type = T_GU; nMa = nM; nNa = 22; }
                else if (k == 5) { type = l == NLAYER - 1 ? T_RESL : T_RESN; nMa = nM; nNa = 4; K = FFD; }
            }
#else
            if (k == 0) {
                if (l == 0) { if (ci == 0) { type = T_IN; nMa = 72; nNa = 10; } }
                else if (ci == 0) { type = T_RESN; pmB = 64; nMb = 8; pnB = 0; nNb = 4; K = FFD; el = 0; ctxdown = true; sigw = CW_CTXCNT; }
                else if (cid >= 32) { type = T_IN; nMa = 64; nNa = 10; Gs = F.G - 32; cs = cid - 32; }
                else if (l == NLAYER - 1) { type = T_IN; pmB = 64; nMb = 8; pnB = 2; nNb = 4; waitw = CW_CTXCNT; }
            }
            else if (k == 2) { if (ci == 0) { type = T_DFT; nMa = 1; nNa = l == 0 ? 144 : 128; rot = F.G - 64; K = 512; } }
            else if (k == 3) { if (ci == 0) { type = T_RESN; nMa = 64; nNa = 4; } }
            else if (k == 4) { if (l == 0 && ci == 0) { type = T_RESN; pmB = 64; nMb = 8; pnB = 0; nNb = 4; }
                               else if (ci == (l == 0 ? 1 : 0)) { type = T_GU; nMa = 64; nNa = 22; if (l == 0) { nshort = 32; ishort = 4; } } }
            else if (k == 5) { const int cdn = (l == 0) ? 1 : 0;
                               if (ci == cdn) { type = l == NLAYER - 1 ? T_RESL : T_RESN; nMa = 64; nNa = 4; K = FFD; } else if (l == 0 && ci == 0) { type = T_GU; pmB = 64; nMb = 8; pnB = 0; nNb = 22; } }
#endif
            if (type == T_NONE) continue;
            pg8::Sched2 S; S.init(nMa, nNa, pmB, nMb, pnB, nNb, Gs, cs, rot); S.ns = nshort; S.is = ishort;
            if (waitw >= 0) {
                pg8::Unit u0; if (!S.next(0, u0)) continue;
                if (F.wave == 0) { unsigned* cw = (unsigned*)(ws + WS_CTL) + waitw + 64 * (cid & 7); unsigned sp = 0;
                    while (__hip_atomic_load(cw, __ATOMIC_RELAXED, __HIP_MEMORY_SCOPE_AGENT) < 4u) { __builtin_amdgcn_s_sleep(8); if (++sp > (1u << 22)) break; }
                    __builtin_amdgcn_fence(__ATOMIC_ACQUIRE, "agent"); asm volatile("s_waitcnt vmcnt(0)" ::: "memory"); }
                __syncthreads();
            } S.wgm = (nNa >= 16) ? WGM_WIDE : ((nNa >= 8) ? WGM_MID : 2);
            if (type == T_IN) {
                {
                    int t_ = F.wave * 64 + lane_id(); asm volatile("" : "+v"(t_)); LAS float* et = (LAS float*)(F.lds + ETAB_OFF);
                    for (int i = t_; i < 3072 + 128; i += NWAVES * 64) et[i] = i < 3072 ? ((const float*)(ws + WS_ROPE))[i] : (i < 3136 ? A.in[9][l * 64 + i - 3072] : A.in[10][l * 64 + i - 3136]);
                }
                compute_rtab(F, ws, S, (const float*)(ws + WS_BIN) + l * 9 * NIN, NIN);
                pg8::Gemm g{(const pg8::bf16_t*)(ws + WS_A), (const pg8::bf16_t*)(ws + WS_WIN) + (size_t)l * NIN * DM, M_ALL, NIN, DM};
                pg8::EpiIn E{ws, rtab};
                pg8::gemm_phase<pg8::EpiIn, pg8::Sched2, true, true>(F.lds, g, S, E, F.wave);
            } else if (type == T_DFT) {
                {
                    if (F.wave == 0) { unsigned* cw = (unsigned*)(ws + WS_CTL) + CW_BFCNT + 64 * l; unsigned sp = 0;
                        while (__hip_atomic_load(cw, __ATOMIC_RELAXED, __HIP_MEMORY_SCOPE_AGENT) < (unsigned)F.G) { __builtin_amdgcn_s_sleep(8); if (++sp > (1u << 22)) break; }
                        __builtin_amdgcn_fence(__ATOMIC_ACQUIRE, "agent"); asm volatile("s_waitcnt vmcnt(0)" ::: "memory"); }
                    __syncthreads();
                }
                pg8::Gemm g{(const pg8::bf16_t*)(ws + WS_DFT), (const pg8::bf16_t*)(ws + WS_T), 256, 36864, 512};
                pg8::EpiDft E{(pg8::bf16_t*)(ws + WS_MIX)};
                pg8::gemm_phase<pg8::EpiDft, pg8::Sched2, true, true>(F.lds, g, S, E, F.wave);
            } else if (type == T_GU) {
                compute_rtab(F, ws, S, (const float*)(ws + WS_BGU) + l * 9 * NGU, NGU);
                pg8::Gemm g{(const pg8::bf16_t*)(ws + WS_A), (const pg8::bf16_t*)(ws + WS_WGU) + (size_t)l * NGU * DM, M_ALL, NGU, DM};
                pg8::EpiGU E{ws, rtab};
                pg8::gemm_phase<pg8::EpiGU, pg8::Sched2, true, true>(F.lds, g, S, E, F.wave);
            } else if (type == T_RESN) {
                const bool down = K == FFD;
                const pg8::bf16_t* Ap = down ? (ctxdown ? (const pg8::bf16_t*)(ws + WS_HC) - (size_t)M_LAT * FFD : (const pg8::bf16_t*)(ws + WS_H)) : (const pg8::bf16_t*)(ws + WS_MIX);
                const pg8::bf16_t* Bp = down ? (const pg8::bf16_t*)(ws + WS_WDN) + (size_t)el * DM * FFD : (const pg8::bf16_t*)(ws + WS_WOUT) + (size_t)el * DM * DM;
                pg8::Gemm g{Ap, Bp, M_ALL, DM, K};
                void* xl_out = (!down && el == NLAYER - 1) ? (void*)(ws + WS_XB2) : (void*)A.out;
                pg8::EpiRes<true> E{(const void*)A.out, xl_out, ws, el * 9 * 6144 + (down ? 5120 : 2048), down ? A.in[6] + (el + 1) * DM : A.in[7] + el * DM, down ? (el + 1) * 9 * 6144 + 1024 : el * 9 * 6144 + 4096};
                pg8::gemm_phase<pg8::EpiRes<true>, pg8::Sched2, true, true>(F.lds, g, S, E, F.wave);
                if (sigw >= 0) {
                    pg8::Unit u0; if (S.next(0, u0)) {
                    asm volatile("s_waitcnt vmcnt(0)" ::: "memory"); __syncthreads();
                    if (F.wave == 0 && lane_id() == 0) { __builtin_amdgcn_fence(__ATOMIC_RELEASE, "agent"); asm volatile("s_waitcnt vmcnt(0)" ::: "memory");
                        __hip_atomic_fetch_add((unsigned*)(ws + WS_CTL) + sigw + 64 * (cid & 7), 1u, __ATOMIC_RELAXED, __HIP_MEMORY_SCOPE_AGENT); } }
                }
            } else {
                pg8::Gemm g{(const pg8::bf16_t*)(ws + WS_H), (const pg8::bf16_t*)(ws + WS_WDN) + (size_t)l * DM * FFD, M_ALL, DM, FFD};
                pg8::EpiRes<false> E{(const void*)(ws + WS_XB2), (void*)A.out, ws, l * 9 * 6144 + 5120, nullptr, 0};
                pg8::gemm_phase<pg8::EpiRes<false>, pg8::Sched2, true, true>(F.lds, g, S, E, F.wave);
            }
        }
        if (ph + 1 < hi) { XcdBarrier bar; bar.bar = (unsigned*)(args.ws + WS_CTL) + CW_BAR; bar.x = xb_xcc_id(); bar.st = MISC + 8; xcd_barrier(bar); }
    }
#if PROBE_S
    if (blockIdx.x == 0 && F0.wave == 0) { const unsigned long long t0 = __builtin_amdgcn_s_memrealtime(); const unsigned long long dl = 5ull * (MISC[40 + ((PROBE_S) & 255)] - MISC[40 + ((PROBE_S) >> 8)]);
        while (__builtin_amdgcn_s_memrealtime() - t0 < dl) __builtin_amdgcn_s_sleep(32); }
#endif
#if PROBE_A
    if (blockIdx.x == 0 && F0.wave == 0) { const unsigned long long t0 = __builtin_amdgcn_s_memrealtime(); MISC[16 + N_PHASES] = (unsigned)t0; unsigned long long dl = 0;
        for (int p = 0; p < N_PHASES; ++p) if ((PROBE_A >> p) & 1) dl += 5ull * (MISC[17 + p] - MISC[16 + p]);
        while (__builtin_amdgcn_s_memrealtime() - t0 < dl) __builtin_amdgcn_s_sleep(32); }
#endif
}
static_assert(EWS_MOD == WS_MOD && EWS_BIN == WS_BIN && EWS_BGU == WS_BGU && EWS_ROPE == WS_ROPE && EWS_SSQ == WS_SSQ && EWS_A == WS_A && EWS_XC == WS_XC && EWS_QB == WS_QB && EWS_KB == WS_KB && EWS_VB == WS_VB && EWS_TC == WS_TC && EWS_T == WS_T && EWS_H == WS_H && EWS_HC == WS_HC, "epilogue offsets vs d_ws map");
#ifndef MK_PER_PHASE
#define MK_PER_PHASE 0
#endif
extern "C" void kernel_launch(void* const* d_in, const int* in_sizes, int n_in, void* d_out, int out_size, void* d_ws, size_t ws_size, hipStream_t stream) {
    static int grid = 0;
    if (grid == 0) {
        if (n_in != 21 || in_sizes[0] != M_LAT * DM || out_size != M_LAT * DM || ws_size < WS_END) { fprintf(stderr, "kernel_launch: unexpected shapes (n_in %d, in0 %d, out %d, ws %zu)\n", n_in, n_in > 0 ? in_sizes[0] : -1, out_size, ws_size); grid = -1; return; }
        int dev = 0, cus = 0, per_cu = 0;
        if (hipGetDevice(&dev) != hipSuccess || hipDeviceGetAttribute(&cus, hipDeviceAttributeMultiprocessorCount, dev) != hipSuccess) { grid = -1; return; }
        if (hipFuncSetAttribute((const void*)fwd_kernel, hipFuncAttributeMaxDynamicSharedMemorySize, LDS_BYTES) != hipSuccess) { fprintf(stderr, "kernel_launch: hipFuncSetAttribute failed\n"); grid = -1; return; }
        if (hipOccupancyMaxActiveBlocksPerMultiprocessor(&per_cu, (const void*)fwd_kernel, NWAVES * 64, LDS_BYTES) != hipSuccess || per_cu < 1) { fprintf(stderr, "kernel_launch: occupancy query reports %d\n", per_cu); }
        (void)hipGetLastError();
        grid = cus;
    }
    if (grid < 0) return;
    (void)hipMemsetAsync((char*)d_ws + WS_CTL, 0, CTL_ZERO_BYTES, stream);
    Args a{};
    for (int i = 0; i < 21; ++i) a.in[i] = (const float*)d_in[i];
    a.out = (float*)d_out; a.ws = (unsigned char*)d_ws;
#if MK_PER_PHASE
#ifndef REP_MASK
#define REP_MASK 0
#endif
    for (int ph = 0; ph < N_PHASES; ++ph) { a.ph_lo = ph; a.ph_hi = ph + 1; for (int rep = 0; rep < (((REP_MASK) >> ph) & 1) + 1; ++rep) hipLaunchKernelGGL(fwd_kernel, dim3(grid), dim3(NWAVES * 64), LDS_BYTES, stream, a); }
#else
    a.ph_lo = 0; a.ph_hi = N_PHASES; hipLaunchKernelGGL(fwd_kernel, dim3(grid), dim3(NWAVES * 64), LDS_BYTES, stream, a);
#endif
    const hipError_t le = hipPeekAtLastError();
    if (le != hipSuccess) fprintf(stderr, "kernel_launch: launch failed: %s\n", hipGetErrorName(le));
}
```

```cpp
#define MK_PER_PHASE 0
#include <hip/hip_runtime.h>
#include <cstdio>
#include <cstdint>
#include <math.h>
constexpr size_t EWS_MOD = 64 * 1024, EWS_BIN = 512 * 1024, EWS_BGU = (1u << 20) + 768 * 1024, EWS_ROPE = EWS_BGU + 512 * 1024, EWS_SSQ = 5u << 20, EWS_A = 56u << 20, EWS_XC = 92u << 20,
                 EWS_QB = 100u << 20, EWS_KB = 118u << 20, EWS_VB = 136u << 20, EWS_TC = 186u << 20, EWS_T = 154u << 20, EWS_H = 100u << 20, EWS_HC = 226u << 20;
namespace pg8 {
#define PG8_LAS __attribute__((address_space(3)))
typedef unsigned short bf16_t;
typedef short bf16x8 __attribute__((ext_vector_type(8)));
typedef float f32x4 __attribute__((ext_vector_type(4)));
typedef unsigned u32x4 __attribute__((ext_vector_type(4)));
constexpr int BM = 256, BK = 64, HALF = 128, HTB = HALF * BK * 2  , STAGE_BYTES = 8 * HTB, NXCD = 8, WGM = 2;

__host__ __device__ __forceinline__ int lds_byte(int r, int c) { const int st = (r >> 4) * 2 + (c >> 5), rr = r & 15, cc = c & 31, ob = rr * 64 + cc * 2; return st * 1024 + (ob ^ (((ob >> 9) & 1) << 5)); }
__host__ __device__ __forceinline__ void stage_rc(int b, int& R, int& C) { const int st = b / 1024, sb = b % 1024, swz = sb ^ (((sb >> 9) & 1) << 5); R = (st >> 1) * 16 + swz / 64; C = (st & 1) * 32 + (swz % 64) / 2; }
__host__ __device__ __forceinline__ int perm32(int rho) { const int n = rho >> 4, i = rho & 15; return 8 * (i >> 2) + 4 * n + (i & 3); }

struct Unit { int pm, pn; };
struct Gemm { const bf16_t* A; const bf16_t* Bt; int M, N, K; };

struct StaticOrder {
    int nM, nN, nwg, G, c;
    __host__ __device__ void init(int M, int N, int G_, int c_) { nM = M / BM; nN = N / BM; nwg = nM * nN; G = G_; c = c_; }
    __host__ __device__ bool next(int i, Unit& u) const {
        const long L = (long)i * G + c; if (L >= nwg) return false;
        int wgid = (int)L; { const int q = nwg / NXCD, r = nwg % NXCD, xcd = wgid % NXCD, off = wgid / NXCD; wgid = (xcd < r ? xcd * (q + 1) : r * (q + 1) + (xcd - r) * q) + off; }
        const int nig = WGM * nN, gid = wgid / nig, fm = gid * WGM, gsz = (nM - fm) < WGM ? (nM - fm) : WGM;
        u.pm = fm + ((wgid % nig) % gsz); u.pn = (wgid % nig) / gsz; return true;
    }
    __device__ __forceinline__ void a_ready(const Unit&) const {}
    __device__ __forceinline__ void done(const Unit&) const {}
};

struct Sched2 {
    int nMa, nNa, nA, pmB, nMb, pnB, nNb, nB, G, c, ns = 0, is = 0, wgm = WGM;
    __device__ void init(int nMa_, int nNa_, int pmB_, int nMb_, int pnB_, int nNb_, int G_, int c_, int rot) { nMa = nMa_; nNa = nNa_; nA = nMa * nNa; pmB = pmB_; nMb = nMb_; pnB = pnB_; nNb = nNb_; nB = nMb * nNb; G = G_; c = (c_ + rot) % G_; }
    __device__ bool next(int i, Unit& u) const {
        long L;
        if (ns == 0 || i < is) { if (ns != 0 && i >= is && c < ns) return false; L = (long)i * G + c; }
        else { if (c < ns) return false; L = (long)is * G + (long)(i - is) * (G - ns) + (c - ns); }
        if (L >= nA + nB) return false;
        if (L < nA) {
            int wgid = (int)L; { const int q = nA / NXCD, r = nA % NXCD, xcd = wgid % NXCD, off = wgid / NXCD; wgid = (xcd < r ? xcd * (q + 1) : r * (q + 1) + (xcd - r) * q) + off; }
            const int nig = wgm * nNa, gid = wgid / nig, fm = gid * wgm, gsz = (nMa - fm) < wgm ? (nMa - fm) : wgm;
            u.pm = fm + ((wgid % nig) % gsz); u.pn = (wgid % nig) / gsz;
        } else { const int r = (int)L - nA; u.pm = pmB + r % nMb; u.pn = pnB + r / nMb; }
        return true;
    }
    __device__ __forceinline__ void a_ready(const Unit&) const {}
    __device__ __forceinline__ void done(const Unit&) const {}
};
__device__ __forceinline__ unsigned cvt_pk_bf16(float lo, float hi) { unsigned r; asm volatile("v_cvt_pk_bf16_f32 %0, %1, %2" : "=v"(r) : "v"(lo), "v"(hi)); return r; }
typedef unsigned u32x2 __attribute__((ext_vector_type(2)));
__device__ __forceinline__ u32x2 pk4(f32x4 v) { u32x2 w; w.x = cvt_pk_bf16(v[0], v[1]); w.y = cvt_pk_bf16(v[2], v[3]); return w; }
#ifndef WT_STORES
#define WT_STORES 0
#endif
#ifndef NT_STORES
#define NT_STORES 0
#endif
__device__ __forceinline__ void st8(void* p, u32x2 v) {
#if WT_STORES
    __hip_atomic_store((unsigned long long*)p, ((unsigned long long)v.y << 32) | v.x, __ATOMIC_RELAXED, __HIP_MEMORY_SCOPE_AGENT);
#elif NT_STORES
    __builtin_nontemporal_store(v, (u32x2*)p);
#else
    *(u32x2*)p = v;
#endif
}
__device__ __forceinline__ float rowsum4(float s) {
    { const unsigned u = __builtin_bit_cast(unsigned, s); auto a = __builtin_amdgcn_permlane16_swap(u, u, false, false); const unsigned a0 = a[0], a1 = a[1]; s = __builtin_bit_cast(float, a0) + __builtin_bit_cast(float, a1); }
    { const unsigned u = __builtin_bit_cast(unsigned, s); auto b = __builtin_amdgcn_permlane32_swap(u, u, false, false); const unsigned b0 = b[0], b1 = b[1]; s = __builtin_bit_cast(float, b0) + __builtin_bit_cast(float, b1); }
    return s;
}
__device__ __forceinline__ float dot4(f32x4 v) { return (v[0] * v[0] + v[1] * v[1]) + (v[2] * v[2] + v[3] * v[3]); }
constexpr int BT_F = (140288 - 131072) / 4, ET_F = (147456 - 131072) / 4;
constexpr int M_LAT_TILES = 64;
constexpr float QSCALE = 0.125f * 1.4426950408889634f;
constexpr float ZS_LAT = 1.0f / 512.0f;
constexpr float ZS_CTX = 0.005524271728019903f;

struct EpiIn {
    static constexpr bool PERM = false, AFTER_DRAIN = false;
    unsigned char* ws; const PG8_LAS float* rtab;
    __device__ __forceinline__ void operator()(const f32x4 (&acc)[2][2][4][2], const Unit& u, int ui, int wr, int wc, int fr, int fq) const {
        const int pm = u.pm, pn = u.pn; const bool lat = pm < M_LAT_TILES; const int bm = lat ? (pm >> 3) : 8;
        const PG8_LAS float* rope = rtab + ET_F;
        bf16_t* QB = (bf16_t*)(ws + EWS_QB); bf16_t* KB = (bf16_t*)(ws + EWS_KB); bf16_t* VB = (bf16_t*)(ws + EWS_VB); bf16_t* T = (bf16_t*)(ws + EWS_T); bf16_t* Tc = (bf16_t*)(ws + EWS_TC);
        const PG8_LAS float* bp = rtab + BT_F + ui * 256 + wc * 32 + fq * 4;
        f32x4 bv[2][2];
#pragma unroll
        for (int bj = 0; bj < 2; ++bj)
#pragma unroll
            for (int n = 0; n < 2; ++n) bv[bj][n] = *(const PG8_LAS f32x4*)(bp + bj * 128 + n * 16);
        const PG8_LAS float* rt = rtab + ui * 256 + wr * 64 + fr;
        if (pn < 4) {
            const PG8_LAS float* gp = rope + 3072 + (pn < 2 ? 0 : 64) + fq * 4; const float qs = pn < 2 ? QSCALE : 1.f;
            f32x4 gv[2][2];
#pragma unroll
            for (int bj = 0; bj < 2; ++bj)
#pragma unroll
                for (int n = 0; n < 2; ++n) gv[bj][n] = *(const PG8_LAS f32x4*)(gp + bj * 32 + n * 16) * qs;
            bf16_t* dst = (pn < 2 ? QB : KB) + (pn & 1) * 256 + wc * 64 + fq * 4;
#pragma unroll
            for (int ai = 0; ai < 2; ++ai)
#pragma unroll
                for (int m = 0; m < 4; ++m) {
                    const int rl = ai * 128 + wr * 64 + m * 16 + fr, row = pm * 256 + rl; const float r = rt[ai * 128 + m * 16];
                    f32x4 v[2][2]; float ssq = 0.f;
#pragma unroll
                    for (int bj = 0; bj < 2; ++bj)
#pragma unroll
                        for (int n = 0; n < 2; ++n) { v[bj][n] = acc[ai][bj][m][n] * r + bv[bj][n]; ssq += dot4(v[bj][n]); }
                    ssq = rowsum4(ssq);
                    const float rn = __builtin_amdgcn_rsqf(ssq * (1.0f / 64.0f) + 1e-6f);
#pragma unroll
                    for (int bj = 0; bj < 2; ++bj)
#pragma unroll
                        for (int n = 0; n < 2; ++n) v[bj][n] = v[bj][n] * rn * gv[bj][n];
                    if (lat) { const int pos = row & 2047;
#pragma unroll
                        for (int bj = 0; bj < 2; ++bj) { const PG8_LAS float* cp = rope + (bj == 0 ? (pos >> 6) : 32 + (pos & 63)) * 16 + fq * 4; const f32x4 c4 = *(const PG8_LAS f32x4*)cp, s4 = *(const PG8_LAS f32x4*)(cp + 1536); const f32x4 t1 = v[bj][0], t2 = v[bj][1];
                            v[bj][0] = t1 * c4 - t2 * s4; v[bj][1] = t2 * c4 + t1 * s4; } }
#pragma unroll
                    for (int bj = 0; bj < 2; ++bj)
#pragma unroll
                        for (int n = 0; n < 2; ++n) *(u32x2*)(dst + (size_t)row * 512 + bj * 32 + n * 16) = pk4(v[bj][n]);
                }
        } else if (pn < 6) {
            bf16_t* dst = VB + (pn - 4) * 256 + wc * 32 + fq * 4;
#pragma unroll
            for (int ai = 0; ai < 2; ++ai)
#pragma unroll
                for (int m = 0; m < 4; ++m) {
                    const int rl = ai * 128 + wr * 64 + m * 16 + fr, row = pm * 256 + rl; const float r = rt[ai * 128 + m * 16];
#pragma unroll
                    for (int bj = 0; bj < 2; ++bj)
#pragma unroll
                        for (int n = 0; n < 2; ++n) *(u32x2*)(dst + (size_t)row * 512 + bj * 128 + n * 16) = pk4(acc[ai][bj][m][n] * r + bv[bj][n]);
                }
        } else {
            const int g = pn - 6; const float zs = lat ? ZS_LAT : ZS_CTX;
            const int b = lat ? (pm >> 3) : (pm - M_LAT_TILES);
            bf16_t* tb = (lat ? T + (size_t)((b * 8 + (pm & 7)) * 512) * 512 : Tc + (size_t)(b * 512) * 512) + (size_t)(g * 128 + wc * 32 + fq * 4) * 512;
#pragma unroll
            for (int ai = 0; ai < 2; ++ai)
#pragma unroll
                for (int m = 0; m < 4; ++m) {
                    const int rl = ai * 128 + wr * 64 + m * 16 + fr; const float r = rt[ai * 128 + m * 16];
#pragma unroll
                    for (int n = 0; n < 2; ++n) { const f32x4 re = (acc[ai][0][m][n] * r + bv[0][n]) * zs, im = (acc[ai][1][m][n] * r + bv[1][n]) * zs;
#pragma unroll
                        for (int i = 0; i < 4; ++i) *(unsigned*)(tb + (size_t)(n * 16 + i) * 512 + rl * 2) = cvt_pk_bf16(re[i], im[i]); }
                }
        }
    }
};
typedef _Float16 h16x2 __attribute__((ext_vector_type(2)));
__device__ __forceinline__ unsigned pkh2(float a, float b) { const h16x2 h = {(_Float16)a, (_Float16)b}; return __builtin_bit_cast(unsigned, h); }
__device__ __forceinline__ u32x2 pkh4(f32x4 v) { u32x2 w; w.x = pkh2(v[0], v[1]); w.y = pkh2(v[2], v[3]); return w; }
__device__ __forceinline__ f32x4 unh4(u32x2 w) { const unsigned lo = w.x, hi = w.y; const h16x2 a = __builtin_bit_cast(h16x2, lo), b = __builtin_bit_cast(h16x2, hi);     return (f32x4){(float)a[0], (float)a[1], (float)b[0], (float)b[1]}; }
template <bool NEXT> struct EpiRes {
    static constexpr bool PERM = false, AFTER_DRAIN = false;
    const void* xl_in; void* xl_out;
    unsigned char* ws; int gate_off;
    const float* ng; int nsc_off;
    __device__ __forceinline__ void operator()(const f32x4 (&acc)[2][2][4][2], const Unit& u, int ui, int wr, int wc, int fr, int fq) const {
        const int pm = u.pm, pn = u.pn; const bool lat = pm < M_LAT_TILES; const int bm = lat ? (pm >> 3) : 8; const int col0 = pn * 256 + wc * 32 + fq * 4;
        const float* gate = (const float*)(ws + EWS_MOD) + gate_off; const float* nsc = (const float*)(ws + EWS_MOD) + nsc_off; bf16_t* A = (bf16_t*)(ws + EWS_A); float* ssq = (float*)(ws + EWS_SSQ);
        const _Float16* xin = lat ? (const _Float16*)xl_in + (size_t)pm * 256 * 1024 : (const _Float16*)(ws + EWS_XC) + (size_t)(pm - M_LAT_TILES) * 256 * 1024;
        _Float16* xout = lat ? (_Float16*)xl_out + (size_t)pm * 256 * 1024 : (_Float16*)(ws + EWS_XC) + (size_t)(pm - M_LAT_TILES) * 256 * 1024;
        float* xoutf = (float*)xl_out + (size_t)pm * 256 * 1024;
        float ssq_[2][4];
#pragma unroll
        for (int ai = 0; ai < 2; ++ai)
#pragma unroll
            for (int m = 0; m < 4; ++m) ssq_[ai][m] = 0.f;
        f32x4 ga[2][2], gv[2][2]; u32x2 preA[4][2], preB[4][2];
        auto loadx = [&](int g, u32x2 (&p)[4][2]) __attribute__((always_inline)) { const int bj = g >> 1, ai = g & 1;
#pragma unroll
            for (int m = 0; m < 4; ++m)
#pragma unroll
                for (int n = 0; n < 2; ++n) p[m][n] = *(const u32x2*)(xin + (size_t)(ai * 128 + wr * 64 + m * 16 + fr) * 1024 + col0 + bj * 128 + n * 16); };
        auto loadg = [&](int bj) __attribute__((always_inline)) {
#pragma unroll
            for (int n = 0; n < 2; ++n) { const int c = col0 + bj * 128 + n * 16; ga[bj][n] = *(const f32x4*)(gate + bm * 6144 + c);
                if (NEXT) gv[bj][n] = *(const f32x4*)(ng + c) * (*(const f32x4*)(nsc + bm * 6144 + c) + 1.0f); } };
        auto proc = [&](int g, const u32x2 (&p)[4][2]) __attribute__((always_inline)) { const int bj = g >> 1, ai = g & 1;
#pragma unroll
            for (int m = 0; m < 4; ++m) {
                const int rl = ai * 128 + wr * 64 + m * 16 + fr; const size_t row = (size_t)pm * 256 + rl;
#pragma unroll
                for (int n = 0; n < 2; ++n) { const size_t off = (size_t)rl * 1024 + col0 + bj * 128 + n * 16; const f32x4 xn = unh4(p[m][n]) + ga[bj][n] * acc[ai][bj][m][n];
                    if (NEXT) *(u32x2*)(xout + off) = pkh4(xn); else *(f32x4*)(xoutf + off) = xn;
                    if (NEXT) { ssq_[ai][m] += dot4(xn); *(u32x2*)(A + row * 1024 + col0 + bj * 128 + n * 16) = pk4(xn * gv[bj][n]); } }
            }
            asm volatile("" ::: "memory"); };
        loadx(0, preA); loadg(0); loadx(1, preB); asm volatile("" ::: "memory");
        proc(0, preA); loadg(1); loadx(2, preA); asm volatile("" ::: "memory");
        proc(1, preB); loadx(3, preB); asm volatile("" ::: "memory");
        proc(2, preA); proc(3, preB);
        if (NEXT) {
#pragma unroll
            for (int ai = 0; ai < 2; ++ai)
#pragma unroll
                for (int m = 0; m < 4; ++m) { const float s = rowsum4(ssq_[ai][m]); if (fq == 0) ssq[((size_t)pm * 256 + ai * 128 + wr * 64 + m * 16 + fr) * 16 + pn * 4 + wc] = s; }
        }
    }
};
struct EpiGU {
    static constexpr bool PERM = false, AFTER_DRAIN = false;
    unsigned char* ws; const PG8_LAS float* rtab;
    __device__ __forceinline__ void operator()(const f32x4 (&acc)[2][2][4][2], const Unit& u, int ui, int wr, int wc, int fr, int fq) const {
        const int pm = u.pm, pn = u.pn; const int bm = pm < M_LAT_TILES ? (pm >> 3) : 8;
        bf16_t* H = (bf16_t*)(ws + EWS_H);
        const PG8_LAS float* bp = rtab + BT_F + ui * 256 + wc * 32 + fq * 4;
        f32x4 bg[2], bu[2];
#pragma unroll
        for (int n = 0; n < 2; ++n) { bg[n] = *(const PG8_LAS f32x4*)(bp + n * 16); bu[n] = *(const PG8_LAS f32x4*)(bp + 128 + n * 16); }
        const PG8_LAS float* rt = rtab + ui * 256 + wr * 64 + fr;
        if (pm >= M_LAT_TILES) H = (bf16_t*)(ws + EWS_HC) - (size_t)16384 * 2816;
        bf16_t* dst = H + pn * 128 + wc * 32 + fq * 4;
#pragma unroll
        for (int ai = 0; ai < 2; ++ai)
#pragma unroll
            for (int m = 0; m < 4; ++m) {
                const int rl = ai * 128 + wr * 64 + m * 16 + fr; const size_t row = (size_t)pm * 256 + rl; const float r = rt[ai * 128 + m * 16];
#pragma unroll
                for (int n = 0; n < 2; ++n) { const f32x4 gg = acc[ai][0][m][n] * r + bg[n], uu = acc[ai][1][m][n] * r + bu[n]; f32x4 h;
#pragma unroll
                    for (int i = 0; i < 4; ++i) h[i] = gg[i] * __builtin_amdgcn_rcpf(1.0f + __builtin_amdgcn_exp2f(-1.4426950408889634f * gg[i])) * uu[i];
                    st8(dst + row * 2816 + n * 16, pk4(h)); }
            }
    }
};
struct EpiDft {
    static constexpr bool PERM = true, AFTER_DRAIN = false;
    bf16_t* MIX;
    __device__ __forceinline__ void operator()(const f32x4 (&acc)[2][2][4][2], const Unit& u, int ui, int wr, int wc, int fr, int fq) const {
        const int pn = u.pn;
#pragma unroll
        for (int bj = 0; bj < 2; ++bj) {
            const int c = pn * 256 + bj * 128 + wc * 32 + fq * 8; int rowbase, rstride, ch;
            if (pn < 128) { const int b = c >> 12, r = (c >> 9) & 7; ch = c & 511; rowbase = b * 2048 + r; rstride = 8; }
            else { const int c2 = c - 32768; const int b = c2 >> 9; ch = c2 & 511; rowbase = 16384 + b * 256; rstride = 1; }
#pragma unroll
            for (int ai = 0; ai < 2; ++ai)
#pragma unroll
                for (int m = 0; m < 4; ++m) { const int mm = ai * 128 + wr * 64 + m * 16 + fr; const size_t row = (size_t)rowbase + (size_t)mm * rstride;
                    const f32x4 v0 = acc[ai][bj][m][0], v1 = acc[ai][bj][m][1]; u32x4 w; w.x = cvt_pk_bf16(v0[0], v0[1]); w.y = cvt_pk_bf16(v0[2], v0[3]); w.z = cvt_pk_bf16(v1[0], v1[1]); w.w = cvt_pk_bf16(v1[2], v1[3]);
                    *(u32x4*)(MIX + row * 1024 + 512 + ch) = w; }
        }
    }
};
template <class Epi, class Sched, bool ALIGN_EPI = false, bool SP2 = false>
__device__ __forceinline__ void gemm_phase(PG8_LAS unsigned char* lds, const Gemm g, const Sched& S, const Epi& E, int wave_) {
    unsigned z_ = 0u; asm volatile("" : "+v"(z_)); int tid_ = wave_ * 64 + (int)__builtin_amdgcn_mbcnt_hi(~0u, __builtin_amdgcn_mbcnt_lo(~0u, z_)); asm volatile("" : "+v"(tid_));
    const int tid = tid_, wid = __builtin_amdgcn_readfirstlane(tid >> 6), lane = tid & 63, wr = wid >> 2, wc = wid & 3, fr = lane & 15, fq = lane >> 4;
    const int K = g.K, nt = K / BK;
    unsigned voffA[2], voffB[2];
#pragma unroll
    for (int i = 0; i < 2; ++i) { int R, C; stage_rc(tid * 16 + i * 8192, R, C); const int Rb = Epi::PERM ? ((R & ~31) + perm32(R & 31)) : R;
        voffA[i] = (unsigned)(R * K + C) * 2u; voffB[i] = (unsigned)(Rb * K + C) * 2u; }
    const size_t kstep = (size_t)(BK * 2);
    const size_t hstep = (size_t)HALF * K * 2;
    const size_t tstep = 2 * hstep;
    const unsigned ldsw = (unsigned)wid * 1024u;
    const int aoff = lds_byte(wr * 64 + fr, fq * 8), boff = lds_byte(wc * 32 + fr, fq * 8);
#define PG8_SA(b, h) (((b) * 2 + (h)) * HTB)
#define PG8_SB(b, h) ((4 + (b) * 2 + (h)) * HTB)
#define PG8_STAGE(bufoff, gbase, voff) do { _Pragma("unroll") for (int _i = 0; _i < 2; ++_i) \
        __builtin_amdgcn_global_load_lds((const unsigned*)((const char*)(gbase) + (voff)[_i]), (PG8_LAS unsigned*)(lds + (bufoff) + ldsw + _i * 8192), 16, 0, 0); } while (0)
#define PG8_LDA(dst, b, h) do { _Pragma("unroll") for (int m = 0; m < 4; ++m) _Pragma("unroll") for (int k = 0; k < 2; ++k) dst[m][k] = *(const PG8_LAS bf16x8*)(lds + PG8_SA(b, h) + aoff + m * 2048 + k * 1024); } while (0)
#define PG8_LDB(dst, b, h) do { _Pragma("unroll") for (int n = 0; n < 2; ++n) _Pragma("unroll") for (int k = 0; k < 2; ++k) dst[n][k] = *(const PG8_LAS bf16x8*)(lds + PG8_SB(b, h) + boff + n * 2048 + k * 1024); } while (0)
#define PG8_MMA(ai, bj, At, Bt) do { __builtin_amdgcn_s_setprio(1); _Pragma("unroll") for (int m = 0; m < 4; ++m) _Pragma("unroll") for (int n = 0; n < 2; ++n) _Pragma("unroll") for (int k = 0; k < 2; ++k) \
        acc[ai][bj][m][n] = __builtin_amdgcn_mfma_f32_16x16x32_bf16(Bt[n][k], At[m][k], acc[ai][bj][m][n], 0, 0, 0); __builtin_amdgcn_s_setprio(0); } while (0)
#define PG8_WAIT_V(n) asm volatile("s_waitcnt vmcnt(" #n ")" ::: "memory")
#define PG8_WAIT_L(n) asm volatile("s_waitcnt lgkmcnt(" #n ")" ::: "memory")
#define PG8_BAR __builtin_amdgcn_s_barrier()
#define PG8_SCHED __builtin_amdgcn_sched_barrier(0)
    Unit cur, nxt; int ui = 0;
    if (!S.next(0, cur)) return;
    f32x4 acc[2][2][4][2];
#pragma unroll
    for (int a = 0; a < 2; ++a)
#pragma unroll
        for (int b = 0; b < 2; ++b)
#pragma unroll
            for (int m = 0; m < 4; ++m)
#pragma unroll
                for (int n = 0; n < 2; ++n) acc[a][b][m][n] = (f32x4){0.f, 0.f, 0.f, 0.f};
    bf16x8 At[4][2], B0[2][2], B1[2][2];
    const char* cA = (const char*)g.A + (size_t)cur.pm * tstep; const char* cB = (const char*)g.Bt + (size_t)cur.pn * tstep;
    S.a_ready(cur);
    if constexpr (SP2) {
        PG8_STAGE(PG8_SB(0, 0), cB, voffB); PG8_STAGE(PG8_SB(0, 1), cB + hstep, voffB); PG8_STAGE(PG8_SA(0, 0), cA, voffA); PG8_STAGE(PG8_SA(0, 1), cA + hstep, voffA);
        if (wr == 1) PG8_BAR;
        PG8_WAIT_V(2); PG8_BAR;
        PG8_STAGE(PG8_SB(1, 0), cB + kstep, voffB); PG8_STAGE(PG8_SA(1, 0), cA + kstep, voffA); PG8_STAGE(PG8_SB(1, 1), cB + hstep + kstep, voffB);
        PG8_WAIT_V(6); PG8_BAR;
    } else {
        PG8_STAGE(PG8_SB(0, 0), cB, voffB); PG8_STAGE(PG8_SA(0, 0), cA, voffA); PG8_STAGE(PG8_SB(0, 1), cB + hstep, voffB); PG8_STAGE(PG8_SA(0, 1), cA + hstep, voffA);
        if (wr == 1) PG8_BAR;
        PG8_WAIT_V(4); PG8_BAR;
        PG8_STAGE(PG8_SB(1, 0), cB + kstep, voffB); PG8_STAGE(PG8_SA(1, 0), cA + kstep, voffA); PG8_STAGE(PG8_SB(1, 1), cB + hstep + kstep, voffB);
        PG8_WAIT_V(6); PG8_BAR;
    }
    for (;;) {
        const bool has_next = S.next(ui + 1, nxt);
        const char* nA = has_next ? (const char*)g.A + (size_t)nxt.pm * tstep : cA; const char* nB = has_next ? (const char*)g.Bt + (size_t)nxt.pn * tstep : cB;
        for (int t = 0; t < nt; t += 2) {
            const bool last = (t == nt - 2);
            const char* a1 = cA + (size_t)(t + 1) * kstep;
            const char* a2 = last ? nA : cA + (size_t)(t + 2) * kstep; const char* b2 = last ? nB : cB + (size_t)(t + 2) * kstep;
            const char* a3 = a2 + kstep; const char* b3 = b2 + kstep;
            if (last && has_next) S.a_ready(nxt);
            if constexpr (SP2) {
            PG8_LDB(B0, 0, 0); PG8_LDB(B1, 0, 1); PG8_SCHED; PG8_LDA(At, 0, 0); PG8_STAGE(PG8_SA(1, 1), a1 + hstep, voffA);
            PG8_WAIT_V(8); PG8_WAIT_L(0); PG8_BAR; PG8_MMA(0, 0, At, B0); PG8_MMA(0, 1, At, B1); PG8_BAR; PG8_SCHED;
            PG8_LDA(At, 0, 1); PG8_STAGE(PG8_SB(0, 0), b2, voffB); PG8_STAGE(PG8_SB(0, 1), b2 + hstep, voffB); PG8_STAGE(PG8_SA(0, 0), a2, voffA);
            PG8_WAIT_V(8); PG8_WAIT_L(0); PG8_BAR; PG8_MMA(1, 0, At, B0); PG8_MMA(1, 1, At, B1); PG8_BAR; PG8_SCHED;
            PG8_LDB(B0, 1, 0); PG8_LDB(B1, 1, 1); PG8_SCHED; PG8_LDA(At, 1, 0); PG8_STAGE(PG8_SA(0, 1), a2 + hstep, voffA);
            PG8_WAIT_V(8); PG8_WAIT_L(0); PG8_BAR; PG8_MMA(0, 0, At, B0); PG8_MMA(0, 1, At, B1); PG8_BAR; PG8_SCHED;
            PG8_LDA(At, 1, 1); PG8_STAGE(PG8_SB(1, 0), b3, voffB); PG8_STAGE(PG8_SB(1, 1), b3 + hstep, voffB); PG8_STAGE(PG8_SA(1, 0), a3, voffA);
            PG8_WAIT_V(8); PG8_WAIT_L(0); PG8_BAR; PG8_MMA(1, 0, At, B0); PG8_MMA(1, 1, At, B1); PG8_BAR; PG8_SCHED;
            } else {
            PG8_LDB(B0, 0, 0); PG8_SCHED; PG8_LDA(At, 0, 0); PG8_STAGE(PG8_SA(1, 1), a1 + hstep, voffA);
            PG8_WAIT_L(8); PG8_BAR; PG8_WAIT_L(0); PG8_MMA(0, 0, At, B0); PG8_BAR; PG8_SCHED;
            PG8_LDB(B1, 0, 1); PG8_STAGE(PG8_SB(0, 0), b2, voffB);
            PG8_BAR; PG8_WAIT_L(0); PG8_MMA(0, 1, At, B1); PG8_BAR;
            PG8_LDA(At, 0, 1); PG8_STAGE(PG8_SA(0, 0), a2, voffA);
            PG8_BAR; PG8_WAIT_L(0); PG8_MMA(1, 0, At, B0); PG8_BAR; PG8_SCHED;
            PG8_STAGE(PG8_SB(0, 1), b2 + hstep, voffB);
            PG8_WAIT_V(6); PG8_BAR; PG8_MMA(1, 1, At, B1); PG8_BAR;
            PG8_LDB(B0, 1, 0); PG8_SCHED; PG8_LDA(At, 1, 0); PG8_STAGE(PG8_SA(0, 1), a2 + hstep, voffA);
            PG8_WAIT_L(8); PG8_BAR; PG8_WAIT_L(0); PG8_MMA(0, 0, At, B0); PG8_BAR; PG8_SCHED;
            PG8_LDB(B1, 1, 1); PG8_STAGE(PG8_SB(1, 0), b3, voffB);
            PG8_BAR; PG8_WAIT_L(0); PG8_MMA(0, 1, At, B1); PG8_BAR;
            PG8_LDA(At, 1, 1); PG8_STAGE(PG8_SA(1, 0), a3, voffA);
            PG8_BAR; PG8_WAIT_L(0); PG8_MMA(1, 0, At, B0); PG8_BAR; PG8_SCHED;
            PG8_STAGE(PG8_SB(1, 1), b3 + hstep, voffB);
            PG8_WAIT_V(6); PG8_BAR; PG8_MMA(1, 1, At, B1); PG8_BAR;
            }
        }
        if constexpr (ALIGN_EPI) { if (wr == 0) PG8_BAR; }
        if constexpr (!Epi::AFTER_DRAIN) { int fr_ = fr, fq_ = fq; asm volatile("" : "+v"(fr_), "+v"(fq_)); E(acc, cur, ui, wr, wc, fr_, fq_); S.done(cur); }
        if (!has_next) break;
#pragma unroll
        for (int a = 0; a < 2; ++a)
#pragma unroll
            for (int b = 0; b < 2; ++b)
#pragma unroll
                for (int m = 0; m < 4; ++m)
#pragma unroll
                    for (int n = 0; n < 2; ++n) acc[a][b][m][n] = (f32x4){0.f, 0.f, 0.f, 0.f};
        cur = nxt; cA = nA; cB = nB; ++ui;
        if constexpr (ALIGN_EPI) { if (wr == 1) PG8_BAR; }
    }
    PG8_WAIT_V(0);
    if constexpr (!ALIGN_EPI) { if (wr == 0) PG8_BAR; }
    PG8_BAR;
    if constexpr (Epi::AFTER_DRAIN) { E.fused(acc, cur, wr, wc, fr, fq, lds, wid, lane); S.done(cur); }
#undef PG8_SA
#undef PG8_SB
#undef PG8_STAGE
#undef PG8_LDA
#undef PG8_LDB
#undef PG8_MMA
#undef PG8_WAIT_V
#undef PG8_WAIT_L
#undef PG8_BAR
#undef PG8_SCHED
}
}
#ifndef EN_ATTEPI
#define EN_ATTEPI 1
#endif
namespace att {
typedef unsigned short bf16;
using bf16x8 = __attribute__((ext_vector_type(8))) short;
using s16x4  = __attribute__((ext_vector_type(4))) short;
using f32x16 = __attribute__((ext_vector_type(16))) float;
using u32x4  = __attribute__((ext_vector_type(4))) unsigned;
constexpr int KVBLK = 64;
constexpr int NBUF = 3;
constexpr size_t SHM_V = KVBLK * 128 * 2, SHM_K = KVBLK * 128 * 2, SHM_ATTN = NBUF * SHM_V + NBUF * SHM_K + 8 * 64 * 4;
#define KSWZ(row, colB) ((row) * 256 + ((colB) ^ (((row) & 7) << 4)))
#define SBAR() __builtin_amdgcn_sched_barrier(0)
#define SWZ(v, M) __builtin_bit_cast(float, __builtin_amdgcn_ds_swizzle(__builtin_bit_cast(int, v), ((M) << 10) | 0x1F))
__device__ __forceinline__ int crow(int r, int hi) { return (r & 3) + 8 * (r >> 2) + 4 * hi; }
__device__ __forceinline__ unsigned cvtpk(float lo, float hi) { unsigned r; asm volatile("v_cvt_pk_bf16_f32 %0, %1, %2" : "=v"(r) : "v"(lo), "v"(hi)); return r; }
__device__ __forceinline__ bf16x8 ld8(const bf16* p) { return *reinterpret_cast<const bf16x8*>(p); }
__device__ __forceinline__ void sm_first(f32x16& p0, f32x16& p1, float negoff) {
  (void)p1; (void)negoff;
#pragma unroll
  for (int r = 0; r < 16; ++r) p0[r] = __builtin_amdgcn_exp2f(p0[r]);
}
__device__ __forceinline__ void sm_finish(f32x16& p0, f32x16& p1, float& l_reg, bf16x8& pa0, bf16x8& pa1, bf16x8& pa2, bf16x8& pa3) {
#pragma unroll
  for (int r = 0; r < 16; ++r) p1[r] = __builtin_amdgcn_exp2f(p1[r]);
  float ps = 0;
#pragma unroll
  for (int r = 0; r < 16; ++r) ps += p0[r];
#pragma unroll
  for (int r = 0; r < 16; ++r) ps += p1[r];
  l_reg += ps;
#define PK4(P, BASE, OUT) do { unsigned a0 = cvtpk(P[BASE + 0], P[BASE + 1]), a1 = cvtpk(P[BASE + 2], P[BASE + 3]);   \
    unsigned b0 = cvtpk(P[BASE + 4], P[BASE + 5]), b1 = cvtpk(P[BASE + 6], P[BASE + 7]);                              \
    auto r0 = __builtin_amdgcn_permlane32_swap(a0, b0, false, false); auto r1 = __builtin_amdgcn_permlane32_swap(a1, b1, false, false); \
    u32x4 w = {r0[0], r1[0], r0[1], r1[1]}; OUT = *reinterpret_cast<bf16x8*>(&w); } while (0)
  PK4(p0, 0, pa0); PK4(p0, 8, pa1); PK4(p1, 0, pa2); PK4(p1, 8, pa3);
#undef PK4
}
__device__ __forceinline__ void qkt(f32x16& p0, f32x16& p1, const bf16* Ks, const bf16x8* qr, int r32, int hi, int mapoff, float negoff) {
  p0 = f32x16{}; p1 = f32x16{}; (void)negoff;
#pragma unroll
  for (int d0 = 0; d0 < 4; ++d0) { const int cb = (mapoff + d0 * 16 + hi * 8) * 2;
    bf16x8 b0 = *reinterpret_cast<const bf16x8*>((const char*)Ks + KSWZ(r32, cb));
    bf16x8 b1 = *reinterpret_cast<const bf16x8*>((const char*)Ks + KSWZ(32 + r32, cb));
    p0 = __builtin_amdgcn_mfma_f32_32x32x16_bf16(b0, qr[d0], p0, 0, 0, 0);
    p1 = __builtin_amdgcn_mfma_f32_32x32x16_bf16(b1, qr[d0], p1, 0, 0, 0); }
}
__device__ __forceinline__ int v_st(int k, int c) { const int kk = (k & ~0xC) | ((k & 4) << 1) | ((k & 8) >> 1); return ((kk >> 3) * 4 + (c >> 5)) * 512 + ((kk & 7) * 32 + (c & 31)) * 2; }
__device__ __forceinline__ int v_rd_base(int lane) { return ((lane & 3) << 3) | (((lane >> 2) & 3) << 6) | (((lane >> 4) & 1) << 5) | (((lane >> 5) & 1) << 8); }
constexpr int v_rd_off(int d0, int ks, int half) { return d0 * 512 + ks * 4096 + half * 2048; }
typedef short v4i16_t __attribute__((ext_vector_type(4)));
template <int OFF> __device__ __forceinline__ s16x4 tr_read(int vb) {
  return __builtin_bit_cast(s16x4, __builtin_amdgcn_ds_read_tr16_b64_v4i16((__attribute__((address_space(3))) v4i16_t*)(uintptr_t)(unsigned)(vb + OFF)));
}
template <int D0> __device__ __forceinline__ void pv_one(f32x16& od, int vb, bf16x8 pa0, bf16x8 pa1, bf16x8 pa2, bf16x8 pa3) {
  const s16x4 l0 = tr_read<v_rd_off(D0, 0, 0)>(vb), h0 = tr_read<v_rd_off(D0, 0, 1)>(vb), l1 = tr_read<v_rd_off(D0, 1, 0)>(vb), h1 = tr_read<v_rd_off(D0, 1, 1)>(vb);
  const s16x4 l2 = tr_read<v_rd_off(D0, 2, 0)>(vb), h2 = tr_read<v_rd_off(D0, 2, 1)>(vb), l3 = tr_read<v_rd_off(D0, 3, 0)>(vb), h3 = tr_read<v_rd_off(D0, 3, 1)>(vb);
#define PK(L, H) (bf16x8){L[0], L[1], L[2], L[3], H[0], H[1], H[2], H[3]}
  od = __builtin_amdgcn_mfma_f32_32x32x16_bf16(pa0, PK(l0, h0), od, 0, 0, 0);
  od = __builtin_amdgcn_mfma_f32_32x32x16_bf16(pa1, PK(l1, h1), od, 0, 0, 0);
  od = __builtin_amdgcn_mfma_f32_32x32x16_bf16(pa2, PK(l2, h2), od, 0, 0, 0);
  od = __builtin_amdgcn_mfma_f32_32x32x16_bf16(pa3, PK(l3, h3), od, 0, 0, 0);
#undef PK
}
__device__ __forceinline__ void pv_d0(f32x16* o, int vb, bf16x8 pa0, bf16x8 pa1, bf16x8 pa2, bf16x8 pa3) {
  pv_one<0>(o[0], vb, pa0, pa1, pa2, pa3); pv_one<1>(o[1], vb, pa0, pa1, pa2, pa3); pv_one<2>(o[2], vb, pa0, pa1, pa2, pa3); pv_one<3>(o[3], vb, pa0, pa1, pa2, pa3);
}
__device__ __forceinline__ void attn_unit(const bf16* __restrict__ Qh, const bf16* __restrict__ Kh, const bf16* __restrict__ Vh, bf16* __restrict__ Oh, long qrow0, long k0a, int nt0, long k0b, int NT,
                                          float lam, float oscale, const float* __restrict__ subg, float negoff, char* lds, int wave_, unsigned lds3) {
  unsigned z_ = 0u; asm volatile("" : "+v"(z_)); int tid_ = wave_ * 64 + (int)__builtin_amdgcn_mbcnt_hi(~0u, __builtin_amdgcn_mbcnt_lo(~0u, z_)); asm volatile("" : "+v"(tid_));
  const int tid = tid_, wid = __builtin_amdgcn_readfirstlane(tid >> 6), lane = tid & 63, r32 = lane & 31, hi = lane >> 5, qsub = wid >> 1, map = wid & 1, mapoff = map * 64;
  bf16* V_lds = (bf16*)lds; bf16* K_lds = (bf16*)(lds + NBUF * SHM_V);
  float* ws = (float*)(lds + NBUF * SHM_V + NBUF * SHM_K) + wid * 64; float* li_l = ws;
  float l_reg = 0; f32x16 o[4] = {}; bf16x8 qr[4];
  const bf16* Qw = Qh + (qrow0 + qsub * 32 + r32) * 512 + mapoff + hi * 8;
#pragma unroll
  for (int d0 = 0; d0 < 4; ++d0) qr[d0] = ld8(Qw + d0 * 16);
  const int vb0 = (int)(uintptr_t)V_lds + v_rd_base(lane);
  int koff[2], voff[2];
#pragma unroll
  for (int i = 0; i < 2; ++i) { const int o = (wid + 8 * i) * 1024 + lane * 16;
    { const int row = o >> 8, cB = (o & 255) ^ ((row & 7) << 4); koff[i] = row * 512 + (cB >> 1); }
    { const int sub = o >> 9, kkhi = sub >> 2, cg = sub & 3, q = (o & 511) >> 1, kklo = q >> 5, cin = q & 31, kk = kkhi * 8 + kklo; voff[i] = kk * 512 + cg * 32 + cin; } }
  typedef __attribute__((address_space(3))) unsigned lds_u32;
  const unsigned ldsK = lds3 + NBUF * (unsigned)SHM_V + (unsigned)wid * 1024u, ldsV = lds3 + (unsigned)wid * 1024u;
#define KROW(j) (((j) < nt0) ? (k0a + (long)(j) * KVBLK) : (k0b + (long)((j) - nt0) * KVBLK))
#define DMAK(b, j) do { const long kr_ = KROW(j) * 512; _Pragma("unroll") for (int i_ = 0; i_ < 2; ++i_) \
    __builtin_amdgcn_global_load_lds((const unsigned*)(Kh + kr_ + koff[i_]), (lds_u32*)(uintptr_t)(ldsK + (b) * (unsigned)SHM_K + i_ * 8192u), 16, 0, 0); } while (0)
#define DMAV(b, j) do { const long kr_ = KROW(j) * 512; _Pragma("unroll") for (int i_ = 0; i_ < 2; ++i_) \
    __builtin_amdgcn_global_load_lds((const unsigned*)(Vh + kr_ + voff[i_]), (lds_u32*)(uintptr_t)(ldsV + (b) * (unsigned)SHM_V + i_ * 8192u), 16, 0, 0); } while (0)
  f32x16 p0, p1; bf16x8 pa0, pa1, pa2 = {}, pa3 = {};
#define KFR(kb, d0, half) (*reinterpret_cast<const bf16x8*>((const char*)K_lds + (kb) * (int)SHM_K + KSWZ((half) * 32 + r32, (mapoff + (d0) * 16 + hi * 8) * 2)))
#define VRD4(S, vbuf, D0, KS) do { const int vb_ = vb0 + (vbuf) * (int)SHM_V; S##a = tr_read<v_rd_off(D0, KS, 0)>(vb_); S##b = tr_read<v_rd_off(D0, KS, 1)>(vb_); S##c = tr_read<v_rd_off(D0, (KS) + 1, 0)>(vb_); S##d = tr_read<v_rd_off(D0, (KS) + 1, 1)>(vb_); } while (0)
#define PKV(L, H) (bf16x8){L[0], L[1], L[2], L[3], H[0], H[1], H[2], H[3]}
#define MM(ACC, A_, B_) ACC = __builtin_amdgcn_mfma_f32_32x32x16_bf16(A_, B_, ACC, 0, 0, 0)
#define FADD(D, S) asm volatile("v_add_f32 %0, %0, %1" : "+v"(D) : "v"(S))
#define SMA(P, c) do { P[2 * (c)] = __builtin_amdgcn_exp2f(P[2 * (c)]); P[2 * (c) + 1] = __builtin_amdgcn_exp2f(P[2 * (c) + 1]); FADD(ls0, P[2 * (c)]); FADD(ls1, P[2 * (c) + 1]); } while (0)
#define SMB_CVT(P, BASE) do { ca0 = cvtpk(P[BASE + 0], P[BASE + 1]); ca1 = cvtpk(P[BASE + 2], P[BASE + 3]); cb0 = cvtpk(P[BASE + 4], P[BASE + 5]); cb1 = cvtpk(P[BASE + 6], P[BASE + 7]); } while (0)
#define SMB_PERM(OUT) do { u32x4 w_ = {ca0, ca1, cb0, cb1}; OUT = *reinterpret_cast<bf16x8*>(&w_); } while (0)
#define STAGE_PV(PA, PB, P, KLD_STMT) do { KLD_STMT; \
    MM(o[0], PA, PKV(vAa, vAb)); SMA(P, 0); SBAR(); MM(o[0], PB, PKV(vAc, vAd)); SMA(P, 1); SBAR(); \
    MM(o[1], PA, PKV(vBa, vBb)); SMA(P, 2); SBAR(); MM(o[1], PB, PKV(vBc, vBd)); SMA(P, 3); SBAR(); \
    MM(o[2], PA, PKV(vCa, vCb)); SMA(P, 4); SBAR(); MM(o[2], PB, PKV(vCc, vCd)); SMA(P, 5); SBAR(); \
    MM(o[3], PA, PKV(vDa, vDb)); SMA(P, 6); SBAR(); MM(o[3], PB, PKV(vDc, vDd)); SMA(P, 7); SBAR(); } while (0)
#define VRD16(vbuf, KS) do { VRD4(vA, vbuf, 0, KS); VRD4(vB, vbuf, 1, KS); VRD4(vC, vbuf, 2, KS); VRD4(vD, vbuf, 3, KS); } while (0)
#define STAGE_QK(PD, P, OUT0, OUT1, vbuf, KS) do { VRD16(vbuf, KS); \
    PD = __builtin_amdgcn_mfma_f32_32x32x16_bf16(kf0, qr[0], f32x16{}, 0, 0, 0); SMB_CVT(P, 0); SBAR(); \
    MM(PD, kf1, qr[1]); SMB_PERM(OUT0); SBAR(); MM(PD, kf2, qr[2]); SMB_CVT(P, 8); SBAR(); MM(PD, kf3, qr[3]); SMB_PERM(OUT1); SBAR(); } while (0)
#define KLD4(kb, half) do { kf0 = KFR(kb, 0, half); kf1 = KFR(kb, 1, half); kf2 = KFR(kb, 2, half); kf3 = KFR(kb, 3, half); } while (0)
  s16x4 vAa, vAb, vAc, vAd, vBa, vBb, vBc, vBd, vCa, vCb, vCc, vCd, vDa, vDb, vDc, vDd; bf16x8 kf0, kf1, kf2, kf3; unsigned ca0, ca1, cb0, cb1; float ls0 = 0.f, ls1 = 0.f;
  DMAK(0, 0); DMAK(1, 1); DMAV(0, 0); asm volatile("s_waitcnt vmcnt(0)" ::: "memory"); __syncthreads();
  KLD4(0, 0); p0 = __builtin_amdgcn_mfma_f32_32x32x16_bf16(kf0, qr[0], f32x16{}, 0, 0, 0); MM(p0, kf1, qr[1]); MM(p0, kf2, qr[2]); MM(p0, kf3, qr[3]);
  VRD16(0, 2);
  int bp = 0, bc = 0, bn = 1, bnn = 2;
#pragma unroll 1
  for (int j = 0; j < NT; ++j) {
    asm volatile("s_waitcnt vmcnt(0)" ::: "memory"); SBAR(); __builtin_amdgcn_s_barrier(); SBAR();
    if (j + 2 < NT) DMAK(bnn, j + 2);
    if (j + 1 < NT) DMAV(bn, j + 1);
    STAGE_PV(pa2, pa3, p0, KLD4(bc, 1));
    STAGE_QK(p1, p0, pa0, pa1, bc, 0);
    const int kbn = (j + 1 < NT) ? bn : bc;
    STAGE_PV(pa0, pa1, p1, KLD4(kbn, 0));
    STAGE_QK(p0, p1, pa2, pa3, bc, 2);
    bp = bc; bc = bn; bn = bnn; bnn = bp;
  }
  MM(o[0], pa2, PKV(vAa, vAb)); MM(o[0], pa3, PKV(vAc, vAd)); MM(o[1], pa2, PKV(vBa, vBb)); MM(o[1], pa3, PKV(vBc, vBd));
  MM(o[2], pa2, PKV(vCa, vCb)); MM(o[2], pa3, PKV(vCc, vCd)); MM(o[3], pa2, PKV(vDa, vDb)); MM(o[3], pa3, PKV(vDc, vDd));
  l_reg = ls0 + ls1;
#undef KLD4
#undef STAGE_QK
#undef VRD16
#undef FADD
#undef STAGE_PV
#undef SMB_PERM
#undef SMB_CVT
#undef SMA
#undef MM
#undef VRD4
#undef PKV
#undef KFR
#undef DMAK
#undef DMAV
#if EN_ATTEPI
  { auto rr = __builtin_amdgcn_permlane32_swap(__float_as_uint(l_reg), __float_as_uint(l_reg), false, false); l_reg = __uint_as_float(rr[0]) + __uint_as_float(rr[1]); }
  if (hi == 0) li_l[r32] = l_reg;
  asm volatile("s_waitcnt lgkmcnt(0)" ::: "memory");
  const float fm = map ? lam : 1.f;
#pragma unroll
  for (int r = 0; r < 16; ++r) { const float rl = __builtin_amdgcn_rcpf(li_l[crow(r, hi)]) * fm;
#pragma unroll
    for (int d0 = 0; d0 < 4; ++d0) o[d0][r] *= rl; }
  __syncthreads();
  float* X = (float*)lds + qsub * 4096 + lane;
  if (map == 1) {
#pragma unroll
    for (int d0 = 0; d0 < 4; ++d0)
#pragma unroll
      for (int r = 0; r < 16; ++r) X[(d0 * 16 + r) * 64] = o[d0][r];
  }
  __syncthreads();
  if (map == 0) {
    float sg[4];
#pragma unroll
    for (int d0 = 0; d0 < 4; ++d0) sg[d0] = subg[d0 * 32 + r32] * oscale;
    bf16* Ow = Oh + (qrow0 + qsub * 32) * 1024 + r32;
#pragma unroll
    for (int r = 0; r < 16; ++r) {
      float ss = 0.f;
#pragma unroll
      for (int d0 = 0; d0 < 4; ++d0) { o[d0][r] -= X[(d0 * 16 + r) * 64]; ss += o[d0][r] * o[d0][r]; }
      ss += SWZ(ss, 1); ss += SWZ(ss, 2); ss += SWZ(ss, 4); ss += SWZ(ss, 8); ss += SWZ(ss, 16);
      const float rn = 1.0f / sqrtf(ss * (1.0f / 128.0f) + 1e-6f);
      const int orow = crow(r, hi);
#pragma unroll
      for (int d0 = 0; d0 < 4; ++d0) { const unsigned w = cvtpk(o[d0][r] * rn * sg[d0], 0.f); Ow[(long)orow * 1024 + d0 * 32] = (bf16)(w & 0xffffu); }
    }
  }
  __syncthreads();
#else
  { float s = l_reg; for (int d0 = 0; d0 < 4; ++d0) for (int r = 0; r < 16; ++r) s += o[d0][r]; Oh[qrow0 * 1024 + tid] = (bf16)(int)s; }
#endif
#undef KROW
}
#undef KSWZ
#undef SBAR
#undef SWZ
}
#ifndef EN_ALL
#define EN_ALL 1
#endif
#ifndef EN_PH0
#define EN_PH0 EN_ALL
#endif
#ifndef EN_PH1
#define EN_PH1 EN_ALL
#endif
#ifndef EN_P1
#define EN_P1 EN_ALL
#endif
#ifndef EN_P2A
#define EN_P2A EN_ALL
#endif
#ifndef EN_P2B
#define EN_P2B EN_ALL
#endif
#ifndef EN_P3
#define EN_P3 EN_ALL
#endif
#ifndef EN_P4
#define EN_P4 EN_ALL
#endif
#ifndef EN_P5
#define EN_P5 EN_ALL
#endif
#ifndef EN_ATT
#define EN_ATT 1
#endif
#ifndef EN_DFT
#define EN_DFT 1
#endif
#ifndef EN_ATTC
#define EN_ATTC 1
#endif
#ifndef SCHED_OLD
#define SCHED_OLD 0
#endif
#ifndef PROBE_A
#define PROBE_A 0
#endif
#ifndef PROBE_S
#define PROBE_S 0
#endif
#if PROBE_S
#define SUBSTAMP(i) do { if (blockIdx.x == 0 && F.wave == 0) ((volatile LAS unsigned*)(F.lds + MISC_OFF))[40 + (i)] = (unsigned)__builtin_amdgcn_s_memrealtime(); } while (0)
#else
#define SUBSTAMP(i) do {} while (0)
#endif
#ifndef PROBE_B
#define PROBE_B 0
#endif
#ifndef WGM_WIDE
#define WGM_WIDE 2
#endif
#ifndef WGM_MID
#define WGM_MID 2
#endif
constexpr int NWAVES = 8;
constexpr int DM = 1024, NBATCH = 8, SEQ = 2048, CTXL = 256, M_LAT = NBATCH * SEQ, M_CTX = NBATCH * CTXL, M_ALL = M_LAT + M_CTX, NIN = 2560, NINSRC = 2048, FFD = 2816, NGU = 5632, NLAYER = 2;
constexpr size_t MiB = 1u << 20;
constexpr size_t WS_CTL = 0, CTL_ZERO_BYTES = 1 * MiB;
constexpr size_t WS_MOD = 64 * 1024;
constexpr size_t WS_BIN = 512 * 1024;
constexpr size_t WS_BGU = 1 * MiB + 768 * 1024;
constexpr size_t WS_ROPE = WS_BGU + 512 * 1024;
constexpr size_t WS_DFT = WS_ROPE + 512 * 1024;
constexpr size_t WS_TF = 4 * MiB;
constexpr size_t WS_SSQ = 5 * MiB;
constexpr size_t WS_WIN = 8 * MiB;
constexpr size_t WS_WOUT = 18 * MiB;
constexpr size_t WS_WGU = 22 * MiB;
constexpr size_t WS_WDN = 44 * MiB;
constexpr size_t WS_A = 56 * MiB;
constexpr size_t WS_XC = 92 * MiB;
constexpr size_t WS_QB = 100 * MiB, WS_KB = 118 * MiB, WS_VB = 136 * MiB;
constexpr size_t WS_T = 154 * MiB;
constexpr size_t WS_TC = 186 * MiB;
constexpr size_t WS_MIX = 190 * MiB;
constexpr size_t WS_H = 100 * MiB;
constexpr size_t WS_HC = 226 * MiB;
constexpr size_t WS_END = 238 * MiB;
constexpr size_t WS_XB2 = 222 * MiB;
static_assert(WS_DFT + 256 * 512 * 2 <= WS_TF && WS_SSQ + (size_t)M_ALL * 64 <= WS_WIN && WS_H + (size_t)M_ALL * FFD * 2 <= WS_END && WS_MIX + (size_t)M_ALL * DM * 2 <= WS_END, "d_ws map");
constexpr int CW_TMO = 0, CW_BAR = 4096, CW_CTXCNT = 8192, CW_BFCNT = 8192 + 512, CW_C3CNT = 8192 + 1024;
constexpr int RING_BYTES = 131072, RTAB_OFF = RING_BYTES, RTAB_BYTES = 8192, LDSCTL_OFF = RTAB_OFF + RTAB_BYTES, MISC_OFF = LDSCTL_OFF + 320, BTAB_OFF = 140288, ETAB_OFF = 147456, LDS_BYTES = ETAB_OFF + 12288 + 512;
static_assert(MISC_OFF + 512 <= BTAB_OFF && BTAB_OFF + 7 * 1024 == ETAB_OFF && BTAB_OFF == RTAB_OFF + 4 * pg8::BT_F && ETAB_OFF == RTAB_OFF + 4 * pg8::ET_F && LDS_BYTES <= 160 * 1024, "LDS map");
constexpr int N_PHASES = 2 + 6 * NLAYER;

#define GAS __attribute__((address_space(1)))
#define LAS __attribute__((address_space(3)))
typedef unsigned short bf16;
typedef unsigned v4u __attribute__((ext_vector_type(4)));
typedef unsigned v2u __attribute__((ext_vector_type(2)));
typedef float f32x4 __attribute__((ext_vector_type(4)));
#define LDS_WAIT() asm volatile("s_waitcnt lgkmcnt(0)" ::: "memory")
#define VM_WAIT() asm volatile("s_waitcnt vmcnt(0)" ::: "memory")
__device__ __forceinline__ unsigned f2bf(float f) { unsigned u = __builtin_bit_cast(unsigned, f); return (u + 0x7fffu + ((u >> 16) & 1u)) >> 16; }
__device__ __forceinline__ unsigned pk2(float lo, float hi) { return f2bf(lo) | (f2bf(hi) << 16); }
__device__ __forceinline__ float bf2f(unsigned short h) { return __builtin_bit_cast(float, (unsigned)h << 16); }
__device__ __forceinline__ int lane_id() { unsigned z = 0u; asm volatile("" : "+v"(z)); return (int)__builtin_amdgcn_mbcnt_hi(~0u, __builtin_amdgcn_mbcnt_lo(~0u, z)); }
template <int M> __device__ __forceinline__ float xshfl(float v) {
    if constexpr (M < 32) return __builtin_bit_cast(float, __builtin_amdgcn_ds_swizzle(__builtin_bit_cast(int, v), (M << 10) | 0x1F));
    else { const unsigned u = __builtin_bit_cast(unsigned, v); auto r = __builtin_amdgcn_permlane32_swap(u, u, false, false); const unsigned r0 = r[0], r1 = r[1];
           unsigned z = 0u; asm volatile("" : "+v"(z)); const bool upper = __builtin_amdgcn_mbcnt_hi(~0u, __builtin_amdgcn_mbcnt_lo(~0u, z)) >= 32u;
           return __builtin_bit_cast(float, upper ? r0 : r1); }
}
__device__ __forceinline__ float wave_sum(float v) {
    v += xshfl<1>(v); v += xshfl<2>(v); v += xshfl<4>(v); v += xshfl<8>(v); v += xshfl<16>(v);
    { const unsigned u = __builtin_bit_cast(unsigned, v); auto r = __builtin_amdgcn_permlane32_swap(u, u, false, false); const unsigned r0 = r[0], r1 = r[1]; v = __builtin_bit_cast(float, r0) + __builtin_bit_cast(float, r1); }
    return v;
}

#define XB_TMO      128
#define XB_XCNT(j)  (256  + 64 * (j))
#define XB_XSUB(j)  (1280 + 64 * (j))
#define XB_XGEN(j)  (2304 + 64 * (j))
#define XB_TOP      3328
#define XB_TOPGEN   3392
#define XCD_BAR_WORDS 3456
#define XB_SPIN_CAP (1u << 18)

__device__ __forceinline__ unsigned xb_ld(unsigned* p)              { return __hip_atomic_load(p, __ATOMIC_RELAXED, __HIP_MEMORY_SCOPE_AGENT); }
__device__ __forceinline__ unsigned xb_add(unsigned* p, unsigned v) { return __hip_atomic_fetch_add(p, v, __ATOMIC_RELAXED, __HIP_MEMORY_SCOPE_AGENT); }
__device__ __forceinline__ unsigned xb_xcc_id() { return (unsigned)__builtin_amdgcn_s_getreg((3 << 11) | 20) & 0xFu; }
#define XB_SPIN(cond, bar) do { unsigned _sp = 0; while (cond) { __builtin_amdgcn_s_sleep(1); \
    if ((++_sp & 255u) == 0u) { if (xb_ld(&(bar)[XB_TMO])) break; if (_sp > XB_SPIN_CAP) { atomicAdd(&(bar)[XB_TMO], 1u); break; } } } } while (0)

struct XcdBarrier {
    unsigned* bar; unsigned x;
    volatile LAS unsigned* st;
    bool t0;
};

__device__ __forceinline__ XcdBarrier xcd_barrier_post(unsigned* bar, volatile LAS unsigned* st) {
    XcdBarrier b; b.bar = bar; b.x = xb_xcc_id(); b.st = st;
    if (threadIdx.x == 0) (void)xb_add(&bar[XB_XCNT(b.x)], 1u);
    return b;
}
__device__ __forceinline__ void xcd_barrier_complete(unsigned* bar, unsigned x, unsigned& nloc, unsigned& nx) {
    const unsigned G = gridDim.x * gridDim.y * gridDim.z;
    unsigned sum, cnt, mine, sp = 0u;
    for (;;) {
        sum = 0u; cnt = 0u; mine = 0u;
#pragma unroll
        for (unsigned j = 0; j < 16; ++j) { const unsigned c = xb_ld(&bar[XB_XCNT(j)]); sum += c; cnt += (c > 0u) ? 1u : 0u; mine = (j == x) ? c : mine; }
        if (sum == G) break;
        __builtin_amdgcn_s_sleep(1);
        if ((++sp & 255u) == 0u) { if (xb_ld(&bar[XB_TMO])) break; if (sp > XB_SPIN_CAP) { atomicAdd(&bar[XB_TMO], 1u); break; } }
    }
    nloc = mine > 0u ? mine : 1u; nx = cnt > 0u ? cnt : 1u;
}

__device__ __forceinline__ void xcd_barrier(const XcdBarrier& b) {
    asm volatile("s_waitcnt vmcnt(0)" ::: "memory");
    __syncthreads();
    if (b.t0) {
        unsigned* bar = b.bar;
        __builtin_amdgcn_s_waitcnt(0);
        unsigned nloc = b.st[0], nx = b.st[1];
        if (nloc == 0u) { xcd_barrier_complete(bar, b.x, nloc, nx); b.st[0] = nloc; b.st[1] = nx; }
        const unsigned old = xb_add(&bar[XB_XSUB(b.x)], 1u);
        const unsigned gen = old / nloc;
        if (old + 1u == (gen + 1u) * nloc) {
            __builtin_amdgcn_fence(__ATOMIC_RELEASE, "agent");
            asm volatile("s_waitcnt vmcnt(0)" ::: "memory");
            const unsigned og = xb_add(&bar[XB_TOP], 1u);
            const unsigned tg = og / nx;
            if (og + 1u == (tg + 1u) * nx) xb_add(&bar[XB_TOPGEN], 1u);
            else XB_SPIN(xb_ld(&bar[XB_TOPGEN]) == tg, bar);
            __builtin_amdgcn_fence(__ATOMIC_ACQUIRE, "agent");
            xb_add(&bar[XB_XGEN(b.x)], 1u);
            asm volatile("s_waitcnt vmcnt(0)" ::: "memory");
        } else {
            XB_SPIN(xb_ld(&bar[XB_XGEN(b.x)]) == gen, bar);
            __builtin_amdgcn_fence(__ATOMIC_ACQUIRE, "agent");
            asm volatile("s_waitcnt vmcnt(0)" ::: "memory");
        }
    }
    __syncthreads();
}


struct Args { const float* in[21]; float* out; unsigned char* ws; int ph_lo, ph_hi; };
struct Frame {
    LAS unsigned char* lds; int wave, vcu, G;
};

struct TrItem { const float* W; bf16* WT; int ldn, ldk, k0, n0, drow0; };
__device__ __forceinline__ void transpose_load(const TrItem& t, f32x4 (&v)[8], int lane) {
    const int r = lane >> 3, c4 = (lane & 7) * 4;
#pragma unroll
    for (int j = 0; j < 8; ++j) v[j] = *(const f32x4*)(t.W + (size_t)(t.k0 + 8 * j + r) * t.ldn + t.n0 + c4);
}
__device__ __forceinline__ void transpose_finish(const TrItem& t, const f32x4 (&v)[8], LAS float* scr, int lane) {
    const int r = lane >> 3, c4 = (lane & 7) * 4;
#pragma unroll
    for (int j = 0; j < 8; ++j) { LAS float* d = scr + (8 * j + r) * 33 + c4; d[0] = v[j][0]; d[1] = v[j][1]; d[2] = v[j][2]; d[3] = v[j][3]; }
    LDS_WAIT(); asm volatile("" ::: "memory");
    const int c = lane & 7;
#pragma unroll
    for (int j = 0; j < 4; ++j) { const int n = (lane >> 3) + 8 * j; const LAS float* s = scr + (8 * c) * 33 + n;
        v4u o; o.x = pk2(s[0 * 33], s[1 * 33]); o.y = pk2(s[2 * 33], s[3 * 33]); o.z = pk2(s[4 * 33], s[5 * 33]); o.w = pk2(s[6 * 33], s[7 * 33]);
        *(GAS v4u*)(t.WT + (size_t)(t.drow0 + n) * t.ldk + t.k0 + 8 * c) = o; }
    LDS_WAIT(); asm volatile("" ::: "memory");
}
__device__ __forceinline__ void ph0(Frame& F, const Args& A, unsigned char* ws) {
    int tid_ = F.wave * 64 + lane_id(); asm volatile("" : "+v"(tid_));
    LAS float* scr = (LAS float*)(F.lds + F.wave * 16384);
    const int gw = F.vcu * NWAVES + F.wave, NGW = F.G * NWAVES;
    SUBSTAMP(0);
    constexpr int I_IN = 16 * 48, I_OUT = 16 * 32, I_G = 16 * 88, I_D = 44 * 32, I_LAYER = I_IN + I_OUT + 2 * I_G + I_D;
    auto decode = [&](int it, TrItem& t) __attribute__((always_inline)) {
        const int l = it / I_LAYER; int r = it % I_LAYER;
        if (r < I_IN) { const int kb = r / 48, nb = r % 48, n0 = nb * 32, pn = n0 >> 8, cc = n0 & 255; const int drow = pn < 4 ? pn * 256 + ((cc >> 5) & 1) * 128 + (cc >> 6) * 32 : n0;
            t = TrItem{A.in[8] + (size_t)l * DM * NINSRC, (bf16*)(ws + WS_WIN) + (size_t)l * NIN * DM, NINSRC, DM, kb * 64, n0, drow}; return; } r -= I_IN;
        if (r < I_OUT) { const int kb = r / 32, nb = r % 32; t = TrItem{A.in[17] + (size_t)l * DM * DM, (bf16*)(ws + WS_WOUT) + (size_t)l * DM * DM, DM, DM, kb * 64, nb * 32, nb * 32}; return; } r -= I_OUT;
        if (r < 2 * I_G) { const int up = r >= I_G; if (up) r -= I_G; const int kb = r / 88, nb = r % 88, n0 = nb * 32; const int drow = (n0 >> 7) * 256 + up * 128 + (n0 & 127);
            t = TrItem{(up ? A.in[19] : A.in[18]) + (size_t)l * DM * FFD, (bf16*)(ws + WS_WGU) + (size_t)l * NGU * DM, FFD, DM, kb * 64, n0, drow}; return; } r -= 2 * I_G;
        { const int kb = r / 32, nb = r % 32; t = TrItem{A.in[20] + (size_t)l * FFD * DM, (bf16*)(ws + WS_WDN) + (size_t)l * DM * FFD, DM, FFD, kb * 64, nb * 32, nb * 32}; } };
    { const int lane = tid_ & 63; const int NITEM = NLAYER * I_LAYER; TrItem ta, tb; f32x4 va[8], vb[8];
      int it = gw;
      if (it < NITEM) { decode(it, ta); transpose_load(ta, va, lane); }
      while (it < NITEM) {
          const int it2 = it + NGW, it3 = it2 + NGW;
          if (it2 < NITEM) { decode(it2, tb); transpose_load(tb, vb, lane); }
          transpose_finish(ta, va, scr, lane);
          if (it2 >= NITEM) break;
          if (it3 < NITEM) { decode(it3, ta); transpose_load(ta, va, lane); }
          transpose_finish(tb, vb, scr, lane);
          it = it3;
      } }
    __syncthreads();
    SUBSTAMP(1);
    LAS float* sl = (LAS float*)F.lds;
    LAS float* red = (LAS float*)(F.lds + 40960);
    { f32x4 v[5];
#pragma unroll
      for (int q = 0; q < 5; ++q) { const int i4 = tid_ + q * (NWAVES * 64); const int j = i4 >> 8, k4 = (i4 & 255) * 4; v[q] = (i4 < 9 * 256) ? *(const f32x4*)((j < 8) ? A.in[1] + j * DM + k4 : A.in[3] + k4) : (f32x4){0.f, 0.f, 0.f, 0.f}; }
#pragma unroll
      for (int q = 0; q < 5; ++q) { const int i4 = tid_ + q * (NWAVES * 64); if (i4 < 9 * 256) { f32x4 s; for (int e = 0; e < 4; ++e) s[e] = v[q][e] / (1.f + __expf(-v[q][e])); *(LAS f32x4*)(sl + i4 * 4) = s; } } }
    __syncthreads();
    { const int lane = tid_ & 63; const int NIT = NLAYER * 24 * 16;
      f32x4 wa[8], wb[8], wc[8];
#define MOD_LOAD(W, it_) do { const int kb_ = (it_) & 15, cb_ = ((it_) >> 4) % 24, l_ = (it_) / (24 * 16); const float* W_ = A.in[4] + (size_t)l_ * DM * 6144 + (size_t)(kb_ * 64 + F.wave * 8) * 6144 + cb_ * 256 + lane * 4; \
        _Pragma("unroll") for (int r = 0; r < 8; ++r) W[r] = *(const f32x4*)(W_ + (size_t)r * 6144); } while (0)
#define MOD_ITEM(W, it_) do { const int kb = (it_) & 15, cb = ((it_) >> 4) % 24, l = (it_) / (24 * 16); \
        f32x4 acc[9]; \
        _Pragma("unroll") for (int j = 0; j < 9; ++j) acc[j] = (f32x4){0.f, 0.f, 0.f, 0.f}; \
        _Pragma("unroll") for (int r4 = 0; r4 < 8; r4 += 4) \
            _Pragma("unroll") for (int j = 0; j < 9; ++j) { const f32x4 s = *(const LAS f32x4*)(sl + j * DM + kb * 64 + F.wave * 8 + r4); acc[j] += W[r4] * s[0] + W[r4 + 1] * s[1] + W[r4 + 2] * s[2] + W[r4 + 3] * s[3]; } \
        _Pragma("unroll") for (int j = 0; j < 9; ++j) *(LAS f32x4*)(red + (F.wave * 9 + j) * 256 + lane * 4) = acc[j]; \
        __syncthreads(); \
        for (int i = tid_; i < 9 * 256; i += NWAVES * 64) { const int j = i >> 8, cn = i & 255; float s = 0.f; \
            _Pragma("unroll") for (int w8 = 0; w8 < 8; ++w8) s += red[(w8 * 9 + j) * 256 + cn]; \
            const int nn = cb * 256 + cn; if (kb == 0) s += A.in[5][l * 6144 + nn]; \
            atomicAdd((float*)(ws + WS_MOD) + (l * 9 + j) * 6144 + nn, s); } \
        __syncthreads(); } while (0)
      for (int it0 = F.vcu; it0 < NIT; it0 += 3 * F.G) {
        const int it1 = it0 + F.G, it2 = it0 + 2 * F.G;
        MOD_LOAD(wa, it0); if (it1 < NIT) MOD_LOAD(wb, it1); if (it2 < NIT) MOD_LOAD(wc, it2);
        MOD_ITEM(wa, it0); if (it1 < NIT) MOD_ITEM(wb, it1); if (it2 < NIT) MOD_ITEM(wc, it2);
      }
#undef MOD_ITEM
#undef MOD_LOAD
    }
    SUBSTAMP(2);
    const int gt = F.vcu * (NWAVES * 64) + tid_, NGT = F.G * NWAVES * 64;
    for (int i = gt; i < 96 * 16; i += NGT) { const int p = i >> 4, j = i & 15; const float inv = powf(10000.0f, -(float)j * (1.0f / 16.0f)); const float ang = (float)(p < 32 ? p : p - 32) * inv;
        float sn, cs; sincosf(ang, &sn, &cs); ((float*)(ws + WS_ROPE))[i] = cs; ((float*)(ws + WS_ROPE))[1536 + i] = sn; }
    for (int i = gt; i < 256 * 512; i += NGT) { const int m = i >> 9, kk = i & 511, n = kk >> 1; const int p = (m * n) & 255; float sn, cs; sincospif((float)p * (1.0f / 128.0f), &sn, &cs);
        ((bf16*)(ws + WS_DFT))[i] = (bf16)f2bf((kk & 1) ? sn : cs); }
    SUBSTAMP(3);
    __syncthreads();
    if (F.vcu < NLAYER * 4 * 32) {
        const int lg = F.vcu >> 5, c0 = (F.vcu & 31) * 4;
        LAS float* wl = (LAS float*)F.lds; LAS float* ct = (LAS float*)(F.lds + 65536); LAS float* st = ct + 128;
        { f32x4 wv[8];
#pragma unroll
          for (int q = 0; q < 8; ++q) wv[q] = *(const f32x4*)(A.in[16] + (size_t)lg * 128 * 128 + (tid_ + q * (NWAVES * 64)) * 4);
#pragma unroll
          for (int q = 0; q < 8; ++q) *(LAS f32x4*)(wl + (tid_ + q * (NWAVES * 64)) * 4) = wv[q]; }
        if (tid_ < 128) { float sn, cs; sincospif((float)tid_ * (1.0f / 64.0f), &sn, &cs); ct[tid_] = cs; st[tid_] = sn; }
        __syncthreads();
        for (int o = tid_; o < 4 * 256; o += NWAVES * 64) { const int d = o & 127, ri = (o >> 7) & 1, cch = c0 + (o >> 8); float s = 0.f;
#pragma unroll 8
            for (int c2 = 0; c2 < 128; ++c2) { const int p = (cch * c2) & 127; s += (ri ? -st[p] : ct[p]) * wl[c2 * 128 + d]; }
            ((float*)(ws + WS_TF))[(size_t)lg * 32768 + cch * 256 + ri * 128 + d] = s; }
    }
    SUBSTAMP(4);
}
__device__ __forceinline__ void ph1(Frame& F, const Args& A, unsigned char* ws) {
    int tid_ = F.wave * 64 + lane_id(); asm volatile("" : "+v"(tid_));
    const float* mod = (const float*)(ws + WS_MOD);
    SUBSTAMP(5);
    { const int gw = F.vcu * NWAVES + F.wave, NGW = F.G * NWAVES; const int lane = tid_ & 63;
      const int RPW = (M_ALL + NGW - 1) / NGW, r0 = gw * RPW, r1 = (r0 + RPW < M_ALL) ? r0 + RPW : M_ALL;
      f32x4 gv[4]; int gbm = -1;
      auto loadrow = [&](int row, f32x4 (&v)[4]) __attribute__((always_inline)) { const float* xr = row < M_LAT ? A.in[0] + (size_t)row * DM : A.in[2] + (size_t)(row - M_LAT) * DM;
#pragma unroll
          for (int j = 0; j < 4; ++j) v[j] = *(const f32x4*)(xr + 256 * j + 4 * lane); };
      auto finish = [&](int row, const f32x4 (&v)[4]) __attribute__((always_inline)) {
          float s = 0.f;
#pragma unroll
          for (int j = 0; j < 4; ++j) s += (v[j][0] * v[j][0] + v[j][1] * v[j][1]) + (v[j][2] * v[j][2] + v[j][3] * v[j][3]);
          s = wave_sum(s);
          const int bm = row < M_LAT ? (row >> 11) : 8;
          if (bm != gbm) { const float* sc = mod + bm * 6144 + 1024; gbm = bm;
#pragma unroll
              for (int j = 0; j < 4; ++j) { const int k = 256 * j + 4 * lane; gv[j] = *(const f32x4*)(A.in[6] + k) * (*(const f32x4*)(sc + k) + 1.0f); } }
          bf16* ar = (bf16*)(ws + WS_A) + (size_t)row * DM;
          _Float16* hr = row < M_LAT ? (_Float16*)A.out + (size_t)row * DM : (_Float16*)(ws + WS_XC) + (size_t)(row - M_LAT) * DM;
#pragma unroll
          for (int j = 0; j < 4; ++j) { v2u h; h.x = pg8::pkh2(v[j][0], v[j][1]); h.y = pg8::pkh2(v[j][2], v[j][3]); *(v2u*)(hr + 256 * j + 4 * lane) = h; }
#pragma unroll
          for (int j = 0; j < 4; ++j) { const f32x4 a = v[j] * gv[j]; v2u w; w.x = pk2(a[0], a[1]); w.y = pk2(a[2], a[3]); *(v2u*)(ar + 256 * j + 4 * lane) = w; }
          if (lane < 16) ((float*)(ws + WS_SSQ))[(size_t)row * 16 + lane] = lane == 0 ? s : 0.f; };
      f32x4 va[4], vb[4], vc[4];
      int row = r0;
      if (row < r1) loadrow(row, va); if (row + 1 < r1) loadrow(row + 1, vb);
      for (; row < r1; row += 3) {
          if (row + 2 < r1) loadrow(row + 2, vc);
          finish(row, va);
          if (row + 1 >= r1) break;
          if (row + 3 < r1) loadrow(row + 3, va);
          finish(row + 1, vb);
          if (row + 2 >= r1) break;
          if (row + 4 < r1) loadrow(row + 4, vb);
          finish(row + 2, vc);
      } }
    __syncthreads();
    SUBSTAMP(6);
    { LAS float* wl = (LAS float*)F.lds;
      LAS float* tl = (LAS float*)(F.lds + 128 * 132 * 4);
      LAS float* shl = (LAS float*)(F.lds + 128 * 132 * 4 + 128 * 64 * 4);
      LAS float* redl = shl + 9 * 128;
      for (int it = F.vcu; it < NLAYER * 4 * 4 * 8; it += F.G) {
          const int kb = it & 7, q = (it >> 3) & 3, g = (it >> 5) & 3, l = it >> 7;
          const float* wsrc = A.in[8] + (size_t)l * DM * NINSRC + (size_t)(kb * 128) * NINSRC + 1536 + g * 128;
          f32x4 wv[8], tv[4];
#pragma unroll
          for (int q = 0; q < 8; ++q) { const int i = tid_ + q * (NWAVES * 64); wv[q] = *(const f32x4*)(wsrc + (size_t)(i >> 5) * NINSRC + (i & 31) * 4); }
          const float* tsrc = (const float*)(ws + WS_TF) + (size_t)(l * 4 + g) * 128 * 256 + q * 64;
#pragma unroll
          for (int q = 0; q < 4; ++q) { const int i = tid_ + q * (NWAVES * 64); tv[q] = *(const f32x4*)(tsrc + (size_t)(i >> 4) * 256 + (i & 15) * 4); }
#pragma unroll
          for (int q = 0; q < 8; ++q) { const int i = tid_ + q * (NWAVES * 64); *(LAS f32x4*)(wl + (i >> 5) * 132 + (i & 31) * 4) = wv[q]; }
#pragma unroll
          for (int q = 0; q < 4; ++q) { const int i = tid_ + q * (NWAVES * 64); *(LAS f32x4*)(tl + (i >> 4) * 64 + (i & 15) * 4) = tv[q]; }
          if (tid_ < 9 * 32) *(LAS f32x4*)(shl + tid_ * 4) = *(const f32x4*)(mod + (l * 9 + (tid_ >> 5)) * 6144 + kb * 128 + (tid_ & 31) * 4);
          __syncthreads();
          const int lane_ = tid_ & 63, l32 = lane_ & 31, hi = lane_ >> 5, wk = F.wave >> 1, wc = F.wave & 1, dcol = wc * 32 + l32;
          typedef float f32x16_t __attribute__((ext_vector_type(16)));
          f32x16_t acc = {};
          { const LAS float* ap = wl + (wk * 32 + l32) * 132 + hi; const LAS float* bp = tl + hi * 64 + dcol;
#pragma unroll 8
            for (int s2 = 0; s2 < 64; ++s2) acc = __builtin_amdgcn_mfma_f32_32x32x2f32(ap[2 * s2], bp[2 * s2 * 64], acc, 0, 0, 0); }
          bf16* dst = (bf16*)(ws + WS_WIN) + (size_t)l * NIN * DM + (size_t)(1536 + g * 256 + q * 64 + dcol) * DM + kb * 128 + wk * 32 + hi * 4;
#pragma unroll
          for (int gq = 0; gq < 4; ++gq) { v2u o; o.x = pk2(acc[4 * gq], acc[4 * gq + 1]); o.y = pk2(acc[4 * gq + 2], acc[4 * gq + 3]); *(v2u*)(dst + 8 * gq) = o; }
#pragma unroll
          for (int j = 0; j < 9; ++j) { float s = 0.f;
#pragma unroll
              for (int gq = 0; gq < 4; ++gq) { const f32x4 sv = *(const LAS f32x4*)(shl + j * 128 + wk * 32 + gq * 8 + hi * 4); s += sv[0] * acc[4 * gq] + sv[1] * acc[4 * gq + 1] + sv[2] * acc[4 * gq + 2] + sv[3] * acc[4 * gq + 3]; }
              redl[((wk * 2 + hi) * 9 + j) * 64 + dcol] = s; }
          __syncthreads();
          for (int i = tid_; i < 9 * 64; i += NWAVES * 64) { const int j = i >> 6, dc = i & 63; float s = 0.f;
#pragma unroll
              for (int w = 0; w < 8; ++w) s += redl[(w * 9 + j) * 64 + dc];
              atomicAdd((float*)(ws + WS_BIN) + (l * 9 + j) * NIN + 1536 + g * 256 + q * 64 + dc, s); }
          __syncthreads();
      } }
    SUBSTAMP(7);
    { LAS unsigned short* sh16 = (LAS unsigned short*)F.lds;
      for (int i = tid_; i < 4 * 16 * 256; i += NWAVES * 64) { const int set = i >> 12, row = (i >> 8) & 15, k4 = (i & 255) * 4; v2u o = {0u, 0u};
          if (row < 9) { const f32x4 v = *(const f32x4*)(mod + ((set >> 1) * 9 + row) * 6144 + ((set & 1) ? 3072 : 0) + k4); o.x = pk2(v[0], v[1]); o.y = pk2(v[2], v[3]); }
          *(LAS v2u*)(sh16 + (size_t)i * 4) = o; }
      __syncthreads();
      typedef short bf8 __attribute__((ext_vector_type(8)));
      const int lane = tid_ & 63, fr = lane & 15, fq = lane >> 4;
      const int gw = F.vcu * NWAVES + F.wave, NGW = F.G * NWAVES;
      for (int t = gw; t < 896; t += NGW) {
          int set, n0; if (t < 96) { set = 0; n0 = t * 16; } else if (t < 448) { set = 1; n0 = (t - 96) * 16; } else if (t < 544) { set = 2; n0 = (t - 448) * 16; } else { set = 3; n0 = (t - 544) * 16; }
          const int l = set >> 1, gu = set & 1;
          const bf16* WT = gu ? (const bf16*)(ws + WS_WGU) + (size_t)l * NGU * DM : (const bf16*)(ws + WS_WIN) + (size_t)l * NIN * DM;
          const bf16* wrow = WT + (size_t)(n0 + fr) * DM + fq * 8; const LAS unsigned short* arow = sh16 + (size_t)set * 16 * 1024 + fr * 1024 + fq * 8;
          pg8::f32x4 acc = {0.f, 0.f, 0.f, 0.f};
#pragma unroll
          for (int s8 = 0; s8 < 32; s8 += 8) { bf8 b[8];
#pragma unroll
              for (int q = 0; q < 8; ++q) b[q] = *(const bf8*)(wrow + (s8 + q) * 32);
#pragma unroll
              for (int q = 0; q < 8; ++q) { const bf8 a = *(const LAS bf8*)(arow + (s8 + q) * 32); acc = __builtin_amdgcn_mfma_f32_16x16x32_bf16(a, b[q], acc, 0, 0, 0); } }
          float* bo = gu ? (float*)(ws + WS_BGU) + l * 9 * NGU : (float*)(ws + WS_BIN) + l * 9 * NIN; const int ldb = gu ? NGU : NIN;
#pragma unroll
          for (int r = 0; r < 4; ++r) { const int j = fq * 4 + r; if (j < 9) bo[j * ldb + n0 + fr] = acc[r]; }
      }
    }
    SUBSTAMP(8);
}
__device__ __forceinline__ void fft8(float (&xr)[8], float (&xi)[8]) {
    const float S = 0.70710678118654752f;
    const float u0r = xr[0] + xr[4], u0i = xi[0] + xi[4], d0r = xr[0] - xr[4], d0i = xi[0] - xi[4];
    const float u1r = xr[1] + xr[5], u1i = xi[1] + xi[5], d1r = xr[1] - xr[5], d1i = xi[1] - xi[5];
    const float u2r = xr[2] + xr[6], u2i = xi[2] + xi[6], d2r = xr[2] - xr[6], d2i = xi[2] - xi[6];
    const float u3r = xr[3] + xr[7], u3i = xi[3] + xi[7], d3r = xr[3] - xr[7], d3i = xi[3] - xi[7];
    const float v0r = d0r, v0i = d0i;
    const float v1r = (d1r + d1i) * S, v1i = (d1i - d1r) * S;
    const float v2r = d2i, v2i = -d2r;
    const float v3r = (d3i - d3r) * S, v3i = -(d3r + d3i) * S;
    { const float p0r = u0r + u2r, p0i = u0i + u2i, p1r = u1r + u3r, p1i = u1i + u3i, p2r = u0r - u2r, p2i = u0i - u2i, qr = u1r - u3r, qi = u1i - u3i; const float p3r = qi, p3i = -qr;
      xr[0] = p0r + p1r; xi[0] = p0i + p1i; xr[4] = p0r - p1r; xi[4] = p0i - p1i; xr[2] = p2r + p3r; xi[2] = p2i + p3i; xr[6] = p2r - p3r; xi[6] = p2i - p3i; }
    { const float p0r = v0r + v2r, p0i = v0i + v2i, p1r = v1r + v3r, p1i = v1i + v3i, p2r = v0r - v2r, p2i = v0i - v2i, qr = v1r - v3r, qi = v1i - v3i; const float p3r = qi, p3i = -qr;
      xr[1] = p0r + p1r; xi[1] = p0i + p1i; xr[5] = p0r - p1r; xi[5] = p0i - p1i; xr[3] = p2r + p3r; xi[3] = p2i + p3i; xr[7] = p2r - p3r; xi[7] = p2i - p3i; }
}
__device__ __forceinline__ void butterfly_phase(Frame& F, unsigned char* ws) {
    bf16* T = (bf16*)(ws + WS_T);
    int tid_ = F.wave * 64 + lane_id(); asm volatile("" : "+v"(tid_));
    const int gt = F.vcu * (NWAVES * 64) + tid_, NGT = F.G * NWAVES * 64;
    for (int it = gt; it < NBATCH * 512 * 128; it += NGT) {
        const int n0 = (it & 127) * 2, bc = it >> 7, b = bc >> 9, ch = bc & 511; bf16* tp = T + ((size_t)(b * 8) * 512 + ch) * 512 + n0 * 2;
        v2u q[8];
#pragma unroll
        for (int j = 0; j < 8; ++j) q[j] = *(const v2u*)(tp + (size_t)j * 512 * 512);
        float ar[8], ai[8], br[8], bi[8];
#define BF_UNP(k) ar[k] = __builtin_bit_cast(float, q[k].x << 16); ai[k] = __builtin_bit_cast(float, q[k].x & 0xffff0000u); br[k] = __builtin_bit_cast(float, q[k].y << 16); bi[k] = __builtin_bit_cast(float, q[k].y & 0xffff0000u);
        BF_UNP(0) BF_UNP(1) BF_UNP(2) BF_UNP(3) BF_UNP(4) BF_UNP(5) BF_UNP(6) BF_UNP(7)
#undef BF_UNP
        fft8(ar, ai); fft8(br, bi);
        const float th0 = (float)n0 * (1.0f / 1024.0f), th1 = (float)(n0 + 1) * (1.0f / 1024.0f);
#define BF_OUT(r) { float s0, c0, s1, c1; sincospif(th0 * (float)(r), &s0, &c0); sincospif(th1 * (float)(r), &s1, &c1); v2u o_; \
          o_.x = pk2(ar[r] * c0 + ai[r] * s0, ai[r] * c0 - ar[r] * s0); o_.y = pk2(br[r] * c1 + bi[r] * s1, bi[r] * c1 - br[r] * s1); *(v2u*)(tp + (size_t)(r) * 512 * 512) = o_; }
        BF_OUT(0) BF_OUT(1) BF_OUT(2) BF_OUT(3) BF_OUT(4) BF_OUT(5) BF_OUT(6) BF_OUT(7)
#undef BF_OUT
    }
}
template <class S> __device__ __forceinline__ void compute_rtab(Frame& F, unsigned char* ws, const S& sched, const float* bias, int NC) {
    LAS float* rt = (LAS float*)(F.lds + RTAB_OFF); LAS float* bt = (LAS float*)(F.lds + BTAB_OFF); pg8::Unit u;
    int tid_ = F.wave * 64 + lane_id(); asm volatile("" : "+v"(tid_));
    const int t = tid_ & 255, par = tid_ >> 8;
    for (int i = 0; i < 7 && sched.next(i, u); ++i) if ((i & 1) == par) { const float* p = (const float*)(ws + WS_SSQ) + ((size_t)u.pm * 256 + t) * 16; float s = 0.f;
        const float bvv = bias[(u.pm < 64 ? (u.pm >> 3) : 8) * NC + u.pn * 256 + t];
#pragma unroll
        for (int q = 0; q < 4; ++q) { const f32x4 a = *(const f32x4*)(p + 4 * q); s += (a[0] + a[1]) + (a[2] + a[3]); }
        rt[i * 256 + t] = __builtin_amdgcn_rsqf(s * (1.0f / 1024.0f) + 1e-6f); bt[i * 256 + t] = bvv; }
    __syncthreads();
}
__device__ __forceinline__ void attn_phase(Frame& F, const Args& A, unsigned char* ws, int l, char* lds) {
    int tid_ = F.wave * 64 + lane_id(); asm volatile("" : "+v"(tid_));
    const float lambda_init = l == 0 ? 0.2f : 0.355509068f;
    const float lam = expf(wave_sum(A.in[11][l * 64 + (tid_ & 63)] * A.in[12][l * 64 + (tid_ & 63)])) - expf(wave_sum(A.in[13][l * 64 + (tid_ & 63)] * A.in[14][l * 64 + (tid_ & 63)])) + lambda_init;
    float gq = fabsf(A.in[9][l * 64 + (tid_ & 63)]), gk = fabsf(A.in[10][l * 64 + (tid_ & 63)]);
#define MAXSTEP(M) do { gq = fmaxf(gq, xshfl<M>(gq)); gk = fmaxf(gk, xshfl<M>(gk)); } while (0)
    MAXSTEP(1); MAXSTEP(2); MAXSTEP(4); MAXSTEP(8); MAXSTEP(16); MAXSTEP(32);
#undef MAXSTEP
    const float negoff = -fmaxf(0.f, 8.0f * 1.4426950408889634f * gq * gk * 1.0001f - 40.0f);
    const att::bf16* QB = (const att::bf16*)(ws + WS_QB); const att::bf16* KB = (const att::bf16*)(ws + WS_KB); const att::bf16* VB = (const att::bf16*)(ws + WS_VB); att::bf16* MIX = (att::bf16*)(ws + WS_MIX);
    const float* subg = A.in[15] + l * 128;
    const int per = (512 + F.G - 1) / F.G;
    for (int u = F.vcu * per; u < (F.vcu + 1) * per && u < 512; ++u) {
        const int qblk = u & 15, bh = u >> 4, b = bh >> 2, h = bh & 3;
        att::attn_unit(QB + h * 128, KB + h * 128, VB + h * 128, MIX + h * 128, (long)b * SEQ + qblk * 128, (long)M_LAT + b * CTXL, 4, (long)b * SEQ, 36, lam, 1.0f - lambda_init, subg, negoff, lds, F.wave, (unsigned)(uintptr_t)F.lds);
    }
#if EN_ATTC
    if (l == 0) for (int u = F.vcu; u < 64; u += F.G) {
        const int qblk = u & 1, bh = u >> 1, b = bh >> 2, h = bh & 3;
        att::attn_unit(QB + h * 128, KB + h * 128, VB + h * 128, MIX + h * 128, (long)M_LAT + b * CTXL + qblk * 128, (long)M_LAT + b * CTXL, 4, 0, 4, lam, 1.0f - lambda_init, subg, negoff, lds, F.wave, (unsigned)(uintptr_t)F.lds);
    }
#endif
}

__global__ void __launch_bounds__(NWAVES * 64, 2) fwd_kernel(const Args args) {
    extern __shared__ __attribute__((aligned(16))) unsigned char lds[];
    Frame F0;
    F0.lds = (LAS unsigned char*)lds;
    F0.wave = __builtin_amdgcn_readfirstlane((int)threadIdx.x >> 6);
    F0.G = gridDim.x; { const int bx = blockIdx.x; F0.vcu = (F0.G % 8 == 0) ? (bx % 8) * (F0.G / 8) + bx / 8 : bx; }
    for (int u = ((int)threadIdx.x); u < (LDS_BYTES - LDSCTL_OFF) / 4; u += NWAVES * 64) ((LAS unsigned*)(F0.lds + LDSCTL_OFF))[u] = 0u;
    __syncthreads();
    volatile LAS unsigned* MISC = (volatile LAS unsigned*)(F0.lds + MISC_OFF);
    (void)xcd_barrier_post((unsigned*)(args.ws + WS_CTL) + CW_BAR, MISC + 8);
    const int lo = args.ph_lo, hi = args.ph_hi;
    const int cid = (int)blockIdx.x;
    const LAS float* rtab = (const LAS float*)(F0.lds + RTAB_OFF);
#pragma unroll 1
    for (int ph = lo; ph < hi; ++ph) {
#if PROBE_A
        if (blockIdx.x == 0 && F0.wave == 0) MISC[16 + ph] = (unsigned)__builtin_amdgcn_s_memrealtime();
#endif
        unsigned char* ws = args.ws; asm volatile("" : "+s"(ws)); const Args& A = args;
        Frame F = F0; asm volatile("" : "+s"(F.G), "+s"(F.vcu), "+s"(F.wave));
        int l = 0, k = -1; if (ph >= 2) { l = (ph - 2) / 6; k = (ph - 2) % 6; }
        if (ph == 0) ph0(F, A, ws);
        else if (ph == 1) ph1(F, A, ws);
        else if (k == 1) continue;
        else if (k == 2) {
            butterfly_phase(F, ws);
            asm volatile("s_waitcnt vmcnt(0)" ::: "memory"); __syncthreads();
            if (F.wave == 0 && lane_id() == 0) { __builtin_amdgcn_fence(__ATOMIC_RELEASE, "agent"); asm volatile("s_waitcnt vmcnt(0)" ::: "memory");
                __hip_atomic_fetch_add((unsigned*)(ws + WS_CTL) + CW_BFCNT + 64 * l, 1u, __ATOMIC_RELAXED, __HIP_MEMORY_SCOPE_AGENT); }
            attn_phase(F, A, ws, l, (char*)lds);
        }
#pragma unroll 1
        for (int ci = 0; ci < 2; ++ci) {
            enum { T_NONE = 0, T_IN = 1, T_DFT = 2, T_RESN = 3, T_RESL = 4, T_GU = 5 };
            int type = T_NONE, nMa = 0, nNa = 0, pmB = 0, nMb = 0, pnB = 0, nNb = 0, Gs = F.G, cs = cid, rot = 0, K = DM, el = l, nshort = 0, ishort = 0; bool ctxdown = false; int sigw = -1, waitw = -1;
#if SCHED_OLD
            const int nM = l == 0 ? 72 : 64;
            if (ci == 0) {
                if (k == 0) { type = T_IN; if (l == 0) { nMa = 72; nNa = 10; } else { nMa = 64; nNa = 10; pmB = 64; nMb = 8; pnB = 2; nNb = 4; } }
                else if (k == 2) { type = T_DFT; nMa = 1; nNa = l == 0 ? 144 : 128; rot = F.G - 64; K = 512; }
                else if (k == 3) { type = T_RESN; nMa = nM; nNa = 4; }
                else if (k == 4) { type = T_GU; nMa = nM; nNa = 22; }
                else if (k == 5) { type = l == NLAYER - 1 ? T_RESL : T_RESN; nMa = nM; nNa = 4; K = FFD; }
            }
#else
            if (k == 0) {
                if (l == 0) { if (ci == 0) { type = T_IN; nMa = 72; nNa = 10; } }
                else if (ci == 0) { type = T_RESN; pmB = 64; nMb = 8; pnB = 0; nNb = 4; K = FFD; el = 0; ctxdown = true; sigw = CW_CTXCNT; }
                else if (cid >= 32) { type = T_IN; nMa = 64; nNa = 10; Gs = F.G - 32; cs = cid - 32; }
                else if (l == NLAYER - 1) { type = T_IN; pmB = 64; nMb = 8; pnB = 2; nNb = 4; waitw = CW_CTXCNT; }
            }
            else if (k == 2) { if (ci == 0) { type = T_DFT; nMa = 1; nNa = l == 0 ? 144 : 128; rot = F.G - 64; K = 512; } }
            else if (k == 3) { if (ci == 0) { type = T_RESN; nMa = 64; nNa = 4; } }
            else if (k == 4) { if (l == 0 && ci == 0) { type = T_RESN; pmB = 64; nMb = 8; pnB = 0; nNb = 4; }
                               else if (ci == (l == 0 ? 1 : 0)) { type = T_GU; nMa = 64; nNa = 22; if (l == 0) { nshort = 32; ishort = 4; } } }
            else if (k == 5) { const int cdn = (l == 0) ? 1 : 0;
                               if (ci == cdn) { type = l == NLAYER - 1 ? T_RESL : T_RESN; nMa = 64; nNa = 4; K = FFD; } else if (l == 0 && ci == 0) { type = T_GU; pmB = 64; nMb = 8; pnB = 0; nNb = 22; } }
#endif
            if (type == T_NONE) continue;
            pg8::Sched2 S; S.init(nMa, nNa, pmB, nMb, pnB, nNb, Gs, cs, rot); S.ns = nshort; S.is = ishort;
            if (waitw >= 0) {
                pg8::Unit u0; if (!S.next(0, u0)) continue;
                if (F.wave == 0) { unsigned* cw = (unsigned*)(ws + WS_CTL) + waitw + 64 * (cid & 7); unsigned sp = 0;
                    while (__hip_atomic_load(cw, __ATOMIC_RELAXED, __HIP_MEMORY_SCOPE_AGENT) < 4u) { __builtin_amdgcn_s_sleep(8); if (++sp > (1u << 22)) break; }
                    __builtin_amdgcn_fence(__ATOMIC_ACQUIRE, "agent"); asm volatile("s_waitcnt vmcnt(0)" ::: "memory"); }
                __syncthreads();
            } S.wgm = (nNa >= 16) ? WGM_WIDE : ((nNa >= 8) ? WGM_MID : 2);
            if (type == T_IN) {
                {
                    int t_ = F.wave * 64 + lane_id(); asm volatile("" : "+v"(t_)); LAS float* et = (LAS float*)(F.lds + ETAB_OFF);
                    for (int i = t_; i < 3072 + 128; i += NWAVES * 64) et[i] = i < 3072 ? ((const float*)(ws + WS_ROPE))[i] : (i < 3136 ? A.in[9][l * 64 + i - 3072] : A.in[10][l * 64 + i - 3136]);
                }
                compute_rtab(F, ws, S, (const float*)(ws + WS_BIN) + l * 9 * NIN, NIN);
                pg8::Gemm g{(const pg8::bf16_t*)(ws + WS_A), (const pg8::bf16_t*)(ws + WS_WIN) + (size_t)l * NIN * DM, M_ALL, NIN, DM};
                pg8::EpiIn E{ws, rtab};
                pg8::gemm_phase<pg8::EpiIn, pg8::Sched2, true, true>(F.lds, g, S, E, F.wave);
            } else if (type == T_DFT) {
                {
                    if (F.wave == 0) { unsigned* cw = (unsigned*)(ws + WS_CTL) + CW_BFCNT + 64 * l; unsigned sp = 0;
                        while (__hip_atomic_load(cw, __ATOMIC_RELAXED, __HIP_MEMORY_SCOPE_AGENT) < (unsigned)F.G) { __builtin_amdgcn_s_sleep(8); if (++sp > (1u << 22)) break; }
                        __builtin_amdgcn_fence(__ATOMIC_ACQUIRE, "agent"); asm volatile("s_waitcnt vmcnt(0)" ::: "memory"); }
                    __syncthreads();
                }
                pg8::Gemm g{(const pg8::bf16_t*)(ws + WS_DFT), (const pg8::bf16_t*)(ws + WS_T), 256, 36864, 512};
                pg8::EpiDft E{(pg8::bf16_t*)(ws + WS_MIX)};
                pg8::gemm_phase<pg8::EpiDft, pg8::Sched2, true, true>(F.lds, g, S, E, F.wave);
            } else if (type == T_GU) {
                compute_rtab(F, ws, S, (const float*)(ws + WS_BGU) + l * 9 * NGU, NGU);
                pg8::Gemm g{(const pg8::bf16_t*)(ws + WS_A), (const pg8::bf16_t*)(ws + WS_WGU) + (size_t)l * NGU * DM, M_ALL, NGU, DM};
                pg8::EpiGU E{ws, rtab};
                pg8::gemm_phase<pg8::EpiGU, pg8::Sched2, true, true>(F.lds, g, S, E, F.wave);
            } else if (type == T_RESN) {
                const bool down = K == FFD;
                const pg8::bf16_t* Ap = down ? (ctxdown ? (const pg8::bf16_t*)(ws + WS_HC) - (size_t)M_LAT * FFD : (const pg8::bf16_t*)(ws + WS_H)) : (const pg8::bf16_t*)(ws + WS_MIX);
                const pg8::bf16_t* Bp = down ? (const pg8::bf16_t*)(ws + WS_WDN) + (size_t)el * DM * FFD : (const pg8::bf16_t*)(ws + WS_WOUT) + (size_t)el * DM * DM;
                pg8::Gemm g{Ap, Bp, M_ALL, DM, K};
                void* xl_out = (!down && el == NLAYER - 1) ? (void*)(ws + WS_XB2) : (void*)A.out;
                pg8::EpiRes<true> E{(const void*)A.out, xl_out, ws, el * 9 * 6144 + (down ? 5120 : 2048), down ? A.in[6] + (el + 1) * DM : A.in[7] + el * DM, down ? (el + 1) * 9 * 6144 + 1024 : el * 9 * 6144 + 4096};
                pg8::gemm_phase<pg8::EpiRes<true>, pg8::Sched2, true, true>(F.lds, g, S, E, F.wave);
                if (sigw >= 0) {
                    pg8::Unit u0; if (S.next(0, u0)) {
                    asm volatile("s_waitcnt vmcnt(0)" ::: "memory"); __syncthreads();
                    if (F.wave == 0 && lane_id() == 0) { __builtin_amdgcn_fence(__ATOMIC_RELEASE, "agent"); asm volatile("s_waitcnt vmcnt(0)" ::: "memory");
                        __hip_atomic_fetch_add((unsigned*)(ws + WS_CTL) + sigw + 64 * (cid & 7), 1u, __ATOMIC_RELAXED, __HIP_MEMORY_SCOPE_AGENT); } }
                }
            } else {
                pg8::Gemm g{(const pg8::bf16_t*)(ws + WS_H), (const pg8::bf16_t*)(ws + WS_WDN) + (size_t)l * DM * FFD, M_ALL, DM, FFD};
                pg8::EpiRes<false> E{(const void*)(ws + WS_XB2), (void*)A.out, ws, l * 9 * 6144 + 5120, nullptr, 0};
                pg8::gemm_phase<pg8::EpiRes<false>, pg8::Sched2, true, true>(F.lds, g, S, E, F.wave);
            }
        }
        if (ph + 1 < hi) { XcdBarrier bar; bar.bar = (unsigned*)(args.ws + WS_CTL) + CW_BAR; bar.x = xb_xcc_id(); bar.st = MISC + 8; bar.t0 = (F0.wave == 0) && (lane_id() == 0); xcd_barrier(bar); }
    }
#if PROBE_S
    if (blockIdx.x == 0 && F0.wave == 0) { const unsigned long long t0 = __builtin_amdgcn_s_memrealtime(); const unsigned long long dl = 5ull * (MISC[40 + ((PROBE_S) & 255)] - MISC[40 + ((PROBE_S) >> 8)]);
        while (__builtin_amdgcn_s_memrealtime() - t0 < dl) __builtin_amdgcn_s_sleep(32); }
#endif
#if PROBE_A
    if (blockIdx.x == 0 && F0.wave == 0) { const unsigned long long t0 = __builtin_amdgcn_s_memrealtime(); MISC[16 + N_PHASES] = (unsigned)t0; unsigned long long dl = 0;
        for (int p = 0; p < N_PHASES; ++p) if ((PROBE_A >> p) & 1) dl += 5ull * (MISC[17 + p] - MISC[16 + p]);
        while (__builtin_amdgcn_s_memrealtime() - t0 < dl) __builtin_amdgcn_s_sleep(32); }
#endif
}
static_assert(EWS_MOD == WS_MOD && EWS_BIN == WS_BIN && EWS_BGU == WS_BGU && EWS_ROPE == WS_ROPE && EWS_SSQ == WS_SSQ && EWS_A == WS_A && EWS_XC == WS_XC && EWS_QB == WS_QB && EWS_KB == WS_KB && EWS_VB == WS_VB && EWS_TC == WS_TC && EWS_T == WS_T && EWS_H == WS_H && EWS_HC == WS_HC, "epilogue offsets vs d_ws map");
#ifndef MK_PER_PHASE
#define MK_PER_PHASE 0
#endif
extern "C" void kernel_launch(void* const* d_in, const int* in_sizes, int n_in, void* d_out, int out_size, void* d_ws, size_t ws_size, hipStream_t stream) {
    static int grid = 0;
    if (grid == 0) {
        if (n_in != 21 || in_sizes[0] != M_LAT * DM || out_size != M_LAT * DM || ws_size < WS_END) { fprintf(stderr, "kernel_launch: unexpected shapes (n_in %d, in0 %d, out %d, ws %zu)\n", n_in, n_in > 0 ? in_sizes[0] : -1, out_size, ws_size); grid = -1; return; }
        int dev = 0, cus = 0, per_cu = 0;
        if (hipGetDevice(&dev) != hipSuccess || hipDeviceGetAttribute(&cus, hipDeviceAttributeMultiprocessorCount, dev) != hipSuccess) { grid = -1; return; }
        if (hipFuncSetAttribute((const void*)fwd_kernel, hipFuncAttributeMaxDynamicSharedMemorySize, LDS_BYTES) != hipSuccess) { fprintf(stderr, "kernel_launch: hipFuncSetAttribute failed\n"); grid = -1; return; }
        if (hipOccupancyMaxActiveBlocksPerMultiprocessor(&per_cu, (const void*)fwd_kernel, NWAVES * 64, LDS_BYTES) != hipSuccess || per_cu < 1) { fprintf(stderr, "kernel_launch: occupancy query reports %d\n", per_cu); }
        (void)hipGetLastError();
        grid = cus;
    }
    if (grid < 0) return;
    (void)hipMemsetAsync((char*)d_ws + WS_CTL, 0, CTL_ZERO_BYTES, stream);
    Args a{};
    for (int i = 0; i < 21; ++i) a.in[i] = (const float*)d_in[i];
    a.out = (float*)d_out; a.ws = (unsigned char*)d_ws;
#if MK_PER_PHASE
#ifndef REP_MASK
#define REP_MASK 0
#endif
    for (int ph = 0; ph < N_PHASES; ++ph) { a.ph_lo = ph; a.ph_hi = ph + 1; for (int rep = 0; rep < (((REP_MASK) >> ph) & 1) + 1; ++rep) hipLaunchKernelGGL(fwd_kernel, dim3(grid), dim3(NWAVES * 64), LDS_BYTES, stream, a); }
#else
    a.ph_lo = 0; a.ph_hi = N_PHASES; hipLaunchKernelGGL(fwd_kernel, dim3(grid), dim3(NWAVES * 64), LDS_BYTES, stream, a);
#endif
    const hipError_t le = hipPeekAtLastError();
    if (le != hipSuccess) fprintf(stderr, "kernel_launch: launch failed: %s\n", hipGetErrorName(le));
}
```

```cpp
#define MK_PER_PHASE 0
#include <hip/hip_runtime.h>
#include <cstdio>
#include <cstdint>
#include <math.h>
constexpr size_t EWS_MOD = 64 * 1024, EWS_BIN = 512 * 1024, EWS_BGU = (1u << 20) + 768 * 1024, EWS_ROPE = EWS_BGU + 512 * 1024, EWS_SSQ = 5u << 20, EWS_A = 56u << 20, EWS_XC = 92u << 20,
                 EWS_QB = 100u << 20, EWS_KB = 118u << 20, EWS_VB = 136u << 20, EWS_TC = 186u << 20, EWS_T = 154u << 20, EWS_H = 100u << 20, EWS_HC = 226u << 20;
namespace pg8 {
#define PG8_LAS __attribute__((address_space(3)))
typedef unsigned short bf16_t;
typedef short bf16x8 __attribute__((ext_vector_type(8)));
typedef float f32x4 __attribute__((ext_vector_type(4)));
typedef unsigned u32x4 __attribute__((ext_vector_type(4)));
constexpr int BM = 256, BK = 64, HALF = 128, HTB = HALF * BK * 2  , STAGE_BYTES = 8 * HTB, NXCD = 8, WGM = 2;

__host__ __device__ __forceinline__ int lds_byte(int r, int c) { const int st = (r >> 4) * 2 + (c >> 5), rr = r & 15, cc = c & 31, ob = rr * 64 + cc * 2; return st * 1024 + (ob ^ (((ob >> 9) & 1) << 5)); }
__host__ __device__ __forceinline__ void stage_rc(int b, int& R, int& C) { const int st = b / 1024, sb = b % 1024, swz = sb ^ (((sb >> 9) & 1) << 5); R = (st >> 1) * 16 + swz / 64; C = (st & 1) * 32 + (swz % 64) / 2; }
__host__ __device__ __forceinline__ int perm32(int rho) { const int n = rho >> 4, i = rho & 15; return 8 * (i >> 2) + 4 * n + (i & 3); }

struct Unit { int pm, pn; };
struct Gemm { const bf16_t* A; const bf16_t* Bt; int M, N, K; };

struct StaticOrder {
    int nM, nN, nwg, G, c;
    __host__ __device__ void init(int M, int N, int G_, int c_) { nM = M / BM; nN = N / BM; nwg = nM * nN; G = G_; c = c_; }
    __host__ __device__ bool next(int i, Unit& u) const {
        const long L = (long)i * G + c; if (L >= nwg) return false;
        int wgid = (int)L; { const int q = nwg / NXCD, r = nwg % NXCD, xcd = wgid % NXCD, off = wgid / NXCD; wgid = (xcd < r ? xcd * (q + 1) : r * (q + 1) + (xcd - r) * q) + off; }
        const int nig = WGM * nN, gid = wgid / nig, fm = gid * WGM, gsz = (nM - fm) < WGM ? (nM - fm) : WGM;
        u.pm = fm + ((wgid % nig) % gsz); u.pn = (wgid % nig) / gsz; return true;
    }
    __device__ __forceinline__ void a_ready(const Unit&) const {}
    __device__ __forceinline__ void done(const Unit&) const {}
};

#ifndef FSORT
#define FSORT 1
#endif
struct Sched2 {
    int nMa, nNa, nA, pmB, nMb, pnB, nNb, nB, G, c, ns = 0, is = 0; static constexpr int wgm = WGM;
    __device__ void init(int nMa_, int nNa_, int pmB_, int nMb_, int pnB_, int nNb_, int G_, int c_, int rot) { nMa = nMa_; nNa = nNa_; nA = nMa * nNa; pmB = pmB_; nMb = nMb_; pnB = pnB_; nNb = nNb_; nB = nMb * nNb; G = G_; c = (c_ + rot) % G_; }
    __device__ bool next(int i, Unit& u) const {
        int L;
        if (ns == 0 || i < is) { if (ns != 0 && i >= is && c < ns) return false; L = i * G + c; }
        else { if (c < ns) return false; L = is * G + (i - is) * (G - ns) + (c - ns); }
        if (L >= nA + nB) return false;
        if (L < nA) {
            int wgid = L; { const int q = nA / NXCD, r = nA % NXCD, xcd = wgid % NXCD, off = wgid / NXCD; wgid = (xcd < r ? xcd * (q + 1) : r * (q + 1) + (xcd - r) * q) + off; }
            const int fs = (FSORT && nNa == 10) ? 6 : 0;
            if (fs == 0) { const int nig = wgm * nNa, gid = wgid / nig, fm = gid * wgm, gsz = (nMa - fm) < wgm ? (nMa - fm) : wgm;
                u.pm = fm + ((wgid % nig) % gsz); u.pn = (wgid % nig) / gsz; }
            else {
                const int q = nA / NXCD, xc = wgid / q, R = q / nNa; int o = wgid - xc * q, nn = fs, base = 0;
                if (o >= R * fs) { o -= R * fs; nn = nNa - fs; base = fs; }
                const int nig = wgm * nn, gid = o / nig, fm = gid * wgm, gsz = (R - fm) < wgm ? (R - fm) : wgm;
                u.pm = xc * R + fm + ((o % nig) % gsz); u.pn = base + (o % nig) / gsz; }
        } else { const int r = L - nA; u.pm = pmB + r % nMb; u.pn = pnB + r / nMb; }
        return true;
    }
    __device__ __forceinline__ void a_ready(const Unit&) const {}
    __device__ __forceinline__ void done(const Unit&) const {}
};
__device__ __forceinline__ unsigned cvt_pk_bf16(float lo, float hi) { unsigned r; asm volatile("v_cvt_pk_bf16_f32 %0, %1, %2" : "=v"(r) : "v"(lo), "v"(hi)); return r; }
typedef unsigned u32x2 __attribute__((ext_vector_type(2)));
__device__ __forceinline__ u32x2 pk4(f32x4 v) { u32x2 w; w.x = cvt_pk_bf16(v[0], v[1]); w.y = cvt_pk_bf16(v[2], v[3]); return w; }
#ifndef WT_STORES
#define WT_STORES 0
#endif
#ifndef NT_STORES
#define NT_STORES 0
#endif
__device__ __forceinline__ void st8(void* p, u32x2 v) {
#if WT_STORES
    __hip_atomic_store((unsigned long long*)p, ((unsigned long long)v.y << 32) | v.x, __ATOMIC_RELAXED, __HIP_MEMORY_SCOPE_AGENT);
#elif NT_STORES
    __builtin_nontemporal_store(v, (u32x2*)p);
#else
    *(u32x2*)p = v;
#endif
}
__device__ __forceinline__ float rowsum4(float s) {
    { const unsigned u = __builtin_bit_cast(unsigned, s); auto a = __builtin_amdgcn_permlane16_swap(u, u, false, false); const unsigned a0 = a[0], a1 = a[1]; s = __builtin_bit_cast(float, a0) + __builtin_bit_cast(float, a1); }
    { const unsigned u = __builtin_bit_cast(unsigned, s); auto b = __builtin_amdgcn_permlane32_swap(u, u, false, false); const unsigned b0 = b[0], b1 = b[1]; s = __builtin_bit_cast(float, b0) + __builtin_bit_cast(float, b1); }
    return s;
}
__device__ __forceinline__ float dot4(f32x4 v) { return (v[0] * v[0] + v[1] * v[1]) + (v[2] * v[2] + v[3] * v[3]); }
constexpr int BT_F = (140288 - 131072) / 4, ET_F = (147456 - 131072) / 4;
constexpr int M_LAT_TILES = 64;
constexpr float QSCALE = 0.125f * 1.4426950408889634f;
constexpr float ZS_LAT = 1.0f / 512.0f;
constexpr float ZS_CTX = 0.005524271728019903f;

struct EpiIn {
    static constexpr bool PERM = false, AFTER_DRAIN = false;
    unsigned char* ws; const PG8_LAS float* rtab;
    __device__ __forceinline__ void operator()(const f32x4 (&acc)[2][2][4][2], const Unit& u, int ui, int wr, int wc, int fr, int fq) const {
        const int pm = u.pm, pn = u.pn; const bool lat = pm < M_LAT_TILES; const int bm = lat ? (pm >> 3) : 8;
        const PG8_LAS float* rope = rtab + ET_F;
        bf16_t* QB = (bf16_t*)(ws + EWS_QB); bf16_t* KB = (bf16_t*)(ws + EWS_KB); bf16_t* VB = (bf16_t*)(ws + EWS_VB); bf16_t* T = (bf16_t*)(ws + EWS_T); bf16_t* Tc = (bf16_t*)(ws + EWS_TC);
        const PG8_LAS float* bp = rtab + BT_F + ui * 256 + wc * 32 + fq * 4;
        f32x4 bv[2][2];
#pragma unroll
        for (int bj = 0; bj < 2; ++bj)
#pragma unroll
            for (int n = 0; n < 2; ++n) bv[bj][n] = *(const PG8_LAS f32x4*)(bp + bj * 128 + n * 16);
        const PG8_LAS float* rt = rtab + ui * 256 + wr * 64 + fr;
        if (pn < 4) {
            const PG8_LAS float* gp = rope + 3072 + (pn < 2 ? 0 : 64) + fq * 4; const float qs = pn < 2 ? QSCALE : 1.f;
            f32x4 gv[2][2];
#pragma unroll
            for (int bj = 0; bj < 2; ++bj)
#pragma unroll
                for (int n = 0; n < 2; ++n) gv[bj][n] = *(const PG8_LAS f32x4*)(gp + bj * 32 + n * 16) * qs;
            bf16_t* dst = (pn < 2 ? QB : KB) + (pn & 1) * 256 + wc * 64 + fq * 4;
#pragma unroll
            for (int ai = 0; ai < 2; ++ai)
#pragma unroll
                for (int m = 0; m < 4; ++m) {
                    const int rl = ai * 128 + wr * 64 + m * 16 + fr, row = pm * 256 + rl; const float r = rt[ai * 128 + m * 16];
                    f32x4 v[2][2]; float ssq = 0.f;
#pragma unroll
                    for (int bj = 0; bj < 2; ++bj)
#pragma unroll
                        for (int n = 0; n < 2; ++n) { v[bj][n] = acc[ai][bj][m][n] * r + bv[bj][n]; ssq += dot4(v[bj][n]); }
                    ssq = rowsum4(ssq);
                    const float rn = __builtin_amdgcn_rsqf(ssq * (1.0f / 64.0f) + 1e-6f);
#pragma unroll
                    for (int bj = 0; bj < 2; ++bj)
#pragma unroll
                        for (int n = 0; n < 2; ++n) v[bj][n] = v[bj][n] * rn * gv[bj][n];
                    if (lat) { const int pos = row & 2047;
#pragma unroll
                        for (int bj = 0; bj < 2; ++bj) { const PG8_LAS float* cp = rope + (bj == 0 ? (pos >> 6) : 32 + (pos & 63)) * 16 + fq * 4; const f32x4 c4 = *(const PG8_LAS f32x4*)cp, s4 = *(const PG8_LAS f32x4*)(cp + 1536); const f32x4 t1 = v[bj][0], t2 = v[bj][1];
                            v[bj][0] = t1 * c4 - t2 * s4; v[bj][1] = t2 * c4 + t1 * s4; } }
#pragma unroll
                    for (int bj = 0; bj < 2; ++bj)
#pragma unroll
                        for (int n = 0; n < 2; ++n) *(u32x2*)(dst + (size_t)row * 512 + bj * 32 + n * 16) = pk4(v[bj][n]);
                }
        } else if (pn < 6) {
            bf16_t* dst = VB + (pn - 4) * 256 + wc * 32 + fq * 4;
#pragma unroll
            for (int ai = 0; ai < 2; ++ai)
#pragma unroll
                for (int m = 0; m < 4; ++m) {
                    const int rl = ai * 128 + wr * 64 + m * 16 + fr, row = pm * 256 + rl; const float r = rt[ai * 128 + m * 16];
#pragma unroll
                    for (int bj = 0; bj < 2; ++bj)
#pragma unroll
                        for (int n = 0; n < 2; ++n) *(u32x2*)(dst + (size_t)row * 512 + bj * 128 + n * 16) = pk4(acc[ai][bj][m][n] * r + bv[bj][n]);
                }
        } else {
            const int g = pn - 6; const float zs = lat ? ZS_LAT : ZS_CTX;
            const int b = lat ? (pm >> 3) : (pm - M_LAT_TILES);
            bf16_t* tb = (lat ? T + (size_t)((b * 8 + (pm & 7)) * 512) * 512 : Tc + (size_t)(b * 512) * 512) + (size_t)(g * 128 + wc * 32 + fq * 4) * 512;
#pragma unroll
            for (int ai = 0; ai < 2; ++ai)
#pragma unroll
                for (int m = 0; m < 4; ++m) {
                    const int rl = ai * 128 + wr * 64 + m * 16 + fr; const float r = rt[ai * 128 + m * 16];
#pragma unroll
                    for (int n = 0; n < 2; ++n) { const f32x4 re = (acc[ai][0][m][n] * r + bv[0][n]) * zs, im = (acc[ai][1][m][n] * r + bv[1][n]) * zs;
#pragma unroll
                        for (int i = 0; i < 4; ++i) *(unsigned*)(tb + (size_t)(n * 16 + i) * 512 + rl * 2) = cvt_pk_bf16(re[i], im[i]); }
                }
        }
    }
};
typedef _Float16 h16x2 __attribute__((ext_vector_type(2)));
__device__ __forceinline__ unsigned pkh2(float a, float b) { const h16x2 h = {(_Float16)a, (_Float16)b}; return __builtin_bit_cast(unsigned, h); }
__device__ __forceinline__ u32x2 pkh4(f32x4 v) { u32x2 w; w.x = pkh2(v[0], v[1]); w.y = pkh2(v[2], v[3]); return w; }
__device__ __forceinline__ f32x4 unh4(u32x2 w) { const unsigned lo = w.x, hi = w.y; const h16x2 a = __builtin_bit_cast(h16x2, lo), b = __builtin_bit_cast(h16x2, hi);     return (f32x4){(float)a[0], (float)a[1], (float)b[0], (float)b[1]}; }
template <bool NEXT> struct EpiRes {
    static constexpr bool PERM = true, AFTER_DRAIN = false;
    const void* xl_in; void* xl_out;
    unsigned char* ws; int gate_off;
    const float* ng; int nsc_off;
    __device__ __forceinline__ void operator()(const f32x4 (&acc)[2][2][4][2], const Unit& u, int ui, int wr, int wc, int fr, int fq) const {
        const int pm = u.pm, pn = u.pn; const bool lat = pm < M_LAT_TILES; const int bm = lat ? (pm >> 3) : 8; const int col0 = pn * 256 + wc * 32 + fq * 8;
        const float* gate = (const float*)(ws + EWS_MOD) + gate_off; const float* nsc = (const float*)(ws + EWS_MOD) + nsc_off; bf16_t* A = (bf16_t*)(ws + EWS_A); float* ssq = (float*)(ws + EWS_SSQ);
        const _Float16* xin = lat ? (const _Float16*)xl_in + (size_t)pm * 256 * 1024 : (const _Float16*)(ws + EWS_XC) + (size_t)(pm - M_LAT_TILES) * 256 * 1024;
        _Float16* xout = lat ? (_Float16*)xl_out + (size_t)pm * 256 * 1024 : (_Float16*)(ws + EWS_XC) + (size_t)(pm - M_LAT_TILES) * 256 * 1024;
        float* xoutf = (float*)xl_out + (size_t)pm * 256 * 1024;
        float ssq_[2][4];
#pragma unroll
        for (int ai = 0; ai < 2; ++ai)
#pragma unroll
            for (int m = 0; m < 4; ++m) ssq_[ai][m] = 0.f;
        f32x4 ga[2][2], gv[2][2]; u32x4 preA[4], preB[4];
        auto loadx = [&](int g, u32x4 (&p)[4]) __attribute__((always_inline)) { const int bj = g >> 1, ai = g & 1;
#pragma unroll
            for (int m = 0; m < 4; ++m) p[m] = *(const u32x4*)(xin + (size_t)(ai * 128 + wr * 64 + m * 16 + fr) * 1024 + col0 + bj * 128); };
        auto loadg = [&](int bj) __attribute__((always_inline)) {
#pragma unroll
            for (int n = 0; n < 2; ++n) { const int c = col0 + bj * 128 + n * 4; ga[bj][n] = *(const f32x4*)(gate + bm * 6144 + c);
                if (NEXT) gv[bj][n] = *(const f32x4*)(ng + c) * (*(const f32x4*)(nsc + bm * 6144 + c) + 1.0f); } };
        auto proc = [&](int g, const u32x4 (&p)[4]) __attribute__((always_inline)) { const int bj = g >> 1, ai = g & 1;
#pragma unroll
            for (int m = 0; m < 4; ++m) {
                const int rl = ai * 128 + wr * 64 + m * 16 + fr; const size_t row = (size_t)pm * 256 + rl; const size_t off = (size_t)rl * 1024 + col0 + bj * 128;
                u32x2 lo; lo.x = p[m].x; lo.y = p[m].y; u32x2 hi2; hi2.x = p[m].z; hi2.y = p[m].w;
                const f32x4 x0 = unh4(lo) + ga[bj][0] * acc[ai][bj][m][0], x1 = unh4(hi2) + ga[bj][1] * acc[ai][bj][m][1];
                if (NEXT) { const u32x2 h0 = pkh4(x0), h1 = pkh4(x1); u32x4 w; w.x = h0.x; w.y = h0.y; w.z = h1.x; w.w = h1.y; *(u32x4*)(xout + off) = w; }
                else { *(f32x4*)(xoutf + off) = x0; *(f32x4*)(xoutf + off + 4) = x1; }
                if (NEXT) { ssq_[ai][m] += dot4(x0) + dot4(x1); const u32x2 a0 = pk4(x0 * gv[bj][0]), a1 = pk4(x1 * gv[bj][1]); u32x4 w; w.x = a0.x; w.y = a0.y; w.z = a1.x; w.w = a1.y; *(u32x4*)(A + row * 1024 + col0 + bj * 128) = w; }
            }
            asm volatile("" ::: "memory"); };
        loadx(0, preA); loadg(0); loadx(1, preB); asm volatile("" ::: "memory");
        proc(0, preA); loadg(1); loadx(2, preA); asm volatile("" ::: "memory");
        proc(1, preB); loadx(3, preB); asm volatile("" ::: "memory");
        proc(2, preA); proc(3, preB);
        if (NEXT) {
#pragma unroll
            for (int ai = 0; ai < 2; ++ai)
#pragma unroll
                for (int m = 0; m < 4; ++m) { const float s = rowsum4(ssq_[ai][m]); if (fq == 0) ssq[((size_t)pm * 256 + ai * 128 + wr * 64 + m * 16 + fr) * 16 + pn * 4 + wc] = s; }
        }
    }
};
struct EpiGU {
    static constexpr bool PERM = true, AFTER_DRAIN = false;
    unsigned char* ws; const PG8_LAS float* rtab;
    __device__ __forceinline__ void operator()(const f32x4 (&acc)[2][2][4][2], const Unit& u, int ui, int wr, int wc, int fr, int fq) const {
        const int pm = u.pm, pn = u.pn; const int bm = pm < M_LAT_TILES ? (pm >> 3) : 8;
        bf16_t* H = (bf16_t*)(ws + EWS_H);
        const PG8_LAS float* bp = rtab + BT_F + ui * 256 + wc * 32 + fq * 8;
        f32x4 bg[2], bu[2];
#pragma unroll
        for (int n = 0; n < 2; ++n) { bg[n] = *(const PG8_LAS f32x4*)(bp + n * 4); bu[n] = *(const PG8_LAS f32x4*)(bp + 128 + n * 4); }
        const PG8_LAS float* rt = rtab + ui * 256 + wr * 64 + fr;
        if (pm >= M_LAT_TILES) H = (bf16_t*)(ws + EWS_HC) - (size_t)16384 * 2816;
        bf16_t* dst = H + pn * 128 + wc * 32 + fq * 8;
#pragma unroll
        for (int ai = 0; ai < 2; ++ai)
#pragma unroll
            for (int m = 0; m < 4; ++m) {
                const int rl = ai * 128 + wr * 64 + m * 16 + fr; const size_t row = (size_t)pm * 256 + rl; const float r = rt[ai * 128 + m * 16];
                u32x2 hp[2];
#pragma unroll
                for (int n = 0; n < 2; ++n) { const f32x4 gg = acc[ai][0][m][n] * r + bg[n], uu = acc[ai][1][m][n] * r + bu[n]; f32x4 h;
#pragma unroll
                    for (int i = 0; i < 4; ++i) h[i] = gg[i] * __builtin_amdgcn_rcpf(1.0f + __builtin_amdgcn_exp2f(-1.4426950408889634f * gg[i])) * uu[i];
                    hp[n] = pk4(h); }
                { u32x4 w; w.x = hp[0].x; w.y = hp[0].y; w.z = hp[1].x; w.w = hp[1].y; *(u32x4*)(dst + row * 2816) = w; }
            }
    }
};
struct EpiDft {
    static constexpr bool PERM = true, AFTER_DRAIN = false;
    bf16_t* MIX;
    __device__ __forceinline__ void operator()(const f32x4 (&acc)[2][2][4][2], const Unit& u, int ui, int wr, int wc, int fr, int fq) const {
        const int pn = u.pn;
#pragma unroll
        for (int bj = 0; bj < 2; ++bj) {
            const int c = pn * 256 + bj * 128 + wc * 32 + fq * 8; int rowbase, rstride, ch;
            if (pn < 128) { const int b = c >> 12, r = (c >> 9) & 7; ch = c & 511; rowbase = b * 2048 + r; rstride = 8; }
            else { const int c2 = c - 32768; const int b = c2 >> 9; ch = c2 & 511; rowbase = 16384 + b * 256; rstride = 1; }
#pragma unroll
            for (int ai = 0; ai < 2; ++ai)
#pragma unroll
                for (int m = 0; m < 4; ++m) { const int mm = ai * 128 + wr * 64 + m * 16 + fr; const size_t row = (size_t)rowbase + (size_t)mm * rstride;
                    const f32x4 v0 = acc[ai][bj][m][0], v1 = acc[ai][bj][m][1]; u32x4 w; w.x = cvt_pk_bf16(v0[0], v0[1]); w.y = cvt_pk_bf16(v0[2], v0[3]); w.z = cvt_pk_bf16(v1[0], v1[1]); w.w = cvt_pk_bf16(v1[2], v1[3]);
                    *(u32x4*)(MIX + row * 1024 + 512 + ch) = w; }
        }
    }
};
struct NoPre { __device__ __forceinline__ void operator()() const {} };
template <class Epi, class Sched, bool ALIGN_EPI = false, bool SP2 = false, class Pre = NoPre>
__device__ __forceinline__ void gemm_phase(PG8_LAS unsigned char* lds, const Gemm g, const Sched& S, const Epi& E, int wave_, const Pre& pre = Pre()) {
    unsigned z_ = 0u; asm volatile("" : "+v"(z_)); int tid_ = wave_ * 64 + (int)__builtin_amdgcn_mbcnt_hi(~0u, __builtin_amdgcn_mbcnt_lo(~0u, z_)); asm volatile("" : "+v"(tid_));
    const int tid = tid_, wid = __builtin_amdgcn_readfirstlane(tid >> 6), lane = tid & 63, wr = wid >> 2, wc = wid & 3, fr = lane & 15, fq = lane >> 4;
    const int K = g.K, nt = K / BK;
    unsigned voffA[2], voffB[2];
#pragma unroll
    for (int i = 0; i < 2; ++i) { int R, C; stage_rc(tid * 16 + i * 8192, R, C); const int Rb = Epi::PERM ? ((R & ~31) + perm32(R & 31)) : R;
        voffA[i] = (unsigned)(R * K + C) * 2u; voffB[i] = (unsigned)(Rb * K + C) * 2u; }
    const size_t kstep = (size_t)(BK * 2);
    const size_t hstep = (size_t)HALF * K * 2;
    const size_t tstep = 2 * hstep;
    const unsigned ldsw = (unsigned)wid * 1024u;
    const int aoff = lds_byte(wr * 64 + fr, fq * 8), boff = lds_byte(wc * 32 + fr, fq * 8);
#define PG8_SA(b, h) (((b) * 2 + (h)) * HTB)
#define PG8_SB(b, h) ((4 + (b) * 2 + (h)) * HTB)
#define PG8_STAGE(bufoff, gbase, voff) do { _Pragma("unroll") for (int _i = 0; _i < 2; ++_i) \
        __builtin_amdgcn_global_load_lds((const unsigned*)((const char*)(gbase) + (voff)[_i]), (PG8_LAS unsigned*)(lds + (bufoff) + ldsw + _i * 8192), 16, 0, 0); } while (0)
#define PG8_LDA(dst, b, h) do { _Pragma("unroll") for (int m = 0; m < 4; ++m) _Pragma("unroll") for (int k = 0; k < 2; ++k) dst[m][k] = *(const PG8_LAS bf16x8*)(lds + PG8_SA(b, h) + aoff + m * 2048 + k * 1024); } while (0)
#define PG8_LDB(dst, b, h) do { _Pragma("unroll") for (int n = 0; n < 2; ++n) _Pragma("unroll") for (int k = 0; k < 2; ++k) dst[n][k] = *(const PG8_LAS bf16x8*)(lds + PG8_SB(b, h) + boff + n * 2048 + k * 1024); } while (0)
#define PG8_MMA(ai, bj, At, Bt) do { __builtin_amdgcn_s_setprio(1); _Pragma("unroll") for (int m = 0; m < 4; ++m) _Pragma("unroll") for (int n = 0; n < 2; ++n) _Pragma("unroll") for (int k = 0; k < 2; ++k) \
        acc[ai][bj][m][n] = __builtin_amdgcn_mfma_f32_16x16x32_bf16(Bt[n][k], At[m][k], acc[ai][bj][m][n], 0, 0, 0); __builtin_amdgcn_s_setprio(0); } while (0)
#define PG8_WAIT_V(n) asm volatile("s_waitcnt vmcnt(" #n ")" ::: "memory")
#define PG8_WAIT_L(n) asm volatile("s_waitcnt lgkmcnt(" #n ")" ::: "memory")
#define PG8_BAR __builtin_amdgcn_s_barrier()
#define PG8_SCHED __builtin_amdgcn_sched_barrier(0)
    Unit cur, nxt; int ui = 0;
    if (!S.next(0, cur)) return;
    f32x4 acc[2][2][4][2];
#pragma unroll
    for (int a = 0; a < 2; ++a)
#pragma unroll
        for (int b = 0; b < 2; ++b)
#pragma unroll
            for (int m = 0; m < 4; ++m)
#pragma unroll
                for (int n = 0; n < 2; ++n) acc[a][b][m][n] = (f32x4){0.f, 0.f, 0.f, 0.f};
    bf16x8 At[4][2], B0[2][2], B1[2][2];
    const char* cA = (const char*)g.A + (size_t)cur.pm * tstep; const char* cB = (const char*)g.Bt + (size_t)cur.pn * tstep;
    S.a_ready(cur);
    if constexpr (SP2) {
        PG8_STAGE(PG8_SB(0, 0), cB, voffB); PG8_STAGE(PG8_SB(0, 1), cB + hstep, voffB); PG8_STAGE(PG8_SA(0, 0), cA, voffA); PG8_STAGE(PG8_SA(0, 1), cA + hstep, voffA);
        pre();
        if (wr == 1) PG8_BAR;
        PG8_WAIT_V(2); PG8_BAR;
        PG8_STAGE(PG8_SB(1, 0), cB + kstep, voffB); PG8_STAGE(PG8_SA(1, 0), cA + kstep, voffA); PG8_STAGE(PG8_SB(1, 1), cB + hstep + kstep, voffB);
        PG8_WAIT_V(6); PG8_BAR;
    } else {
        PG8_STAGE(PG8_SB(0, 0), cB, voffB); PG8_STAGE(PG8_SA(0, 0), cA, voffA); PG8_STAGE(PG8_SB(0, 1), cB + hstep, voffB); PG8_STAGE(PG8_SA(0, 1), cA + hstep, voffA);
        if (wr == 1) PG8_BAR;
        PG8_WAIT_V(4); PG8_BAR;
        PG8_STAGE(PG8_SB(1, 0), cB + kstep, voffB); PG8_STAGE(PG8_SA(1, 0), cA + kstep, voffA); PG8_STAGE(PG8_SB(1, 1), cB + hstep + kstep, voffB);
        PG8_WAIT_V(6); PG8_BAR;
    }
    for (;;) {
        const bool has_next = S.next(ui + 1, nxt);
        const char* nA = has_next ? (const char*)g.A + (size_t)nxt.pm * tstep : cA; const char* nB = has_next ? (const char*)g.Bt + (size_t)nxt.pn * tstep : cB;
        for (int t = 0; t < nt; t += 2) {
            const bool last = (t == nt - 2);
            const char* a1 = cA + (size_t)(t + 1) * kstep;
            const char* a2 = last ? nA : cA + (size_t)(t + 2) * kstep; const char* b2 = last ? nB : cB + (size_t)(t + 2) * kstep;
            const char* a3 = a2 + kstep; const char* b3 = b2 + kstep;
            if (last && has_next) S.a_ready(nxt);
            if constexpr (SP2) {
            PG8_LDB(B0, 0, 0); PG8_LDB(B1, 0, 1); PG8_SCHED; PG8_LDA(At, 0, 0); PG8_STAGE(PG8_SA(1, 1), a1 + hstep, voffA);
            PG8_WAIT_V(8); PG8_WAIT_L(0); PG8_BAR; PG8_MMA(0, 0, At, B0); PG8_MMA(0, 1, At, B1); PG8_BAR; PG8_SCHED;
            PG8_LDA(At, 0, 1); PG8_STAGE(PG8_SB(0, 0), b2, voffB); PG8_STAGE(PG8_SB(0, 1), b2 + hstep, voffB); PG8_STAGE(PG8_SA(0, 0), a2, voffA);
            PG8_WAIT_V(8); PG8_WAIT_L(0); PG8_BAR; PG8_MMA(1, 0, At, B0); PG8_MMA(1, 1, At, B1); PG8_BAR; PG8_SCHED;
            PG8_LDB(B0, 1, 0); PG8_LDB(B1, 1, 1); PG8_SCHED; PG8_LDA(At, 1, 0); PG8_STAGE(PG8_SA(0, 1), a2 + hstep, voffA);
            PG8_WAIT_V(8); PG8_WAIT_L(0); PG8_BAR; PG8_MMA(0, 0, At, B0); PG8_MMA(0, 1, At, B1); PG8_BAR; PG8_SCHED;
            PG8_LDA(At, 1, 1); PG8_STAGE(PG8_SB(1, 0), b3, voffB); PG8_STAGE(PG8_SB(1, 1), b3 + hstep, voffB); PG8_STAGE(PG8_SA(1, 0), a3, voffA);
            PG8_WAIT_V(8); PG8_WAIT_L(0); PG8_BAR; PG8_MMA(1, 0, At, B0); PG8_MMA(1, 1, At, B1); PG8_BAR; PG8_SCHED;
            } else {
            PG8_LDB(B0, 0, 0); PG8_SCHED; PG8_LDA(At, 0, 0); PG8_STAGE(PG8_SA(1, 1), a1 + hstep, voffA);
            PG8_WAIT_L(8); PG8_BAR; PG8_WAIT_L(0); PG8_MMA(0, 0, At, B0); PG8_BAR; PG8_SCHED;
            PG8_LDB(B1, 0, 1); PG8_STAGE(PG8_SB(0, 0), b2, voffB);
            PG8_BAR; PG8_WAIT_L(0); PG8_MMA(0, 1, At, B1); PG8_BAR;
            PG8_LDA(At, 0, 1); PG8_STAGE(PG8_SA(0, 0), a2, voffA);
            PG8_BAR; PG8_WAIT_L(0); PG8_MMA(1, 0, At, B0); PG8_BAR; PG8_SCHED;
            PG8_STAGE(PG8_SB(0, 1), b2 + hstep, voffB);
            PG8_WAIT_V(6); PG8_BAR; PG8_MMA(1, 1, At, B1); PG8_BAR;
            PG8_LDB(B0, 1, 0); PG8_SCHED; PG8_LDA(At, 1, 0); PG8_STAGE(PG8_SA(0, 1), a2 + hstep, voffA);
            PG8_WAIT_L(8); PG8_BAR; PG8_WAIT_L(0); PG8_MMA(0, 0, At, B0); PG8_BAR; PG8_SCHED;
            PG8_LDB(B1, 1, 1); PG8_STAGE(PG8_SB(1, 0), b3, voffB);
            PG8_BAR; PG8_WAIT_L(0); PG8_MMA(0, 1, At, B1); PG8_BAR;
            PG8_LDA(At, 1, 1); PG8_STAGE(PG8_SA(1, 0), a3, voffA);
            PG8_BAR; PG8_WAIT_L(0); PG8_MMA(1, 0, At, B0); PG8_BAR; PG8_SCHED;
            PG8_STAGE(PG8_SB(1, 1), b3 + hstep, voffB);
            PG8_WAIT_V(6); PG8_BAR; PG8_MMA(1, 1, At, B1); PG8_BAR;
            }
        }
        if constexpr (ALIGN_EPI) { if (wr == 0) PG8_BAR; }
        if constexpr (!Epi::AFTER_DRAIN) { int fr_ = fr, fq_ = fq; asm volatile("" : "+v"(fr_), "+v"(fq_)); E(acc, cur, ui, wr, wc, fr_, fq_); S.done(cur); }
        if (!has_next) break;
#pragma unroll
        for (int a = 0; a < 2; ++a)
#pragma unroll
            for (int b = 0; b < 2; ++b)
#pragma unroll
                for (int m = 0; m < 4; ++m)
#pragma unroll
                    for (int n = 0; n < 2; ++n) acc[a][b][m][n] = (f32x4){0.f, 0.f, 0.f, 0.f};
        cur = nxt; cA = nA; cB = nB; ++ui;
        if constexpr (ALIGN_EPI) { if (wr == 1) PG8_BAR; }
    }
    PG8_WAIT_V(0);
    if constexpr (!ALIGN_EPI) { if (wr == 0) PG8_BAR; }
    PG8_BAR;
    if constexpr (Epi::AFTER_DRAIN) { E.fused(acc, cur, wr, wc, fr, fq, lds, wid, lane); S.done(cur); }
#undef PG8_SA
#undef PG8_SB
#undef PG8_STAGE
#undef PG8_LDA
#undef PG8_LDB
#undef PG8_MMA
#undef PG8_WAIT_V
#undef PG8_WAIT_L
#undef PG8_BAR
#undef PG8_SCHED
}
}
#ifndef EN_ATTEPI
#define EN_ATTEPI 1
#endif
#ifndef ATT_PROBE
#define ATT_PROBE 0
#endif
namespace att {
typedef unsigned short bf16;
using bf16x8 = __attribute__((ext_vector_type(8))) short;
using s16x4  = __attribute__((ext_vector_type(4))) short;
using f32x16 = __attribute__((ext_vector_type(16))) float;
using u32x4  = __attribute__((ext_vector_type(4))) unsigned;
constexpr int KVBLK = 64;
constexpr int NBUF = 3;
constexpr size_t SHM_V = KVBLK * 128 * 2, SHM_K = KVBLK * 128 * 2, SHM_ATTN = NBUF * SHM_V + NBUF * SHM_K + 8 * 64 * 4;
#define KSWZ(row, colB) ((row) * 256 + ((colB) ^ (((row) & 7) << 4)))
#define SBAR() __builtin_amdgcn_sched_barrier(0)
#define SWZ(v, M) __builtin_bit_cast(float, __builtin_amdgcn_ds_swizzle(__builtin_bit_cast(int, v), ((M) << 10) | 0x1F))
__device__ __forceinline__ int crow(int r, int hi) { return (r & 3) + 8 * (r >> 2) + 4 * hi; }
__device__ __forceinline__ unsigned cvtpk(float lo, float hi) { unsigned r; asm volatile("v_cvt_pk_bf16_f32 %0, %1, %2" : "=v"(r) : "v"(lo), "v"(hi)); return r; }
__device__ __forceinline__ bf16x8 ld8(const bf16* p) { return *reinterpret_cast<const bf16x8*>(p); }
__device__ __forceinline__ void sm_first(f32x16& p0, f32x16& p1, float negoff) {
  (void)p1; (void)negoff;
#pragma unroll
  for (int r = 0; r < 16; ++r) p0[r] = __builtin_amdgcn_exp2f(p0[r]);
}
__device__ __forceinline__ void sm_finish(f32x16& p0, f32x16& p1, float& l_reg, bf16x8& pa0, bf16x8& pa1, bf16x8& pa2, bf16x8& pa3) {
#pragma unroll
  for (int r = 0; r < 16; ++r) p1[r] = __builtin_amdgcn_exp2f(p1[r]);
  float ps = 0;
#pragma unroll
  for (int r = 0; r < 16; ++r) ps += p0[r];
#pragma unroll
  for (int r = 0; r < 16; ++r) ps += p1[r];
  l_reg += ps;
#define PK4(P, BASE, OUT) do { unsigned a0 = cvtpk(P[BASE + 0], P[BASE + 1]), a1 = cvtpk(P[BASE + 2], P[BASE + 3]);   \
    unsigned b0 = cvtpk(P[BASE + 4], P[BASE + 5]), b1 = cvtpk(P[BASE + 6], P[BASE + 7]);                              \
    auto r0 = __builtin_amdgcn_permlane32_swap(a0, b0, false, false); auto r1 = __builtin_amdgcn_permlane32_swap(a1, b1, false, false); \
    u32x4 w = {r0[0], r1[0], r0[1], r1[1]}; OUT = *reinterpret_cast<bf16x8*>(&w); } while (0)
  PK4(p0, 0, pa0); PK4(p0, 8, pa1); PK4(p1, 0, pa2); PK4(p1, 8, pa3);
#undef PK4
}
__device__ __forceinline__ void qkt(f32x16& p0, f32x16& p1, const bf16* Ks, const bf16x8* qr, int r32, int hi, int mapoff, float negoff) {
  p0 = f32x16{}; p1 = f32x16{}; (void)negoff;
#pragma unroll
  for (int d0 = 0; d0 < 4; ++d0) { const int cb = (mapoff + d0 * 16 + hi * 8) * 2;
    bf16x8 b0 = *reinterpret_cast<const bf16x8*>((const char*)Ks + KSWZ(r32, cb));
    bf16x8 b1 = *reinterpret_cast<const bf16x8*>((const char*)Ks + KSWZ(32 + r32, cb));
    p0 = __builtin_amdgcn_mfma_f32_32x32x16_bf16(b0, qr[d0], p0, 0, 0, 0);
    p1 = __builtin_amdgcn_mfma_f32_32x32x16_bf16(b1, qr[d0], p1, 0, 0, 0); }
}
__device__ __forceinline__ int v_st(int k, int c) { const int kk = (k & ~0xC) | ((k & 4) << 1) | ((k & 8) >> 1); return ((kk >> 3) * 4 + (c >> 5)) * 512 + ((kk & 7) * 32 + (c & 31)) * 2; }
__device__ __forceinline__ int v_rd_base(int lane) { return ((lane & 3) << 3) | (((lane >> 2) & 3) << 6) | (((lane >> 4) & 1) << 5) | (((lane >> 5) & 1) << 8); }
constexpr int v_rd_off(int d0, int ks, int half) { return d0 * 512 + ks * 4096 + half * 2048; }
typedef short v4i16_t __attribute__((ext_vector_type(4)));
template <int OFF> __device__ __forceinline__ s16x4 tr_read(int vb) {
  return __builtin_bit_cast(s16x4, __builtin_amdgcn_ds_read_tr16_b64_v4i16((__attribute__((address_space(3))) v4i16_t*)(uintptr_t)(unsigned)(vb + OFF)));
}
template <int D0> __device__ __forceinline__ void pv_one(f32x16& od, int vb, bf16x8 pa0, bf16x8 pa1, bf16x8 pa2, bf16x8 pa3) {
  const s16x4 l0 = tr_read<v_rd_off(D0, 0, 0)>(vb), h0 = tr_read<v_rd_off(D0, 0, 1)>(vb), l1 = tr_read<v_rd_off(D0, 1, 0)>(vb), h1 = tr_read<v_rd_off(D0, 1, 1)>(vb);
  const s16x4 l2 = tr_read<v_rd_off(D0, 2, 0)>(vb), h2 = tr_read<v_rd_off(D0, 2, 1)>(vb), l3 = tr_read<v_rd_off(D0, 3, 0)>(vb), h3 = tr_read<v_rd_off(D0, 3, 1)>(vb);
#define PK(L, H) (bf16x8){L[0], L[1], L[2], L[3], H[0], H[1], H[2], H[3]}
  od = __builtin_amdgcn_mfma_f32_32x32x16_bf16(pa0, PK(l0, h0), od, 0, 0, 0);
  od = __builtin_amdgcn_mfma_f32_32x32x16_bf16(pa1, PK(l1, h1), od, 0, 0, 0);
  od = __builtin_amdgcn_mfma_f32_32x32x16_bf16(pa2, PK(l2, h2), od, 0, 0, 0);
  od = __builtin_amdgcn_mfma_f32_32x32x16_bf16(pa3, PK(l3, h3), od, 0, 0, 0);
#undef PK
}
__device__ __forceinline__ void pv_d0(f32x16* o, int vb, bf16x8 pa0, bf16x8 pa1, bf16x8 pa2, bf16x8 pa3) {
  pv_one<0>(o[0], vb, pa0, pa1, pa2, pa3); pv_one<1>(o[1], vb, pa0, pa1, pa2, pa3); pv_one<2>(o[2], vb, pa0, pa1, pa2, pa3); pv_one<3>(o[3], vb, pa0, pa1, pa2, pa3);
}
__device__ __forceinline__ void attn_unit(const bf16* __restrict__ Qh, const bf16* __restrict__ Kh, const bf16* __restrict__ Vh, bf16* __restrict__ Oh, long qrow0, long k0a, int nt0, long k0b, int NT,
                                          float lam, float oscale, const float* __restrict__ subg, float negoff, char* lds, int wave_, unsigned lds3) {
  unsigned z_ = 0u; asm volatile("" : "+v"(z_)); int tid_ = wave_ * 64 + (int)__builtin_amdgcn_mbcnt_hi(~0u, __builtin_amdgcn_mbcnt_lo(~0u, z_)); asm volatile("" : "+v"(tid_));
  const int tid = tid_, wid = __builtin_amdgcn_readfirstlane(tid >> 6), lane = tid & 63, r32 = lane & 31, hi = lane >> 5, qsub = wid >> 1, map = wid & 1, mapoff = map * 64;
  bf16* V_lds = (bf16*)lds; bf16* K_lds = (bf16*)(lds + NBUF * SHM_V);
  float* ws = (float*)(lds + NBUF * SHM_V + NBUF * SHM_K) + wid * 64; float* li_l = ws;
#if ATT_PROBE == 2
  volatile __attribute__((address_space(3))) unsigned* ast2_ = (volatile __attribute__((address_space(3))) unsigned*)(uintptr_t)(lds3 + 139584u);
  const bool astamp2_ = blockIdx.x == 0 && wid == 0 && NT == 36 && ast2_[80] == 0u;
  if (astamp2_) ast2_[80] = (unsigned)__builtin_amdgcn_s_memrealtime();
#endif
  float l_reg = 0; f32x16 o[4] = {}; bf16x8 qr[4];
  const bf16* Qw = Qh + (qrow0 + qsub * 32 + r32) * 512 + mapoff + hi * 8;
#pragma unroll
  for (int d0 = 0; d0 < 4; ++d0) qr[d0] = ld8(Qw + d0 * 16);
  const int vb0 = (int)(uintptr_t)V_lds + v_rd_base(lane);
  int koff[2], voff[2];
#pragma unroll
  for (int i = 0; i < 2; ++i) { const int o = (wid + 8 * i) * 1024 + lane * 16;
    { const int row = o >> 8, cB = (o & 255) ^ ((row & 7) << 4); koff[i] = row * 512 + (cB >> 1); }
    { const int sub = o >> 9, kkhi = sub >> 2, cg = sub & 3, q = (o & 511) >> 1, kklo = q >> 5, cin = q & 31, kk = kkhi * 8 + kklo; voff[i] = kk * 512 + cg * 32 + cin; } }
  typedef __attribute__((address_space(3))) unsigned lds_u32;
  const unsigned ldsK = lds3 + NBUF * (unsigned)SHM_V + (unsigned)wid * 1024u, ldsV = lds3 + (unsigned)wid * 1024u;
#define KROW(j) (((j) < nt0) ? (k0a + (long)(j) * KVBLK) : (k0b + (long)((j) - nt0) * KVBLK))
#define DMAK(b, j) do { const long kr_ = KROW(j) * 512; _Pragma("unroll") for (int i_ = 0; i_ < 2; ++i_) \
    __builtin_amdgcn_global_load_lds((const unsigned*)(Kh + kr_ + koff[i_]), (lds_u32*)(uintptr_t)(ldsK + (b) * (unsigned)SHM_K + i_ * 8192u), 16, 0, 0); } while (0)
#define DMAV(b, j) do { const long kr_ = KROW(j) * 512; _Pragma("unroll") for (int i_ = 0; i_ < 2; ++i_) \
    __builtin_amdgcn_global_load_lds((const unsigned*)(Vh + kr_ + voff[i_]), (lds_u32*)(uintptr_t)(ldsV + (b) * (unsigned)SHM_V + i_ * 8192u), 16, 0, 0); } while (0)
  f32x16 p0, p1; bf16x8 pa0, pa1, pa2 = {}, pa3 = {};
#define KFR(kb, d0, half) (*reinterpret_cast<const bf16x8*>((const char*)K_lds + (kb) * (int)SHM_K + KSWZ((half) * 32 + r32, (mapoff + (d0) * 16 + hi * 8) * 2)))
#define VRD4(S, vbuf, D0, KS) do { const int vb_ = vb0 + (vbuf) * (int)SHM_V; S##a = tr_read<v_rd_off(D0, KS, 0)>(vb_); S##b = tr_read<v_rd_off(D0, KS, 1)>(vb_); S##c = tr_read<v_rd_off(D0, (KS) + 1, 0)>(vb_); S##d = tr_read<v_rd_off(D0, (KS) + 1, 1)>(vb_); } while (0)
#define PKV(L, H) (bf16x8){L[0], L[1], L[2], L[3], H[0], H[1], H[2], H[3]}
#define MM(ACC, A_, B_) ACC = __builtin_amdgcn_mfma_f32_32x32x16_bf16(A_, B_, ACC, 0, 0, 0)
#define FADD(D, S) asm volatile("v_add_f32 %0, %0, %1" : "+v"(D) : "v"(S))
#define SMA(P, c) do { P[2 * (c)] = __builtin_amdgcn_exp2f(P[2 * (c)]); P[2 * (c) + 1] = __builtin_amdgcn_exp2f(P[2 * (c) + 1]); FADD(ls0, P[2 * (c)]); FADD(ls1, P[2 * (c) + 1]); } while (0)
#define SMB_CVT(P, BASE) do { ca0 = cvtpk(P[BASE + 0], P[BASE + 1]); ca1 = cvtpk(P[BASE + 2], P[BASE + 3]); cb0 = cvtpk(P[BASE + 4], P[BASE + 5]); cb1 = cvtpk(P[BASE + 6], P[BASE + 7]); } while (0)
#define SMB_PERM(OUT) do { u32x4 w_ = {ca0, ca1, cb0, cb1}; OUT = *reinterpret_cast<bf16x8*>(&w_); } while (0)
#define STAGE_PV(PA, PB, P, KLD_STMT) do { KLD_STMT; \
    MM(o[0], PKV(vAa, vAb), PA); SMA(P, 0); SBAR(); MM(o[0], PKV(vAc, vAd), PB); SMA(P, 1); SBAR(); \
    MM(o[1], PKV(vBa, vBb), PA); SMA(P, 2); SBAR(); MM(o[1], PKV(vBc, vBd), PB); SMA(P, 3); SBAR(); \
    MM(o[2], PKV(vCa, vCb), PA); SMA(P, 4); SBAR(); MM(o[2], PKV(vCc, vCd), PB); SMA(P, 5); SBAR(); \
    MM(o[3], PKV(vDa, vDb), PA); SMA(P, 6); SBAR(); MM(o[3], PKV(vDc, vDd), PB); SMA(P, 7); SBAR(); } while (0)
#define VRD16(vbuf, KS) do { VRD4(vA, vbuf, 0, KS); VRD4(vB, vbuf, 1, KS); VRD4(vC, vbuf, 2, KS); VRD4(vD, vbuf, 3, KS); } while (0)
#define STAGE_QK(PD, P, OUT0, OUT1, vbuf, KS) do { VRD16(vbuf, KS); \
    PD = __builtin_amdgcn_mfma_f32_32x32x16_bf16(kf0, qr[0], f32x16{}, 0, 0, 0); SMB_CVT(P, 0); SBAR(); \
    MM(PD, kf1, qr[1]); SMB_PERM(OUT0); SBAR(); MM(PD, kf2, qr[2]); SMB_CVT(P, 8); SBAR(); MM(PD, kf3, qr[3]); SMB_PERM(OUT1); SBAR(); } while (0)
#define KLD4(kb, half) do { kf0 = KFR(kb, 0, half); kf1 = KFR(kb, 1, half); kf2 = KFR(kb, 2, half); kf3 = KFR(kb, 3, half); } while (0)
  s16x4 vAa, vAb, vAc, vAd, vBa, vBb, vBc, vBd, vCa, vCb, vCc, vCd, vDa, vDb, vDc, vDd; bf16x8 kf0, kf1, kf2, kf3; unsigned ca0, ca1, cb0, cb1; float ls0 = 0.f, ls1 = 0.f;
  DMAK(0, 0); DMAK(1, 1); DMAV(0, 0); asm volatile("s_waitcnt vmcnt(0)" ::: "memory"); __syncthreads();
  KLD4(0, 0); p0 = __builtin_amdgcn_mfma_f32_32x32x16_bf16(kf0, qr[0], f32x16{}, 0, 0, 0); MM(p0, kf1, qr[1]); MM(p0, kf2, qr[2]); MM(p0, kf3, qr[3]);
  VRD16(0, 2);
  if (wid >= 4) __builtin_amdgcn_s_setprio(1);
  int bp = 0, bc = 0, bn = 1, bnn = 2;
#pragma unroll 1
  for (int j = 0; j < NT; ++j) {
    asm volatile("s_waitcnt vmcnt(0)" ::: "memory"); SBAR(); __builtin_amdgcn_s_barrier(); SBAR();
    if (j + 2 < NT) DMAK(bnn, j + 2);
    if (j + 1 < NT) DMAV(bn, j + 1);
    STAGE_PV(pa2, pa3, p0, KLD4(bc, 1));
    STAGE_QK(p1, p0, pa0, pa1, bc, 0);
    const int kbn = (j + 1 < NT) ? bn : bc;
    STAGE_PV(pa0, pa1, p1, KLD4(kbn, 0));
    STAGE_QK(p0, p1, pa2, pa3, bc, 2);
    bp = bc; bc = bn; bn = bnn; bnn = bp;
  }
  MM(o[0], PKV(vAa, vAb), pa2); MM(o[0], PKV(vAc, vAd), pa3); MM(o[1], PKV(vBa, vBb), pa2); MM(o[1], PKV(vBc, vBd), pa3);
  MM(o[2], PKV(vCa, vCb), pa2); MM(o[2], PKV(vCc, vCd), pa3); MM(o[3], PKV(vDa, vDb), pa2); MM(o[3], PKV(vDc, vDd), pa3);
  l_reg = ls0 + ls1;
  __builtin_amdgcn_s_setprio(0);
#undef KLD4
#undef STAGE_QK
#undef VRD16
#undef FADD
#undef STAGE_PV
#undef SMB_PERM
#undef SMB_CVT
#undef SMA
#undef MM
#undef VRD4
#undef PKV
#undef KFR
#undef DMAK
#undef DMAV
#if EN_ATTEPI
  { const unsigned u_ = __float_as_uint(l_reg); auto rr = __builtin_amdgcn_permlane32_swap(u_, u_, false, false); const unsigned r0_ = rr[0], r1_ = rr[1]; l_reg = __uint_as_float(r0_) + __uint_as_float(r1_); }
  { const float rl = __builtin_amdgcn_rcpf(l_reg) * (map ? lam : 1.f);
#pragma unroll
    for (int d0 = 0; d0 < 4; ++d0)
#pragma unroll
      for (int r = 0; r < 16; ++r) o[d0][r] *= rl; }
  typedef float f32x4_t __attribute__((ext_vector_type(4)));
  f32x4_t sgv[4][4];
  if (map == 0) {
#pragma unroll
    for (int d0 = 0; d0 < 4; ++d0)
#pragma unroll
      for (int g = 0; g < 4; ++g) sgv[d0][g] = *reinterpret_cast<const f32x4_t*>(subg + d0 * 32 + 8 * g + 4 * hi) * oscale;
  }
  __syncthreads();
  float* X = (float*)lds + (qsub * 64 + lane) * 68;
  if (map == 1) {
#pragma unroll
    for (int d0 = 0; d0 < 4; ++d0)
#pragma unroll
      for (int g = 0; g < 4; ++g) { f32x4_t x_ = {o[d0][4 * g], o[d0][4 * g + 1], o[d0][4 * g + 2], o[d0][4 * g + 3]}; *reinterpret_cast<f32x4_t*>(X + d0 * 16 + 4 * g) = x_; }
  }
  __syncthreads();
  if (map == 0) {
    float ss = 0.f;
#pragma unroll
    for (int d0 = 0; d0 < 4; ++d0)
#pragma unroll
      for (int g = 0; g < 4; ++g) { const f32x4_t x_ = *reinterpret_cast<const f32x4_t*>(X + d0 * 16 + 4 * g);
#pragma unroll
        for (int i = 0; i < 4; ++i) { o[d0][4 * g + i] -= x_[i]; ss += o[d0][4 * g + i] * o[d0][4 * g + i]; } }
    { const unsigned u_ = __float_as_uint(ss); auto rr = __builtin_amdgcn_permlane32_swap(u_, u_, false, false); const unsigned r0_ = rr[0], r1_ = rr[1]; ss = __uint_as_float(r0_) + __uint_as_float(r1_); }
    const float rn = __builtin_amdgcn_rsqf(ss * (1.0f / 128.0f) + 1e-6f);
    char* Xs = (char*)lds + qsub * (64 * 68 * 4);
#pragma unroll
    for (int d0 = 0; d0 < 4; ++d0)
#pragma unroll
      for (int g = 0; g < 4; ++g) { const f32x4_t sv = sgv[d0][g] * rn;
        const unsigned w0 = cvtpk(o[d0][4 * g] * sv[0], o[d0][4 * g + 1] * sv[1]), w1 = cvtpk(o[d0][4 * g + 2] * sv[2], o[d0][4 * g + 3] * sv[3]);
        typedef unsigned u32x2_t __attribute__((ext_vector_type(2))); u32x2_t w = {w0, w1}; *reinterpret_cast<u32x2_t*>(Xs + r32 * 272 + (d0 * 32 + 8 * g + 4 * hi) * 2) = w; }
    asm volatile("s_waitcnt lgkmcnt(0)" ::: "memory");
    bf16* Ob = Oh + (qrow0 + qsub * 32) * 1024;
#pragma unroll
    for (int k = 0; k < 8; ++k) { const int p = lane + 64 * k, row = p >> 4, c16 = p & 15; const u32x4 v = *reinterpret_cast<const u32x4*>(Xs + row * 272 + c16 * 16); *reinterpret_cast<u32x4*>(Ob + (long)row * 1024 + c16 * 8) = v; }
  }
  __syncthreads();
#if ATT_PROBE == 2
  if (astamp2_) ast2_[81] = (unsigned)__builtin_amdgcn_s_memrealtime();
#endif
#else
  { float s = l_reg; for (int d0 = 0; d0 < 4; ++d0) for (int r = 0; r < 16; ++r) s += o[d0][r]; Oh[qrow0 * 1024 + tid] = (bf16)(int)s; }
#endif
#undef KROW
}
#undef KSWZ
#undef SBAR
#undef SWZ
}
#ifndef EN_ALL
#define EN_ALL 1
#endif
#ifndef EN_PH0
#define EN_PH0 EN_ALL
#endif
#ifndef EN_PH1
#define EN_PH1 EN_ALL
#endif
#ifndef EN_P1
#define EN_P1 EN_ALL
#endif
#ifndef EN_P2A
#define EN_P2A EN_ALL
#endif
#ifndef EN_P2B
#define EN_P2B EN_ALL
#endif
#ifndef EN_P3
#define EN_P3 EN_ALL
#endif
#ifndef EN_P4
#define EN_P4 EN_ALL
#endif
#ifndef EN_P5
#define EN_P5 EN_ALL
#endif
#ifndef EN_ATT
#define EN_ATT 1
#endif
#ifndef EN_DFT
#define EN_DFT 1
#endif
#ifndef EN_ATTC
#define EN_ATTC 1
#endif
#ifndef SCHED_OLD
#define SCHED_OLD 0
#endif
#ifndef PROBE_A
#define PROBE_A 0
#endif
#ifndef PROBE_S
#define PROBE_S 0
#endif
#if PROBE_S
#define SUBSTAMP(i) do { if (blockIdx.x == 0 && F.wave == 0) ((volatile LAS unsigned*)(F.lds + MISC_OFF))[40 + (i)] = (unsigned)__builtin_amdgcn_s_memrealtime(); } while (0)
#else
#define SUBSTAMP(i) do {} while (0)
#endif
#ifndef FSORT
#define FSORT 1
#endif
#ifndef FORCE_IRREG
#define FORCE_IRREG 0
#endif
#ifndef BF_HALF
#define BF_HALF 1
#endif
#ifndef STAG9
#define STAG9 1
#endif
#ifndef ECD
#define ECD 1
#endif
#ifndef DEFER_WDN
#define DEFER_WDN 1
#endif
#ifndef PH0_BAL
#define PH0_BAL 1
#endif
#ifndef LOCAL_BAR
#define LOCAL_BAR 1
#endif
#ifndef PROBE_B
#define PROBE_B 0
#endif
#ifndef WGM_WIDE
#define WGM_WIDE 2
#endif
#ifndef WGM_MID
#define WGM_MID 2
#endif
constexpr int NWAVES = 8;
constexpr int DM = 1024, NBATCH = 8, SEQ = 2048, CTXL = 256, M_LAT = NBATCH * SEQ, M_CTX = NBATCH * CTXL, M_ALL = M_LAT + M_CTX, NIN = 2560, NINSRC = 2048, FFD = 2816, NGU = 5632, NLAYER = 2;
constexpr size_t MiB = 1u << 20;
constexpr size_t WS_CTL = 0, CTL_ZERO_BYTES = 1 * MiB;
constexpr size_t WS_MOD = 64 * 1024;
constexpr size_t WS_BIN = 512 * 1024;
constexpr size_t WS_BGU = 1 * MiB + 768 * 1024;
constexpr size_t WS_ROPE = WS_BGU + 512 * 1024;
constexpr size_t WS_DFT = WS_ROPE + 512 * 1024;
constexpr size_t WS_TF = 4 * MiB;
constexpr size_t WS_SSQ = 5 * MiB;
constexpr size_t WS_WIN = 8 * MiB;
constexpr size_t WS_WOUT = 18 * MiB;
constexpr size_t WS_WGU = 22 * MiB;
constexpr size_t WS_WDN = 44 * MiB;
constexpr size_t WS_A = 56 * MiB;
constexpr size_t WS_XC = 92 * MiB;
constexpr size_t WS_QB = 100 * MiB, WS_KB = 118 * MiB, WS_VB = 136 * MiB;
constexpr size_t WS_T = 154 * MiB;
constexpr size_t WS_TC = 186 * MiB;
constexpr size_t WS_MIX = 190 * MiB;
constexpr size_t WS_H = 100 * MiB;
constexpr size_t WS_HC = 226 * MiB;
constexpr size_t WS_END = 238 * MiB;
constexpr size_t WS_XB2 = 222 * MiB;
static_assert(WS_DFT + 256 * 512 * 2 <= WS_TF && WS_SSQ + (size_t)M_ALL * 64 <= WS_WIN && WS_H + (size_t)M_ALL * FFD * 2 <= WS_END && WS_MIX + (size_t)M_ALL * DM * 2 <= WS_END, "d_ws map");
constexpr int CW_TMO = 0, CW_BAR = 4096, CW_CTXCNT = 8192, CW_BFCNT = 8192 + 512, CW_C3CNT = 8192 + 1024, CW_HWX = 12288, CW_LBAR = 13312, CW_BFG = 13824, CW_FGCNT = 14912, CW_GUC = 8192 + 2048, CW_DT = 8192 + 3072;
constexpr int RING_BYTES = 131072, RTAB_OFF = RING_BYTES, RTAB_BYTES = 8192, LDSCTL_OFF = RTAB_OFF + RTAB_BYTES, MISC_OFF = LDSCTL_OFF + 320, BTAB_OFF = 140288, ETAB_OFF = 147456, LDS_BYTES = ETAB_OFF + 12288 + 512;
static_assert(MISC_OFF + 512 <= BTAB_OFF && BTAB_OFF + 7 * 1024 == ETAB_OFF && BTAB_OFF == RTAB_OFF + 4 * pg8::BT_F && ETAB_OFF == RTAB_OFF + 4 * pg8::ET_F && LDS_BYTES <= 160 * 1024, "LDS map");
constexpr int N_PHASES = 2 + 6 * NLAYER;

#define GAS __attribute__((address_space(1)))
#define LAS __attribute__((address_space(3)))
typedef unsigned short bf16;
typedef unsigned v4u __attribute__((ext_vector_type(4)));
typedef unsigned v2u __attribute__((ext_vector_type(2)));
typedef float f32x4 __attribute__((ext_vector_type(4)));
#define LDS_WAIT() asm volatile("s_waitcnt lgkmcnt(0)" ::: "memory")
#define VM_WAIT() asm volatile("s_waitcnt vmcnt(0)" ::: "memory")
__device__ __forceinline__ unsigned f2bf(float f) { unsigned u = __builtin_bit_cast(unsigned, f); return (u + 0x7fffu + ((u >> 16) & 1u)) >> 16; }
__device__ __forceinline__ unsigned pk2(float lo, float hi) { return f2bf(lo) | (f2bf(hi) << 16); }
__device__ __forceinline__ float bf2f(unsigned short h) { return __builtin_bit_cast(float, (unsigned)h << 16); }
__device__ __forceinline__ int lane_id() { unsigned z = 0u; asm volatile("" : "+v"(z)); return (int)__builtin_amdgcn_mbcnt_hi(~0u, __builtin_amdgcn_mbcnt_lo(~0u, z)); }
template <int M> __device__ __forceinline__ float xshfl(float v) {
    if constexpr (M < 32) return __builtin_bit_cast(float, __builtin_amdgcn_ds_swizzle(__builtin_bit_cast(int, v), (M << 10) | 0x1F));
    else { const unsigned u = __builtin_bit_cast(unsigned, v); auto r = __builtin_amdgcn_permlane32_swap(u, u, false, false); const unsigned r0 = r[0], r1 = r[1];
           unsigned z = 0u; asm volatile("" : "+v"(z)); const bool upper = __builtin_amdgcn_mbcnt_hi(~0u, __builtin_amdgcn_mbcnt_lo(~0u, z)) >= 32u;
           return __builtin_bit_cast(float, upper ? r0 : r1); }
}
__device__ __forceinline__ float wave_sum(float v) {
    v += xshfl<1>(v); v += xshfl<2>(v); v += xshfl<4>(v); v += xshfl<8>(v); v += xshfl<16>(v);
    { const unsigned u = __builtin_bit_cast(unsigned, v); auto r = __builtin_amdgcn_permlane32_swap(u, u, false, false); const unsigned r0 = r[0], r1 = r[1]; v = __builtin_bit_cast(float, r0) + __builtin_bit_cast(float, r1); }
    return v;
}

#define XB_TMO      128
#define XB_XCNT(j)  (256  + 64 * (j))
#define XB_XSUB(j)  (1280 + 64 * (j))
#define XB_XGEN(j)  (2304 + 64 * (j))
#define XB_TOP      3328
#define XB_TOPGEN   3392
#define XCD_BAR_WORDS 3456
#define XB_SPIN_CAP (1u << 18)

__device__ __forceinline__ unsigned xb_ld(unsigned* p)              { return __hip_atomic_load(p, __ATOMIC_RELAXED, __HIP_MEMORY_SCOPE_AGENT); }
__device__ __forceinline__ unsigned xb_add(unsigned* p, unsigned v) { return __hip_atomic_fetch_add(p, v, __ATOMIC_RELAXED, __HIP_MEMORY_SCOPE_AGENT); }
__device__ __forceinline__ unsigned xb_xcc_id() { return (unsigned)__builtin_amdgcn_s_getreg((3 << 11) | 20) & 0xFu; }
#define XB_SPIN(cond, bar) do { unsigned _sp = 0; while (cond) { __builtin_amdgcn_s_sleep(1); \
    if ((++_sp & 255u) == 0u) { if (xb_ld(&(bar)[XB_TMO])) break; if (_sp > XB_SPIN_CAP) { atomicAdd(&(bar)[XB_TMO], 1u); break; } } } } while (0)

struct XcdBarrier {
    unsigned* bar; unsigned x;
    volatile LAS unsigned* st;
    bool t0;
};

__device__ __forceinline__ XcdBarrier xcd_barrier_post(unsigned* bar, volatile LAS unsigned* st) {
    XcdBarrier b; b.bar = bar; b.x = xb_xcc_id(); b.st = st;
    if (threadIdx.x == 0) (void)xb_add(&bar[XB_XCNT(b.x)], 1u);
    return b;
}
__device__ __forceinline__ void xcd_barrier_complete(unsigned* bar, unsigned x, unsigned& nloc, unsigned& nx) {
    const unsigned G = gridDim.x * gridDim.y * gridDim.z;
    unsigned sum, cnt, mine, sp = 0u;
    for (;;) {
        sum = 0u; cnt = 0u; mine = 0u;
#pragma unroll
        for (unsigned j = 0; j < 16; ++j) { const unsigned c = xb_ld(&bar[XB_XCNT(j)]); sum += c; cnt += (c > 0u) ? 1u : 0u; mine = (j == x) ? c : mine; }
        if (sum == G) break;
        __builtin_amdgcn_s_sleep(1);
        if ((++sp & 255u) == 0u) { if (xb_ld(&bar[XB_TMO])) break; if (sp > XB_SPIN_CAP) { atomicAdd(&bar[XB_TMO], 1u); break; } }
    }
    nloc = mine > 0u ? mine : 1u; nx = cnt > 0u ? cnt : 1u;
}

__device__ __forceinline__ void xcd_barrier(const XcdBarrier& b) {
    asm volatile("s_waitcnt vmcnt(0)" ::: "memory");
    __syncthreads();
    if (b.t0) {
        unsigned* bar = b.bar;
        __builtin_amdgcn_s_waitcnt(0);
        unsigned nloc = b.st[0], nx = b.st[1];
        if (nloc == 0u) { xcd_barrier_complete(bar, b.x, nloc, nx); b.st[0] = nloc; b.st[1] = nx; }
        const unsigned old = xb_add(&bar[XB_XSUB(b.x)], 1u);
        const unsigned gen = old / nloc;
        if (old + 1u == (gen + 1u) * nloc) {
            __builtin_amdgcn_fence(__ATOMIC_RELEASE, "agent");
            asm volatile("s_waitcnt vmcnt(0)" ::: "memory");
            const unsigned og = xb_add(&bar[XB_TOP], 1u);
            const unsigned tg = og / nx;
            if (og + 1u == (tg + 1u) * nx) xb_add(&bar[XB_TOPGEN], 1u);
            else XB_SPIN(xb_ld(&bar[XB_TOPGEN]) == tg, bar);
            __builtin_amdgcn_fence(__ATOMIC_ACQUIRE, "agent");
            xb_add(&bar[XB_XGEN(b.x)], 1u);
            asm volatile("s_waitcnt vmcnt(0)" ::: "memory");
        } else {
            XB_SPIN(xb_ld(&bar[XB_XGEN(b.x)]) == gen, bar);
            __builtin_amdgcn_fence(__ATOMIC_ACQUIRE, "agent");
            asm volatile("s_waitcnt vmcnt(0)" ::: "memory");
        }
    }
    __syncthreads();
}


struct Args { const float* in[21]; float* out; unsigned char* ws; int ph_lo, ph_hi; };
struct Frame {
    LAS unsigned char* lds; int wave, vcu, G;
};

struct TrItem { const float* W; bf16* WT; int ldn, ldk, k0, n0, drow0; };
__device__ __forceinline__ void transpose_load(const TrItem& t, f32x4 (&v)[8], int lane) {
    const int r = lane >> 3, c4 = (lane & 7) * 4;
#pragma unroll
    for (int j = 0; j < 8; ++j) v[j] = *(const f32x4*)(t.W + (size_t)(t.k0 + 8 * j + r) * t.ldn + t.n0 + c4);
}
template <bool WT = false> __device__ __forceinline__ void transpose_finish(const TrItem& t, const f32x4 (&v)[8], LAS float* scr, int lane) {
    const int r = lane >> 3, c4 = (lane & 7) * 4;
#pragma unroll
    for (int j = 0; j < 8; ++j) { LAS float* d = scr + (8 * j + r) * 33 + c4; d[0] = v[j][0]; d[1] = v[j][1]; d[2] = v[j][2]; d[3] = v[j][3]; }
    LDS_WAIT(); asm volatile("" ::: "memory");
    const int c = lane & 7;
#pragma unroll
    for (int j = 0; j < 4; ++j) { const int n = (lane >> 3) + 8 * j; const LAS float* s = scr + (8 * c) * 33 + n;
        v4u o; o.x = pk2(s[0 * 33], s[1 * 33]); o.y = pk2(s[2 * 33], s[3 * 33]); o.z = pk2(s[4 * 33], s[5 * 33]); o.w = pk2(s[6 * 33], s[7 * 33]);
        bf16* dp_ = t.WT + (size_t)(t.drow0 + n) * t.ldk + t.k0 + 8 * c;
        if (WT) { __hip_atomic_store((unsigned long long*)dp_, ((unsigned long long)o.y << 32) | o.x, __ATOMIC_RELAXED, __HIP_MEMORY_SCOPE_AGENT); __hip_atomic_store((unsigned long long*)dp_ + 1, ((unsigned long long)o.w << 32) | o.z, __ATOMIC_RELAXED, __HIP_MEMORY_SCOPE_AGENT); }
        else *(GAS v4u*)dp_ = o; }
    LDS_WAIT(); asm volatile("" ::: "memory");
}
__device__ __forceinline__ void deferred_wdn(Frame& F, const Args& A, unsigned char* ws, int widx, int nwg, int l) {
    int tid_ = F.wave * 64 + lane_id(); asm volatile("" : "+v"(tid_)); const int lane = tid_ & 63;
    LAS float* scr = (LAS float*)(F.lds + F.wave * 16384);
    constexpr int I_D = 44 * 32, I_OUT = 16 * 32;
    for (int it = widx * NWAVES + F.wave; it < I_D + I_OUT; it += nwg * NWAVES) {
        TrItem t;
        if (it < I_D) { const int kb = it / 32, nb = it % 32; t = TrItem{A.in[20] + (size_t)l * FFD * DM, (bf16*)(ws + WS_WDN) + (size_t)l * DM * FFD, DM, FFD, kb * 64, nb * 32, nb * 32}; }
        else { const int r = it - I_D, kb = r / 32, nb = r % 32; t = TrItem{A.in[17] + (size_t)l * DM * DM, (bf16*)(ws + WS_WOUT) + (size_t)l * DM * DM, DM, DM, kb * 64, nb * 32, nb * 32}; }
        f32x4 v[8]; transpose_load(t, v, lane); transpose_finish<true>(t, v, scr, lane);
    }
}
__device__ __forceinline__ void ph0(Frame& F, const Args& A, unsigned char* ws) {
    int tid_ = F.wave * 64 + lane_id(); asm volatile("" : "+v"(tid_));
    LAS float* scr = (LAS float*)(F.lds + F.wave * 16384);
    const int gw = F.vcu * NWAVES + F.wave, NGW = F.G * NWAVES;
    SUBSTAMP(0);
    constexpr int I_IN = 16 * 48, I_OUT = 16 * 32, I_G = 16 * 88, I_D = 44 * 32, I_LAYER = I_IN + I_OUT + 2 * I_G + I_D;
    const bool dfr = DEFER_WDN && F.G == 256; const int IL = dfr ? I_LAYER - I_D - I_OUT : I_LAYER;
    auto decode = [&](int it, TrItem& t) __attribute__((always_inline)) {
        const int l = it / IL; int r = it % IL;
        if (r < I_IN) { const int kb = r / 48, nb = r % 48, n0 = nb * 32, pn = n0 >> 8, cc = n0 & 255; const int drow = pn < 4 ? pn * 256 + ((cc >> 5) & 1) * 128 + (cc >> 6) * 32 : n0;
            t = TrItem{A.in[8] + (size_t)l * DM * NINSRC, (bf16*)(ws + WS_WIN) + (size_t)l * NIN * DM, NINSRC, DM, kb * 64, n0, drow}; return; } r -= I_IN;
        if (!dfr) { if (r < I_OUT) { const int kb = r / 32, nb = r % 32; t = TrItem{A.in[17] + (size_t)l * DM * DM, (bf16*)(ws + WS_WOUT) + (size_t)l * DM * DM, DM, DM, kb * 64, nb * 32, nb * 32}; return; } r -= I_OUT; }
        if (r < 2 * I_G) { const int up = r >= I_G; if (up) r -= I_G; const int kb = r / 88, nb = r % 88, n0 = nb * 32; const int drow = (n0 >> 7) * 256 + up * 128 + (n0 & 127);
            t = TrItem{(up ? A.in[19] : A.in[18]) + (size_t)l * DM * FFD, (bf16*)(ws + WS_WGU) + (size_t)l * NGU * DM, FFD, DM, kb * 64, n0, drow}; return; } r -= 2 * I_G;
        { const int kb = r / 32, nb = r % 32; t = TrItem{A.in[20] + (size_t)l * FFD * DM, (bf16*)(ws + WS_WDN) + (size_t)l * DM * FFD, DM, FFD, kb * 64, nb * 32, nb * 32}; } };
    { const int lane = tid_ & 63; TrItem ta, tb; f32x4 va[8], vb[8];
      const bool split_ = dfr && PH0_BAL; const bool hi_ = split_ && F.vcu >= 192;
      const int NITEM = split_ ? (hi_ ? NLAYER * IL : 1536 * 3) : NLAYER * IL, STRIDE = split_ ? (hi_ ? 512 : 1536) : NGW;
      int it = hi_ ? 1536 * 3 + (gw - 1536) : gw;
      if (it < NITEM) { decode(it, ta); transpose_load(ta, va, lane); }
      while (it < NITEM) {
          const int it2 = it + STRIDE, it3 = it2 + STRIDE;
          if (it2 < NITEM) { decode(it2, tb); transpose_load(tb, vb, lane); }
          transpose_finish(ta, va, scr, lane);
          if (it2 >= NITEM) break;
          if (it3 < NITEM) { decode(it3, ta); transpose_load(ta, va, lane); }
          transpose_finish(tb, vb, scr, lane);
          it = it3;
      } }
    __syncthreads();
    SUBSTAMP(1);
    LAS float* sl = (LAS float*)F.lds;
    LAS float* red = (LAS float*)(F.lds + 40960);
    { f32x4 v[5];
#pragma unroll
      for (int q = 0; q < 5; ++q) { const int i4 = tid_ + q * (NWAVES * 64); const int j = i4 >> 8, k4 = (i4 & 255) * 4; v[q] = (i4 < 9 * 256) ? *(const f32x4*)((j < 8) ? A.in[1] + j * DM + k4 : A.in[3] + k4) : (f32x4){0.f, 0.f, 0.f, 0.f}; }
#pragma unroll
      for (int q = 0; q < 5; ++q) { const int i4 = tid_ + q * (NWAVES * 64); if (i4 < 9 * 256) { f32x4 s; for (int e = 0; e < 4; ++e) s[e] = v[q][e] / (1.f + __expf(-v[q][e])); *(LAS f32x4*)(sl + i4 * 4) = s; } } }
    __syncthreads();
    {
        const int cq = tid_ & 15, rg = tid_ >> 4;
        for (int it = F.vcu; it < NLAYER * 96; it += F.G) {
            const int l = it / 96, cb = it % 96;
            const float* W_ = A.in[4] + (size_t)l * DM * 6144 + (size_t)rg * 6144 + cb * 64 + cq * 4;
            f32x4 w[32];
#pragma unroll
            for (int i = 0; i < 32; ++i) w[i] = *(const f32x4*)(W_ + (size_t)(32 * i) * 6144);
            f32x4 acc[9];
#pragma unroll
            for (int j = 0; j < 9; ++j) acc[j] = (f32x4){0.f, 0.f, 0.f, 0.f};
#pragma unroll
            for (int i = 0; i < 32; ++i)
#pragma unroll
                for (int j = 0; j < 9; ++j) acc[j] += w[i] * sl[j * DM + rg + 32 * i];
#pragma unroll
            for (int j = 0; j < 9; ++j) *(LAS f32x4*)(red + (rg * 9 + j) * 64 + cq * 4) = acc[j];
            __syncthreads();
            for (int i = tid_; i < 9 * 64; i += NWAVES * 64) { const int j = i >> 6, cn = i & 63; float s = 0.f;
#pragma unroll
                for (int r = 0; r < 32; ++r) s += red[(r * 9 + j) * 64 + cn];
                const int nn = cb * 64 + cn;
                ((float*)(ws + WS_MOD))[(l * 9 + j) * 6144 + nn] = s + A.in[5][l * 6144 + nn]; }
            __syncthreads();
        }
    }
    SUBSTAMP(2);
    const int gt = F.vcu * (NWAVES * 64) + tid_, NGT = F.G * NWAVES * 64;
    for (int i = gt; i < 96 * 16; i += NGT) { const int p = i >> 4, j = i & 15; const float inv = powf(10000.0f, -(float)j * (1.0f / 16.0f)); const float ang = (float)(p < 32 ? p : p - 32) * inv;
        float sn, cs; sincosf(ang, &sn, &cs); ((float*)(ws + WS_ROPE))[i] = cs; ((float*)(ws + WS_ROPE))[1536 + i] = sn; }
    for (int i = gt; i < 256 * 512; i += NGT) { const int m = i >> 9, kk = i & 511, n = kk >> 1; const int p = (m * n) & 255; float sn, cs; sincospif((float)p * (1.0f / 128.0f), &sn, &cs);
        ((bf16*)(ws + WS_DFT))[i] = (bf16)f2bf((kk & 1) ? sn : cs); }
    SUBSTAMP(3);
    __syncthreads();
    for (int it = F.vcu; it < NLAYER * 4 * 32; it += F.G) {
        const int lg = it >> 5, rb = (it >> 3) & 3, cb = it & 7, ri = cb >> 2;
        LAS float* ct = (LAS float*)F.lds; LAS float* st = ct + 128; LAS float* comb = ct + 256;
        const int lane = tid_ & 63, l32 = lane & 31, hi = lane >> 5;
        const int d = (cb * 32 + l32) & 127, cc = rb * 32 + l32, cp0 = F.wave * 16 + hi;
        float bv[8];
#pragma unroll
        for (int s2 = 0; s2 < 8; ++s2) bv[s2] = A.in[16][(size_t)lg * 128 * 128 + (size_t)(cp0 + 2 * s2) * 128 + d];
        if (tid_ < 128) { float sn, cs; sincospif((float)tid_ * (1.0f / 64.0f), &sn, &cs); ct[tid_] = cs; st[tid_] = sn; }
        __syncthreads();
        typedef float f32x16_t __attribute__((ext_vector_type(16)));
        f32x16_t acc = {};
#pragma unroll
        for (int s2 = 0; s2 < 8; ++s2) { const int p = (cc * (cp0 + 2 * s2)) & 127; const float a = ri ? -st[p] : ct[p]; acc = __builtin_amdgcn_mfma_f32_32x32x2f32(a, bv[s2], acc, 0, 0, 0); }
#pragma unroll
        for (int r = 0; r < 16; ++r) comb[(F.wave * 16 + r) * 64 + lane] = acc[r];
        __syncthreads();
#pragma unroll
        for (int rr = 0; rr < 2; ++rr) { const int r = F.wave * 2 + rr; float s = 0.f;
#pragma unroll
            for (int w8 = 0; w8 < 8; ++w8) s += comb[(w8 * 16 + r) * 64 + lane];
            const int row = rb * 32 + 8 * (r >> 2) + 4 * hi + (r & 3);
            ((float*)(ws + WS_TF))[(size_t)lg * 32768 + row * 256 + cb * 32 + l32] = s; }
        __syncthreads();
    }
    SUBSTAMP(4);
}
__device__ __forceinline__ void ph1(Frame& F, const Args& A, unsigned char* ws, bool grp) {
    int tid_ = F.wave * 64 + lane_id(); asm volatile("" : "+v"(tid_));
    const float* mod = (const float*)(ws + WS_MOD);
    SUBSTAMP(5);
    { const int gw = F.vcu * NWAVES + F.wave, NGW = F.G * NWAVES; const int lane = tid_ & 63;
      const int RPW = (M_ALL + NGW - 1) / NGW; int r0 = gw * RPW, r1 = (r0 + RPW < M_ALL) ? r0 + RPW : M_ALL;
      const int gv_ = (int)blockIdx.x & 7;
      if (grp) { r0 = (((int)blockIdx.x >> 3) * NWAVES + F.wave) * 9; r1 = r0 + 9; }
      auto rowof = [&](int i) __attribute__((always_inline)) { return grp ? (i < 2048 ? gv_ * 2048 + i : M_LAT + gv_ * 256 + i - 2048) : i; };
      f32x4 gv[4]; int gbm = -1;
      auto loadrow = [&](int ri, f32x4 (&v)[4]) __attribute__((always_inline)) { const int row = rowof(ri); const float* xr = row < M_LAT ? A.in[0] + (size_t)row * DM : A.in[2] + (size_t)(row - M_LAT) * DM;
#pragma unroll
          for (int j = 0; j < 4; ++j) v[j] = *(const f32x4*)(xr + 256 * j + 4 * lane); };
      auto finish = [&](int ri, const f32x4 (&v)[4]) __attribute__((always_inline)) { const int row = rowof(ri);
          float s = 0.f;
#pragma unroll
          for (int j = 0; j < 4; ++j) s += (v[j][0] * v[j][0] + v[j][1] * v[j][1]) + (v[j][2] * v[j][2] + v[j][3] * v[j][3]);
          s = wave_sum(s);
          const int bm = row < M_LAT ? (row >> 11) : 8;
          if (bm != gbm) { const float* sc = mod + bm * 6144 + 1024; gbm = bm;
#pragma unroll
              for (int j = 0; j < 4; ++j) { const int k = 256 * j + 4 * lane; gv[j] = *(const f32x4*)(A.in[6] + k) * (*(const f32x4*)(sc + k) + 1.0f); } }
          bf16* ar = (bf16*)(ws + WS_A) + (size_t)row * DM;
          _Float16* hr = row < M_LAT ? (_Float16*)A.out + (size_t)row * DM : (_Float16*)(ws + WS_XC) + (size_t)(row - M_LAT) * DM;
#pragma unroll
          for (int j = 0; j < 4; ++j) { v2u h; h.x = pg8::pkh2(v[j][0], v[j][1]); h.y = pg8::pkh2(v[j][2], v[j][3]); *(v2u*)(hr + 256 * j + 4 * lane) = h; }
#pragma unroll
          for (int j = 0; j < 4; ++j) { const f32x4 a = v[j] * gv[j]; v2u w; w.x = pk2(a[0], a[1]); w.y = pk2(a[2], a[3]); *(v2u*)(ar + 256 * j + 4 * lane) = w; }
          if (lane < 16) ((float*)(ws + WS_SSQ))[(size_t)row * 16 + lane] = lane == 0 ? s : 0.f; };
      f32x4 va[4], vb[4], vc[4];
      int row = r0;
      if (row < r1) loadrow(row, va); if (row + 1 < r1) loadrow(row + 1, vb);
      for (; row < r1; row += 3) {
          if (row + 2 < r1) loadrow(row + 2, vc);
          finish(row, va);
          if (row + 1 >= r1) break;
          if (row + 3 < r1) loadrow(row + 3, va);
          finish(row + 1, vb);
          if (row + 2 >= r1) break;
          if (row + 4 < r1) loadrow(row + 4, vb);
          finish(row + 2, vc);
      } }
    __syncthreads();
    SUBSTAMP(6);
    { LAS float* wl = (LAS float*)F.lds;
      LAS float* tl = (LAS float*)(F.lds + 128 * 132 * 4);
      LAS float* shl = (LAS float*)(F.lds + 128 * 132 * 4 + 128 * 64 * 4);
      LAS float* redl = shl + 9 * 128;
      for (int it = F.vcu; it < NLAYER * 4 * 4 * 8; it += F.G) {
          const int kb = it & 7, q = (it >> 3) & 3, g = (it >> 5) & 3, l = it >> 7;
          const float* wsrc = A.in[8] + (size_t)l * DM * NINSRC + (size_t)(kb * 128) * NINSRC + 1536 + g * 128;
          f32x4 wv[8], tv[4];
#pragma unroll
          for (int q = 0; q < 8; ++q) { const int i = tid_ + q * (NWAVES * 64); wv[q] = *(const f32x4*)(wsrc + (size_t)(i >> 5) * NINSRC + (i & 31) * 4); }
          const float* tsrc = (const float*)(ws + WS_TF) + (size_t)(l * 4 + g) * 128 * 256 + q * 64;
#pragma unroll
          for (int q = 0; q < 4; ++q) { const int i = tid_ + q * (NWAVES * 64); tv[q] = *(const f32x4*)(tsrc + (size_t)(i >> 4) * 256 + (i & 15) * 4); }
#pragma unroll
          for (int q = 0; q < 8; ++q) { const int i = tid_ + q * (NWAVES * 64); *(LAS f32x4*)(wl + (i >> 5) * 132 + (i & 31) * 4) = wv[q]; }
#pragma unroll
          for (int q = 0; q < 4; ++q) { const int i = tid_ + q * (NWAVES * 64); *(LAS f32x4*)(tl + (i >> 4) * 64 + (i & 15) * 4) = tv[q]; }
          if (tid_ < 9 * 32) *(LAS f32x4*)(shl + tid_ * 4) = *(const f32x4*)(mod + (l * 9 + (tid_ >> 5)) * 6144 + kb * 128 + (tid_ & 31) * 4);
          __syncthreads();
          const int lane_ = tid_ & 63, l32 = lane_ & 31, hi = lane_ >> 5, wk = F.wave >> 1, wc = F.wave & 1, dcol = wc * 32 + l32;
          typedef float f32x16_t __attribute__((ext_vector_type(16)));
          f32x16_t acc = {};
          { const LAS float* ap = wl + (wk * 32 + l32) * 132 + hi; const LAS float* bp = tl + hi * 64 + dcol;
#pragma unroll 8
            for (int s2 = 0; s2 < 64; ++s2) acc = __builtin_amdgcn_mfma_f32_32x32x2f32(ap[2 * s2], bp[2 * s2 * 64], acc, 0, 0, 0); }
          bf16* dst = (bf16*)(ws + WS_WIN) + (size_t)l * NIN * DM + (size_t)(1536 + g * 256 + q * 64 + dcol) * DM + kb * 128 + wk * 32 + hi * 4;
#pragma unroll
          for (int gq = 0; gq < 4; ++gq) { v2u o; o.x = pk2(acc[4 * gq], acc[4 * gq + 1]); o.y = pk2(acc[4 * gq + 2], acc[4 * gq + 3]); __hip_atomic_store((unsigned long long*)(dst + 8 * gq), ((unsigned long long)o.y << 32) | o.x, __ATOMIC_RELAXED, __HIP_MEMORY_SCOPE_AGENT); }
#pragma unroll
          for (int j = 0; j < 9; ++j) { float s = 0.f;
#pragma unroll
              for (int gq = 0; gq < 4; ++gq) { const f32x4 sv = *(const LAS f32x4*)(shl + j * 128 + wk * 32 + gq * 8 + hi * 4); s += sv[0] * acc[4 * gq] + sv[1] * acc[4 * gq + 1] + sv[2] * acc[4 * gq + 2] + sv[3] * acc[4 * gq + 3]; }
              redl[((wk * 2 + hi) * 9 + j) * 64 + dcol] = s; }
          __syncthreads();
          for (int i = tid_; i < 9 * 64; i += NWAVES * 64) { const int j = i >> 6, dc = i & 63; float s = 0.f;
#pragma unroll
              for (int w = 0; w < 8; ++w) s += redl[(w * 9 + j) * 64 + dc];
              atomicAdd((float*)(ws + WS_BIN) + (l * 9 + j) * NIN + 1536 + g * 256 + q * 64 + dc, s); }
          __syncthreads();
      } }
    SUBSTAMP(7);
    for (int t0 = F.vcu * 4; t0 < 896; t0 += F.G * 4) {
      LAS unsigned short* sh16 = (LAS unsigned short*)F.lds; LAS float* comb = (LAS float*)(F.lds + 32768);
      int set, nb; if (t0 < 96) { set = 0; nb = t0; } else if (t0 < 448) { set = 1; nb = t0 - 96; } else if (t0 < 544) { set = 2; nb = t0 - 448; } else { set = 3; nb = t0 - 544; }
      const int l = set >> 1, gu = set & 1;
#pragma unroll
      for (int q = 0; q < 8; ++q) { const int i = tid_ + q * (NWAVES * 64); const int row = i >> 8, k4 = (i & 255) * 4; v2u o = {0u, 0u};
          if (row < 9) { const f32x4 v = *(const f32x4*)(mod + (l * 9 + row) * 6144 + (gu ? 3072 : 0) + k4); o.x = pk2(v[0], v[1]); o.y = pk2(v[2], v[3]); }
          *(LAS v2u*)(sh16 + (size_t)i * 4) = o; }
      typedef short bf8 __attribute__((ext_vector_type(8)));
      const int lane = tid_ & 63, fr = lane & 15, fq = lane >> 4, tk = F.wave & 3, kh = F.wave >> 2;
      const int n0 = (nb + tk) * 16;
      const bf16* WT = gu ? (const bf16*)(ws + WS_WGU) + (size_t)l * NGU * DM : (const bf16*)(ws + WS_WIN) + (size_t)l * NIN * DM;
      const bf16* wrow = WT + (size_t)(n0 + fr) * DM + kh * 512 + fq * 8; const LAS unsigned short* arow = sh16 + fr * 1024 + kh * 512 + fq * 8;
      bf8 b[16];
#pragma unroll
      for (int q = 0; q < 16; ++q) b[q] = *(const bf8*)(wrow + q * 32);
      __syncthreads();
      pg8::f32x4 acc = {0.f, 0.f, 0.f, 0.f};
#pragma unroll
      for (int q = 0; q < 16; ++q) { const bf8 a = *(const LAS bf8*)(arow + q * 32); acc = __builtin_amdgcn_mfma_f32_16x16x32_bf16(a, b[q], acc, 0, 0, 0); }
      if (kh) *(LAS pg8::f32x4*)(comb + (tk * 64 + lane) * 4) = acc;
      __syncthreads();
      if (!kh) { const pg8::f32x4 o2 = *(const LAS pg8::f32x4*)(comb + (tk * 64 + lane) * 4); acc += o2;
          float* bo = gu ? (float*)(ws + WS_BGU) + l * 9 * NGU : (float*)(ws + WS_BIN) + l * 9 * NIN; const int ldb = gu ? NGU : NIN;
#pragma unroll
          for (int r = 0; r < 4; ++r) { const int j = fq * 4 + r; if (j < 9) __hip_atomic_store(bo + j * ldb + n0 + fr, acc[r], __ATOMIC_RELAXED, __HIP_MEMORY_SCOPE_AGENT); } }
      __syncthreads();
    }
    SUBSTAMP(8);
}
__device__ __forceinline__ void fft8(float (&xr)[8], float (&xi)[8]) {
    const float S = 0.70710678118654752f;
    const float u0r = xr[0] + xr[4], u0i = xi[0] + xi[4], d0r = xr[0] - xr[4], d0i = xi[0] - xi[4];
    const float u1r = xr[1] + xr[5], u1i = xi[1] + xi[5], d1r = xr[1] - xr[5], d1i = xi[1] - xi[5];
    const float u2r = xr[2] + xr[6], u2i = xi[2] + xi[6], d2r = xr[2] - xr[6], d2i = xi[2] - xi[6];
    const float u3r = xr[3] + xr[7], u3i = xi[3] + xi[7], d3r = xr[3] - xr[7], d3i = xi[3] - xi[7];
    const float v0r = d0r, v0i = d0i;
    const float v1r = (d1r + d1i) * S, v1i = (d1i - d1r) * S;
    const float v2r = d2i, v2i = -d2r;
    const float v3r = (d3i - d3r) * S, v3i = -(d3r + d3i) * S;
    { const float p0r = u0r + u2r, p0i = u0i + u2i, p1r = u1r + u3r, p1i = u1i + u3i, p2r = u0r - u2r, p2i = u0i - u2i, qr = u1r - u3r, qi = u1i - u3i; const float p3r = qi, p3i = -qr;
      xr[0] = p0r + p1r; xi[0] = p0i + p1i; xr[4] = p0r - p1r; xi[4] = p0i - p1i; xr[2] = p2r + p3r; xi[2] = p2i + p3i; xr[6] = p2r - p3r; xi[6] = p2i - p3i; }
    { const float p0r = v0r + v2r, p0i = v0i + v2i, p1r = v1r + v3r, p1i = v1i + v3i, p2r = v0r - v2r, p2i = v0i - v2i, qr = v1r - v3r, qi = v1i - v3i; const float p3r = qi, p3i = -qr;
      xr[1] = p0r + p1r; xi[1] = p0i + p1i; xr[5] = p0r - p1r; xi[5] = p0i - p1i; xr[3] = p2r + p3r; xi[3] = p2i + p3i; xr[7] = p2r - p3r; xi[7] = p2i - p3i; }
}
__device__ __forceinline__ void butterfly_phase(Frame& F, unsigned char* ws, int grp, int l) {
    bf16* T = (bf16*)(ws + WS_T);
    int tid_ = F.wave * 64 + lane_id(); asm volatile("" : "+v"(tid_));
    int gt = F.vcu * (NWAVES * 64) + tid_, NGT = F.G * NWAVES * 64, itend = NBATCH * 512 * 128;
    if (grp >= 0) {
        const int w_ = (int)blockIdx.x >> 3; const int lo_ = l == 0 ? 26 : 24; if (BF_HALF && w_ >= 8 && w_ < lo_) return;
        const int np_ = BF_HALF ? 8 + 32 - lo_ : 32, p_ = BF_HALF ? (w_ < 8 ? w_ : w_ - lo_ + 8) : w_;
        NGT = np_ * NWAVES * 64; gt = grp * (512 * 128) + p_ * (NWAVES * 64) + tid_; itend = (grp + 1) * (512 * 128); }
    for (int it = gt; it < itend; it += NGT) {
        const int n0 = (it & 127) * 2, bc = it >> 7, b = bc >> 9, ch = bc & 511; bf16* tp = T + ((size_t)(b * 8) * 512 + ch) * 512 + n0 * 2;
        v2u q[8];
#pragma unroll
        for (int j = 0; j < 8; ++j) q[j] = *(const v2u*)(tp + (size_t)j * 512 * 512);
        float ar[8], ai[8], br[8], bi[8];
#define BF_UNP(k) ar[k] = __builtin_bit_cast(float, q[k].x << 16); ai[k] = __builtin_bit_cast(float, q[k].x & 0xffff0000u); br[k] = __builtin_bit_cast(float, q[k].y << 16); bi[k] = __builtin_bit_cast(float, q[k].y & 0xffff0000u);
        BF_UNP(0) BF_UNP(1) BF_UNP(2) BF_UNP(3) BF_UNP(4) BF_UNP(5) BF_UNP(6) BF_UNP(7)
#undef BF_UNP
        fft8(ar, ai); fft8(br, bi);
        float c0[8], s0[8], c1[8], s1[8];
        sincospif((float)n0 * (1.0f / 1024.0f), &s0[1], &c0[1]); sincospif((float)(n0 + 1) * (1.0f / 1024.0f), &s1[1], &c1[1]);
#define BF_CM(C, S, d, a, b) C[d] = C[a] * C[b] - S[a] * S[b]; S[d] = C[a] * S[b] + S[a] * C[b];
        BF_CM(c0, s0, 2, 1, 1) BF_CM(c0, s0, 3, 2, 1) BF_CM(c0, s0, 4, 2, 2) BF_CM(c0, s0, 5, 4, 1) BF_CM(c0, s0, 6, 3, 3) BF_CM(c0, s0, 7, 4, 3)
        BF_CM(c1, s1, 2, 1, 1) BF_CM(c1, s1, 3, 2, 1) BF_CM(c1, s1, 4, 2, 2) BF_CM(c1, s1, 5, 4, 1) BF_CM(c1, s1, 6, 3, 3) BF_CM(c1, s1, 7, 4, 3)
#undef BF_CM
        { v2u o_; o_.x = pk2(ar[0], ai[0]); o_.y = pk2(br[0], bi[0]); *(v2u*)tp = o_; }
#define BF_OUT(r) { v2u o_; o_.x = pk2(ar[r] * c0[r] + ai[r] * s0[r], ai[r] * c0[r] - ar[r] * s0[r]); o_.y = pk2(br[r] * c1[r] + bi[r] * s1[r], bi[r] * c1[r] - br[r] * s1[r]); *(v2u*)(tp + (size_t)(r) * 512 * 512) = o_; }
        BF_OUT(1) BF_OUT(2) BF_OUT(3) BF_OUT(4) BF_OUT(5) BF_OUT(6) BF_OUT(7)
#undef BF_OUT
    }
}
template <bool SYNC, class S> __device__ __forceinline__ void compute_rtab(Frame& F, unsigned char* ws, const S& sched, const float* bias, int NC) {
    LAS float* rt = (LAS float*)(F.lds + RTAB_OFF); LAS float* bt = (LAS float*)(F.lds + BTAB_OFF); pg8::Unit u;
    int tid_ = F.wave * 64 + lane_id(); asm volatile("" : "+v"(tid_));
    const int t = tid_ & 255, par = tid_ >> 8;
    for (int i = 0; i < 7 && sched.next(i, u); ++i) if ((i & 1) == par) { const float* p = (const float*)(ws + WS_SSQ) + ((size_t)u.pm * 256 + t) * 16; float s = 0.f;
        const float bvv = bias[(u.pm < 64 ? (u.pm >> 3) : 8) * NC + u.pn * 256 + t];
#pragma unroll
        for (int q = 0; q < 4; ++q) { const f32x4 a = *(const f32x4*)(p + 4 * q); s += (a[0] + a[1]) + (a[2] + a[3]); }
        rt[i * 256 + t] = __builtin_amdgcn_rsqf(s * (1.0f / 1024.0f) + 1e-6f); bt[i * 256 + t] = bvv; }
    if (SYNC) __syncthreads();
}
__device__ __forceinline__ void attn_phase(Frame& F, const Args& A, unsigned char* ws, int l, char* lds) {
    int tid_ = F.wave * 64 + lane_id(); asm volatile("" : "+v"(tid_));
    const float lambda_init = l == 0 ? 0.2f : 0.355509068f;
    const float lam = expf(wave_sum(A.in[11][l * 64 + (tid_ & 63)] * A.in[12][l * 64 + (tid_ & 63)])) - expf(wave_sum(A.in[13][l * 64 + (tid_ & 63)] * A.in[14][l * 64 + (tid_ & 63)])) + lambda_init;
    float gq = fabsf(A.in[9][l * 64 + (tid_ & 63)]), gk = fabsf(A.in[10][l * 64 + (tid_ & 63)]);
#define MAXSTEP(M) do { gq = fmaxf(gq, xshfl<M>(gq)); gk = fmaxf(gk, xshfl<M>(gk)); } while (0)
    MAXSTEP(1); MAXSTEP(2); MAXSTEP(4); MAXSTEP(8); MAXSTEP(16); MAXSTEP(32);
#undef MAXSTEP
    const float negoff = -fmaxf(0.f, 8.0f * 1.4426950408889634f * gq * gk * 1.0001f - 40.0f);
    const att::bf16* QB = (const att::bf16*)(ws + WS_QB); const att::bf16* KB = (const att::bf16*)(ws + WS_KB); const att::bf16* VB = (const att::bf16*)(ws + WS_VB); att::bf16* MIX = (att::bf16*)(ws + WS_MIX);
    const float* subg = A.in[15] + l * 128;
    const int per = (512 + F.G - 1) / F.G;
    for (int u = F.vcu * per; u < (F.vcu + 1) * per && u < 512; ++u) {
        const int qblk = u & 15, bh = u >> 4, b = bh >> 2, h = bh & 3;
        att::attn_unit(QB + h * 128, KB + h * 128, VB + h * 128, MIX + h * 128, (long)b * SEQ + qblk * 128, (long)M_LAT + b * CTXL, 4, (long)b * SEQ, 36, lam, 1.0f - lambda_init, subg, negoff, lds, F.wave, (unsigned)(uintptr_t)F.lds);
    }
#if EN_ATTC
    if (l == 0) {
        const bool gm = (F.G & 7) == 0 && (F.G >> 3) >= 8;
        for (int u = gm ? (((int)blockIdx.x >> 3) < 8 ? (((int)blockIdx.x & 7) * 8 + ((int)blockIdx.x >> 3)) : 64) : F.vcu; u < 64; u += gm ? 64 : F.G) {
            const int qblk = u & 1, bh = u >> 1, b = bh >> 2, h = bh & 3;
            att::attn_unit(QB + h * 128, KB + h * 128, VB + h * 128, MIX + h * 128, (long)M_LAT + b * CTXL + qblk * 128, (long)M_LAT + b * CTXL, 4, 0, 4, lam, 1.0f - lambda_init, subg, negoff, lds, F.wave, (unsigned)(uintptr_t)F.lds);
        }
    }
#endif
}

__device__ __forceinline__ void group_arrive(unsigned* cw0, int v, bool t0, volatile LAS unsigned* gen) {
    asm volatile("s_waitcnt vmcnt(0)" ::: "memory");
    __syncthreads();
    if (t0) { const unsigned g_ = *gen; *gen = g_ + 1u; (void)xb_add(cw0 + 64 * v, 1u); }
}
__device__ __forceinline__ void group_barrier(unsigned* cw0, int v, unsigned nloc, bool t0, volatile LAS unsigned* gen, unsigned wmask, unsigned wgen) {
    asm volatile("s_waitcnt vmcnt(0)" ::: "memory");
    __syncthreads();
    if (t0) {
        unsigned* cw = cw0 + 64 * v; const unsigned g_ = *gen; *gen = g_ + 1u; (void)xb_add(cw, 1u); const unsigned target = (g_ + 1u) * nloc; unsigned sp = 0u;
        while (xb_ld(cw) < target) { __builtin_amdgcn_s_sleep(1); if (++sp > XB_SPIN_CAP * 16u) break; }
        for (int g2 = 0; g2 < 8; ++g2) if ((wmask >> g2) & 1u) { while (xb_ld(cw0 + 64 * g2) < (wgen + 1u) * nloc) { __builtin_amdgcn_s_sleep(1); if (++sp > XB_SPIN_CAP * 16u) break; } }
        __builtin_amdgcn_fence(__ATOMIC_ACQUIRE, "agent"); asm volatile("s_waitcnt vmcnt(0)" ::: "memory");
    }
    __syncthreads();
}
__global__ void __launch_bounds__(NWAVES * 64, 2) fwd_kernel(const Args args) {
    extern __shared__ __attribute__((aligned(16))) unsigned char lds[];
    Frame F0;
    F0.lds = (LAS unsigned char*)lds;
    F0.wave = __builtin_amdgcn_readfirstlane((int)threadIdx.x >> 6);
    F0.G = gridDim.x; { const int bx = blockIdx.x; F0.vcu = (F0.G % 8 == 0) ? (bx % 8) * (F0.G / 8) + bx / 8 : bx; }
    for (int u = ((int)threadIdx.x); u < (LDS_BYTES - LDSCTL_OFF) / 4; u += NWAVES * 64) ((LAS unsigned*)(F0.lds + LDSCTL_OFF))[u] = 0u;
    __syncthreads();
    volatile LAS unsigned* MISC = (volatile LAS unsigned*)(F0.lds + MISC_OFF);
    (void)xcd_barrier_post((unsigned*)(args.ws + WS_CTL) + CW_BAR, MISC + 8);
    if (threadIdx.x == 0) __hip_atomic_store((unsigned*)(args.ws + WS_CTL) + CW_HWX + blockIdx.x, xb_xcc_id() + 1u, __ATOMIC_RELAXED, __HIP_MEMORY_SCOPE_AGENT);
    const int lo = args.ph_lo, hi = args.ph_hi;
    const int cid = (int)blockIdx.x;
    const LAS float* rtab = (const LAS float*)(F0.lds + RTAB_OFF);
#pragma unroll 1
    for (int ph = lo; ph < hi; ++ph) {
#if PROBE_A
        if (blockIdx.x == 0 && F0.wave == 0) MISC[16 + ph] = (unsigned)__builtin_amdgcn_s_memrealtime();
#endif
        unsigned char* ws = args.ws; asm volatile("" : "+s"(ws)); const Args& A = args;
        Frame F = F0; asm volatile("" : "+s"(F.G), "+s"(F.vcu), "+s"(F.wave));
        int l = 0, k = -1; if (ph >= 2) { l = (ph - 2) / 6; k = (ph - 2) % 6; }
        if (LOCAL_BAR && lo == 0 && ph == 1) {
            if (F.wave == 0) {
                unsigned* ctl = (unsigned*)(ws + WS_CTL); const int ln = lane_id(); bool ok = F.G == 256;
                if (ok) { const unsigned rep = xb_ld(ctl + CW_HWX + (ln & 7)); ok = rep != 0u;
                    for (int q = 0; q < 4; ++q) ok = ok && (xb_ld(ctl + CW_HWX + ln + 64 * q) == rep); }
                const bool all = __builtin_amdgcn_ballot_w64(!ok) == 0ull;
                if (ln == 0) MISC[13] = (all && !FORCE_IRREG) ? 1u : 2u; }
            __syncthreads();
        }
        if (LOCAL_BAR && lo == 0 && ph == 2 && MISC[13] == 1u) {
            if (F.wave == 0 && lane_id() == 0) { unsigned* cw = (unsigned*)(ws + WS_CTL) + CW_FGCNT; unsigned sp = 0;
                while (xb_ld(cw) < (unsigned)F.G) { __builtin_amdgcn_s_sleep(1); if (++sp > (1u << 22)) break; }
                __builtin_amdgcn_fence(__ATOMIC_ACQUIRE, "agent"); asm volatile("s_waitcnt vmcnt(0)" ::: "memory"); }
            __syncthreads();
        }
        if (DEFER_WDN && lo == 0 && (ph == 5 || ph == 11) && F.G == 256) {
            if (F.wave == 0 && lane_id() == 0) { unsigned* cw = (unsigned*)(ws + WS_CTL) + CW_DT + (ph == 5 ? 0 : 64); unsigned sp = 0;
                while (xb_ld(cw) < (ph == 5 ? 48u : 96u)) { __builtin_amdgcn_s_sleep(1); if (++sp > (1u << 22)) break; }
                __builtin_amdgcn_fence(__ATOMIC_ACQUIRE, "agent"); asm volatile("s_waitcnt vmcnt(0)" ::: "memory"); }
            __syncthreads();
        }
        if (ph == 0) ph0(F, A, ws);
        else if (ph == 1) { ph1(F, A, ws, LOCAL_BAR && MISC[13] == 1u);
            asm volatile("s_waitcnt vmcnt(0)" ::: "memory"); __syncthreads();
            if (F.wave == 0 && lane_id() == 0) __hip_atomic_fetch_add((unsigned*)(ws + WS_CTL) + CW_FGCNT, 1u, __ATOMIC_RELAXED, __HIP_MEMORY_SCOPE_AGENT); }
        else if (k == 1) continue;
        else if (k == 2) {
            const bool bgrp = LOCAL_BAR && MISC[13] == 1u && F.G == 256;
            butterfly_phase(F, ws, bgrp ? (cid & 7) : -1, l);
            asm volatile("s_waitcnt vmcnt(0)" ::: "memory"); __syncthreads();
            if (F.wave == 0 && lane_id() == 0) {
                if (bgrp) __hip_atomic_fetch_add((unsigned*)(ws + WS_CTL) + CW_BFG + 64 * (8 * l + (cid & 7)), 1u, __ATOMIC_RELAXED, __HIP_MEMORY_SCOPE_AGENT);
                else { __builtin_amdgcn_fence(__ATOMIC_RELEASE, "agent"); asm volatile("s_waitcnt vmcnt(0)" ::: "memory");
                    __hip_atomic_fetch_add((unsigned*)(ws + WS_CTL) + CW_BFCNT + 64 * l, 1u, __ATOMIC_RELAXED, __HIP_MEMORY_SCOPE_AGENT); } }
            attn_phase(F, A, ws, l, (char*)lds);
        }
#pragma unroll 1
        for (int ci = 0; ci < 2; ++ci) {
            enum { T_NONE = 0, T_IN = 1, T_DFT = 2, T_RESN = 3, T_RESL = 4, T_GU = 5 };
            const bool stag9 = STAG9 && LOCAL_BAR && MISC[13] == 1u && F.G == 256 && l == NLAYER - 1;
            const bool ecd = ECD && LOCAL_BAR && MISC[13] == 1u && F.G == 256 && NLAYER == 2;
            int type = T_NONE, nMa = 0, nNa = 0, pmB = 0, nMb = 0, pnB = 0, nNb = 0, Gs = F.G, cs = cid, rot = 0, K = DM, el = l, nshort = 0, ishort = 0; bool ctxdown = false; int sigw = -1, waitw = -1;
#if SCHED_OLD
            const int nM = l == 0 ? 72 : 64;
            if (ci == 0) {
                if (k == 0) { type = T_IN; if (l == 0) { nMa = 72; nNa = 10; } else { nMa = 64; nNa = 10; pmB = 64; nMb = 8; pnB = 2; nNb = 4; } }
                else if (k == 2) { type = T_DFT; nMa = 1; nNa = l == 0 ? 144 : 128; rot = F.G - 64; K = 512; }
                else if (k == 3) { type = T_RESN; nMa = nM; nNa = 4; }
                else if (k == 4) { type = T_GU; nMa = nM; nNa = 22; }
                else if (k == 5) { type = l == NLAYER - 1 ? T_RESL : T_RESN; nMa = nM; nNa = 4; K = FFD; }
            }
#else
            if (k == 0) {
                if (l == 0) { if (ci == 0) { type = T_IN; nMa = 64; nNa = 10; pmB = 64; nMb = 8; pnB = 0; nNb = 10; } }
                else if (ci == 0) { type = T_RESN; pmB = 64; nMb = 8; pnB = 0; nNb = 4; K = FFD; el = 0; ctxdown = true; sigw = CW_CTXCNT; if (ecd) waitw = CW_GUC; }
                else if (cid >= 32) { type = T_IN; nMa = 64; nNa = 10; Gs = F.G - 32; cs = cid - 32; }
                else if (l == NLAYER - 1) { type = T_IN; pmB = 64; nMb = 8; pnB = 2; nNb = 4; waitw = CW_CTXCNT; }
            }
            else if (k == 2) { if (ci == 0) { type = T_DFT; nMa = 1; nNa = 128; if (l == 0) { pmB = 0; nMb = 1; pnB = 128; nNb = 16; } rot = F.G - 64; K = 512; } }
            else if (k == 3) { if (ci == 0) { type = T_RESN; nMa = 64; nNa = 4; } }
            else if (k == 4) { if (l == 0 && ci == 0) { type = T_RESN; pmB = 64; nMb = 8; pnB = 0; nNb = 4; }
                               else if (ci == (l == 0 ? 1 : 0)) { type = T_GU; nMa = 64; nNa = 22; if (l == 0) { nshort = 32; ishort = 4; } else if (stag9) { nshort = 256; ishort = 5; } }
                               else if (stag9 && ci == 1 && cid < 128) { type = T_GU; pmB = 8 * (cid & 7) + 6 + ((cid >> 3) & 1); nMb = 1; pnB = 14 + (cid >> 4); nNb = 1; Gs = 1; cs = 0; } }
            else if (k == 5) { const int cdn = (l == 0) ? 1 : 0;
                               if (ci == cdn) { type = l == NLAYER - 1 ? T_RESL : T_RESN; nMa = 64; nNa = 4; K = FFD; if (stag9) rot = 128; } else if (l == 0 && ci == 0) { type = T_GU; pmB = 64; nMb = 8; pnB = 0; nNb = 22; if (ecd) rot = 224; } }
#endif
            if (type == T_NONE) continue;
            if (type == T_DFT && l == 0 && F.G == 256) {
                const int c2 = (cid + rot) % F.G; nMb = 0;
                if (c2 >= 128 && c2 < 144) { nMa = 0; nNa = 0; pmB = 0; nMb = 1; pnB = 128 + 2 * (c2 & 7) + ((c2 - 128) >> 3); nNb = 1; Gs = 1; cs = 0; rot = 0; } }
            pg8::Sched2 S; S.init(nMa, nNa, pmB, nMb, pnB, nNb, Gs, cs, rot); S.ns = nshort; S.is = ishort;
            if (waitw >= 0) {
                pg8::Unit u0; if (!S.next(0, u0)) continue;
                if (F.wave == 0) { unsigned* cw = (unsigned*)(ws + WS_CTL) + waitw + 64 * (cid & 7); unsigned sp = 0;
                    while (__hip_atomic_load(cw, __ATOMIC_RELAXED, __HIP_MEMORY_SCOPE_AGENT) < (waitw == CW_GUC ? 22u : 4u)) { __builtin_amdgcn_s_sleep(8); if (++sp > (1u << 22)) break; }
                    if (k == 0 && l == 1 && ci == 1 && cid < 32 && ECD && LOCAL_BAR && MISC[13] == 1u && F.G == 256) {
                        unsigned* cw0 = (unsigned*)(ws + WS_CTL) + CW_LBAR; const unsigned tg = MISC[12] * 32u;
                        while (xb_ld(cw0 + 64 * (cid & 7)) < tg) { __builtin_amdgcn_s_sleep(1); if (++sp > (1u << 22)) break; }
                        for (int g2 = 0; g2 < 8; ++g2) while (xb_ld(cw0 + 64 * g2) < 6u * 32u) { __builtin_amdgcn_s_sleep(1); if (++sp > (1u << 22)) break; } }
                    __builtin_amdgcn_fence(__ATOMIC_ACQUIRE, "agent"); asm volatile("s_waitcnt vmcnt(0)" ::: "memory"); }
                __syncthreads();
            }
            if (type == T_IN) {
                const float* bias_ = (const float*)(ws + WS_BIN) + l * 9 * NIN; const float* qg_ = A.in[9] + l * 64; const float* kg_ = A.in[10] + l * 64;
                auto pre = [&]() __attribute__((always_inline)) {
                    int t_ = F.wave * 64 + lane_id(); asm volatile("" : "+v"(t_)); LAS float* et = (LAS float*)(F.lds + ETAB_OFF);
                    for (int i = t_; i < 3072 + 128; i += NWAVES * 64) et[i] = i < 3072 ? ((const float*)(ws + WS_ROPE))[i] : (i < 3136 ? qg_[i - 3072] : kg_[i - 3136]);
                    compute_rtab<false>(F, ws, S, bias_, NIN); };
                pg8::Gemm g{(const pg8::bf16_t*)(ws + WS_A), (const pg8::bf16_t*)(ws + WS_WIN) + (size_t)l * NIN * DM, M_ALL, NIN, DM};
                pg8::EpiIn E{ws, rtab};
                pg8::gemm_phase<pg8::EpiIn, pg8::Sched2, true, true>(F.lds, g, S, E, F.wave, pre);
            } else if (type == T_DFT) {
                {
                    if (F.wave == 0) { const bool bgrp = LOCAL_BAR && MISC[13] == 1u && F.G == 256; unsigned* cw = (unsigned*)(ws + WS_CTL) + (bgrp ? CW_BFG + 64 * (8 * l + (cid & 7)) : CW_BFCNT + 64 * l); const unsigned need = bgrp ? (unsigned)(F.G >> 3) : (unsigned)F.G; unsigned sp = 0;
                        while (__hip_atomic_load(cw, __ATOMIC_RELAXED, __HIP_MEMORY_SCOPE_AGENT) < need) { __builtin_amdgcn_s_sleep(8); if (++sp > (1u << 22)) break; }
                        __builtin_amdgcn_fence(__ATOMIC_ACQUIRE, "agent"); asm volatile("s_waitcnt vmcnt(0)" ::: "memory"); }
                    __syncthreads();
                }
                pg8::Gemm g{(const pg8::bf16_t*)(ws + WS_DFT), (const pg8::bf16_t*)(ws + WS_T), 256, 36864, 512};
                pg8::EpiDft E{(pg8::bf16_t*)(ws + WS_MIX)};
                pg8::gemm_phase<pg8::EpiDft, pg8::Sched2, true, true>(F.lds, g, S, E, F.wave);
            } else if (type == T_GU) {
                const float* bias_ = (const float*)(ws + WS_BGU) + l * 9 * NGU;
                auto pre = [&]() __attribute__((always_inline)) { compute_rtab<false>(F, ws, S, bias_, NGU); };
                pg8::Gemm g{(const pg8::bf16_t*)(ws + WS_A), (const pg8::bf16_t*)(ws + WS_WGU) + (size_t)l * NGU * DM, M_ALL, NGU, DM};
                pg8::EpiGU E{ws, rtab};
                pg8::gemm_phase<pg8::EpiGU, pg8::Sched2, true, true>(F.lds, g, S, E, F.wave, pre);
                if (k == 5 && l == 0 && ECD && LOCAL_BAR && MISC[13] == 1u && F.G == 256 && NLAYER == 2) { pg8::Unit u0; if (S.next(0, u0)) { asm volatile("s_waitcnt vmcnt(0)" ::: "memory"); __syncthreads();
                    if (F.wave == 0 && lane_id() == 0) (void)xb_add((unsigned*)(ws + WS_CTL) + CW_GUC + 64 * (cid & 7), 1u); } }
                if (k == 4 && ci == 0 && l == NLAYER - 1 && STAG9 && LOCAL_BAR && MISC[13] == 1u && F.G == 256) { asm volatile("s_waitcnt vmcnt(0)" ::: "memory"); __syncthreads();
                    if (F.wave == 0 && lane_id() == 0) (void)xb_add((unsigned*)(ws + WS_CTL) + CW_C3CNT + 64 * (cid & 7), 1u); }
            } else if (type == T_RESN) {
                const bool down = K == FFD;
                const pg8::bf16_t* Ap = down ? (ctxdown ? (const pg8::bf16_t*)(ws + WS_HC) - (size_t)M_LAT * FFD : (const pg8::bf16_t*)(ws + WS_H)) : (const pg8::bf16_t*)(ws + WS_MIX);
                const pg8::bf16_t* Bp = down ? (const pg8::bf16_t*)(ws + WS_WDN) + (size_t)el * DM * FFD : (const pg8::bf16_t*)(ws + WS_WOUT) + (size_t)el * DM * DM;
                pg8::Gemm g{Ap, Bp, M_ALL, DM, K};
                void* xl_out = (!down && el == NLAYER - 1) ? (void*)(ws + WS_XB2) : (void*)A.out;
                pg8::EpiRes<true> E{(const void*)A.out, xl_out, ws, el * 9 * 6144 + (down ? 5120 : 2048), down ? A.in[6] + (el + 1) * DM : A.in[7] + el * DM, down ? (el + 1) * 9 * 6144 + 1024 : el * 9 * 6144 + 4096};
                pg8::gemm_phase<pg8::EpiRes<true>, pg8::Sched2, true, true>(F.lds, g, S, E, F.wave);
                if (sigw >= 0) {
                    pg8::Unit u0; if (S.next(0, u0)) {
                    asm volatile("s_waitcnt vmcnt(0)" ::: "memory"); __syncthreads();
                    if (F.wave == 0 && lane_id() == 0) { if (!(LOCAL_BAR && MISC[13] == 1u)) { __builtin_amdgcn_fence(__ATOMIC_RELEASE, "agent"); asm volatile("s_waitcnt vmcnt(0)" ::: "memory"); }
                        __hip_atomic_fetch_add((unsigned*)(ws + WS_CTL) + sigw + 64 * (cid & 7), 1u, __ATOMIC_RELAXED, __HIP_MEMORY_SCOPE_AGENT); } }
                }
            } else {
                pg8::Gemm g{(const pg8::bf16_t*)(ws + WS_H), (const pg8::bf16_t*)(ws + WS_WDN) + (size_t)l * DM * FFD, M_ALL, DM, FFD};
                pg8::EpiRes<false> E{(const void*)(ws + WS_XB2), (void*)A.out, ws, l * 9 * 6144 + 5120, nullptr, 0};
                pg8::gemm_phase<pg8::EpiRes<false>, pg8::Sched2, true, true>(F.lds, g, S, E, F.wave);
            }
        }
        if (DEFER_WDN && ph == 2 && F.G == 256 && cid >= 208) {
            deferred_wdn(F, A, ws, cid - 208, 48, 0);
            asm volatile("s_waitcnt vmcnt(0)" ::: "memory"); __syncthreads();
            if (F.wave == 0 && lane_id() == 0) (void)xb_add((unsigned*)(ws + WS_CTL) + CW_DT, 1u); }
        if (DEFER_WDN && ph == 6 && F.G == 256 && (cid < 32 || cid >= 192)) {
            deferred_wdn(F, A, ws, cid < 32 ? cid : cid - 160, 96, 1);
            asm volatile("s_waitcnt vmcnt(0)" ::: "memory"); __syncthreads();
            if (F.wave == 0 && lane_id() == 0) (void)xb_add((unsigned*)(ws + WS_CTL) + CW_DT + 64, 1u); }
        if (ph + 1 < hi && LOCAL_BAR && MISC[13] == 1u && lo == 0 && ph >= 1) {
            const int v = cid & 7; unsigned wmask = 0u, wgen = 0u;
            if (k == 3) { wmask = 0xFFu; wgen = l == 0 ? 2u : 7u; }
            else if (k == 5) { wmask = 0xFFu; wgen = 5u; }
            else if (k == 2 && l == NLAYER - 1) { wmask = 0xFFu; wgen = 6u; }
            else if (k == 4 && l == NLAYER - 1 && v < 4) { wmask = 3u << (2 * v); wgen = 8u; }
            if (STAG9 && k == 4 && l == NLAYER - 1 && F0.G == 256) {
                asm volatile("s_waitcnt vmcnt(0)" ::: "memory"); __syncthreads();
                if ((F0.wave == 0) && (lane_id() == 0)) { unsigned* ctl = (unsigned*)(args.ws + WS_CTL); unsigned sp = 0u;
                    if (cid < 128) { (void)xb_add(ctl + CW_C3CNT + 512 + 64 * v, 1u); while (xb_ld(ctl + CW_C3CNT + 512 + 64 * v) < 16u) { __builtin_amdgcn_s_sleep(1); if (++sp > XB_SPIN_CAP * 16u) break; } }
                    while (xb_ld(ctl + CW_C3CNT + 64 * v) < 32u) { __builtin_amdgcn_s_sleep(1); if (++sp > XB_SPIN_CAP * 16u) break; }
                    for (int g2 = 0; g2 < 8; ++g2) if ((wmask >> g2) & 1u) { while (xb_ld(ctl + CW_LBAR + 64 * g2) < (wgen + 1u) * 32u) { __builtin_amdgcn_s_sleep(1); if (++sp > XB_SPIN_CAP * 16u) break; } }
                    __builtin_amdgcn_fence(__ATOMIC_ACQUIRE, "agent"); asm volatile("s_waitcnt vmcnt(0)" ::: "memory"); }
                __syncthreads();
            } else if (ECD && k == 5 && l == 0 && cid < 32 && F0.G == 256 && NLAYER == 2)
                group_arrive((unsigned*)(args.ws + WS_CTL) + CW_LBAR, v, (F0.wave == 0) && (lane_id() == 0), MISC + 12);
            else
            group_barrier((unsigned*)(args.ws + WS_CTL) + CW_LBAR, v, (unsigned)(F0.G >> 3), (F0.wave == 0) && (lane_id() == 0), MISC + 12, wmask, wgen);
        }
        else if (ph + 1 < hi) { XcdBarrier bar; bar.bar = (unsigned*)(args.ws + WS_CTL) + CW_BAR; bar.x = xb_xcc_id(); bar.st = MISC + 8; bar.t0 = (F0.wave == 0) && (lane_id() == 0); xcd_barrier(bar); }
    }
#if PROBE_S
    if (blockIdx.x == 0 && F0.wave == 0) { const unsigned long long t0 = __builtin_amdgcn_s_memrealtime(); const unsigned long long dl = 5ull * (MISC[40 + ((PROBE_S) & 255)] - MISC[40 + ((PROBE_S) >> 8)]);
        while (__builtin_amdgcn_s_memrealtime() - t0 < dl) __builtin_amdgcn_s_sleep(32); }
#endif
#if PROBE_A
    if (blockIdx.x == 0 && F0.wave == 0) { const unsigned long long t0 = __builtin_amdgcn_s_memrealtime(); MISC[16 + N_PHASES] = (unsigned)t0; unsigned long long dl = 0;
        for (int p = 0; p < N_PHASES; ++p) if ((PROBE_A >> p) & 1) dl += 5ull * (MISC[17 + p] - MISC[16 + p]);
        while (__builtin_amdgcn_s_memrealtime() - t0 < dl) __builtin_amdgcn_s_sleep(32); }
#endif
}
static_assert(EWS_MOD == WS_MOD && EWS_BIN == WS_BIN && EWS_BGU == WS_BGU && EWS_ROPE == WS_ROPE && EWS_SSQ == WS_SSQ && EWS_A == WS_A && EWS_XC == WS_XC && EWS_QB == WS_QB && EWS_KB == WS_KB && EWS_VB == WS_VB && EWS_TC == WS_TC && EWS_T == WS_T && EWS_H == WS_H && EWS_HC == WS_HC, "epilogue offsets vs d_ws map");
#ifndef MK_PER_PHASE
#define MK_PER_PHASE 0
#endif
extern "C" void kernel_launch(void* const* d_in, const int* in_sizes, int n_in, void* d_out, int out_size, void* d_ws, size_t ws_size, hipStream_t stream) {
    static int grid = 0;
    if (grid == 0) {
        if (n_in != 21 || in_sizes[0] != M_LAT * DM || out_size != M_LAT * DM || ws_size < WS_END) { fprintf(stderr, "kernel_launch: unexpected shapes (n_in %d, in0 %d, out %d, ws %zu)\n", n_in, n_in > 0 ? in_sizes[0] : -1, out_size, ws_size); grid = -1; return; }
        int dev = 0, cus = 0, per_cu = 0;
        if (hipGetDevice(&dev) != hipSuccess || hipDeviceGetAttribute(&cus, hipDeviceAttributeMultiprocessorCount, dev) != hipSuccess) { grid = -1; return; }
        if (hipFuncSetAttribute((const void*)fwd_kernel, hipFuncAttributeMaxDynamicSharedMemorySize, LDS_BYTES) != hipSuccess) { fprintf(stderr, "kernel_launch: hipFuncSetAttribute failed\n"); grid = -1; return; }
        if (hipOccupancyMaxActiveBlocksPerMultiprocessor(&per_cu, (const void*)fwd_kernel, NWAVES * 64, LDS_BYTES) != hipSuccess || per_cu < 1) { fprintf(stderr, "kernel_launch: occupancy query reports %d\n", per_cu); }
        (void)hipGetLastError();
        grid = cus;
    }
    if (grid < 0) return;
    (void)hipMemsetAsync((char*)d_ws + WS_CTL, 0, CTL_ZERO_BYTES, stream);
    Args a{};
    for (int i = 0; i < 21; ++i) a.in[i] = (const float*)d_in[i];
    a.out = (float*)d_out; a.ws = (unsigned char*)d_ws;
#if MK_PER_PHASE
#ifndef REP_MASK
#define REP_MASK 0
#endif
    for (int ph = 0; ph < N_PHASES; ++ph) { a.ph_lo = ph; a.ph_hi = ph + 1; for (int rep = 0; rep < (((REP_MASK) >> ph) & 1) + 1; ++rep) hipLaunchKernelGGL(fwd_kernel, dim3(grid), dim3(NWAVES * 64), LDS_BYTES, stream, a); }
#else
    a.ph_lo = 0; a.ph_hi = N_PHASES; hipLaunchKernelGGL(fwd_kernel, dim3(grid), dim3(NWAVES * 64), LDS_BYTES, stream, a);
#endif
    const hipError_t le = hipPeekAtLastError();
    if (le != hipSuccess) fprintf(stderr, "kernel_launch: launch failed: %s\n", hipGetErrorName(le));
}
```
